# Optimizing an MI355X kernel written in HIP

```python
import jax
import jax.numpy as jnp
from jax import lax
import numpy as np

D_MODEL = 1024
BATCH = 8
SEQ = 4096
DEPTH = 2

GRID_W = 64
CTX_LEN = 256
N_ATTN_LAYERS = (DEPTH + 1) // 2
N_RWKV_LAYERS = DEPTH // 2
NORM_EPS = 1e-6
ROPE_THETA = 10000.0
Q_BLOCK = 128
NEG_INF = -1e30
N_MODS = 6

MLA_HEADS = 4
MLA_Q_RANK = 384
MLA_KV_RANK = 256
MLA_NOPE = 128
MLA_ROPE = 64
MLA_V = 128

SWA_HEADS = 8
SWA_KV_HEADS = 2
SWA_GROUP = SWA_HEADS // SWA_KV_HEADS
SWA_HEAD_DIM = 64
WINDOW = 128

IN_SPLITS = (MLA_Q_RANK,
             MLA_Q_RANK + MLA_KV_RANK,
             MLA_Q_RANK + MLA_KV_RANK + MLA_ROPE,
             MLA_Q_RANK + MLA_KV_RANK + MLA_ROPE + SWA_HEADS * SWA_HEAD_DIM,
             MLA_Q_RANK + MLA_KV_RANK + MLA_ROPE + (SWA_HEADS + SWA_KV_HEADS) * SWA_HEAD_DIM)
IN_WIDTH = MLA_Q_RANK + MLA_KV_RANK + MLA_ROPE + (SWA_HEADS + 2 * SWA_KV_HEADS) * SWA_HEAD_DIM
MIX_WIDTH = MLA_HEADS * MLA_V + SWA_HEADS * SWA_HEAD_DIM

RWKV_HEAD = 64
RWKV_HEADS = D_MODEL // RWKV_HEAD
DECAY_LORA = 64
ICLR_LORA = 64
GATE_LORA = 128
GN_EPS = 64e-5

N_EXPERTS = 64
TOP_K = 6
N_GROUPS = 8
TOPK_GROUPS = 4
D_EXPERT = 256
D_SHARED = 256
ROUTED_SCALE = 2.5
EXPERT_CHUNK = 8

kernel_name = 'hybrid_mla_swa_rwkv7_moe_prefix_dit'


def rms_norm(x, g):
    xf = x.astype(jnp.float32)
    y = xf * lax.rsqrt(jnp.mean(xf * xf, axis=-1, keepdims=True) + NORM_EPS)
    return (y * g.astype(jnp.float32)).astype(x.dtype)


def modulate(n, shift, scale):
    return n * (1.0 + scale) + shift


def axial_rope_tables(n_lat, n_ctx, dim):
    rows = n_lat // GRID_W
    nf = dim // 4
    inv = ROPE_THETA ** (-jnp.arange(nf, dtype=jnp.float32) / nf)
    row = jnp.repeat(jnp.arange(rows, dtype=jnp.float32), GRID_W)
    col = jnp.tile(jnp.arange(GRID_W, dtype=jnp.float32), rows)
    ar = row[:, None] * inv
    ac = col[:, None] * inv
    ang = jnp.concatenate([ar, ar, ac, ac], axis=-1)
    cos = jnp.concatenate([jnp.ones((n_ctx, dim), jnp.float32), jnp.cos(ang)], axis=0)
    sin = jnp.concatenate([jnp.zeros((n_ctx, dim), jnp.float32), jnp.sin(ang)], axis=0)
    return cos, sin


def rotate_half_axial(x):
    lead = x.shape[:-1]
    d = x.shape[-1]
    xr = x.reshape(*lead, 2, 2, d // 4)
    rot = jnp.stack([-xr[..., 1, :], xr[..., 0, :]], axis=-2)
    return rot.reshape(*lead, d)


def apply_rope(x, cos, sin):
    cos = cos.astype(x.dtype)[:, None, :]
    sin = sin.astype(x.dtype)[:, None, :]
    return x * cos + rotate_half_axial(x) * sin


def softmax_attend(q, k, v, scale):
    s = jnp.einsum('bqhd,bkhd->bhqk', q, k).astype(jnp.float32) * scale
    p = jax.nn.softmax(s, axis=-1).astype(v.dtype)
    return jnp.einsum('bhqk,bkhd->bqhd', p, v)


def dense_attend_blocks(q_lat, k_all, v_all, scale):
    B, S = q_lat.shape[:2]
    nb = S // Q_BLOCK
    qb = jnp.moveaxis(q_lat.reshape(B, nb, Q_BLOCK, *q_lat.shape[2:]), 1, 0)
    out = lax.map(lambda qj: softmax_attend(qj, k_all, v_all, scale), qb)
    return jnp.moveaxis(out, 0, 1).reshape(B, S, *out.shape[3:])


def sink_softmax(s, sink):
    sk = sink.astype(jnp.float32)[None, :, :, None, None]
    m = jnp.maximum(jnp.max(s, axis=-1, keepdims=True), sk)
    p = jnp.exp(s - m)
    return p / (jnp.sum(p, axis=-1, keepdims=True) + jnp.exp(sk - m))


def ctx_sink_attend(q, k, v, sink, scale):
    s = jnp.einsum('bqhgd,bkhd->bhgqk', q, k).astype(jnp.float32) * scale
    p = sink_softmax(s, sink).astype(v.dtype)
    return jnp.einsum('bhgqk,bkhd->bqhgd', p, v)


def window_sink_attend(q_lat, k_ctx, v_ctx, k_lat, v_lat, sink, scale):
    B, S = q_lat.shape[:2]
    nb = S // Q_BLOCK
    band = Q_BLOCK + 2 * WINDOW
    pad = ((0, 0), (WINDOW, WINDOW), (0, 0), (0, 0))
    kp = jnp.pad(k_lat, pad)
    vp = jnp.pad(v_lat, pad)
    qb = jnp.moveaxis(q_lat.reshape(B, nb, Q_BLOCK, *q_lat.shape[2:]), 1, 0)

    def block(args):
        j, qj = args
        start = j * Q_BLOCK
        kb = lax.dynamic_slice_in_dim(kp, start, band, axis=1)
        vb = lax.dynamic_slice_in_dim(vp, start, band, axis=1)
        qpos = start + jnp.arange(Q_BLOCK)
        kpos = start - WINDOW + jnp.arange(band)
        valid = (jnp.abs(qpos[:, None] - kpos[None, :]) <= WINDOW) & (kpos >= 0)[None, :] & (kpos < S)[None, :]
        s_band = jnp.einsum('bqhgd,bkhd->bhgqk', qj, kb).astype(jnp.float32) * scale
        s_band = jnp.where(valid, s_band, NEG_INF)
        s_ctx = jnp.einsum('bqhgd,bkhd->bhgqk', qj, k_ctx).astype(jnp.float32) * scale
        p = sink_softmax(jnp.concatenate([s_ctx, s_band], axis=-1), sink).astype(v_lat.dtype)
        return jnp.einsum('bhgqk,bkhd->bqhgd', p, jnp.concatenate([v_ctx, vb], axis=1))

    out = lax.map(block, (jnp.arange(nb), qb))
    return jnp.moveaxis(out, 0, 1).reshape(B, S, *q_lat.shape[2:])


def attn_mixer(n_ctx, n_lat, rope_mla, rope_swa, w_in, q_norm, kv_norm, w_uq, w_ukv, sinks, w_o, with_ctx):
    B, Lc, _ = n_ctx.shape
    S = n_lat.shape[1]
    L = Lc + S
    u = jnp.concatenate([n_ctx, n_lat], axis=1) @ w_in
    cq, ckv, kr, qs, ks, vs = jnp.split(u, IN_SPLITS, axis=-1)
    cos, sin = rope_mla
    q = (rms_norm(cq, q_norm) @ w_uq).reshape(B, L, MLA_HEADS, MLA_NOPE + MLA_ROPE)
    kv = (rms_norm(ckv, kv_norm) @ w_ukv).reshape(B, L, MLA_HEADS, MLA_NOPE + MLA_V)
    q = jnp.concatenate([q[..., :MLA_NOPE], apply_rope(q[..., MLA_NOPE:], cos, sin)], axis=-1)
    k_rope = apply_rope(kr[:, :, None, :], cos, sin)
    k = jnp.concatenate([kv[..., :MLA_NOPE], jnp.broadcast_to(k_rope, (B, L, MLA_HEADS, MLA_ROPE))], axis=-1)
    v = kv[..., MLA_NOPE:]
    scale_a = (MLA_NOPE + MLA_ROPE) ** -0.5
    a_lat = dense_attend_blocks(q[:, Lc:], k, v, scale_a)
    cos, sin = rope_swa
    qs = apply_rope(qs.reshape(B, L, SWA_HEADS, SWA_HEAD_DIM), cos, sin)
    qs = qs.reshape(B, L, SWA_KV_HEADS, SWA_GROUP, SWA_HEAD_DIM)
    ks = apply_rope(ks.reshape(B, L, SWA_KV_HEADS, SWA_HEAD_DIM), cos, sin)
    vs = vs.reshape(B, L, SWA_KV_HEADS, SWA_HEAD_DIM)
    sink = sinks.reshape(SWA_KV_HEADS, SWA_GROUP)
    scale_b = SWA_HEAD_DIM ** -0.5
    b_lat = window_sink_attend(qs[:, Lc:], ks[:, :Lc], vs[:, :Lc], ks[:, Lc:], vs[:, Lc:], sink, scale_b)
    o_lat = jnp.concatenate([a_lat.reshape(B, S, -1), b_lat.reshape(B, S, -1)], axis=-1) @ w_o
    o_ctx = None
    if with_ctx:
        a_ctx = softmax_attend(q[:, :Lc], k[:, :Lc], v[:, :Lc], scale_a)
        b_ctx = ctx_sink_attend(qs[:, :Lc], ks[:, :Lc], vs[:, :Lc], sink, scale_b)
        o_ctx = jnp.concatenate([a_ctx.reshape(B, Lc, -1), b_ctx.reshape(B, Lc, -1)], axis=-1) @ w_o
    return o_ctx, o_lat


def token_shift_bi(x):
    half = x.shape[-1] // 2
    prev = jnp.pad(x[:, :-1, :half], ((0, 0), (1, 0), (0, 0)))
    nxt = jnp.pad(x[:, 1:, half:], ((0, 0), (0, 1), (0, 0)))
    return jnp.concatenate([prev, nxt], axis=-1)


def rwkv_features(n, mu, w_r, w_k, w_v, g1, g2):
    xx = token_shift_bi(n) - n
    xr, xw, xk, xv, xa, xg = [n + xx * mu[i] for i in range(6)]
    r = xr @ w_r
    k = xk @ w_k
    v = xv @ w_v
    g = jax.nn.sigmoid(xg @ g1) @ g2
    return r, k, v, g, xw, xa


def wkv7_scan(state0, r, decay, k, v, kk, a, reverse):
    def step(S, inp):
        r_t, w_t, k_t, v_t, kk_t, a_t = inp
        sa = jnp.einsum('bhvk,bhk->bhv', S, kk_t)
        S = S * w_t[:, :, None, :] - sa[..., None] * (kk_t * a_t)[:, :, None, :] + v_t[..., None] * k_t[:, :, None, :]
        return S, jnp.einsum('bhvk,bhk->bhv', S, r_t)

    xs = tuple(jnp.moveaxis(t, 1, 0) for t in (r, decay, k, v, kk, a))
    S, ys = lax.scan(step, state0, xs, reverse=reverse)
    return S, jnp.moveaxis(ys, 0, 1)


def wkv_direction(state0, feats, w0, w1, w2, a0, a1, a2, k_k, k_a, r_k, reverse):
    r, k, v, _, xw, xa = feats
    B, T, _ = k.shape

    def heads(t):
        return t.astype(jnp.float32).reshape(B, T, RWKV_HEADS, RWKV_HEAD)

    w_log = -jax.nn.softplus(-(w0 + jnp.tanh(xw @ w1) @ w2).astype(jnp.float32)) - 0.5
    decay = jnp.exp(-jnp.exp(w_log))
    a = jax.nn.sigmoid((a0 + (xa @ a1) @ a2).astype(jnp.float32))
    kk = heads(k * k_k)
    kk = kk / jnp.maximum(jnp.sqrt(jnp.sum(kk * kk, axis=-1, keepdims=True)), 1e-12)
    k_mod = k.astype(jnp.float32) * (1.0 + (a - 1.0) * k_a.astype(jnp.float32))
    r_h, k_h, v_h, a_h = heads(r), heads(k_mod), heads(v), heads(a)
    state, y = wkv7_scan(state0, r_h, heads(decay), k_h, v_h, kk, a_h, reverse)
    bonus = jnp.sum(r_h * k_h * r_k.astype(jnp.float32), axis=-1, keepdims=True) * v_h
    return state, y, bonus


def rwkv_readout(y, bonus, g, ln_w, ln_b, w_o, dtype):
    B, T = y.shape[:2]
    mu = jnp.mean(y, axis=-1, keepdims=True)
    var = jnp.mean(jnp.square(y - mu), axis=-1, keepdims=True)
    yn = ((y - mu) * lax.rsqrt(var + GN_EPS)).reshape(B, T, D_MODEL)
    yn = yn * ln_w.astype(jnp.float32) + ln_b.astype(jnp.float32)
    out = (yn + bonus.reshape(B, T, D_MODEL)) * g.astype(jnp.float32)
    return out.astype(dtype) @ w_o


def rwkv_mixer(n_ctx, n_lat, mu, w_r, w_k, w_v, w_o, g1, g2, w0, w1, w2, a0, a1, a2, k_k, k_a, r_k,
               ln_w, ln_b, with_ctx):
    B = n_ctx.shape[0]
    feats_c = rwkv_features(n_ctx, mu, w_r, w_k, w_v, g1, g2)
    feats_l = rwkv_features(n_lat, mu, w_r, w_k, w_v, g1, g2)
    y_c = b_c = y_l = b_l = 0.0
    for d, reverse in ((0, False), (1, True)):
        dparams = (w0[d], w1[d], w2[d], a0[d], a1[d], a2[d], k_k, k_a, r_k)
        state0 = jnp.zeros((B, RWKV_HEADS, RWKV_HEAD, RWKV_HEAD), jnp.float32)
        s_ctx, yc, bc = wkv_direction(state0, feats_c, *dparams, reverse)
        _, yl, bl = wkv_direction(s_ctx, feats_l, *dparams, reverse)
        y_l = y_l + yl
        b_l = b_l + bl
        y_c = y_c + yc
        b_c = b_c + bc
    o_lat = rwkv_readout(y_l, b_l, feats_l[3], ln_w, ln_b, w_o, n_lat.dtype)
    o_ctx = rwkv_readout(y_c, b_c, feats_c[3], ln_w, ln_b, w_o, n_ctx.dtype) if with_ctx else None
    return o_ctx, o_lat


def moe_ffn(h, w_router, e_bias, w_gate, w_up, w_down, ws_gate, ws_up, ws_down):
    B, L, D = h.shape
    t = h.reshape(B * L, D)
    scores = jax.nn.sigmoid((t @ w_router).astype(jnp.float32))
    choice = scores + e_bias.astype(jnp.float32)
    grp = choice.reshape(-1, N_GROUPS, N_EXPERTS // N_GROUPS)
    grp_score = jnp.sum(lax.top_k(grp, 2)[0], axis=-1)
    gidx = lax.top_k(grp_score, TOPK_GROUPS)[1]
    gmask = jnp.max(jax.nn.one_hot(gidx, N_GROUPS, dtype=jnp.float32), axis=1) > 0
    emask = jnp.repeat(gmask, N_EXPERTS // N_GROUPS, axis=1)
    eidx = lax.top_k(jnp.where(emask, choice, -jnp.inf), TOP_K)[1]
    wsel = jnp.take_along_axis(scores, eidx, axis=1)
    wsel = ROUTED_SCALE * wsel / jnp.sum(wsel, axis=-1, keepdims=True)
    gates = jnp.einsum('tk,tke->te', wsel, jax.nn.one_hot(eidx, N_EXPERTS, dtype=jnp.float32)).astype(t.dtype)
    out = (jax.nn.silu(t @ ws_gate) * (t @ ws_up)) @ ws_down
    for e0 in range(0, N_EXPERTS, EXPERT_CHUNK):
        sl = slice(e0, e0 + EXPERT_CHUNK)
        hg = jnp.einsum('td,edf->tef', t, w_gate[sl])
        hu = jnp.einsum('td,edf->tef', t, w_up[sl])
        act = jax.nn.silu(hg) * hu * gates[:, sl, None]
        out = out + jnp.einsum('tef,efd->td', act, w_down[sl])
    return out.reshape(B, L, D)


def setup_inputs(seed: int = 0) -> dict:
    key = jax.random.key(seed)
    keys = iter(jax.random.split(key, 64))

    def nrm(shape, scale):
        return jax.random.normal(next(keys), shape, jnp.float32) * scale

    def gain(shape):
        return 1.0 + nrm(shape, 0.02)

    def unif(shape, lo, hi):
        return jax.random.uniform(next(keys), shape, jnp.float32, lo, hi)

    D, NA, NR = D_MODEL, N_ATTN_LAYERS, N_RWKV_LAYERS
    return {
        'x': nrm((BATCH, SEQ, D), 1.0),
        'c': nrm((BATCH, D), 1.0),
        'ctx': nrm((BATCH, CTX_LEN, D), 1.0),
        'c_ctx': nrm((D,), 1.0),
        'ada_w': nrm((DEPTH, D, N_MODS * D), 0.5 * D ** -0.5),
        'ada_b': nrm((DEPTH, N_MODS * D), 0.01),
        'norm_mix': gain((DEPTH, D)),
        'norm_ffn': gain((DEPTH, D)),
        'norm_final': gain((D,)),
        'attn_w_in': nrm((NA, D, IN_WIDTH), D ** -0.5),
        'attn_q_norm': gain((NA, MLA_Q_RANK)),
        'attn_kv_norm': gain((NA, MLA_KV_RANK)),
        'attn_w_uq': nrm((NA, MLA_Q_RANK, MLA_HEADS * (MLA_NOPE + MLA_ROPE)), MLA_Q_RANK ** -0.5),
        'attn_w_ukv': nrm((NA, MLA_KV_RANK, MLA_HEADS * (MLA_NOPE + MLA_V)), MLA_KV_RANK ** -0.5),
        'attn_sinks': nrm((NA, SWA_HEADS), 1.0),
        'attn_w_o': nrm((NA, MIX_WIDTH, D), MIX_WIDTH ** -0.5),
        'rwkv_mu': unif((NR, 6, D), 0.0, 1.0),
        'rwkv_w_r': nrm((NR, D, D), D ** -0.5),
        'rwkv_w_k': nrm((NR, D, D), D ** -0.5),
        'rwkv_w_v': nrm((NR, D, D), D ** -0.5),
        'rwkv_w_o': nrm((NR, D, D), D ** -0.5),
        'rwkv_g1': nrm((NR, D, GATE_LORA), D ** -0.5),
        'rwkv_g2': nrm((NR, GATE_LORA, D), GATE_LORA ** -0.5),
        'rwkv_w0': unif((NR, 2, D), -4.0, 1.0),
        'rwkv_w1': nrm((NR, 2, D, DECAY_LORA), D ** -0.5),
        'rwkv_w2': nrm((NR, 2, DECAY_LORA, D), DECAY_LORA ** -0.5),
        'rwkv_a0': nrm((NR, 2, D), 0.5),
        'rwkv_a1': nrm((NR, 2, D, ICLR_LORA), D ** -0.5),
        'rwkv_a2': nrm((NR, 2, ICLR_LORA, D), ICLR_LORA ** -0.5),
        'rwkv_k_k': 0.85 + nrm((NR, D), 0.05),
        'rwkv_k_a': 1.0 + nrm((NR, D), 0.05),
        'rwkv_r_k': nrm((NR, RWKV_HEADS, RWKV_HEAD), 0.1),
        'rwkv_ln_w': gain((NR, D)),
        'rwkv_ln_b': nrm((NR, D), 0.01),
        'moe_router': nrm((DEPTH, D, N_EXPERTS), D ** -0.5),
        'moe_bias': nrm((DEPTH, N_EXPERTS), 0.01),
        'moe_w_gate': nrm((DEPTH, N_EXPERTS, D, D_EXPERT), D ** -0.5),
        'moe_w_up': nrm((DEPTH, N_EXPERTS, D, D_EXPERT), D ** -0.5),
        'moe_w_down': nrm((DEPTH, N_EXPERTS, D_EXPERT, D), D_EXPERT ** -0.5),
        'moe_ws_gate': nrm((DEPTH, D, D_SHARED), D ** -0.5),
        'moe_ws_up': nrm((DEPTH, D, D_SHARED), D ** -0.5),
        'moe_ws_down': nrm((DEPTH, D_SHARED, D), D_SHARED ** -0.5),
    }


def reference(x, c, ctx, c_ctx, ada_w, ada_b, norm_mix, norm_ffn, norm_final,
              attn_w_in, attn_q_norm, attn_kv_norm, attn_w_uq, attn_w_ukv, attn_sinks, attn_w_o,
              rwkv_mu, rwkv_w_r, rwkv_w_k, rwkv_w_v, rwkv_w_o, rwkv_g1, rwkv_g2,
              rwkv_w0, rwkv_w1, rwkv_w2, rwkv_a0, rwkv_a1, rwkv_a2, rwkv_k_k, rwkv_k_a, rwkv_r_k,
              rwkv_ln_w, rwkv_ln_b,
              moe_router, moe_bias, moe_w_gate, moe_w_up, moe_w_down,
              moe_ws_gate, moe_ws_up, moe_ws_down):
    S = x.shape[1]
    Lc = ctx.shape[1]
    rope_mla = axial_rope_tables(S, Lc, MLA_ROPE)
    rope_swa = axial_rope_tables(S, Lc, SWA_HEAD_DIM)
    h_ctx = ctx
    for l in range(DEPTH):
        with_ctx = l < DEPTH - 1
        i = l // 2
        mods = jnp.split((jax.nn.silu(c) @ ada_w[l] + ada_b[l])[:, None, :], N_MODS, axis=-1)
        cmods = jnp.split(jax.nn.silu(c_ctx) @ ada_w[l] + ada_b[l], N_MODS, axis=-1)
        n_lat = modulate(rms_norm(x, norm_mix[l]), mods[0], mods[1])
        n_ctx = modulate(rms_norm(h_ctx, norm_mix[l]), cmods[0], cmods[1])
        if l % 2 == 0:
            o_ctx, o_lat = attn_mixer(n_ctx, n_lat, rope_mla, rope_swa, attn_w_in[i], attn_q_norm[i],
                                      attn_kv_norm[i], attn_w_uq[i], attn_w_ukv[i], attn_sinks[i],
                                      attn_w_o[i], with_ctx)
        else:
            o_ctx, o_lat = rwkv_mixer(n_ctx, n_lat, rwkv_mu[i], rwkv_w_r[i], rwkv_w_k[i], rwkv_w_v[i],
                                      rwkv_w_o[i], rwkv_g1[i], rwkv_g2[i], rwkv_w0[i], rwkv_w1[i],
                                      rwkv_w2[i], rwkv_a0[i], rwkv_a1[i], rwkv_a2[i], rwkv_k_k[i],
                                      rwkv_k_a[i], rwkv_r_k[i], rwkv_ln_w[i], rwkv_ln_b[i], with_ctx)
        x = x + mods[2] * o_lat
        moe_args = (moe_router[l], moe_bias[l], moe_w_gate[l], moe_w_up[l], moe_w_down[l],
                    moe_ws_gate[l], moe_ws_up[l], moe_ws_down[l])
        n_lat = modulate(rms_norm(x, norm_ffn[l]), mods[3], mods[4])
        if with_ctx:
            h_ctx = h_ctx + cmods[2] * o_ctx
            n_ctx = modulate(rms_norm(h_ctx, norm_ffn[l]), cmods[3], cmods[4])
            f = moe_ffn(jnp.concatenate([n_ctx, n_lat], axis=1), *moe_args)
            h_ctx = h_ctx + cmods[5] * f[:, :Lc]
            x = x + mods[5] * f[:, Lc:]
        else:
            x = x + mods[5] * moe_ffn(n_lat, *moe_args)
    return rms_norm(x, norm_final)
```

```cpp
#include <hip/hip_runtime.h>
#include <stdint.h>
#include <stdio.h>

#ifndef MEGA
#define MEGA 1
#endif

typedef unsigned short u16;
typedef short bf16x8 __attribute__((ext_vector_type(8)));
typedef short s16x4 __attribute__((ext_vector_type(4)));
typedef float f32x16 __attribute__((ext_vector_type(16)));
typedef float f32x4 __attribute__((ext_vector_type(4)));
typedef float f32x2 __attribute__((ext_vector_type(2)));
typedef unsigned u32x4 __attribute__((ext_vector_type(4)));
typedef __bf16 bf2 __attribute__((ext_vector_type(2)));
#define DEVI __device__ __forceinline__
#define LAS __attribute__((address_space(3)))

constexpr int NB = 8, SEQ = 4096, LC = 256, LT = 4352, DM = 1024, T0 = NB * LT, TL = NB * SEQ;
constexpr int NCHUNK = 4;
constexpr float LOG2E = 1.4426950408889634f;
constexpr float QA_SCALE = 0.07216878364870322f * LOG2E;
constexpr float QS_SCALE = 0.125f * LOG2E;

enum { I_X = 0, I_C, I_CTX, I_CCTX, I_ADAW, I_ADAB, I_NMIX, I_NFFN, I_NFIN, I_AWIN, I_AQN, I_AKVN, I_AWUQ, I_AWUKV, I_ASINK, I_AWO,
       I_RMU, I_RWR, I_RWK, I_RWV, I_RWO, I_RG1, I_RG2, I_RW0, I_RW1, I_RW2, I_RA0, I_RA1, I_RA2, I_RKK, I_RKA, I_RRK, I_RLNW, I_RLNB,
       I_MROUT, I_MBIAS, I_MWG, I_MWU, I_MWD, I_MSG, I_MSU, I_MSD, N_IN };

struct Params { const float* in[N_IN]; float* out; char* ws; };

constexpr size_t OFF_BAR = 0, OFF_CNT = 16384, OFF_ROPE = 20480, OFF_MODS = 32768, OFF_WSTAT = 524288;
constexpr size_t W_IN = OFF_WSTAT, W_UQ = W_IN + 3145728, W_UK = W_UQ + 589824, W_UV = W_UK + 262144, W_OA = W_UV + 262144,
                 W_RR = W_OA + 2097152, W_RK = W_RR + 2097152, W_RV = W_RK + 2097152, W_RO = W_RV + 2097152,
                 W_G1 = W_RO + 2097152, W_W1 = W_G1 + 262144, W_A1 = W_W1 + 262144, W_G2 = W_A1 + 262144, W_W2 = W_G2 + 262144, W_A2 = W_W2 + 262144,
                 W_SGU = W_A2 + 262144, W_SD = W_SGU + 2 * 1048576, W_END = W_SD + 2 * 524288;
constexpr size_t OFF_XC = OFF_WSTAT + 20971520;
constexpr size_t OFF_TOKE = OFF_XC + 8388608, OFF_TOKR = OFF_TOKE + 835584, OFF_LTOK = OFF_TOKR + 835584, OFF_LG = OFF_LTOK + 8912896;
constexpr size_t OFF_D = OFF_XC + 8388608 + 20971520;
constexpr size_t WGU_BYTES = 64ull * 512 * 1024 * 2, WD_BYTES = 64ull * 1024 * 256 * 2;
constexpr size_t OFF_WGU = OFF_D, OFF_WD = OFF_D + WGU_BYTES;
constexpr size_t OFF_G = OFF_D + WGU_BYTES + WD_BYTES;
constexpr size_t SZ_T0D = (size_t)T0 * 1024 * 2;
constexpr size_t A_N0 = OFF_G, A_CQ = A_N0 + SZ_T0D, A_CKV = A_CQ + (size_t)T0 * 384 * 2, A_QA = A_CKV + (size_t)T0 * 256 * 2, A_KA = A_QA + (size_t)T0 * 768 * 2,
                 A_VA = A_KA + (size_t)T0 * 768 * 2, A_QS = A_VA + (size_t)T0 * 512 * 2, A_KS = A_QS + (size_t)T0 * 512 * 2, A_VS = A_KS + (size_t)T0 * 128 * 2, A_END = A_VS + (size_t)T0 * 128 * 2;
constexpr size_t M_N1 = OFF_G, M_ACT = M_N1 + SZ_T0D, M_OUTR = M_ACT + (size_t)7 * T0 * 256 * 2, M_END = M_OUTR + (size_t)7 * 8704 * 1024 * 2;
constexpr size_t R_XM0 = OFF_D, R_XM1 = R_XM0 + SZ_T0D, R_XM2 = R_XM1 + SZ_T0D, R_RR = R_XM2 + SZ_T0D, R_RK = R_RR + SZ_T0D, R_RV = R_RK + SZ_T0D, R_NN = R_RV + SZ_T0D,
                 R_HG = R_NN + SZ_T0D, R_HW = R_HG + (size_t)T0 * 128 * 2, R_HA = R_HW + (size_t)T0 * 128 * 2, R_RKB = R_HA + (size_t)T0 * 128 * 2, R_END = R_RKB + (size_t)2 * T0 * 16 * 4;
constexpr size_t R_GG = R_XM0, R_YF = R_XM1, R_YB = R_XM2, R_RD = R_NN;
constexpr size_t WS_NEED = R_END;

constexpr int LDS_BYTES = 64 + 131072;

DEVI unsigned pack2(float a, float b) { f32x2 v = {a, b}; bf2 r = __builtin_convertvector(v, bf2); return __builtin_bit_cast(unsigned, r); }
DEVI float bf_lo(unsigned u) { return __builtin_bit_cast(float, u << 16); }
DEVI float bf_hi(unsigned u) { return __builtin_bit_cast(float, u & 0xffff0000u); }
DEVI float bf1(u16 u) { return __builtin_bit_cast(float, ((unsigned)u) << 16); }
DEVI float dppf(float x, const int ctrl_sel) {
    int xi = __builtin_bit_cast(int, x), y;
    if (ctrl_sel == 0) y = __builtin_amdgcn_mov_dpp(xi, 0xB1, 0xF, 0xF, true);
    else if (ctrl_sel == 1) y = __builtin_amdgcn_mov_dpp(xi, 0x4E, 0xF, 0xF, true);
    else y = __builtin_amdgcn_mov_dpp(xi, 0x141, 0xF, 0xF, true);
    return __builtin_bit_cast(float, y);
}
DEVI float red8_sum(float x) { x += dppf(x, 0); x += dppf(x, 1); x += dppf(x, 2); return x; }
DEVI float red8_max(float x) { x = fmaxf(x, dppf(x, 0)); x = fmaxf(x, dppf(x, 1)); x = fmaxf(x, dppf(x, 2)); return x; }
DEVI float red4_sum(float x) { x += dppf(x, 0); x += dppf(x, 1); return x; }
DEVI float wave_sum(float x) { for (int o = 32; o > 0; o >>= 1) x += __shfl_xor(x, o); return x; }
DEVI float wave_max(float x) { for (int o = 32; o > 0; o >>= 1) x = fmaxf(x, __shfl_xor(x, o)); return x; }
DEVI float sigmoidf_(float x) { return 1.f / (1.f + __expf(-x)); }
DEVI float siluf_(float x) { return x / (1.f + __expf(-x)); }
DEVI float tanhf_(float x) { float e = __expf(2.f * x); return 1.f - 2.f / (e + 1.f); }

#define XB_TMO      128
#define XB_XCNT(j)  (256  + 64 * (j))
#define XB_XSUB(j)  (1280 + 64 * (j))
#define XB_XGEN(j)  (2304 + 64 * (j))
#define XB_TOP      3328
#define XB_TOPGEN   3392
#define XCD_BAR_WORDS 3456
#define XB_SPIN_CAP (1u << 20)
DEVI unsigned xb_ld(unsigned* p)              { return __hip_atomic_load(p, __ATOMIC_RELAXED, __HIP_MEMORY_SCOPE_AGENT); }
DEVI unsigned xb_add(unsigned* p, unsigned v) { return __hip_atomic_fetch_add(p, v, __ATOMIC_RELAXED, __HIP_MEMORY_SCOPE_AGENT); }
DEVI unsigned xb_xcc_id() { return (unsigned)__builtin_amdgcn_s_getreg((3 << 11) | 20) & 0xFu; }
#define XB_SPIN(cond, bar) do { unsigned _sp = 0; while (cond) { __builtin_amdgcn_s_sleep(1); \
    if ((++_sp & 255u) == 0u) { if (xb_ld(&(bar)[XB_TMO])) break; if (_sp > XB_SPIN_CAP) { atomicAdd(&(bar)[XB_TMO], 1u); break; } } } } while (0)
struct XcdBarrier { unsigned* bar; unsigned x; volatile LAS unsigned* st; };
DEVI XcdBarrier xcd_barrier_post(unsigned* bar, volatile LAS unsigned* st) {
    XcdBarrier b; b.bar = bar; b.x = xb_xcc_id(); b.st = st;
    if (threadIdx.x == 0) (void)xb_add(&bar[XB_XCNT(b.x)], 1u);
    return b;
}
DEVI void xcd_barrier_complete(unsigned* bar, unsigned x, unsigned& nloc, unsigned& nx) {
    const unsigned G = gridDim.x * gridDim.y * gridDim.z;
    unsigned sum, cnt, mine, sp = 0u;
    for (;;) {
        sum = 0u; cnt = 0u; mine = 0u;
#pragma unroll
        for (unsigned j = 0; j < 16; ++j) { const unsigned c = xb_ld(&bar[XB_XCNT(j)]); sum += c; cnt += (c > 0u) ? 1u : 0u; mine = (j == x) ? c : mine; }
        if (sum == G) break;
        __builtin_amdgcn_s_sleep(1);
        if ((++sp & 255u) == 0u) { if (xb_ld(&bar[XB_TMO])) break; if (sp > XB_SPIN_CAP) { atomicAdd(&bar[XB_TMO], 1u); break; } }
    }
    nloc = mine > 0u ? mine : 1u; nx = cnt > 0u ? cnt : 1u;
}
DEVI void xcd_barrier(const XcdBarrier& b) {
    asm volatile("s_waitcnt vmcnt(0)" ::: "memory");
    __syncthreads();
    if (threadIdx.x == 0) {
        unsigned* bar = b.bar;
        __builtin_amdgcn_s_waitcnt(0);
        unsigned nloc = b.st[0], nx = b.st[1];
        if (nloc == 0u) { xcd_barrier_complete(bar, b.x, nloc, nx); b.st[0] = nloc; b.st[1] = nx; }
        const unsigned old = xb_add(&bar[XB_XSUB(b.x)], 1u);
        const unsigned gen = old / nloc;
        if (old + 1u == (gen + 1u) * nloc) {
            __builtin_amdgcn_fence(__ATOMIC_RELEASE, "agent");
            asm volatile("s_waitcnt vmcnt(0)" ::: "memory");
            const unsigned og = xb_add(&bar[XB_TOP], 1u);
            const unsigned tg = og / nx;
            if (og + 1u == (tg + 1u) * nx) xb_add(&bar[XB_TOPGEN], 1u);
            else XB_SPIN(xb_ld(&bar[XB_TOPGEN]) == tg, bar);
            __builtin_amdgcn_fence(__ATOMIC_ACQUIRE, "agent");
            xb_add(&bar[XB_XGEN(b.x)], 1u);
            asm volatile("s_waitcnt vmcnt(0)" ::: "memory");
        } else {
            XB_SPIN(xb_ld(&bar[XB_XGEN(b.x)]) == gen, bar);
            __builtin_amdgcn_fence(__ATOMIC_ACQUIRE, "agent");
            asm volatile("s_waitcnt vmcnt(0)" ::: "memory");
        }
    }
    __syncthreads();
}

struct RowSrc { const float* ctx; const float* lat; };
DEVI const float* row_ptr(const RowSrc& s, int mode, int r, int& bb) {
    if (mode == 0) { int b = r / LT, pp = r - b * LT; if (pp < LC) { bb = 8; return s.ctx + (size_t)(b * LC + pp) * DM; } bb = b; return s.lat + (size_t)(b * SEQ + pp - LC) * DM; }
    bb = r >> 12; return s.lat + (size_t)r * DM;
}
DEVI float* row_ptr_w(float* ctx, float* lat, int mode, int r, int& bb) {
    if (mode == 0) { int b = r / LT, pp = r - b * LT; if (pp < LC) { bb = 8; return ctx + (size_t)(b * LC + pp) * DM; } bb = b; return lat + (size_t)(b * SEQ + pp - LC) * DM; }
    bb = r >> 12; return lat + (size_t)r * DM;
}

DEVI float sumsq8(const bf16x8& v) {
    float s = 0.f;
    const unsigned* u = (const unsigned*)&v;
#pragma unroll
    for (int i = 0; i < 4; ++i) { bf2 b = __builtin_bit_cast(bf2, u[i]); s = __builtin_amdgcn_fdot2_f32_bf16(b, b, s, false); }
    return s;
}
template <int BM, int BN, bool ROWNORM, class ARow, class Epi>
DEVI void gemm_tile(ARow arow, const u16* __restrict__ Bt, int ldb, int K, Epi epi, char* lds) {
    constexpr int WN = BN / 64, NA = BM / 64, NBC = BN / 64, STR = 72;
    const int tid = threadIdx.x, lane = tid & 63, w = tid >> 6, wm = w / WN, wn = w % WN, l31 = lane & 31, h = lane >> 5;
    u16* sA = (u16*)lds; u16* sB = sA + 2 * BM * STR;
    const int crow = tid >> 3, kc = tid & 7;
    const u16* pa[NA]; const u16* pb[NBC];
#pragma unroll
    for (int i = 0; i < NA; ++i) pa[i] = arow(crow + 64 * i) + kc * 8;
#pragma unroll
    for (int i = 0; i < NBC; ++i) pb[i] = Bt + (size_t)(crow + 64 * i) * ldb + kc * 8;
    u32x4 ra[NA], rb[NBC];
#pragma unroll
    for (int i = 0; i < NA; ++i) ra[i] = *(const u32x4*)pa[i];
#pragma unroll
    for (int i = 0; i < NBC; ++i) rb[i] = *(const u32x4*)pb[i];
    f32x16 acc[2][2];
#pragma unroll
    for (int a = 0; a < 2; ++a)
#pragma unroll
        for (int b = 0; b < 2; ++b)
#pragma unroll
            for (int i = 0; i < 16; ++i) acc[a][b][i] = 0.f;
    float ss[2] = {0.f, 0.f};
    const int nk = K >> 6;
    for (int kt = 0; kt < nk; ++kt) {
        u16* a_ = sA + (kt & 1) * BM * STR; u16* b_ = sB + (kt & 1) * BN * STR;
#pragma unroll
        for (int i = 0; i < NA; ++i) *(u32x4*)(a_ + (crow + 64 * i) * STR + kc * 8) = ra[i];
#pragma unroll
        for (int i = 0; i < NBC; ++i) *(u32x4*)(b_ + (crow + 64 * i) * STR + kc * 8) = rb[i];
        __syncthreads();
        {
            const int kn = (kt + 1 < nk) ? kt + 1 : kt;
#pragma unroll
            for (int i = 0; i < NA; ++i) ra[i] = *(const u32x4*)(pa[i] + kn * 64);
#pragma unroll
            for (int i = 0; i < NBC; ++i) rb[i] = *(const u32x4*)(pb[i] + kn * 64);
        }
#pragma unroll
        for (int ks = 0; ks < 4; ++ks) {
            bf16x8 af[2], bfr[2];
#pragma unroll
            for (int mi = 0; mi < 2; ++mi) af[mi] = *(const bf16x8*)(a_ + (wm * 64 + mi * 32 + l31) * STR + ks * 16 + h * 8);
#pragma unroll
            for (int ni = 0; ni < 2; ++ni) bfr[ni] = *(const bf16x8*)(b_ + (wn * 64 + ni * 32 + l31) * STR + ks * 16 + h * 8);
            if (ROWNORM) { ss[0] += sumsq8(af[0]); ss[1] += sumsq8(af[1]); }
#pragma unroll
            for (int mi = 0; mi < 2; ++mi)
#pragma unroll
                for (int ni = 0; ni < 2; ++ni) acc[mi][ni] = __builtin_amdgcn_mfma_f32_32x32x16_bf16(bfr[ni], af[mi], acc[mi][ni], 0, 0, 0);
        }
    }
    if (ROWNORM) {
#pragma unroll
        for (int mi = 0; mi < 2; ++mi) {
            float s = ss[mi] + __shfl_xor(ss[mi], 32);
            float r = rsqrtf(s / (float)K + 1e-6f);
#pragma unroll
            for (int ni = 0; ni < 2; ++ni)
#pragma unroll
                for (int i = 0; i < 16; ++i) acc[mi][ni][i] *= r;
        }
    }
#pragma unroll
    for (int mi = 0; mi < 2; ++mi) epi(wm * 64 + mi * 32 + l31, wn * 64, acc[mi], h);
    __syncthreads();
}
DEVI void store_tile_bf16(u16* dst, const f32x16& t, int h) {
#pragma unroll
    for (int g = 0; g < 4; ++g) { uint2 v; v.x = pack2(t[4 * g], t[4 * g + 1]); v.y = pack2(t[4 * g + 2], t[4 * g + 3]); *(uint2*)(dst + 8 * g + 4 * h) = v; }
}
DEVI void rope_tile(f32x16& t, int axis, int pp, int h, const float2* __restrict__ tab) {
    if (pp < LC) return;
    const int s = pp - LC; const int coord = axis ? (s & 63) : (s >> 6);
#pragma unroll
    for (int g = 0; g < 2; ++g)
#pragma unroll
        for (int i = 0; i < 4; ++i) {
            const float2 cs = tab[coord * 16 + 8 * g + 4 * h + i];
            const float x1 = t[4 * g + i], x2 = t[4 * (g + 2) + i];
            t[4 * g + i] = x1 * cs.x - x2 * cs.y; t[4 * (g + 2) + i] = x2 * cs.x + x1 * cs.y;
        }
}

struct CJob { const float* src; u16* dst; const float* gain; int K, ldsrc, nlog, nvalid, sseg, sstride, soff, dseg, dstride, doff; int nmat; size_t smat, dmat; };
DEVI void get_job(const Params& p, int j, int layer, CJob& J) {
    char* ws = p.ws;
    J.gain = nullptr; J.nmat = 1; J.smat = 0; J.dmat = 0; J.sseg = 1 << 30; J.sstride = 0; J.soff = 0; J.dseg = 1 << 30; J.dstride = 0; J.doff = 0;
    auto plain = [&](const float* src, size_t dstoff, int K, int N) { J.src = src; J.dst = (u16*)(ws + dstoff); J.K = K; J.ldsrc = N; J.nlog = N; J.nvalid = N; };
    switch (j) {
    case 0: plain(p.in[I_AWIN], W_IN, 1024, 1472); J.nlog = 1536; break;
    case 1: plain(p.in[I_AWUQ], W_UQ, 384, 768); J.gain = p.in[I_AQN]; break;
    case 2: plain(p.in[I_AWUKV], W_UK, 256, 1024); J.nlog = 512; J.nvalid = 512; J.sseg = 128; J.sstride = 256; J.soff = 0; J.gain = p.in[I_AKVN]; break;
    case 3: plain(p.in[I_AWUKV], W_UV, 256, 1024); J.nlog = 512; J.nvalid = 512; J.sseg = 128; J.sstride = 256; J.soff = 128; J.gain = p.in[I_AKVN]; break;
    case 4: plain(p.in[I_AWO], W_OA, 1024, 1024); break;
    case 5: plain(p.in[I_RWR], W_RR, 1024, 1024); break;
    case 6: plain(p.in[I_RWK], W_RK, 1024, 1024); break;
    case 7: plain(p.in[I_RWV], W_RV, 1024, 1024); break;
    case 8: plain(p.in[I_RWO], W_RO, 1024, 1024); break;
    case 9: plain(p.in[I_RG1], W_G1, 1024, 128); break;
    case 10: plain(p.in[I_RW1], W_W1, 1024, 64); break;
    case 11: plain(p.in[I_RW1] + 1024 * 64, W_W1 + 64 * 1024 * 2, 1024, 64); break;
    case 12: plain(p.in[I_RA1], W_A1, 1024, 64); break;
    case 13: plain(p.in[I_RA1] + 1024 * 64, W_A1 + 64 * 1024 * 2, 1024, 64); break;
    case 14: plain(p.in[I_RG2], W_G2, 128, 1024); break;
    case 15: plain(p.in[I_RW2], W_W2, 64, 1024); break;
    case 16: plain(p.in[I_RW2] + 64 * 1024, W_W2 + 1024 * 64 * 2, 64, 1024); break;
    case 17: plain(p.in[I_RA2], W_A2, 64, 1024); break;
    case 18: plain(p.in[I_RA2] + 64 * 1024, W_A2 + 1024 * 64 * 2, 64, 1024); break;
    case 19: plain(p.in[I_MSG], W_SGU, 1024, 256); J.dseg = 32; J.dstride = 64; J.doff = 0; break;
    case 20: plain(p.in[I_MSU], W_SGU, 1024, 256); J.dseg = 32; J.dstride = 64; J.doff = 32; break;
    case 21: plain(p.in[I_MSG] + 1024 * 256, W_SGU + 1048576, 1024, 256); J.dseg = 32; J.dstride = 64; J.doff = 0; break;
    case 22: plain(p.in[I_MSU] + 1024 * 256, W_SGU + 1048576, 1024, 256); J.dseg = 32; J.dstride = 64; J.doff = 32; break;
    case 23: plain(p.in[I_MSD], W_SD, 256, 1024); break;
    case 24: plain(p.in[I_MSD] + 256 * 1024, W_SD + 524288, 256, 1024); break;
    case 25: plain(p.in[I_MWG] + (size_t)layer * 64 * 1024 * 256, OFF_WGU, 1024, 256); J.dseg = 32; J.dstride = 64; J.doff = 0; J.nmat = 64; J.smat = 1024 * 256; J.dmat = 512 * 1024; break;
    case 26: plain(p.in[I_MWU] + (size_t)layer * 64 * 1024 * 256, OFF_WGU, 1024, 256); J.dseg = 32; J.dstride = 64; J.doff = 32; J.nmat = 64; J.smat = 1024 * 256; J.dmat = 512 * 1024; break;
    default: plain(p.in[I_MWD] + (size_t)layer * 64 * 256 * 1024, OFF_WD, 256, 1024); J.nmat = 64; J.smat = 256 * 1024; J.dmat = 1024 * 256; break;
    }
}
DEVI int job_tiles(const CJob& J) { return J.nmat * (J.nlog / 64) * ((J.K + 127) / 128); }
DEVI void conv_tile(const CJob& J, int t, char* lds) {
    const int ktiles = (J.K + 127) / 128, ntiles = J.nlog / 64;
    const int mat = t / (ktiles * ntiles); const int r = t - mat * ktiles * ntiles; const int nt = r / ktiles, ktile = r - nt * ktiles;
    const float* src = J.src + (size_t)mat * J.smat; u16* dst = J.dst + (size_t)mat * J.dmat;
    unsigned* sm = (unsigned*)lds;
    const int tid = threadIdx.x, ng = tid & 15, kp = tid >> 4;
    const int n0 = nt * 64 + ng * 4;
    const int scol = (n0 / J.sseg) * J.sstride + J.soff + (n0 % J.sseg);
    const bool nval = n0 < J.nvalid;
#pragma unroll
    for (int pass = 0; pass < 2; ++pass) {
        const int k = ktile * 128 + pass * 64 + kp * 2;
        float4 v0 = make_float4(0.f, 0.f, 0.f, 0.f), v1 = v0;
        if (nval && k < J.K) {
            v0 = *(const float4*)(src + (size_t)k * J.ldsrc + scol); v1 = *(const float4*)(src + (size_t)(k + 1) * J.ldsrc + scol);
            if (J.gain) { const float g0 = J.gain[k], g1 = J.gain[k + 1]; v0.x *= g0; v0.y *= g0; v0.z *= g0; v0.w *= g0; v1.x *= g1; v1.y *= g1; v1.z *= g1; v1.w *= g1; }
        }
        const int kk = pass * 32 + kp;
        sm[(ng * 4 + 0) * 66 + kk] = pack2(v0.x, v1.x); sm[(ng * 4 + 1) * 66 + kk] = pack2(v0.y, v1.y);
        sm[(ng * 4 + 2) * 66 + kk] = pack2(v0.z, v1.z); sm[(ng * 4 + 3) * 66 + kk] = pack2(v0.w, v1.w);
    }
    __syncthreads();
#pragma unroll
    for (int i = 0; i < 2; ++i) {
        const int c = tid + 512 * i, row = c >> 4, ch = c & 15;
        const int n = nt * 64 + row; const int drow = (n / J.dseg) * J.dstride + J.doff + (n % J.dseg);
        const int k = ktile * 128 + ch * 8;
        if (k < J.K) { uint2 lo = *(const uint2*)(sm + row * 66 + ch * 4), hi = *(const uint2*)(sm + row * 66 + ch * 4 + 2); uint4 v = make_uint4(lo.x, lo.y, hi.x, hi.y); *(uint4*)(dst + (size_t)drow * J.K + k) = v; }
    }
    __syncthreads();
}
DEVI void conv_jobs(const Params& p, int jlo, int jhi, int layer, int u0, int nunits_before, char* lds) {
    int total = 0;
    for (int j = jlo; j < jhi; ++j) { CJob J; get_job(p, j, layer, J); total += job_tiles(J); }
    for (int u = u0; u < nunits_before + total; u += gridDim.x) {
        if (u < nunits_before) continue;
        int t = u - nunits_before; int j = jlo; CJob J;
        for (;; ++j) { get_job(p, j, layer, J); const int n = job_tiles(J); if (t < n) break; t -= n; }
        conv_tile(J, t, lds);
    }
}
DEVI void mods_unit(const Params& p, int u, char* lds) {
    const int l = u / 96, cg = u % 96;
    float* sil = (float*)lds;
    float* red = sil + 1024 * 12;
    const int tid = threadIdx.x, lane = tid & 63, w = tid >> 6;
    for (int i = tid; i < 9 * 1024; i += 512) { const int bb = i >> 10, k = i & 1023; const float v = bb < 8 ? p.in[I_C][bb * 1024 + k] : p.in[I_CCTX][k]; sil[k * 12 + bb] = siluf_(v); }
    __syncthreads();
    float acc[9];
#pragma unroll
    for (int i = 0; i < 9; ++i) acc[i] = 0.f;
    const float* wp = p.in[I_ADAW] + (size_t)l * 1024 * 6144 + cg * 64 + lane;
#pragma unroll 4
    for (int kk = 0; kk < 128; ++kk) {
        const int k = w * 128 + kk; const float wv = wp[(size_t)k * 6144];
        const float4 s0 = *(const float4*)(sil + k * 12), s1 = *(const float4*)(sil + k * 12 + 4); const float s2 = sil[k * 12 + 8];
        acc[0] += s0.x * wv; acc[1] += s0.y * wv; acc[2] += s0.z * wv; acc[3] += s0.w * wv; acc[4] += s1.x * wv; acc[5] += s1.y * wv; acc[6] += s1.z * wv; acc[7] += s1.w * wv; acc[8] += s2 * wv;
    }
#pragma unroll
    for (int i = 0; i < 9; ++i) red[(w * 9 + i) * 64 + lane] = acc[i];
    __syncthreads();
    for (int i = tid; i < 9 * 64; i += 512) {
        const int bb = i >> 6, c = i & 63; float s = 0.f;
        for (int ww = 0; ww < 8; ++ww) s += red[(ww * 9 + bb) * 64 + c];
        const int col = cg * 64 + c;
        ((float*)(p.ws + OFF_MODS))[(size_t)(l * 9 + bb) * 6144 + col] = s + p.in[I_ADAB][l * 6144 + col];
    }
    __syncthreads();
}
DEVI void phase_prologue(const Params& p, char* lds) {
    const int bid = blockIdx.x, G = gridDim.x;
    if (bid == G - 1) {
        int* cnt = (int*)(p.ws + OFF_CNT);
        for (int i = threadIdx.x; i < 2 * NCHUNK * 64; i += 512) cnt[i] = 0;
        float2* tab = (float2*)(p.ws + OFF_ROPE);
        for (int i = threadIdx.x; i < 64 * 16; i += 512) { const int coord = i >> 4, f = i & 15; const float inv = exp2f(-(float)f * (13.287712379549449f / 16.f)); const float a = (float)coord * inv; tab[i] = make_float2(cosf(a), sinf(a)); }
    }
    for (int u = bid; u < 192; u += G) mods_unit(p, u, lds);
    const int u0 = bid + ((192 - bid + G - 1) / G) * G;
    conv_jobs(p, 0, 28, 0, u0, 192, lds);
}

DEVI void norm_rows(const RowSrc& src, int mode, int nrows, const float* __restrict__ gain, const float* __restrict__ mods_l, int ishift, int iscale, u16* __restrict__ dst) {
    const int lane = threadIdx.x & 63, w = threadIdx.x >> 6;
    for (int r = blockIdx.x * 8 + w; r < nrows; r += gridDim.x * 8) {
        int bb; const float* xr = row_ptr(src, mode, r, bb);
        float4 v[4]; float ss = 0.f;
#pragma unroll
        for (int i = 0; i < 4; ++i) { v[i] = ((const float4*)xr)[lane + 64 * i]; ss += v[i].x * v[i].x + v[i].y * v[i].y + v[i].z * v[i].z + v[i].w * v[i].w; }
        ss = wave_sum(ss);
        const float rs = rsqrtf(ss * (1.f / 1024.f) + 1e-6f);
        const float* msh = mods_l + (size_t)bb * 6144 + ishift * 1024; const float* msc = mods_l + (size_t)bb * 6144 + iscale * 1024;
#pragma unroll
        for (int i = 0; i < 4; ++i) {
            const int c = (lane + 64 * i) * 4;
            const float4 g = *(const float4*)(gain + c), sh = *(const float4*)(msh + c), sc = *(const float4*)(msc + c);
            uint2 o; o.x = pack2(v[i].x * rs * g.x * (1.f + sc.x) + sh.x, v[i].y * rs * g.y * (1.f + sc.y) + sh.y);
            o.y = pack2(v[i].z * rs * g.z * (1.f + sc.z) + sh.z, v[i].w * rs * g.w * (1.f + sc.w) + sh.w);
            *(uint2*)(dst + (size_t)r * DM + c) = o;
        }
    }
}

DEVI void phase_gemm_win(const Params& p, char* lds) {
    const u16* A = (const u16*)(p.ws + A_N0); const u16* W = (const u16*)(p.ws + W_IN);
    u16* CQ = (u16*)(p.ws + A_CQ); u16* CKV = (u16*)(p.ws + A_CKV); u16* KA = (u16*)(p.ws + A_KA); u16* QS = (u16*)(p.ws + A_QS); u16* KS = (u16*)(p.ws + A_KS); u16* VS = (u16*)(p.ws + A_VS);
    const float2* tab = (const float2*)(p.ws + OFF_ROPE);
    const int NT = 12, MT = T0 / 256;
    for (int u = blockIdx.x; u < NT * MT; u += gridDim.x) {
        const int mt = u / NT, nt = u % NT; const int m0 = mt * 256, n0 = nt * 128;
        auto arow = [&](int r) { return A + (size_t)(m0 + r) * DM; };
        auto epi = [&](int r, int cw, f32x16 (&t)[2], int h) {
            const int row = m0 + r; const int b = row / LT, pp = row - b * LT;
#pragma unroll
            for (int ni = 0; ni < 2; ++ni) {
                const int c32 = n0 + cw + ni * 32;
                if (c32 < 384) store_tile_bf16(CQ + (size_t)row * 384 + c32, t[ni], h);
                else if (c32 < 640) store_tile_bf16(CKV + (size_t)row * 256 + (c32 - 384), t[ni], h);
                else if (c32 < 704) { const int cc = c32 - 640; rope_tile(t[ni], cc >> 5, pp, h, tab);
                    for (int hd = 0; hd < 4; ++hd) store_tile_bf16(KA + ((size_t)(b * 4 + hd) * LT + pp) * 192 + 128 + cc, t[ni], h); }
                else if (c32 < 1216) { const int cc = c32 - 704; rope_tile(t[ni], (cc >> 5) & 1, pp, h, tab);
#pragma unroll
                    for (int i = 0; i < 16; ++i) t[ni][i] *= QS_SCALE;
                    store_tile_bf16(QS + ((size_t)(b * 8 + (cc >> 6)) * LT + pp) * 64 + (cc & 63), t[ni], h); }
                else if (c32 < 1344) { const int cc = c32 - 1216; rope_tile(t[ni], (cc >> 5) & 1, pp, h, tab);
                    store_tile_bf16(KS + ((size_t)(b * 2 + (cc >> 6)) * LT + pp) * 64 + (cc & 63), t[ni], h); }
                else if (c32 < 1472) { const int cc = c32 - 1344; store_tile_bf16(VS + ((size_t)(b * 2 + (cc >> 6)) * LT + pp) * 64 + (cc & 63), t[ni], h); }
            }
        };
        gemm_tile<256, 128, false>(arow, W + (size_t)n0 * DM, DM, DM, epi, lds);
    }
}
DEVI void phase_gemm_qkv(const Params& p, char* lds) {
    const u16* CQ = (const u16*)(p.ws + A_CQ); const u16* CKV = (const u16*)(p.ws + A_CKV);
    u16* QA = (u16*)(p.ws + A_QA); u16* KA = (u16*)(p.ws + A_KA); u16* VA = (u16*)(p.ws + A_VA);
    const float2* tab = (const float2*)(p.ws + OFF_ROPE);
    const int MT = T0 / 256;
    for (int u = blockIdx.x; u < 14 * MT; u += gridDim.x) {
        const int mt = u / 14, j = u % 14; const int m0 = mt * 256;
        if (j < 6) {
            const int n0 = j * 128;
            auto arow = [&](int r) { return CQ + (size_t)(m0 + r) * 384; };
            auto epi = [&](int r, int cw, f32x16 (&t)[2], int h) {
                const int row = m0 + r; const int b = row / LT, pp = row - b * LT;
#pragma unroll
                for (int ni = 0; ni < 2; ++ni) {
                    const int c32 = n0 + cw + ni * 32; const int hd = c32 / 192, wi = c32 - hd * 192;
                    if (wi >= 128) rope_tile(t[ni], (wi - 128) >> 5, pp, h, tab);
#pragma unroll
                    for (int i = 0; i < 16; ++i) t[ni][i] *= QA_SCALE;
                    store_tile_bf16(QA + ((size_t)(b * 4 + hd) * LT + pp) * 192 + wi, t[ni], h);
                }
            };
            gemm_tile<256, 128, true>(arow, (const u16*)(p.ws + W_UQ) + (size_t)n0 * 384, 384, 384, epi, lds);
        } else {
            const bool isv = j >= 10; const int n0 = (isv ? j - 10 : j - 6) * 128;
            auto arow = [&](int r) { return CKV + (size_t)(m0 + r) * 256; };
            auto epi = [&](int r, int cw, f32x16 (&t)[2], int h) {
                const int row = m0 + r; const int b = row / LT, pp = row - b * LT;
#pragma unroll
                for (int ni = 0; ni < 2; ++ni) {
                    const int c32 = n0 + cw + ni * 32; const int hd = c32 >> 7, wi = c32 & 127;
                    if (isv) store_tile_bf16(VA + ((size_t)(b * 4 + hd) * LT + pp) * 128 + wi, t[ni], h);
                    else store_tile_bf16(KA + ((size_t)(b * 4 + hd) * LT + pp) * 192 + wi, t[ni], h);
                }
            };
            gemm_tile<256, 128, true>(arow, (const u16*)(p.ws + (isv ? W_UV : W_UK)) + (size_t)n0 * 256, 256, 256, epi, lds);
        }
    }
}

template <int DQK, int DV, bool SWA>
DEVI void attn_unit(const u16* __restrict__ Q, const u16* __restrict__ Kp, const u16* __restrict__ Vp, int q0, int a0, int na, int b0, int nb2,
                    float m_init, u16* __restrict__ outp  , char* lds) {
    constexpr int KSTR = DQK + 8, VSTR = DV + 32, KCH = DQK / 8, VCH = DV / 8, NKC = 64 * KCH / 512, NVC = 64 * VCH / 512, NS = DQK / 16, NDT = DV / 32;
    const int tid = threadIdx.x, lane = tid & 63, w = tid >> 6, l31 = lane & 31, h = lane >> 5;
    u16* sK = (u16*)lds; u16* sV = sK + 2 * 64 * KSTR;
    const int qpos = q0 + w * 32 + l31;
    bf16x8 qf[NS];
#pragma unroll
    for (int s = 0; s < NS; ++s) qf[s] = *(const bf16x8*)(Q + (size_t)qpos * DQK + s * 16 + h * 8);
    f32x16 o[NDT];
#pragma unroll
    for (int d = 0; d < NDT; ++d)
#pragma unroll
        for (int i = 0; i < 16; ++i) o[d][i] = 0.f;
    float m = m_init, lsum = 0.f;
    const int nt = na + nb2;
    u32x4 rk[NKC], rv[NVC];
    auto tile_pos = [&](int t) { return t < na ? a0 + 64 * t : b0 + 64 * (t - na); };
    auto gload = [&](int t) {
        const int kp0 = tile_pos(t);
        const u16* kb_ = Kp + (size_t)kp0 * DQK + tid * 8; const u16* vb_ = Vp + (size_t)kp0 * DV + tid * 8;
#pragma unroll
        for (int i = 0; i < NKC; ++i) rk[i] = *(const u32x4*)(kb_ + 4096 * i);
#pragma unroll
        for (int i = 0; i < NVC; ++i) rv[i] = *(const u32x4*)(vb_ + 4096 * i);
    };
    gload(0);
    const int tr_row = 4 * h + ((lane & 15) >> 2), tr_col = 16 * ((lane >> 4) & 1) + 4 * (lane & 3);
    for (int t = 0; t < nt; ++t) {
        u16* k_ = sK + (t & 1) * 64 * KSTR; u16* v_ = sV + (t & 1) * 64 * VSTR;
#pragma unroll
        for (int i = 0; i < NKC; ++i) { const int c = tid + 512 * i, row = c / KCH, ch = c % KCH; *(u32x4*)(k_ + row * KSTR + ch * 8) = rk[i]; }
#pragma unroll
        for (int i = 0; i < NVC; ++i) { const int c = tid + 512 * i, row = c / VCH, ch = c % VCH; *(u32x4*)(v_ + row * VSTR + ch * 8) = rv[i]; }
        __syncthreads();
        if (t + 1 < nt) gload(t + 1);
        f32x16 st[2];
#pragma unroll
        for (int k2 = 0; k2 < 2; ++k2) {
#pragma unroll
            for (int i = 0; i < 16; ++i) st[k2][i] = 0.f;
#pragma unroll
            for (int s = 0; s < NS; ++s) {
                const bf16x8 kf = *(const bf16x8*)(k_ + (k2 * 32 + l31) * KSTR + s * 16 + h * 8);
                st[k2] = __builtin_amdgcn_mfma_f32_32x32x16_bf16(kf, qf[s], st[k2], 0, 0, 0);
            }
        }
        if (SWA && t >= na) {
            const int kp0 = tile_pos(t);
#pragma unroll
            for (int k2 = 0; k2 < 2; ++k2)
#pragma unroll
                for (int i = 0; i < 16; ++i) {
                    const int key = kp0 + k2 * 32 + (i & 3) + 8 * (i >> 2) + 4 * h; const int d = qpos - key;
                    if (d > 128 || d < -128) st[k2][i] = -1e30f;
                }
        }
        float mx = st[0][0];
#pragma unroll
        for (int k2 = 0; k2 < 2; ++k2)
#pragma unroll
            for (int i = 0; i < 16; ++i) mx = fmaxf(mx, st[k2][i]);
        mx = fmaxf(mx, __shfl_xor(mx, 32));
        const float mn = fmaxf(m, mx); const float alpha = __builtin_amdgcn_exp2f(m - mn); m = mn;
        float ps = 0.f;
#pragma unroll
        for (int k2 = 0; k2 < 2; ++k2)
#pragma unroll
            for (int i = 0; i < 16; ++i) { const float pv = __builtin_amdgcn_exp2f(st[k2][i] - mn); st[k2][i] = pv; ps += pv; }
        lsum = lsum * alpha + ps;
#pragma unroll
        for (int d = 0; d < NDT; ++d)
#pragma unroll
            for (int i = 0; i < 16; ++i) o[d][i] *= alpha;
#pragma unroll
        for (int s16 = 0; s16 < 4; ++s16) {
            bf16x8 pf; unsigned* pu = (unsigned*)&pf;
#pragma unroll
            for (int jj = 0; jj < 4; ++jj) pu[jj] = pack2(st[s16 >> 1][8 * (s16 & 1) + 2 * jj], st[s16 >> 1][8 * (s16 & 1) + 2 * jj + 1]);
#pragma unroll
            for (int d = 0; d < NDT; ++d) {
                const u16* base = v_ + (16 * s16 + tr_row) * VSTR + d * 32 + tr_col;
                const s16x4 lo = __builtin_amdgcn_ds_read_tr16_b64_v4i16((LAS s16x4*)(base));
                const s16x4 hi = __builtin_amdgcn_ds_read_tr16_b64_v4i16((LAS s16x4*)(base + 8 * VSTR));
                bf16x8 vf; vf[0] = lo[0]; vf[1] = lo[1]; vf[2] = lo[2]; vf[3] = lo[3]; vf[4] = hi[0]; vf[5] = hi[1]; vf[6] = hi[2]; vf[7] = hi[3];
                o[d] = __builtin_amdgcn_mfma_f32_32x32x16_bf16(vf, pf, o[d], 0, 0, 0);
            }
        }
    }
    float lt = lsum + __shfl_xor(lsum, 32);
    if (SWA) lt += __builtin_amdgcn_exp2f(m_init - m);
    const float inv = 1.f / lt;
    u16* orow = outp + (size_t)qpos * DM;
#pragma unroll
    for (int d = 0; d < NDT; ++d)
#pragma unroll
        for (int g = 0; g < 4; ++g) { uint2 v; v.x = pack2(o[d][4 * g] * inv, o[d][4 * g + 1] * inv); v.y = pack2(o[d][4 * g + 2] * inv, o[d][4 * g + 3] * inv); *(uint2*)(orow + d * 32 + 8 * g + 4 * h) = v; }
    __syncthreads();
}
DEVI void phase_attention(const Params& p, char* lds) {
    const u16* QA = (const u16*)(p.ws + A_QA); const u16* KA = (const u16*)(p.ws + A_KA); const u16* VA = (const u16*)(p.ws + A_VA);
    const u16* QS = (const u16*)(p.ws + A_QS); const u16* KS = (const u16*)(p.ws + A_KS); const u16* VS = (const u16*)(p.ws + A_VS);
    u16* mix = (u16*)(p.ws + A_N0);
    for (int u = blockIdx.x; u < 1632; u += gridDim.x) {
        if (u < 544) {
            int b, hd, q0, na;
            if (u < 512) { b = u >> 6; hd = (u >> 4) & 3; q0 = LC + (u & 15) * 256; na = 68; }
            else { const int v = u - 512; b = v >> 2; hd = v & 3; q0 = 0; na = 4; }
            const size_t bh = (size_t)(b * 4 + hd) * LT;
            attn_unit<192, 128, false>(QA + bh * 192, KA + bh * 192, VA + bh * 128, q0, 0, na, 0, 0, -1e30f, mix + (size_t)b * LT * DM + hd * 128, lds);
        } else {
            int b, hd, q0, b0 = 0, nb2 = 0;
            if (u < 1568) { const int v = u - 544; b = v >> 7; hd = (v >> 4) & 7; const int s0 = (v & 15) * 256; q0 = LC + s0;
                int lo = s0 - 128; if (lo < 0) lo = 0; int hi = s0 + 256 + 128; if (hi > SEQ) hi = SEQ; b0 = LC + lo; nb2 = (hi - lo) >> 6; }
            else { const int v = u - 1568; b = v >> 3; hd = v & 7; q0 = 0; }
            const int kvh = hd >> 2; const size_t qb = (size_t)(b * 8 + hd) * LT, kb = (size_t)(b * 2 + kvh) * LT;
            attn_unit<64, 64, true>(QS + qb * 64, KS + kb * 64, VS + kb * 64, q0, 0, 4, b0, nb2, p.in[I_ASINK][hd] * LOG2E, mix + (size_t)b * LT * DM + 512 + hd * 64, lds);
        }
    }
}
DEVI void phase_gemm_wo(const Params& p, const u16* A, const u16* W, const RowSrc& resid, int mode, int layer, char* lds) {
    float* XC = (float*)(p.ws + OFF_XC); float* XL = p.out;
    const float* mods_l = (const float*)(p.ws + OFF_MODS) + (size_t)layer * 9 * 6144;
    const int MT = (mode == 0 ? T0 : TL) / 256;
    for (int u = blockIdx.x; u < 8 * MT; u += gridDim.x) {
        const int mt = u >> 3, nt = u & 7; const int m0 = mt * 256, n0 = nt * 128;
        auto arow = [&](int r) { return A + (size_t)(m0 + r) * DM; };
        auto epi = [&](int r, int cw, f32x16 (&t)[2], int h) {
            int bb; const float* rs = row_ptr(resid, mode, m0 + r, bb); int bb2; float* xo = row_ptr_w(XC, XL, mode, m0 + r, bb2);
            const float* mg = mods_l + (size_t)bb * 6144 + 2 * 1024;
#pragma unroll
            for (int ni = 0; ni < 2; ++ni)
#pragma unroll
                for (int g = 0; g < 4; ++g) {
                    const int c = n0 + cw + ni * 32 + 8 * g + 4 * h;
                    const float4 rv = *(const float4*)(rs + c), gv = *(const float4*)(mg + c);
                    float4 ov; ov.x = rv.x + gv.x * t[ni][4 * g]; ov.y = rv.y + gv.y * t[ni][4 * g + 1]; ov.z = rv.z + gv.z * t[ni][4 * g + 2]; ov.w = rv.w + gv.w * t[ni][4 * g + 3];
                    *(float4*)(xo + c) = ov;
                }
        };
        gemm_tile<256, 128, false>(arow, W + (size_t)n0 * DM, DM, DM, epi, lds);
    }
}

DEVI void phase_moe_route(const Params& p, int layer, char* lds) {
    const int mode = layer == 0 ? 0 : 1; const int ntok = layer == 0 ? T0 : TL; const int tc = ntok / NCHUNK;
    RowSrc src; src.ctx = (const float*)(p.ws + OFF_XC); src.lat = p.out;
    const float* gain = p.in[I_NFFN] + layer * 1024; const float* mods_l = (const float*)(p.ws + OFF_MODS) + (size_t)layer * 9 * 6144;
    const float* wr = p.in[I_MROUT] + (size_t)layer * 1024 * 64; const float ebias = p.in[I_MBIAS][layer * 64 + (threadIdx.x & 63)];
    u16* n1 = (u16*)(p.ws + M_N1);
    int* cnt = (int*)(p.ws + OFF_CNT) + layer * NCHUNK * 64;
    int* tok_e = (int*)(p.ws + OFF_TOKE); int* tok_r = (int*)(p.ws + OFF_TOKR); int* ltok = (int*)(p.ws + OFF_LTOK); float* lg = (float*)(p.ws + OFF_LG);
    const int lane = threadIdx.x & 63, w = threadIdx.x >> 6;
    float* sn = (float*)lds + w * 4096;
    for (int t0 = (blockIdx.x * 8 + w) * 4; t0 < ntok; t0 += gridDim.x * 32) {
#pragma unroll
        for (int j = 0; j < 4; ++j) {
            const int r = t0 + j; int bb; const float* xr = row_ptr(src, mode, r, bb);
            float4 v[4]; float ss = 0.f;
#pragma unroll
            for (int i = 0; i < 4; ++i) { v[i] = ((const float4*)xr)[lane + 64 * i]; ss += v[i].x * v[i].x + v[i].y * v[i].y + v[i].z * v[i].z + v[i].w * v[i].w; }
            ss = wave_sum(ss);
            const float rs = rsqrtf(ss * (1.f / 1024.f) + 1e-6f);
            const float* msh = mods_l + (size_t)bb * 6144 + 3 * 1024; const float* msc = mods_l + (size_t)bb * 6144 + 4 * 1024;
#pragma unroll
            for (int i = 0; i < 4; ++i) {
                const int c = (lane + 64 * i) * 4;
                const float4 g = *(const float4*)(gain + c), sh = *(const float4*)(msh + c), sc = *(const float4*)(msc + c);
                const float y0 = v[i].x * rs * g.x * (1.f + sc.x) + sh.x, y1 = v[i].y * rs * g.y * (1.f + sc.y) + sh.y, y2 = v[i].z * rs * g.z * (1.f + sc.z) + sh.z, y3 = v[i].w * rs * g.w * (1.f + sc.w) + sh.w;
                uint2 o; o.x = pack2(y0, y1); o.y = pack2(y2, y3);
                *(uint2*)(n1 + (size_t)r * DM + c) = o;
                sn[(c + 0) * 4 + j] = y0; sn[(c + 1) * 4 + j] = y1; sn[(c + 2) * 4 + j] = y2; sn[(c + 3) * 4 + j] = y3;
            }
        }
        __builtin_amdgcn_s_waitcnt(0xc07f);
        __builtin_amdgcn_wave_barrier();
        float a0 = 0.f, a1 = 0.f, a2 = 0.f, a3 = 0.f;
#pragma unroll 8
        for (int k = 0; k < 1024; ++k) { const float wv = wr[k * 64 + lane]; const float4 s = *(const float4*)(sn + k * 4); a0 += s.x * wv; a1 += s.y * wv; a2 += s.z * wv; a3 += s.w * wv; }
        __builtin_amdgcn_wave_barrier();
        const float lgt[4] = {a0, a1, a2, a3};
#pragma unroll
        for (int j = 0; j < 4; ++j) {
            const int tok = t0 + j;
            const float score = 1.f / (1.f + expf(-lgt[j])); const float choice = score + ebias;
            const float m1 = red8_max(choice);
            const unsigned long long bm = __ballot(choice == m1);
            const unsigned gm = (unsigned)(bm >> (lane & 56)) & 0xffu; const int first = __ffs(gm) - 1;
            const float m2 = red8_max(((lane & 7) == first) ? -INFINITY : choice);
            const float gs = m1 + m2;
            int rank = 0;
#pragma unroll
            for (int g2 = 0; g2 < 8; ++g2) { const float og = __shfl(gs, g2 * 8); rank += (og > gs || (og == gs && g2 < (lane >> 3))) ? 1 : 0; }
            float cm = rank < 4 ? choice : -INFINITY;
            unsigned long long sel = 0ull; float ssum = 0.f;
#pragma unroll
            for (int it = 0; it < 6; ++it) {
                const float mxv = wave_max(cm);
                const unsigned long long bmm = __ballot(cm == mxv);
                const int win = __ffsll((long long)bmm) - 1;
                sel |= 1ull << win; ssum += __shfl(score, win);
                if (lane == win) cm = -INFINITY;
            }
            if ((sel >> lane) & 1ull) {
                const int jj = __popcll(sel & ((1ull << lane) - 1ull));
                const int ch = tok / tc; const int rk = atomicAdd(&cnt[ch * 64 + lane], 1);
                tok_e[tok * 6 + jj] = lane; tok_r[tok * 6 + jj] = rk;
                ltok[((size_t)ch * 64 + lane) * tc + rk] = tok; lg[((size_t)ch * 64 + lane) * tc + rk] = 2.5f * score / ssum;
            }
        }
    }
}
struct SegTab { int* cnt; int* off; int* tpre; };
DEVI SegTab build_segtab(const Params& p, int layer, int tc, char* lds_tab) {
    SegTab T; T.cnt = (int*)lds_tab; T.off = T.cnt + 264; T.tpre = T.off + 264;
    const int* cnt = (const int*)(p.ws + OFF_CNT) + layer * NCHUNK * 64;
    const int tid = threadIdx.x;
    if (tid < 260) { const int ch = tid / 65, e = tid % 65; T.cnt[tid] = e < 64 ? cnt[ch * 64 + e] : tc; }
    __syncthreads();
    if (tid < 64) {
        int lc[5], lt_[5]; int sc = 0, st = 0;
#pragma unroll
        for (int j = 0; j < 5; ++j) { const int s = 5 * tid + j; const int v = s < 260 ? T.cnt[s] : 0; lc[j] = sc; lt_[j] = st; sc += v; st += (v + 127) >> 7; }
        int ic = sc, it = st;
        for (int o = 1; o < 64; o <<= 1) { const int a = __shfl_up(ic, o), b2 = __shfl_up(it, o); if (tid >= o) { ic += a; it += b2; } }
        const int bc = ic - sc, bt = it - st;
#pragma unroll
        for (int j = 0; j < 5; ++j) { const int s = 5 * tid + j; if (s <= 260) { T.tpre[s] = bt + lt_[j]; T.off[s] = bc + lc[j]; } }
    }
    __syncthreads();
    return T;
}
DEVI int find_seg(const SegTab& T, int lo_seg, int hi_seg, int mt) {
    int lo = lo_seg, hi = hi_seg;
    while (hi - lo > 1) { const int mid = (lo + hi) >> 1; if (T.tpre[mid] <= mt) lo = mid; else hi = mid; }
    return lo;
}
DEVI void phase_moe_gemm1(const Params& p, int layer, char* lds) {
    const int ntok = layer == 0 ? T0 : TL; const int tc = ntok / NCHUNK;
    char* tabmem = lds + 110592; SegTab T = build_segtab(p, layer, tc, tabmem);
    const u16* n1 = (const u16*)(p.ws + M_N1); u16* act = (u16*)(p.ws + M_ACT);
    const int* ltok = (const int*)(p.ws + OFF_LTOK); const float* lg = (const float*)(p.ws + OFF_LG);
    const int nunits = T.tpre[260] * 2;
    for (int u = blockIdx.x; u < nunits; u += gridDim.x) {
        const int mt = u >> 1, nt = u & 1; const int seg = find_seg(T, 0, 260, mt); const int ch = seg / 65, e = seg % 65;
        const int cntv = T.cnt[seg], row0 = (mt - T.tpre[seg]) * 128; const int n0 = nt * 256;
        const int* lt = ltok + ((size_t)ch * 64 + e) * tc; const float* lgp = lg + ((size_t)ch * 64 + e) * tc;
        const u16* W = e < 64 ? (const u16*)(p.ws + OFF_WGU) + (size_t)e * 512 * 1024 : (const u16*)(p.ws + W_SGU) + (size_t)layer * 512 * 1024;
        auto arow = [&](int r) { int s = row0 + r; if (s >= cntv) s = cntv - 1; const int tok = e < 64 ? lt[s] : ch * tc + s; return n1 + (size_t)tok * DM; };
        const size_t arow0 = (size_t)ch * 7 * tc + (T.off[seg] - T.off[ch * 65]) + row0;
        auto epi = [&](int r, int cw, f32x16 (&t)[2], int h) {
            const int s = row0 + r; if (s >= cntv) return;
            const float gw = e < 64 ? lgp[s] : 1.f;
            u16* dst = act + (arow0 + r) * 256 + ((n0 + cw) >> 1);
#pragma unroll
            for (int g = 0; g < 4; ++g) {
                float o4[4];
#pragma unroll
                for (int i = 0; i < 4; ++i) { const float gt = t[0][4 * g + i], up = t[1][4 * g + i]; o4[i] = gt / (1.f + __expf(-gt)) * up * gw; }
                uint2 v; v.x = pack2(o4[0], o4[1]); v.y = pack2(o4[2], o4[3]); *(uint2*)(dst + 8 * g + 4 * h) = v;
            }
        };
        gemm_tile<128, 256, false>(arow, W + (size_t)n0 * DM, DM, DM, epi, lds);
    }
}
DEVI void phase_moe_gemm2(const Params& p, int layer, int ch, char* lds) {
    const int ntok = layer == 0 ? T0 : TL; const int tc = ntok / NCHUNK;
    char* tabmem = lds + 110592; SegTab T = build_segtab(p, layer, tc, tabmem);
    const u16* act = (const u16*)(p.ws + M_ACT); u16* outr = (u16*)(p.ws + M_OUTR);
    const int t_lo = T.tpre[ch * 65], t_hi = T.tpre[ch * 65 + 65];
    const int nunits = (t_hi - t_lo) * 4;
    for (int u = blockIdx.x; u < nunits; u += gridDim.x) {
        const int mt = t_lo + (u >> 2), nt = u & 3; const int seg = find_seg(T, ch * 65, ch * 65 + 65, mt); const int e = seg % 65;
        const int cntv = T.cnt[seg], row0 = (mt - T.tpre[seg]) * 128; const int n0 = nt * 256;
        const size_t lrow0 = (size_t)(T.off[seg] - T.off[ch * 65]) + row0;
        const u16* A = act + ((size_t)ch * 7 * tc + lrow0) * 256;
        const u16* W = e < 64 ? (const u16*)(p.ws + OFF_WD) + (size_t)e * 1024 * 256 : (const u16*)(p.ws + W_SD) + (size_t)layer * 1024 * 256;
        auto arow = [&](int r) { int s = row0 + r; if (s >= cntv) s = cntv - 1; return A + (size_t)(s - row0) * 256; };
        auto epi = [&](int r, int cw, f32x16 (&t)[2], int h) {
            if (row0 + r >= cntv) return;
            u16* dst = outr + (lrow0 + r) * DM + n0 + cw;
            store_tile_bf16(dst, t[0], h); store_tile_bf16(dst + 32, t[1], h);
        };
        gemm_tile<128, 256, false>(arow, W + (size_t)n0 * 256, 256, 256, epi, lds);
    }
}
DEVI void phase_moe_combine(const Params& p, int layer, int ch, char* lds) {
    const int mode = layer == 0 ? 0 : 1; const int ntok = layer == 0 ? T0 : TL; const int tc = ntok / NCHUNK;
    SegTab T = build_segtab(p, layer, tc, lds);
    const u16* outr = (const u16*)(p.ws + M_OUTR); const int* tok_e = (const int*)(p.ws + OFF_TOKE); const int* tok_r = (const int*)(p.ws + OFF_TOKR);
    float* XC = (float*)(p.ws + OFF_XC); float* XL = p.out;
    const float* mods_l = (const float*)(p.ws + OFF_MODS) + (size_t)layer * 9 * 6144;
    const int lane = threadIdx.x & 63, w = threadIdx.x >> 6;
    for (int tl = blockIdx.x * 8 + w; tl < tc; tl += gridDim.x * 8) {
        const int tok = ch * tc + tl; int bb; float* xr = row_ptr_w(XC, XL, mode, tok, bb);
        const float* mg = mods_l + (size_t)bb * 6144 + 5 * 1024;
        int rows[7];
#pragma unroll
        for (int j = 0; j < 6; ++j) rows[j] = T.off[ch * 65 + tok_e[tok * 6 + j]] - T.off[ch * 65] + tok_r[tok * 6 + j];
        rows[6] = 6 * tc + tl;
#pragma unroll
        for (int i = 0; i < 2; ++i) {
            const int c = (lane + 64 * i) * 8;
            float acc[8];
#pragma unroll
            for (int q = 0; q < 8; ++q) acc[q] = 0.f;
#pragma unroll
            for (int j = 0; j < 7; ++j) {
                const uint4 v = *(const uint4*)(outr + (size_t)rows[j] * DM + c);
                acc[0] += bf_lo(v.x); acc[1] += bf_hi(v.x); acc[2] += bf_lo(v.y); acc[3] += bf_hi(v.y); acc[4] += bf_lo(v.z); acc[5] += bf_hi(v.z); acc[6] += bf_lo(v.w); acc[7] += bf_hi(v.w);
            }
            float4 x0 = *(float4*)(xr + c), x1 = *(float4*)(xr + c + 4); const float4 g0 = *(const float4*)(mg + c), g1 = *(const float4*)(mg + c + 4);
            x0.x += g0.x * acc[0]; x0.y += g0.y * acc[1]; x0.z += g0.z * acc[2]; x0.w += g0.w * acc[3]; x1.x += g1.x * acc[4]; x1.y += g1.y * acc[5]; x1.z += g1.z * acc[6]; x1.w += g1.w * acc[7];
            *(float4*)(xr + c) = x0; *(float4*)(xr + c + 4) = x1;
        }
    }
}

DEVI void phase_rwkv_mix(const Params& p, int i0, int i1, int i2) {
    const u16* nn = (const u16*)(p.ws + R_NN); u16* xm = (u16*)(p.ws + R_XM0);
    const float* mu = p.in[I_RMU]; const int idx[3] = {i0, i1, i2};
    const int lane = threadIdx.x & 63, w = threadIdx.x >> 6;
    for (int r = blockIdx.x * 8 + w; r < T0; r += gridDim.x * 8) {
        const int b = r / LT, pp = r - b * LT;
        const bool hasprev = (pp != 0) && (pp != LC), hasnext = (pp != LC - 1) && (pp != LT - 1);
#pragma unroll
        for (int half = 0; half < 2; ++half) {
            const int c = half * 512 + lane * 8;
            const uint4 cur = *(const uint4*)(nn + (size_t)r * DM + c);
            uint4 sh = make_uint4(0, 0, 0, 0);
            if (half == 0) { if (hasprev) sh = *(const uint4*)(nn + (size_t)(r - 1) * DM + c); }
            else { if (hasnext) sh = *(const uint4*)(nn + (size_t)(r + 1) * DM + c); }
            float nv[8], xx[8];
            nv[0] = bf_lo(cur.x); nv[1] = bf_hi(cur.x); nv[2] = bf_lo(cur.y); nv[3] = bf_hi(cur.y); nv[4] = bf_lo(cur.z); nv[5] = bf_hi(cur.z); nv[6] = bf_lo(cur.w); nv[7] = bf_hi(cur.w);
            xx[0] = bf_lo(sh.x) - nv[0]; xx[1] = bf_hi(sh.x) - nv[1]; xx[2] = bf_lo(sh.y) - nv[2]; xx[3] = bf_hi(sh.y) - nv[3]; xx[4] = bf_lo(sh.z) - nv[4]; xx[5] = bf_hi(sh.z) - nv[5]; xx[6] = bf_lo(sh.w) - nv[6]; xx[7] = bf_hi(sh.w) - nv[7];
#pragma unroll
            for (int j = 0; j < 3; ++j) {
                const float4 m0 = *(const float4*)(mu + idx[j] * 1024 + c), m1 = *(const float4*)(mu + idx[j] * 1024 + c + 4);
                uint4 o; o.x = pack2(nv[0] + xx[0] * m0.x, nv[1] + xx[1] * m0.y); o.y = pack2(nv[2] + xx[2] * m0.z, nv[3] + xx[3] * m0.w);
                o.z = pack2(nv[4] + xx[4] * m1.x, nv[5] + xx[5] * m1.y); o.w = pack2(nv[6] + xx[6] * m1.z, nv[7] + xx[7] * m1.w);
                *(uint4*)(xm + (size_t)j * T0 * DM + (size_t)r * DM + c) = o;
            }
        }
    }
}
DEVI void phase_rwkv_gemm_rkv(const Params& p, char* lds) {
    const int MT = T0 / 256;
    for (int u = blockIdx.x; u < 3 * 8 * MT; u += gridDim.x) {
        const int j = u / (8 * MT), v = u % (8 * MT); const int mt = v >> 3, nt = v & 7; const int m0 = mt * 256, n0 = nt * 128;
        const u16* A = (const u16*)(p.ws + R_XM0) + (size_t)j * T0 * DM; const u16* W = (const u16*)(p.ws + W_RR) + (size_t)j * DM * DM; u16* O = (u16*)(p.ws + R_RR) + (size_t)j * T0 * DM;
        auto arow = [&](int r) { return A + (size_t)(m0 + r) * DM; };
        auto epi = [&](int r, int cw, f32x16 (&t)[2], int h) { u16* dst = O + (size_t)(m0 + r) * DM + n0 + cw; store_tile_bf16(dst, t[0], h); store_tile_bf16(dst + 32, t[1], h); };
        gemm_tile<256, 128, false>(arow, W + (size_t)n0 * DM, DM, DM, epi, lds);
    }
}
DEVI void phase_rwkv_gemm_small(const Params& p, char* lds) {
    const int MT = T0 / 256;
    for (int u = blockIdx.x; u < 3 * MT; u += gridDim.x) {
        const int j = u / MT, mt = u % MT; const int m0 = mt * 256;
        const u16* A = (const u16*)(p.ws + R_XM0) + (size_t)j * T0 * DM;
        const u16* W = (const u16*)(p.ws + (j == 0 ? W_W1 : j == 1 ? W_A1 : W_G1)); u16* O = (u16*)(p.ws + (j == 0 ? R_HW : j == 1 ? R_HA : R_HG));
        auto arow = [&](int r) { return A + (size_t)(m0 + r) * DM; };
        auto epi = [&](int r, int cw, f32x16 (&t)[2], int h) {
#pragma unroll
            for (int ni = 0; ni < 2; ++ni) {
#pragma unroll
                for (int i = 0; i < 16; ++i) { const float x = t[ni][i]; t[ni][i] = j == 0 ? tanhf_(x) : j == 1 ? x : sigmoidf_(x); }
                store_tile_bf16(O + (size_t)(m0 + r) * 128 + cw + ni * 32, t[ni], h);
            }
        };
        gemm_tile<256, 128, false>(arow, W, DM, DM, epi, lds);
    }
}
DEVI void phase_rwkv_gemm_g(const Params& p, char* lds) {
    const int MT = T0 / 256; const u16* A = (const u16*)(p.ws + R_HG); const u16* W = (const u16*)(p.ws + W_G2); u16* O = (u16*)(p.ws + R_GG);
    for (int u = blockIdx.x; u < 8 * MT; u += gridDim.x) {
        const int mt = u >> 3, nt = u & 7; const int m0 = mt * 256, n0 = nt * 128;
        auto arow = [&](int r) { return A + (size_t)(m0 + r) * 128; };
        auto epi = [&](int r, int cw, f32x16 (&t)[2], int h) { u16* dst = O + (size_t)(m0 + r) * DM + n0 + cw; store_tile_bf16(dst, t[0], h); store_tile_bf16(dst + 32, t[1], h); };
        gemm_tile<256, 128, false>(arow, W + (size_t)n0 * 128, 128, 128, epi, lds);
    }
}
DEVI void phase_rwkv_scan(const Params& p, char* lds) {
    float* WD = (float*)lds; float* KKA = WD + 4096; float* KK = KKA + 4096; float* KM = KK + 4096; float* RR = KM + 4096; float* VV = RR + 4096; float* YB = VV + 4096;
    const u16* r_g = (const u16*)(p.ws + R_RR); const u16* k_g = (const u16*)(p.ws + R_RK); const u16* v_g = (const u16*)(p.ws + R_RV);
    const u16* hw = (const u16*)(p.ws + R_HW); const u16* ha = (const u16*)(p.ws + R_HA);
    const int tid = threadIdx.x, lane = tid & 63, w = tid >> 6, l31 = lane & 31, hh = lane >> 5;
    for (int u = blockIdx.x; u < 256; u += gridDim.x) {
        const int dir = u & 1, hd = (u >> 1) & 15, b = u >> 5;
        u16* y_g = (u16*)(p.ws + (dir ? R_YB : R_YF)); float* rkb = (float*)(p.ws + R_RKB) + (size_t)dir * T0 * 16;
        const int mat = w >> 2, stt = (w >> 1) & 1, ctt = w & 1;
        const u16* w2t = (const u16*)(p.ws + (mat ? W_A2 : W_W2)) + (size_t)dir * 1024 * 64 + (size_t)(hd * 64 + ctt * 32 + l31) * 64;
        bf16x8 wfr[4];
#pragma unroll
        for (int ks = 0; ks < 4; ++ks) wfr[ks] = *(const bf16x8*)(w2t + ks * 16 + hh * 8);
        const float* bias0 = (mat ? p.in[I_RA0] : p.in[I_RW0]) + dir * 1024 + hd * 64 + ctt * 32;
        const u16* hsrc = mat ? ha : hw;
        const int pst = tid >> 3, oct = tid & 7; const int cg = hd * 64 + oct * 8;
        float kkc[8], kac[8], rkc[8];
#pragma unroll
        for (int i = 0; i < 8; ++i) { kkc[i] = p.in[I_RKK][cg + i]; kac[i] = p.in[I_RKA][cg + i]; rkc[i] = p.in[I_RRK][cg + i]; }
        float S[8];
#pragma unroll
        for (int i = 0; i < 8; ++i) S[i] = 0.f;
        const int vrow = tid >> 3;
        for (int ci = 0; ci < 68; ++ci) {
            int pc; if (ci < 4) pc = dir ? 3 - ci : ci; else pc = 4 + (dir ? 63 - (ci - 4) : ci - 4);
            const size_t row0 = (size_t)b * LT + pc * 64;
            {
                f32x16 acc;
#pragma unroll
                for (int i = 0; i < 16; ++i) acc[i] = 0.f;
                const u16* hp = hsrc + (row0 + stt * 32 + l31) * 128 + dir * 64;
#pragma unroll
                for (int ks = 0; ks < 4; ++ks) { const bf16x8 af = *(const bf16x8*)(hp + ks * 16 + hh * 8); acc = __builtin_amdgcn_mfma_f32_32x32x16_bf16(wfr[ks], af, acc, 0, 0, 0); }
                float* dstm = (mat ? KKA : WD) + (stt * 32 + l31) * 64 + ctt * 32;
#pragma unroll
                for (int g = 0; g < 4; ++g) {
                    const float4 b4 = *(const float4*)(bias0 + 8 * g + 4 * hh);
                    float4 o4; const float x0 = acc[4 * g] + b4.x, x1 = acc[4 * g + 1] + b4.y, x2 = acc[4 * g + 2] + b4.z, x3 = acc[4 * g + 3] + b4.w;
                    if (mat) { o4.x = sigmoidf_(x0); o4.y = sigmoidf_(x1); o4.z = sigmoidf_(x2); o4.w = sigmoidf_(x3); }
                    else { o4.x = __expf(-0.6065306597126334f * sigmoidf_(x0)); o4.y = __expf(-0.6065306597126334f * sigmoidf_(x1)); o4.z = __expf(-0.6065306597126334f * sigmoidf_(x2)); o4.w = __expf(-0.6065306597126334f * sigmoidf_(x3)); }
                    *(float4*)(dstm + 8 * g + 4 * hh) = o4;
                }
            }
            __syncthreads();
            {
                const size_t grow = row0 + pst; const size_t go = grow * DM + cg;
                const uint4 ru = *(const uint4*)(r_g + go), ku = *(const uint4*)(k_g + go), vu = *(const uint4*)(v_g + go);
                float rv[8], kv[8], vv[8];
                rv[0] = bf_lo(ru.x); rv[1] = bf_hi(ru.x); rv[2] = bf_lo(ru.y); rv[3] = bf_hi(ru.y); rv[4] = bf_lo(ru.z); rv[5] = bf_hi(ru.z); rv[6] = bf_lo(ru.w); rv[7] = bf_hi(ru.w);
                kv[0] = bf_lo(ku.x); kv[1] = bf_hi(ku.x); kv[2] = bf_lo(ku.y); kv[3] = bf_hi(ku.y); kv[4] = bf_lo(ku.z); kv[5] = bf_hi(ku.z); kv[6] = bf_lo(ku.w); kv[7] = bf_hi(ku.w);
                vv[0] = bf_lo(vu.x); vv[1] = bf_hi(vu.x); vv[2] = bf_lo(vu.y); vv[3] = bf_hi(vu.y); vv[4] = bf_lo(vu.z); vv[5] = bf_hi(vu.z); vv[6] = bf_lo(vu.w); vv[7] = bf_hi(vu.w);
                float av[8];
                { const float4 a0 = *(const float4*)(KKA + pst * 64 + oct * 8), a1 = *(const float4*)(KKA + pst * 64 + oct * 8 + 4); av[0] = a0.x; av[1] = a0.y; av[2] = a0.z; av[3] = a0.w; av[4] = a1.x; av[5] = a1.y; av[6] = a1.z; av[7] = a1.w; }
                float kk[8], km[8], ssq = 0.f, rks = 0.f;
#pragma unroll
                for (int i = 0; i < 8; ++i) { kk[i] = kv[i] * kkc[i]; ssq += kk[i] * kk[i]; km[i] = kv[i] * (1.f + (av[i] - 1.f) * kac[i]); rks += rv[i] * km[i] * rkc[i]; }
                ssq = red8_sum(ssq); rks = red8_sum(rks);
                const float inv = 1.f / fmaxf(sqrtf(ssq), 1e-12f);
                float* o;
                o = KK + pst * 64 + oct * 8; *(float4*)o = make_float4(kk[0] * inv, kk[1] * inv, kk[2] * inv, kk[3] * inv); *(float4*)(o + 4) = make_float4(kk[4] * inv, kk[5] * inv, kk[6] * inv, kk[7] * inv);
                o = KKA + pst * 64 + oct * 8; *(float4*)o = make_float4(kk[0] * inv * av[0], kk[1] * inv * av[1], kk[2] * inv * av[2], kk[3] * inv * av[3]); *(float4*)(o + 4) = make_float4(kk[4] * inv * av[4], kk[5] * inv * av[5], kk[6] * inv * av[6], kk[7] * inv * av[7]);
                o = KM + pst * 64 + oct * 8; *(float4*)o = make_float4(km[0], km[1], km[2], km[3]); *(float4*)(o + 4) = make_float4(km[4], km[5], km[6], km[7]);
                o = RR + pst * 64 + oct * 8; *(float4*)o = make_float4(rv[0], rv[1], rv[2], rv[3]); *(float4*)(o + 4) = make_float4(rv[4], rv[5], rv[6], rv[7]);
                o = VV + pst * 64 + oct * 8; *(float4*)o = make_float4(vv[0], vv[1], vv[2], vv[3]); *(float4*)(o + 4) = make_float4(vv[4], vv[5], vv[6], vv[7]);
                if (oct == 0) rkb[grow * 16 + hd] = rks;
            }
            __syncthreads();
            for (int st = 0; st < 64; ++st) {
                const int ix = dir ? 63 - st : st;
                const float4 k0 = *(const float4*)(KK + ix * 64 + oct * 8), k1 = *(const float4*)(KK + ix * 64 + oct * 8 + 4);
                const float4 w0 = *(const float4*)(WD + ix * 64 + oct * 8), w1 = *(const float4*)(WD + ix * 64 + oct * 8 + 4);
                const float4 b0 = *(const float4*)(KKA + ix * 64 + oct * 8), b1 = *(const float4*)(KKA + ix * 64 + oct * 8 + 4);
                const float4 m0 = *(const float4*)(KM + ix * 64 + oct * 8), m1 = *(const float4*)(KM + ix * 64 + oct * 8 + 4);
                const float4 r0 = *(const float4*)(RR + ix * 64 + oct * 8), r1 = *(const float4*)(RR + ix * 64 + oct * 8 + 4);
                const float vx = VV[ix * 64 + vrow];
                float sa = S[0] * k0.x + S[1] * k0.y + S[2] * k0.z + S[3] * k0.w + S[4] * k1.x + S[5] * k1.y + S[6] * k1.z + S[7] * k1.w;
                sa = red8_sum(sa);
                S[0] = S[0] * w0.x - sa * b0.x + vx * m0.x; S[1] = S[1] * w0.y - sa * b0.y + vx * m0.y; S[2] = S[2] * w0.z - sa * b0.z + vx * m0.z; S[3] = S[3] * w0.w - sa * b0.w + vx * m0.w;
                S[4] = S[4] * w1.x - sa * b1.x + vx * m1.x; S[5] = S[5] * w1.y - sa * b1.y + vx * m1.y; S[6] = S[6] * w1.z - sa * b1.z + vx * m1.z; S[7] = S[7] * w1.w - sa * b1.w + vx * m1.w;
                float y = S[0] * r0.x + S[1] * r0.y + S[2] * r0.z + S[3] * r0.w + S[4] * r1.x + S[5] * r1.y + S[6] * r1.z + S[7] * r1.w;
                y = red8_sum(y);
                if (oct == 0) YB[ix * 64 + vrow] = y;
            }
            __syncthreads();
            if (pc >= 4) {
                const float4 y0 = *(const float4*)(YB + pst * 64 + oct * 8), y1 = *(const float4*)(YB + pst * 64 + oct * 8 + 4);
                uint4 o; o.x = pack2(y0.x, y0.y); o.y = pack2(y0.z, y0.w); o.z = pack2(y1.x, y1.y); o.w = pack2(y1.z, y1.w);
                *(uint4*)(y_g + (row0 + pst) * DM + cg) = o;
            }
            __syncthreads();
        }
    }
}
DEVI void phase_rwkv_readout(const Params& p) {
    const u16* yf = (const u16*)(p.ws + R_YF); const u16* yb = (const u16*)(p.ws + R_YB); const u16* vg = (const u16*)(p.ws + R_RV); const u16* gg = (const u16*)(p.ws + R_GG);
    const float* rkb = (const float*)(p.ws + R_RKB); u16* rd = (u16*)(p.ws + R_RD);
    const float* lnw = p.in[I_RLNW]; const float* lnb = p.in[I_RLNB];
    const int lane = threadIdx.x & 63, w = threadIdx.x >> 6;
    for (int t = blockIdx.x * 8 + w; t < TL; t += gridDim.x * 8) {
        const int b = t >> 12, s = t & 4095; const size_t row = (size_t)b * LT + LC + s; const int c = lane * 16; const int hd = lane >> 2;
        float y[16], vv[16], gv[16];
#pragma unroll
        for (int q = 0; q < 2; ++q) {
            const uint4 a = *(const uint4*)(yf + row * DM + c + 8 * q), bq = *(const uint4*)(yb + row * DM + c + 8 * q), v4 = *(const uint4*)(vg + row * DM + c + 8 * q), g4 = *(const uint4*)(gg + row * DM + c + 8 * q);
            y[8 * q + 0] = bf_lo(a.x) + bf_lo(bq.x); y[8 * q + 1] = bf_hi(a.x) + bf_hi(bq.x); y[8 * q + 2] = bf_lo(a.y) + bf_lo(bq.y); y[8 * q + 3] = bf_hi(a.y) + bf_hi(bq.y);
            y[8 * q + 4] = bf_lo(a.z) + bf_lo(bq.z); y[8 * q + 5] = bf_hi(a.z) + bf_hi(bq.z); y[8 * q + 6] = bf_lo(a.w) + bf_lo(bq.w); y[8 * q + 7] = bf_hi(a.w) + bf_hi(bq.w);
            vv[8 * q + 0] = bf_lo(v4.x); vv[8 * q + 1] = bf_hi(v4.x); vv[8 * q + 2] = bf_lo(v4.y); vv[8 * q + 3] = bf_hi(v4.y); vv[8 * q + 4] = bf_lo(v4.z); vv[8 * q + 5] = bf_hi(v4.z); vv[8 * q + 6] = bf_lo(v4.w); vv[8 * q + 7] = bf_hi(v4.w);
            gv[8 * q + 0] = bf_lo(g4.x); gv[8 * q + 1] = bf_hi(g4.x); gv[8 * q + 2] = bf_lo(g4.y); gv[8 * q + 3] = bf_hi(g4.y); gv[8 * q + 4] = bf_lo(g4.z); gv[8 * q + 5] = bf_hi(g4.z); gv[8 * q + 6] = bf_lo(g4.w); gv[8 * q + 7] = bf_hi(g4.w);
        }
        float sm = 0.f;
#pragma unroll
        for (int i = 0; i < 16; ++i) sm += y[i];
        sm = red4_sum(sm); const float mean = sm * (1.f / 64.f);
        float vs = 0.f;
#pragma unroll
        for (int i = 0; i < 16; ++i) { const float d = y[i] - mean; vs += d * d; }
        vs = red4_sum(vs); const float rstd = rsqrtf(vs * (1.f / 64.f) + 64e-5f);
        const float bon = rkb[row * 16 + hd] + rkb[(size_t)T0 * 16 + row * 16 + hd];
        unsigned ow[8];
#pragma unroll
        for (int i = 0; i < 8; ++i) {
            const int c0 = c + 2 * i;
            const float o0 = ((y[2 * i] - mean) * rstd * lnw[c0] + lnb[c0] + bon * vv[2 * i]) * gv[2 * i];
            const float o1 = ((y[2 * i + 1] - mean) * rstd * lnw[c0 + 1] + lnb[c0 + 1] + bon * vv[2 * i + 1]) * gv[2 * i + 1];
            ow[i] = pack2(o0, o1);
        }
        *(uint4*)(rd + (size_t)t * DM + c) = make_uint4(ow[0], ow[1], ow[2], ow[3]); *(uint4*)(rd + (size_t)t * DM + c + 8) = make_uint4(ow[4], ow[5], ow[6], ow[7]);
    }
}
DEVI void phase_final_norm(const Params& p) {
    const float* g = p.in[I_NFIN]; float* X = p.out;
    const int lane = threadIdx.x & 63, w = threadIdx.x >> 6;
    for (int r = blockIdx.x * 8 + w; r < TL; r += gridDim.x * 8) {
        float4* xr = (float4*)(X + (size_t)r * DM); float4 v[4]; float ss = 0.f;
#pragma unroll
        for (int i = 0; i < 4; ++i) { v[i] = xr[lane + 64 * i]; ss += v[i].x * v[i].x + v[i].y * v[i].y + v[i].z * v[i].z + v[i].w * v[i].w; }
        ss = wave_sum(ss); const float rs = rsqrtf(ss * (1.f / 1024.f) + 1e-6f);
#pragma unroll
        for (int i = 0; i < 4; ++i) { const float4 gg = ((const float4*)g)[lane + 64 * i]; float4 o; o.x = v[i].x * rs * gg.x; o.y = v[i].y * rs * gg.y; o.z = v[i].z * rs * gg.z; o.w = v[i].w * rs * gg.w; xr[lane + 64 * i] = o; }
    }
}

constexpr int N_PHASES = 36;
template <int PH> DEVI void run_phase(const Params& p, char* lds) {
    const float* mods = (const float*)(p.ws + OFF_MODS);
    RowSrc in_src; in_src.ctx = p.in[I_CTX]; in_src.lat = p.in[I_X];
    RowSrc x_src; x_src.ctx = (const float*)(p.ws + OFF_XC); x_src.lat = p.out;
    if constexpr (PH == 0) phase_prologue(p, lds);
    else if constexpr (PH == 1) norm_rows(in_src, 0, T0, p.in[I_NMIX], mods, 0, 1, (u16*)(p.ws + A_N0));
    else if constexpr (PH == 2) phase_gemm_win(p, lds);
    else if constexpr (PH == 3) phase_gemm_qkv(p, lds);
    else if constexpr (PH == 4) phase_attention(p, lds);
    else if constexpr (PH == 5) phase_gemm_wo(p, (const u16*)(p.ws + A_N0), (const u16*)(p.ws + W_OA), in_src, 0, 0, lds);
    else if constexpr (PH == 6) phase_moe_route(p, 0, lds);
    else if constexpr (PH == 7) phase_moe_gemm1(p, 0, lds);
    else if constexpr (PH >= 8 && PH < 16) { if constexpr ((PH & 1) == 0) phase_moe_gemm2(p, 0, (PH - 8) >> 1, lds); else phase_moe_combine(p, 0, (PH - 8) >> 1, lds); }
    else if constexpr (PH == 16) norm_rows(x_src, 0, T0, p.in[I_NMIX] + 1024, mods + 9 * 6144, 0, 1, (u16*)(p.ws + R_NN));
    else if constexpr (PH == 17) phase_rwkv_mix(p, 0, 2, 3);
    else if constexpr (PH == 18) phase_rwkv_gemm_rkv(p, lds);
    else if constexpr (PH == 19) phase_rwkv_mix(p, 1, 4, 5);
    else if constexpr (PH == 20) phase_rwkv_gemm_small(p, lds);
    else if constexpr (PH == 21) phase_rwkv_gemm_g(p, lds);
    else if constexpr (PH == 22) phase_rwkv_scan(p, lds);
    else if constexpr (PH == 23) phase_rwkv_readout(p);
    else if constexpr (PH == 24) { phase_gemm_wo(p, (const u16*)(p.ws + R_RD), (const u16*)(p.ws + W_RO), x_src, 1, 1, lds); conv_jobs(p, 25, 28, 1, blockIdx.x, 0, lds); }
    else if constexpr (PH == 25) phase_moe_route(p, 1, lds);
    else if constexpr (PH == 26) phase_moe_gemm1(p, 1, lds);
    else if constexpr (PH >= 27 && PH < 35) { if constexpr (((PH - 27) & 1) == 0) phase_moe_gemm2(p, 1, (PH - 27) >> 1, lds); else phase_moe_combine(p, 1, (PH - 27) >> 1, lds); }
    else if constexpr (PH == 35) phase_final_norm(p);
}

#if MEGA
DEVI void moe_block(const Params& p, int layer, char* lds, const XcdBarrier& bar) {
    phase_moe_route(p, layer, lds); xcd_barrier(bar);
    phase_moe_gemm1(p, layer, lds); xcd_barrier(bar);
    for (int ch = 0; ch < NCHUNK; ++ch) {
        phase_moe_gemm2(p, layer, ch, lds); xcd_barrier(bar);
        phase_moe_combine(p, layer, ch, lds); xcd_barrier(bar);
    }
}
__global__ void __launch_bounds__(512, 2) k_mega(Params p) {
    extern __shared__ __attribute__((aligned(16))) char smem[];
    if (threadIdx.x == 0) *(uint4*)smem = make_uint4(0u, 0u, 0u, 0u);
    __syncthreads();
    const XcdBarrier bar = xcd_barrier_post((unsigned*)(p.ws + OFF_BAR), (volatile LAS unsigned*)smem);
    char* lds = smem + 64;
    run_phase<0>(p, lds); xcd_barrier(bar);
    run_phase<1>(p, lds); xcd_barrier(bar);
    run_phase<2>(p, lds); xcd_barrier(bar);
    run_phase<3>(p, lds); xcd_barrier(bar);
    run_phase<4>(p, lds); xcd_barrier(bar);
    run_phase<5>(p, lds); xcd_barrier(bar);
    moe_block(p, 0, lds, bar);
    run_phase<16>(p, lds); xcd_barrier(bar);
    run_phase<17>(p, lds); xcd_barrier(bar);
    run_phase<18>(p, lds); xcd_barrier(bar);
    run_phase<19>(p, lds); xcd_barrier(bar);
    run_phase<20>(p, lds); xcd_barrier(bar);
    run_phase<21>(p, lds); xcd_barrier(bar);
    run_phase<22>(p, lds); xcd_barrier(bar);
    run_phase<23>(p, lds); xcd_barrier(bar);
    run_phase<24>(p, lds); xcd_barrier(bar);
    moe_block(p, 1, lds, bar);
    run_phase<35>(p, lds);
}
extern "C" void kernel_launch(void* const* d_in, const int* in_sizes, int n_in, void* d_out, int out_size, void* d_ws, size_t ws_size, hipStream_t stream) {
    Params p{};
    for (int i = 0; i < N_IN; ++i) p.in[i] = (const float*)d_in[i];
    p.out = (float*)d_out; p.ws = (char*)d_ws;
    if (ws_size < WS_NEED) { fprintf(stderr, "workspace too small: %zu < %zu\n", ws_size, (size_t)WS_NEED); return; }
    static int grid = 0;
    if (!grid) {
        int dev = 0, cus = 0, per_cu = 0;
        (void)hipGetDevice(&dev);
        (void)hipDeviceGetAttribute(&cus, hipDeviceAttributeMultiprocessorCount, dev);
        (void)hipFuncSetAttribute((const void*)k_mega, hipFuncAttributeMaxDynamicSharedMemorySize, LDS_BYTES);
        (void)hipOccupancyMaxActiveBlocksPerMultiprocessor(&per_cu, (const void*)k_mega, 512, LDS_BYTES);
        if (per_cu < 1) { fprintf(stderr, "occupancy query says 0 blocks per CU\n"); per_cu = 1; }
        grid = cus;
    }
    (void)hipMemsetAsync(p.ws + OFF_BAR, 0, XCD_BAR_WORDS * sizeof(unsigned), stream);
    k_mega<<<grid, 512, LDS_BYTES, stream>>>(p);
}
#else
template <int PH> __global__ void __launch_bounds__(512, 2) k_phase(Params p) {
    extern __shared__ __attribute__((aligned(16))) char smem[];
    run_phase<PH>(p, smem + 64);
}
template <int PH> static void launch_phase(const Params& p, hipStream_t s) {
    static bool attr = false;
    if (!attr) { hipFuncSetAttribute((const void*)k_phase<PH>, hipFuncAttributeMaxDynamicSharedMemorySize, LDS_BYTES); attr = true; }
    k_phase<PH><<<256, 512, LDS_BYTES, s>>>(p);
}
template <int PH> static void launch_all(const Params& p, hipStream_t s) {
    launch_phase<PH>(p, s);
    if constexpr (PH + 1 < N_PHASES) launch_all<PH + 1>(p, s);
}

extern "C" void kernel_launch(void* const* d_in, const int* in_sizes, int n_in, void* d_out, int out_size, void* d_ws, size_t ws_size, hipStream_t stream) {
    Params p{};
    for (int i = 0; i < N_IN; ++i) p.in[i] = (const float*)d_in[i];
    p.out = (float*)d_out; p.ws = (char*)d_ws;
    if (ws_size < WS_NEED) { fprintf(stderr, "workspace too small: %zu < %zu\n", ws_size, (size_t)WS_NEED); return; }
    launch_all<0>(p, stream);
}
#endif
```

```cpp
#include <hip/hip_runtime.h>
#include <stdint.h>
#include <stdio.h>

#ifndef MEGA
#define MEGA 1
#endif

typedef unsigned short u16;
typedef short bf16x8 __attribute__((ext_vector_type(8)));
typedef short s16x4 __attribute__((ext_vector_type(4)));
typedef float f32x16 __attribute__((ext_vector_type(16)));
typedef float f32x4 __attribute__((ext_vector_type(4)));
typedef float f32x2 __attribute__((ext_vector_type(2)));
typedef unsigned u32x4 __attribute__((ext_vector_type(4)));
typedef __bf16 bf2 __attribute__((ext_vector_type(2)));
#define DEVI __device__ __forceinline__
#define LAS __attribute__((address_space(3)))

constexpr int NB = 8, SEQ = 4096, LC = 256, LT = 4352, DM = 1024, T0 = NB * LT, TL = NB * SEQ;
constexpr int NCHUNK = 4;
constexpr float LOG2E = 1.4426950408889634f;
constexpr float QA_SCALE = 0.07216878364870322f * LOG2E;
constexpr float QS_SCALE = 0.125f * LOG2E;

enum { I_X = 0, I_C, I_CTX, I_CCTX, I_ADAW, I_ADAB, I_NMIX, I_NFFN, I_NFIN, I_AWIN, I_AQN, I_AKVN, I_AWUQ, I_AWUKV, I_ASINK, I_AWO,
       I_RMU, I_RWR, I_RWK, I_RWV, I_RWO, I_RG1, I_RG2, I_RW0, I_RW1, I_RW2, I_RA0, I_RA1, I_RA2, I_RKK, I_RKA, I_RRK, I_RLNW, I_RLNB,
       I_MROUT, I_MBIAS, I_MWG, I_MWU, I_MWD, I_MSG, I_MSU, I_MSD, N_IN };

struct Params { const float* in[N_IN]; float* out; char* ws; };

constexpr size_t OFF_BAR = 0, OFF_CNT = 16384, OFF_ROPE = 20480, OFF_MODS = 32768, OFF_WSTAT = 524288;
constexpr size_t W_IN = OFF_WSTAT, W_UQ = W_IN + 3145728, W_UK = W_UQ + 589824, W_UV = W_UK + 262144, W_OA = W_UV + 262144,
                 W_RR = W_OA + 2097152, W_RK = W_RR + 2097152, W_RV = W_RK + 2097152, W_RO = W_RV + 2097152,
                 W_G1 = W_RO + 2097152, W_W1 = W_G1 + 262144, W_A1 = W_W1 + 262144, W_G2 = W_A1 + 262144, W_W2 = W_G2 + 262144, W_A2 = W_W2 + 262144,
                 W_SGU = W_A2 + 262144, W_SD = W_SGU + 2 * 1048576, W_END = W_SD + 2 * 524288;
constexpr size_t OFF_XC = OFF_WSTAT + 20971520;
constexpr size_t OFF_TOKE = OFF_XC + 8388608, OFF_TOKR = OFF_TOKE + 835584, OFF_LTOK = OFF_TOKR + 835584, OFF_LG = OFF_LTOK + 8912896;
constexpr size_t OFF_D = OFF_XC + 8388608 + 20971520;
constexpr size_t WGU_BYTES = 64ull * 512 * 1024 * 2, WD_BYTES = 64ull * 1024 * 256 * 2;
constexpr size_t OFF_WGU = OFF_D, OFF_WD = OFF_D + WGU_BYTES;
constexpr size_t OFF_G = OFF_D + WGU_BYTES + WD_BYTES;
constexpr size_t SZ_T0D = (size_t)T0 * 1024 * 2;
constexpr size_t A_N0 = OFF_G, A_CQ = A_N0 + SZ_T0D, A_CKV = A_CQ + (size_t)T0 * 384 * 2, A_QA = A_CKV + (size_t)T0 * 256 * 2, A_KA = A_QA + (size_t)T0 * 768 * 2,
                 A_VA = A_KA + (size_t)T0 * 768 * 2, A_QS = A_VA + (size_t)T0 * 512 * 2, A_KS = A_QS + (size_t)T0 * 512 * 2, A_VS = A_KS + (size_t)T0 * 128 * 2, A_END = A_VS + (size_t)T0 * 128 * 2;
constexpr size_t M_N1 = OFF_G, M_ACT = M_N1 + SZ_T0D, M_OUTR = M_ACT + (size_t)7 * T0 * 256 * 2, M_END = M_OUTR + (size_t)7 * 8704 * 1024 * 2;
constexpr size_t R_XM0 = OFF_D, R_XM1 = R_XM0 + SZ_T0D, R_XM2 = R_XM1 + SZ_T0D, R_RR = R_XM2 + SZ_T0D, R_RK = R_RR + SZ_T0D, R_RV = R_RK + SZ_T0D, R_NN = R_RV + SZ_T0D,
                 R_HG = R_NN + SZ_T0D, R_HW = R_HG + (size_t)T0 * 128 * 2, R_HA = R_HW + (size_t)T0 * 128 * 2, R_RKB = R_HA + (size_t)T0 * 128 * 2, R_END = R_RKB + (size_t)2 * T0 * 16 * 4;
constexpr size_t R_GG = R_XM0, R_YF = R_XM1, R_YB = R_XM2, R_RD = R_NN;
constexpr size_t WS_NEED = R_END;

constexpr int LDS_BYTES = 64 + 131072;

DEVI unsigned pack2(float a, float b) { f32x2 v = {a, b}; bf2 r = __builtin_convertvector(v, bf2); return __builtin_bit_cast(unsigned, r); }
DEVI float bf_lo(unsigned u) { return __builtin_bit_cast(float, u << 16); }
DEVI float bf_hi(unsigned u) { return __builtin_bit_cast(float, u & 0xffff0000u); }
DEVI float bf1(u16 u) { return __builtin_bit_cast(float, ((unsigned)u) << 16); }
DEVI float dppf(float x, const int ctrl_sel) {
    int xi = __builtin_bit_cast(int, x), y;
    if (ctrl_sel == 0) y = __builtin_amdgcn_mov_dpp(xi, 0xB1, 0xF, 0xF, true);
    else if (ctrl_sel == 1) y = __builtin_amdgcn_mov_dpp(xi, 0x4E, 0xF, 0xF, true);
    else y = __builtin_amdgcn_mov_dpp(xi, 0x141, 0xF, 0xF, true);
    return __builtin_bit_cast(float, y);
}
DEVI float red8_sum(float x) { x += dppf(x, 0); x += dppf(x, 1); x += dppf(x, 2); return x; }
DEVI float red8_max(float x) { x = fmaxf(x, dppf(x, 0)); x = fmaxf(x, dppf(x, 1)); x = fmaxf(x, dppf(x, 2)); return x; }
DEVI float red4_sum(float x) { x += dppf(x, 0); x += dppf(x, 1); return x; }
DEVI float wave_sum(float x) { for (int o = 32; o > 0; o >>= 1) x += __shfl_xor(x, o); return x; }
DEVI float wave_max(float x) { for (int o = 32; o > 0; o >>= 1) x = fmaxf(x, __shfl_xor(x, o)); return x; }
DEVI float sigmoidf_(float x) { return 1.f / (1.f + __expf(-x)); }
DEVI float siluf_(float x) { return x / (1.f + __expf(-x)); }
DEVI float tanhf_(float x) { float e = __expf(2.f * x); return 1.f - 2.f / (e + 1.f); }

#define XB_TMO      128
#define XB_XCNT(j)  (256  + 64 * (j))
#define XB_XSUB(j)  (1280 + 64 * (j))
#define XB_XGEN(j)  (2304 + 64 * (j))
#define XB_TOP      3328
#define XB_TOPGEN   3392
#define XCD_BAR_WORDS 3456
#define XB_SPIN_CAP (1u << 20)
DEVI unsigned xb_ld(unsigned* p)              { return __hip_atomic_load(p, __ATOMIC_RELAXED, __HIP_MEMORY_SCOPE_AGENT); }
DEVI unsigned xb_add(unsigned* p, unsigned v) { return __hip_atomic_fetch_add(p, v, __ATOMIC_RELAXED, __HIP_MEMORY_SCOPE_AGENT); }
DEVI unsigned xb_xcc_id() { return (unsigned)__builtin_amdgcn_s_getreg((3 << 11) | 20) & 0xFu; }
#define XB_SPIN(cond, bar) do { unsigned _sp = 0; while (cond) { __builtin_amdgcn_s_sleep(1); \
    if ((++_sp & 255u) == 0u) { if (xb_ld(&(bar)[XB_TMO])) break; if (_sp > XB_SPIN_CAP) { atomicAdd(&(bar)[XB_TMO], 1u); break; } } } } while (0)
struct XcdBarrier { unsigned* bar; unsigned x; volatile LAS unsigned* st; };
DEVI XcdBarrier xcd_barrier_post(unsigned* bar, volatile LAS unsigned* st) {
    XcdBarrier b; b.bar = bar; b.x = xb_xcc_id(); b.st = st;
    if (threadIdx.x == 0) (void)xb_add(&bar[XB_XCNT(b.x)], 1u);
    return b;
}
DEVI void xcd_barrier_complete(unsigned* bar, unsigned x, unsigned& nloc, unsigned& nx) {
    const unsigned G = gridDim.x * gridDim.y * gridDim.z;
    unsigned sum, cnt, mine, sp = 0u;
    for (;;) {
        sum = 0u; cnt = 0u; mine = 0u;
#pragma unroll
        for (unsigned j = 0; j < 16; ++j) { const unsigned c = xb_ld(&bar[XB_XCNT(j)]); sum += c; cnt += (c > 0u) ? 1u : 0u; mine = (j == x) ? c : mine; }
        if (sum == G) break;
        __builtin_amdgcn_s_sleep(1);
        if ((++sp & 255u) == 0u) { if (xb_ld(&bar[XB_TMO])) break; if (sp > XB_SPIN_CAP) { atomicAdd(&bar[XB_TMO], 1u); break; } }
    }
    nloc = mine > 0u ? mine : 1u; nx = cnt > 0u ? cnt : 1u;
}
DEVI void xcd_barrier(const XcdBarrier& b) {
    asm volatile("s_waitcnt vmcnt(0)" ::: "memory");
    __syncthreads();
    if (threadIdx.x == 0) {
        unsigned* bar = b.bar;
        __builtin_amdgcn_s_waitcnt(0);
        unsigned nloc = b.st[0], nx = b.st[1];
        if (nloc == 0u) { xcd_barrier_complete(bar, b.x, nloc, nx); b.st[0] = nloc; b.st[1] = nx; }
        const unsigned old = xb_add(&bar[XB_XSUB(b.x)], 1u);
        const unsigned gen = old / nloc;
        if (old + 1u == (gen + 1u) * nloc) {
            __builtin_amdgcn_fence(__ATOMIC_RELEASE, "agent");
            asm volatile("s_waitcnt vmcnt(0)" ::: "memory");
            const unsigned og = xb_add(&bar[XB_TOP], 1u);
            const unsigned tg = og / nx;
            if (og + 1u == (tg + 1u) * nx) xb_add(&bar[XB_TOPGEN], 1u);
            else XB_SPIN(xb_ld(&bar[XB_TOPGEN]) == tg, bar);
            __builtin_amdgcn_fence(__ATOMIC_ACQUIRE, "agent");
            xb_add(&bar[XB_XGEN(b.x)], 1u);
            asm volatile("s_waitcnt vmcnt(0)" ::: "memory");
        } else {
            XB_SPIN(xb_ld(&bar[XB_XGEN(b.x)]) == gen, bar);
            __builtin_amdgcn_fence(__ATOMIC_ACQUIRE, "agent");
            asm volatile("s_waitcnt vmcnt(0)" ::: "memory");
        }
    }
    __syncthreads();
}

struct RowSrc { const float* ctx; const float* lat; };
DEVI const float* row_ptr(const RowSrc& s, int mode, int r, int& bb) {
    if (mode == 0) { int b = r / LT, pp = r - b * LT; if (pp < LC) { bb = 8; return s.ctx + (size_t)(b * LC + pp) * DM; } bb = b; return s.lat + (size_t)(b * SEQ + pp - LC) * DM; }
    bb = r >> 12; return s.lat + (size_t)r * DM;
}
DEVI float* row_ptr_w(float* ctx, float* lat, int mode, int r, int& bb) {
    if (mode == 0) { int b = r / LT, pp = r - b * LT; if (pp < LC) { bb = 8; return ctx + (size_t)(b * LC + pp) * DM; } bb = b; return lat + (size_t)(b * SEQ + pp - LC) * DM; }
    bb = r >> 12; return lat + (size_t)r * DM;
}

DEVI float sumsq8(const bf16x8& v) {
    float s = 0.f;
    const unsigned* u = (const unsigned*)&v;
#pragma unroll
    for (int i = 0; i < 4; ++i) { bf2 b = __builtin_bit_cast(bf2, u[i]); s = __builtin_amdgcn_fdot2_f32_bf16(b, b, s, false); }
    return s;
}
template <int BM, int BN, bool ROWNORM, class ARow, class Epi>
DEVI void gemm_tile(ARow arow, const u16* __restrict__ Bt, int ldb, int K, Epi epi, char* lds) {
    constexpr int WN = BN / 64, NA = BM / 64, NBC = BN / 64, STR = 72;
    const int tid = threadIdx.x, lane = tid & 63, w = tid >> 6, wm = w / WN, wn = w % WN, l31 = lane & 31, h = lane >> 5;
    u16* sA = (u16*)lds; u16* sB = sA + 2 * BM * STR;
    const int crow = tid >> 3, kc = tid & 7;
    const u16* pa[NA]; const u16* pb[NBC];
#pragma unroll
    for (int i = 0; i < NA; ++i) pa[i] = arow(crow + 64 * i) + kc * 8;
#pragma unroll
    for (int i = 0; i < NBC; ++i) pb[i] = Bt + (size_t)(crow + 64 * i) * ldb + kc * 8;
    u32x4 ra[NA], rb[NBC];
#pragma unroll
    for (int i = 0; i < NA; ++i) ra[i] = *(const u32x4*)pa[i];
#pragma unroll
    for (int i = 0; i < NBC; ++i) rb[i] = *(const u32x4*)pb[i];
    f32x16 acc[2][2];
#pragma unroll
    for (int a = 0; a < 2; ++a)
#pragma unroll
        for (int b = 0; b < 2; ++b)
#pragma unroll
            for (int i = 0; i < 16; ++i) acc[a][b][i] = 0.f;
    float ss[2] = {0.f, 0.f};
    const int nk = K >> 6;
    for (int kt = 0; kt < nk; ++kt) {
        u16* a_ = sA + (kt & 1) * BM * STR; u16* b_ = sB + (kt & 1) * BN * STR;
#pragma unroll
        for (int i = 0; i < NA; ++i) *(u32x4*)(a_ + (crow + 64 * i) * STR + kc * 8) = ra[i];
#pragma unroll
        for (int i = 0; i < NBC; ++i) *(u32x4*)(b_ + (crow + 64 * i) * STR + kc * 8) = rb[i];
        __syncthreads();
        {
            const int kn = (kt + 1 < nk) ? kt + 1 : kt;
#pragma unroll
            for (int i = 0; i < NA; ++i) ra[i] = *(const u32x4*)(pa[i] + kn * 64);
#pragma unroll
            for (int i = 0; i < NBC; ++i) rb[i] = *(const u32x4*)(pb[i] + kn * 64);
        }
#pragma unroll
        for (int ks = 0; ks < 4; ++ks) {
            bf16x8 af[2], bfr[2];
#pragma unroll
            for (int mi = 0; mi < 2; ++mi) af[mi] = *(const bf16x8*)(a_ + (wm * 64 + mi * 32 + l31) * STR + ks * 16 + h * 8);
#pragma unroll
            for (int ni = 0; ni < 2; ++ni) bfr[ni] = *(const bf16x8*)(b_ + (wn * 64 + ni * 32 + l31) * STR + ks * 16 + h * 8);
            if (ROWNORM) { ss[0] += sumsq8(af[0]); ss[1] += sumsq8(af[1]); }
#pragma unroll
            for (int mi = 0; mi < 2; ++mi)
#pragma unroll
                for (int ni = 0; ni < 2; ++ni) acc[mi][ni] = __builtin_amdgcn_mfma_f32_32x32x16_bf16(bfr[ni], af[mi], acc[mi][ni], 0, 0, 0);
        }
    }
    if (ROWNORM) {
#pragma unroll
        for (int mi = 0; mi < 2; ++mi) {
            float s = ss[mi] + __shfl_xor(ss[mi], 32);
            float r = rsqrtf(s / (float)K + 1e-6f);
#pragma unroll
            for (int ni = 0; ni < 2; ++ni)
#pragma unroll
                for (int i = 0; i < 16; ++i) acc[mi][ni][i] *= r;
        }
    }
#pragma unroll
    for (int mi = 0; mi < 2; ++mi) epi(wm * 64 + mi * 32 + l31, wn * 64, acc[mi], h);
    __syncthreads();
}
DEVI void store_tile_bf16(u16* dst, const f32x16& t, int h) {
#pragma unroll
    for (int g = 0; g < 4; ++g) { uint2 v; v.x = pack2(t[4 * g], t[4 * g + 1]); v.y = pack2(t[4 * g + 2], t[4 * g + 3]); *(uint2*)(dst + 8 * g + 4 * h) = v; }
}
DEVI void rope_tile(f32x16& t, int axis, int pp, int h, const float2* __restrict__ tab) {
    if (pp < LC) return;
    const int s = pp - LC; const int coord = axis ? (s & 63) : (s >> 6);
#pragma unroll
    for (int g = 0; g < 2; ++g)
#pragma unroll
        for (int i = 0; i < 4; ++i) {
            const float2 cs = tab[coord * 16 + 8 * g + 4 * h + i];
            const float x1 = t[4 * g + i], x2 = t[4 * (g + 2) + i];
            t[4 * g + i] = x1 * cs.x - x2 * cs.y; t[4 * (g + 2) + i] = x2 * cs.x + x1 * cs.y;
        }
}

struct CJob { const float* src; u16* dst; const float* gain; int K, ldsrc, nlog, nvalid, sseg, sstride, soff, dseg, dstride, doff; int nmat; size_t smat, dmat; };
DEVI void get_job(const Params& p, int j, int layer, CJob& J) {
    char* ws = p.ws;
    J.gain = nullptr; J.nmat = 1; J.smat = 0; J.dmat = 0; J.sseg = 1 << 30; J.sstride = 0; J.soff = 0; J.dseg = 1 << 30; J.dstride = 0; J.doff = 0;
    auto plain = [&](const float* src, size_t dstoff, int K, int N) { J.src = src; J.dst = (u16*)(ws + dstoff); J.K = K; J.ldsrc = N; J.nlog = N; J.nvalid = N; };
    switch (j) {
    case 0: plain(p.in[I_AWIN], W_IN, 1024, 1472); J.nlog = 1536; break;
    case 1: plain(p.in[I_AWUQ], W_UQ, 384, 768); J.gain = p.in[I_AQN]; break;
    case 2: plain(p.in[I_AWUKV], W_UK, 256, 1024); J.nlog = 512; J.nvalid = 512; J.sseg = 128; J.sstride = 256; J.soff = 0; J.gain = p.in[I_AKVN]; break;
    case 3: plain(p.in[I_AWUKV], W_UV, 256, 1024); J.nlog = 512; J.nvalid = 512; J.sseg = 128; J.sstride = 256; J.soff = 128; J.gain = p.in[I_AKVN]; break;
    case 4: plain(p.in[I_AWO], W_OA, 1024, 1024); break;
    case 5: plain(p.in[I_RWR], W_RR, 1024, 1024); break;
    case 6: plain(p.in[I_RWK], W_RK, 1024, 1024); break;
    case 7: plain(p.in[I_RWV], W_RV, 1024, 1024); break;
    case 8: plain(p.in[I_RWO], W_RO, 1024, 1024); break;
    case 9: plain(p.in[I_RG1], W_G1, 1024, 128); break;
    case 10: plain(p.in[I_RW1], W_W1, 1024, 64); break;
    case 11: plain(p.in[I_RW1] + 1024 * 64, W_W1 + 64 * 1024 * 2, 1024, 64); break;
    case 12: plain(p.in[I_RA1], W_A1, 1024, 64); break;
    case 13: plain(p.in[I_RA1] + 1024 * 64, W_A1 + 64 * 1024 * 2, 1024, 64); break;
    case 14: plain(p.in[I_RG2], W_G2, 128, 1024); break;
    case 15: plain(p.in[I_RW2], W_W2, 64, 1024); break;
    case 16: plain(p.in[I_RW2] + 64 * 1024, W_W2 + 1024 * 64 * 2, 64, 1024); break;
    case 17: plain(p.in[I_RA2], W_A2, 64, 1024); break;
    case 18: plain(p.in[I_RA2] + 64 * 1024, W_A2 + 1024 * 64 * 2, 64, 1024); break;
    case 19: plain(p.in[I_MSG], W_SGU, 1024, 256); J.dseg = 32; J.dstride = 64; J.doff = 0; break;
    case 20: plain(p.in[I_MSU], W_SGU, 1024, 256); J.dseg = 32; J.dstride = 64; J.doff = 32; break;
    case 21: plain(p.in[I_MSG] + 1024 * 256, W_SGU + 1048576, 1024, 256); J.dseg = 32; J.dstride = 64; J.doff = 0; break;
    case 22: plain(p.in[I_MSU] + 1024 * 256, W_SGU + 1048576, 1024, 256); J.dseg = 32; J.dstride = 64; J.doff = 32; break;
    case 23: plain(p.in[I_MSD], W_SD, 256, 1024); break;
    case 24: plain(p.in[I_MSD] + 256 * 1024, W_SD + 524288, 256, 1024); break;
    case 25: plain(p.in[I_MWG] + (size_t)layer * 64 * 1024 * 256, OFF_WGU, 1024, 256); J.dseg = 32; J.dstride = 64; J.doff = 0; J.nmat = 64; J.smat = 1024 * 256; J.dmat = 512 * 1024; break;
    case 26: plain(p.in[I_MWU] + (size_t)layer * 64 * 1024 * 256, OFF_WGU, 1024, 256); J.dseg = 32; J.dstride = 64; J.doff = 32; J.nmat = 64; J.smat = 1024 * 256; J.dmat = 512 * 1024; break;
    default: plain(p.in[I_MWD] + (size_t)layer * 64 * 256 * 1024, OFF_WD, 256, 1024); J.nmat = 64; J.smat = 256 * 1024; J.dmat = 1024 * 256; break;
    }
}
DEVI int job_tiles(const CJob& J) { return J.nmat * (J.nlog / 64) * ((J.K + 127) / 128); }
DEVI void conv_tile(const CJob& J, int t, char* lds) {
    const int ktiles = (J.K + 127) / 128, ntiles = J.nlog / 64;
    const int mat = t / (ktiles * ntiles); const int r = t - mat * ktiles * ntiles; const int nt = r / ktiles, ktile = r - nt * ktiles;
    const float* src = J.src + (size_t)mat * J.smat; u16* dst = J.dst + (size_t)mat * J.dmat;
    unsigned* sm = (unsigned*)lds;
    const int tid = threadIdx.x, ng = tid & 15, kp = tid >> 4;
    const int n0 = nt * 64 + ng * 4;
    const int scol = (n0 / J.sseg) * J.sstride + J.soff + (n0 % J.sseg);
    const bool nval = n0 < J.nvalid;
#pragma unroll
    for (int pass = 0; pass < 2; ++pass) {
        const int k = ktile * 128 + pass * 64 + kp * 2;
        float4 v0 = make_float4(0.f, 0.f, 0.f, 0.f), v1 = v0;
        if (nval && k < J.K) {
            v0 = *(const float4*)(src + (size_t)k * J.ldsrc + scol); v1 = *(const float4*)(src + (size_t)(k + 1) * J.ldsrc + scol);
            if (J.gain) { const float g0 = J.gain[k], g1 = J.gain[k + 1]; v0.x *= g0; v0.y *= g0; v0.z *= g0; v0.w *= g0; v1.x *= g1; v1.y *= g1; v1.z *= g1; v1.w *= g1; }
        }
        const int kk = pass * 32 + kp;
        sm[(ng * 4 + 0) * 66 + kk] = pack2(v0.x, v1.x); sm[(ng * 4 + 1) * 66 + kk] = pack2(v0.y, v1.y);
        sm[(ng * 4 + 2) * 66 + kk] = pack2(v0.z, v1.z); sm[(ng * 4 + 3) * 66 + kk] = pack2(v0.w, v1.w);
    }
    __syncthreads();
#pragma unroll
    for (int i = 0; i < 2; ++i) {
        const int c = tid + 512 * i, row = c >> 4, ch = c & 15;
        const int n = nt * 64 + row; const int drow = (n / J.dseg) * J.dstride + J.doff + (n % J.dseg);
        const int k = ktile * 128 + ch * 8;
        if (k < J.K) { uint2 lo = *(const uint2*)(sm + row * 66 + ch * 4), hi = *(const uint2*)(sm + row * 66 + ch * 4 + 2); uint4 v = make_uint4(lo.x, lo.y, hi.x, hi.y); *(uint4*)(dst + (size_t)drow * J.K + k) = v; }
    }
    __syncthreads();
}
DEVI void conv_jobs(const Params& p, int jlo, int jhi, int layer, int unit_base, char* lds) {
    const int G = gridDim.x, bid = blockIdx.x;
    int acc = unit_base;
    for (int j = jlo; j < jhi; ++j) {
        CJob J; get_job(p, j, layer, J); const int n = job_tiles(J);
        const int t0 = (bid - (acc % G) + G) % G;
        for (int t = t0; t < n; t += G) conv_tile(J, t, lds);
        acc += n;
    }
}
DEVI void mods_unit(const Params& p, int u, char* lds) {
    const int l = u / 96, cg = u % 96;
    float* sil = (float*)lds;
    float* red = sil + 1024 * 12;
    const int tid = threadIdx.x, lane = tid & 63, w = tid >> 6;
    for (int i = tid; i < 9 * 1024; i += 512) { const int bb = i >> 10, k = i & 1023; const float v = bb < 8 ? p.in[I_C][bb * 1024 + k] : p.in[I_CCTX][k]; sil[k * 12 + bb] = siluf_(v); }
    __syncthreads();
    float acc[9];
#pragma unroll
    for (int i = 0; i < 9; ++i) acc[i] = 0.f;
    const float* wp = p.in[I_ADAW] + (size_t)l * 1024 * 6144 + cg * 64 + lane;
#pragma unroll 4
    for (int kk = 0; kk < 128; ++kk) {
        const int k = w * 128 + kk; const float wv = wp[(size_t)k * 6144];
        const float4 s0 = *(const float4*)(sil + k * 12), s1 = *(const float4*)(sil + k * 12 + 4); const float s2 = sil[k * 12 + 8];
        acc[0] += s0.x * wv; acc[1] += s0.y * wv; acc[2] += s0.z * wv; acc[3] += s0.w * wv; acc[4] += s1.x * wv; acc[5] += s1.y * wv; acc[6] += s1.z * wv; acc[7] += s1.w * wv; acc[8] += s2 * wv;
    }
#pragma unroll
    for (int i = 0; i < 9; ++i) red[(w * 9 + i) * 64 + lane] = acc[i];
    __syncthreads();
    for (int i = tid; i < 9 * 64; i += 512) {
        const int bb = i >> 6, c = i & 63; float s = 0.f;
        for (int ww = 0; ww < 8; ++ww) s += red[(ww * 9 + bb) * 64 + c];
        const int col = cg * 64 + c;
        ((float*)(p.ws + OFF_MODS))[(size_t)(l * 9 + bb) * 6144 + col] = s + p.in[I_ADAB][l * 6144 + col];
    }
    __syncthreads();
}
DEVI void phase_prologue(const Params& p, char* lds) {
    const int bid = blockIdx.x, G = gridDim.x;
    if (bid == G - 1) {
        int* cnt = (int*)(p.ws + OFF_CNT);
        for (int i = threadIdx.x; i < 2 * NCHUNK * 64; i += 512) cnt[i] = 0;
        float2* tab = (float2*)(p.ws + OFF_ROPE);
        for (int i = threadIdx.x; i < 64 * 16; i += 512) { const int coord = i >> 4, f = i & 15; const float inv = exp2f(-(float)f * (13.287712379549449f / 16.f)); const float a = (float)coord * inv; tab[i] = make_float2(cosf(a), sinf(a)); }
    }
    for (int u = bid; u < 192; u += G) mods_unit(p, u, lds);
    conv_jobs(p, 0, 25, 0, 192, lds);
}

DEVI void norm_rows(const RowSrc& src, int mode, int nrows, const float* __restrict__ gain, const float* __restrict__ mods_l, int ishift, int iscale, u16* __restrict__ dst) {
    const int lane = threadIdx.x & 63, w = threadIdx.x >> 6;
    for (int r = blockIdx.x * 8 + w; r < nrows; r += gridDim.x * 8) {
        int bb; const float* xr = row_ptr(src, mode, r, bb);
        float4 v[4]; float ss = 0.f;
#pragma unroll
        for (int i = 0; i < 4; ++i) { v[i] = ((const float4*)xr)[lane + 64 * i]; ss += v[i].x * v[i].x + v[i].y * v[i].y + v[i].z * v[i].z + v[i].w * v[i].w; }
        ss = wave_sum(ss);
        const float rs = rsqrtf(ss * (1.f / 1024.f) + 1e-6f);
        const float* msh = mods_l + (size_t)bb * 6144 + ishift * 1024; const float* msc = mods_l + (size_t)bb * 6144 + iscale * 1024;
#pragma unroll
        for (int i = 0; i < 4; ++i) {
            const int c = (lane + 64 * i) * 4;
            const float4 g = *(const float4*)(gain + c), sh = *(const float4*)(msh + c), sc = *(const float4*)(msc + c);
            uint2 o; o.x = pack2(v[i].x * rs * g.x * (1.f + sc.x) + sh.x, v[i].y * rs * g.y * (1.f + sc.y) + sh.y);
            o.y = pack2(v[i].z * rs * g.z * (1.f + sc.z) + sh.z, v[i].w * rs * g.w * (1.f + sc.w) + sh.w);
            *(uint2*)(dst + (size_t)r * DM + c) = o;
        }
    }
}

DEVI void phase_gemm_win(const Params& p, char* lds) {
    const u16* A = (const u16*)(p.ws + A_N0); const u16* W = (const u16*)(p.ws + W_IN);
    u16* CQ = (u16*)(p.ws + A_CQ); u16* CKV = (u16*)(p.ws + A_CKV); u16* KA = (u16*)(p.ws + A_KA); u16* QS = (u16*)(p.ws + A_QS); u16* KS = (u16*)(p.ws + A_KS); u16* VS = (u16*)(p.ws + A_VS);
    const float2* tab = (const float2*)(p.ws + OFF_ROPE);
    const int NT = 12, MT = T0 / 256;
    for (int u = blockIdx.x; u < NT * MT; u += gridDim.x) {
        const int mt = u / NT, nt = u % NT; const int m0 = mt * 256, n0 = nt * 128;
        auto arow = [&](int r) { return A + (size_t)(m0 + r) * DM; };
        auto epi = [&](int r, int cw, f32x16 (&t)[2], int h) {
            const int row = m0 + r; const int b = row / LT, pp = row - b * LT;
#pragma unroll
            for (int ni = 0; ni < 2; ++ni) {
                const int c32 = n0 + cw + ni * 32;
                if (c32 < 384) store_tile_bf16(CQ + (size_t)row * 384 + c32, t[ni], h);
                else if (c32 < 640) store_tile_bf16(CKV + (size_t)row * 256 + (c32 - 384), t[ni], h);
                else if (c32 < 704) { const int cc = c32 - 640; rope_tile(t[ni], cc >> 5, pp, h, tab);
                    for (int hd = 0; hd < 4; ++hd) store_tile_bf16(KA + ((size_t)(b * 4 + hd) * LT + pp) * 192 + 128 + cc, t[ni], h); }
                else if (c32 < 1216) { const int cc = c32 - 704; rope_tile(t[ni], (cc >> 5) & 1, pp, h, tab);
#pragma unroll
                    for (int i = 0; i < 16; ++i) t[ni][i] *= QS_SCALE;
                    store_tile_bf16(QS + ((size_t)(b * 8 + (cc >> 6)) * LT + pp) * 64 + (cc & 63), t[ni], h); }
                else if (c32 < 1344) { const int cc = c32 - 1216; rope_tile(t[ni], (cc >> 5) & 1, pp, h, tab);
                    store_tile_bf16(KS + ((size_t)(b * 2 + (cc >> 6)) * LT + pp) * 64 + (cc & 63), t[ni], h); }
                else if (c32 < 1472) { const int cc = c32 - 1344; store_tile_bf16(VS + ((size_t)(b * 2 + (cc >> 6)) * LT + pp) * 64 + (cc & 63), t[ni], h); }
            }
        };
        gemm_tile<256, 128, false>(arow, W + (size_t)n0 * DM, DM, DM, epi, lds);
    }
}
DEVI void phase_gemm_qkv(const Params& p, char* lds) {
    const u16* CQ = (const u16*)(p.ws + A_CQ); const u16* CKV = (const u16*)(p.ws + A_CKV);
    u16* QA = (u16*)(p.ws + A_QA); u16* KA = (u16*)(p.ws + A_KA); u16* VA = (u16*)(p.ws + A_VA);
    const float2* tab = (const float2*)(p.ws + OFF_ROPE);
    const int MT = T0 / 256;
    for (int u = blockIdx.x; u < 14 * MT; u += gridDim.x) {
        const int mt = u / 14, j = u % 14; const int m0 = mt * 256;
        if (j < 6) {
            const int n0 = j * 128;
            auto arow = [&](int r) { return CQ + (size_t)(m0 + r) * 384; };
            auto epi = [&](int r, int cw, f32x16 (&t)[2], int h) {
                const int row = m0 + r; const int b = row / LT, pp = row - b * LT;
#pragma unroll
                for (int ni = 0; ni < 2; ++ni) {
                    const int c32 = n0 + cw + ni * 32; const int hd = c32 / 192, wi = c32 - hd * 192;
                    if (wi >= 128) rope_tile(t[ni], (wi - 128) >> 5, pp, h, tab);
#pragma unroll
                    for (int i = 0; i < 16; ++i) t[ni][i] *= QA_SCALE;
                    store_tile_bf16(QA + ((size_t)(b * 4 + hd) * LT + pp) * 192 + wi, t[ni], h);
                }
            };
            gemm_tile<256, 128, true>(arow, (const u16*)(p.ws + W_UQ) + (size_t)n0 * 384, 384, 384, epi, lds);
        } else {
            const bool isv = j >= 10; const int n0 = (isv ? j - 10 : j - 6) * 128;
            auto arow = [&](int r) { return CKV + (size_t)(m0 + r) * 256; };
            auto epi = [&](int r, int cw, f32x16 (&t)[2], int h) {
                const int row = m0 + r; const int b = row / LT, pp = row - b * LT;
#pragma unroll
                for (int ni = 0; ni < 2; ++ni) {
                    const int c32 = n0 + cw + ni * 32; const int hd = c32 >> 7, wi = c32 & 127;
                    if (isv) store_tile_bf16(VA + ((size_t)(b * 4 + hd) * LT + pp) * 128 + wi, t[ni], h);
                    else store_tile_bf16(KA + ((size_t)(b * 4 + hd) * LT + pp) * 192 + wi, t[ni], h);
                }
            };
            gemm_tile<256, 128, true>(arow, (const u16*)(p.ws + (isv ? W_UV : W_UK)) + (size_t)n0 * 256, 256, 256, epi, lds);
        }
    }
}

template <int DQK, int DV, bool SWA>
DEVI void attn_unit(const u16* __restrict__ Q, const u16* __restrict__ Kp, const u16* __restrict__ Vp, int q0, int a0, int na, int b0, int nb2,
                    float m_init, u16* __restrict__ outp  , char* lds) {
    constexpr int KSTR = DQK + 8, VSTR = DV + 32, KCH = DQK / 8, VCH = DV / 8, NKC = 64 * KCH / 512, NVC = 64 * VCH / 512, NS = DQK / 16, NDT = DV / 32;
    const int tid = threadIdx.x, lane = tid & 63, w = tid >> 6, l31 = lane & 31, h = lane >> 5;
    u16* sK = (u16*)lds; u16* sV = sK + 2 * 64 * KSTR;
    const int qpos = q0 + w * 32 + l31;
    bf16x8 qf[NS];
#pragma unroll
    for (int s = 0; s < NS; ++s) qf[s] = *(const bf16x8*)(Q + (size_t)qpos * DQK + s * 16 + h * 8);
    f32x16 o[NDT];
#pragma unroll
    for (int d = 0; d < NDT; ++d)
#pragma unroll
        for (int i = 0; i < 16; ++i) o[d][i] = 0.f;
    float m = m_init, lsum = 0.f;
    const int nt = na + nb2;
    u32x4 rk[NKC], rv[NVC];
    auto tile_pos = [&](int t) { return t < na ? a0 + 64 * t : b0 + 64 * (t - na); };
    auto gload = [&](int t) {
        const int kp0 = tile_pos(t);
        const u16* kb_ = Kp + (size_t)kp0 * DQK + tid * 8; const u16* vb_ = Vp + (size_t)kp0 * DV + tid * 8;
#pragma unroll
        for (int i = 0; i < NKC; ++i) rk[i] = *(const u32x4*)(kb_ + 4096 * i);
#pragma unroll
        for (int i = 0; i < NVC; ++i) rv[i] = *(const u32x4*)(vb_ + 4096 * i);
    };
    gload(0);
    const int tr_row = 4 * h + ((lane & 15) >> 2), tr_col = 16 * ((lane >> 4) & 1) + 4 * (lane & 3);
    for (int t = 0; t < nt; ++t) {
        u16* k_ = sK + (t & 1) * 64 * KSTR; u16* v_ = sV + (t & 1) * 64 * VSTR;
#pragma unroll
        for (int i = 0; i < NKC; ++i) { const int c = tid + 512 * i, row = c / KCH, ch = c % KCH; *(u32x4*)(k_ + row * KSTR + ch * 8) = rk[i]; }
#pragma unroll
        for (int i = 0; i < NVC; ++i) { const int c = tid + 512 * i, row = c / VCH, ch = c % VCH; *(u32x4*)(v_ + row * VSTR + ch * 8) = rv[i]; }
        __syncthreads();
        if (t + 1 < nt) gload(t + 1);
        f32x16 st[2];
#pragma unroll
        for (int k2 = 0; k2 < 2; ++k2) {
#pragma unroll
            for (int i = 0; i < 16; ++i) st[k2][i] = 0.f;
#pragma unroll
            for (int s = 0; s < NS; ++s) {
                const bf16x8 kf = *(const bf16x8*)(k_ + (k2 * 32 + l31) * KSTR + s * 16 + h * 8);
                st[k2] = __builtin_amdgcn_mfma_f32_32x32x16_bf16(kf, qf[s], st[k2], 0, 0, 0);
            }
        }
        if (SWA && t >= na) {
            const int kp0 = tile_pos(t);
#pragma unroll
            for (int k2 = 0; k2 < 2; ++k2)
#pragma unroll
                for (int i = 0; i < 16; ++i) {
                    const int key = kp0 + k2 * 32 + (i & 3) + 8 * (i >> 2) + 4 * h; const int d = qpos - key;
                    if (d > 128 || d < -128) st[k2][i] = -1e30f;
                }
        }
        float mx = st[0][0];
#pragma unroll
        for (int k2 = 0; k2 < 2; ++k2)
#pragma unroll
            for (int i = 0; i < 16; ++i) mx = fmaxf(mx, st[k2][i]);
        mx = fmaxf(mx, __shfl_xor(mx, 32));
        const float mn = fmaxf(m, mx); const float alpha = __builtin_amdgcn_exp2f(m - mn); m = mn;
        float ps = 0.f;
#pragma unroll
        for (int k2 = 0; k2 < 2; ++k2)
#pragma unroll
            for (int i = 0; i < 16; ++i) { const float pv = __builtin_amdgcn_exp2f(st[k2][i] - mn); st[k2][i] = pv; ps += pv; }
        lsum = lsum * alpha + ps;
#pragma unroll
        for (int d = 0; d < NDT; ++d)
#pragma unroll
            for (int i = 0; i < 16; ++i) o[d][i] *= alpha;
#pragma unroll
        for (int s16 = 0; s16 < 4; ++s16) {
            bf16x8 pf; unsigned* pu = (unsigned*)&pf;
#pragma unroll
            for (int jj = 0; jj < 4; ++jj) pu[jj] = pack2(st[s16 >> 1][8 * (s16 & 1) + 2 * jj], st[s16 >> 1][8 * (s16 & 1) + 2 * jj + 1]);
#pragma unroll
            for (int d = 0; d < NDT; ++d) {
                const u16* base = v_ + (16 * s16 + tr_row) * VSTR + d * 32 + tr_col;
                const s16x4 lo = __builtin_amdgcn_ds_read_tr16_b64_v4i16((LAS s16x4*)(base));
                const s16x4 hi = __builtin_amdgcn_ds_read_tr16_b64_v4i16((LAS s16x4*)(base + 8 * VSTR));
                bf16x8 vf; vf[0] = lo[0]; vf[1] = lo[1]; vf[2] = lo[2]; vf[3] = lo[3]; vf[4] = hi[0]; vf[5] = hi[1]; vf[6] = hi[2]; vf[7] = hi[3];
                o[d] = __builtin_amdgcn_mfma_f32_32x32x16_bf16(vf, pf, o[d], 0, 0, 0);
            }
        }
    }
    float lt = lsum + __shfl_xor(lsum, 32);
    if (SWA) lt += __builtin_amdgcn_exp2f(m_init - m);
    const float inv = 1.f / lt;
    u16* orow = outp + (size_t)qpos * DM;
#pragma unroll
    for (int d = 0; d < NDT; ++d)
#pragma unroll
        for (int g = 0; g < 4; ++g) { uint2 v; v.x = pack2(o[d][4 * g] * inv, o[d][4 * g + 1] * inv); v.y = pack2(o[d][4 * g + 2] * inv, o[d][4 * g + 3] * inv); *(uint2*)(orow + d * 32 + 8 * g + 4 * h) = v; }
    __syncthreads();
}
DEVI void phase_attention(const Params& p, char* lds) {
    const u16* QA = (const u16*)(p.ws + A_QA); const u16* KA = (const u16*)(p.ws + A_KA); const u16* VA = (const u16*)(p.ws + A_VA);
    const u16* QS = (const u16*)(p.ws + A_QS); const u16* KS = (const u16*)(p.ws + A_KS); const u16* VS = (const u16*)(p.ws + A_VS);
    u16* mix = (u16*)(p.ws + A_N0);
    for (int u = blockIdx.x; u < 1632; u += gridDim.x) {
        if (u < 544) {
            int b, hd, q0, na;
            if (u < 512) { b = u >> 6; hd = (u >> 4) & 3; q0 = LC + (u & 15) * 256; na = 68; }
            else { const int v = u - 512; b = v >> 2; hd = v & 3; q0 = 0; na = 4; }
            const size_t bh = (size_t)(b * 4 + hd) * LT;
            attn_unit<192, 128, false>(QA + bh * 192, KA + bh * 192, VA + bh * 128, q0, 0, na, 0, 0, -1e30f, mix + (size_t)b * LT * DM + hd * 128, lds);
        } else {
            int b, hd, q0, b0 = 0, nb2 = 0;
            if (u < 1568) { const int v = u - 544; b = v >> 7; hd = (v >> 4) & 7; const int s0 = (v & 15) * 256; q0 = LC + s0;
                int lo = s0 - 128; if (lo < 0) lo = 0; int hi = s0 + 256 + 128; if (hi > SEQ) hi = SEQ; b0 = LC + lo; nb2 = (hi - lo) >> 6; }
            else { const int v = u - 1568; b = v >> 3; hd = v & 7; q0 = 0; }
            const int kvh = hd >> 2; const size_t qb = (size_t)(b * 8 + hd) * LT, kb = (size_t)(b * 2 + kvh) * LT;
            attn_unit<64, 64, true>(QS + qb * 64, KS + kb * 64, VS + kb * 64, q0, 0, 4, b0, nb2, p.in[I_ASINK][hd] * LOG2E, mix + (size_t)b * LT * DM + 512 + hd * 64, lds);
        }
    }
}
DEVI void phase_gemm_wo(const Params& p, const u16* A, const u16* W, const RowSrc& resid, int mode, int layer, char* lds) {
    float* XC = (float*)(p.ws + OFF_XC); float* XL = p.out;
    const float* mods_l = (const float*)(p.ws + OFF_MODS) + (size_t)layer * 9 * 6144;
    const int MT = (mode == 0 ? T0 : TL) / 256;
    for (int u = blockIdx.x; u < 8 * MT; u += gridDim.x) {
        const int mt = u >> 3, nt = u & 7; const int m0 = mt * 256, n0 = nt * 128;
        auto arow = [&](int r) { return A + (size_t)(m0 + r) * DM; };
        auto epi = [&](int r, int cw, f32x16 (&t)[2], int h) {
            int bb; const float* rs = row_ptr(resid, mode, m0 + r, bb); int bb2; float* xo = row_ptr_w(XC, XL, mode, m0 + r, bb2);
            const float* mg = mods_l + (size_t)bb * 6144 + 2 * 1024;
#pragma unroll
            for (int ni = 0; ni < 2; ++ni)
#pragma unroll
                for (int g = 0; g < 4; ++g) {
                    const int c = n0 + cw + ni * 32 + 8 * g + 4 * h;
                    const float4 rv = *(const float4*)(rs + c), gv = *(const float4*)(mg + c);
                    float4 ov; ov.x = rv.x + gv.x * t[ni][4 * g]; ov.y = rv.y + gv.y * t[ni][4 * g + 1]; ov.z = rv.z + gv.z * t[ni][4 * g + 2]; ov.w = rv.w + gv.w * t[ni][4 * g + 3];
                    *(float4*)(xo + c) = ov;
                }
        };
        gemm_tile<256, 128, false>(arow, W + (size_t)n0 * DM, DM, DM, epi, lds);
    }
}

DEVI void phase_moe_route(const Params& p, int layer, char* lds) {
    const int mode = layer == 0 ? 0 : 1; const int ntok = layer == 0 ? T0 : TL; const int tc = ntok / NCHUNK;
    RowSrc src; src.ctx = (const float*)(p.ws + OFF_XC); src.lat = p.out;
    const float* gain = p.in[I_NFFN] + layer * 1024; const float* mods_l = (const float*)(p.ws + OFF_MODS) + (size_t)layer * 9 * 6144;
    const float* wr = p.in[I_MROUT] + (size_t)layer * 1024 * 64; const float ebias = p.in[I_MBIAS][layer * 64 + (threadIdx.x & 63)];
    u16* n1 = (u16*)(p.ws + M_N1);
    int* cnt = (int*)(p.ws + OFF_CNT) + layer * NCHUNK * 64;
    int* tok_e = (int*)(p.ws + OFF_TOKE); int* tok_r = (int*)(p.ws + OFF_TOKR); int* ltok = (int*)(p.ws + OFF_LTOK); float* lg = (float*)(p.ws + OFF_LG);
    const int lane = threadIdx.x & 63, w = threadIdx.x >> 6;
    float* sn = (float*)lds + w * 4096;
    for (int t0 = (blockIdx.x * 8 + w) * 4; t0 < ntok; t0 += gridDim.x * 32) {
#pragma unroll
        for (int j = 0; j < 4; ++j) {
            const int r = t0 + j; int bb; const float* xr = row_ptr(src, mode, r, bb);
            float4 v[4]; float ss = 0.f;
#pragma unroll
            for (int i = 0; i < 4; ++i) { v[i] = ((const float4*)xr)[lane + 64 * i]; ss += v[i].x * v[i].x + v[i].y * v[i].y + v[i].z * v[i].z + v[i].w * v[i].w; }
            ss = wave_sum(ss);
            const float rs = rsqrtf(ss * (1.f / 1024.f) + 1e-6f);
            const float* msh = mods_l + (size_t)bb * 6144 + 3 * 1024; const float* msc = mods_l + (size_t)bb * 6144 + 4 * 1024;
#pragma unroll
            for (int i = 0; i < 4; ++i) {
                const int c = (lane + 64 * i) * 4;
                const float4 g = *(const float4*)(gain + c), sh = *(const float4*)(msh + c), sc = *(const float4*)(msc + c);
                const float y0 = v[i].x * rs * g.x * (1.f + sc.x) + sh.x, y1 = v[i].y * rs * g.y * (1.f + sc.y) + sh.y, y2 = v[i].z * rs * g.z * (1.f + sc.z) + sh.z, y3 = v[i].w * rs * g.w * (1.f + sc.w) + sh.w;
                uint2 o; o.x = pack2(y0, y1); o.y = pack2(y2, y3);
                *(uint2*)(n1 + (size_t)r * DM + c) = o;
                sn[(c + 0) * 4 + j] = y0; sn[(c + 1) * 4 + j] = y1; sn[(c + 2) * 4 + j] = y2; sn[(c + 3) * 4 + j] = y3;
            }
        }
        __builtin_amdgcn_s_waitcnt(0xc07f);
        __builtin_amdgcn_wave_barrier();
        float a0 = 0.f, a1 = 0.f, a2 = 0.f, a3 = 0.f;
#pragma unroll 8
        for (int k = 0; k < 1024; ++k) { const float wv = wr[k * 64 + lane]; const float4 s = *(const float4*)(sn + k * 4); a0 += s.x * wv; a1 += s.y * wv; a2 += s.z * wv; a3 += s.w * wv; }
        __builtin_amdgcn_wave_barrier();
        const float lgt[4] = {a0, a1, a2, a3};
#pragma unroll
        for (int j = 0; j < 4; ++j) {
            const int tok = t0 + j;
            const float score = 1.f / (1.f + expf(-lgt[j])); const float choice = score + ebias;
            const float m1 = red8_max(choice);
            const unsigned long long bm = __ballot(choice == m1);
            const unsigned gm = (unsigned)(bm >> (lane & 56)) & 0xffu; const int first = __ffs(gm) - 1;
            const float m2 = red8_max(((lane & 7) == first) ? -INFINITY : choice);
            const float gs = m1 + m2;
            int rank = 0;
#pragma unroll
            for (int g2 = 0; g2 < 8; ++g2) { const float og = __shfl(gs, g2 * 8); rank += (og > gs || (og == gs && g2 < (lane >> 3))) ? 1 : 0; }
            float cm = rank < 4 ? choice : -INFINITY;
            unsigned long long sel = 0ull; float ssum = 0.f;
#pragma unroll
            for (int it = 0; it < 6; ++it) {
                const float mxv = wave_max(cm);
                const unsigned long long bmm = __ballot(cm == mxv);
                const int win = __ffsll((long long)bmm) - 1;
                sel |= 1ull << win; ssum += __shfl(score, win);
                if (lane == win) cm = -INFINITY;
            }
            if ((sel >> lane) & 1ull) {
                const int jj = __popcll(sel & ((1ull << lane) - 1ull));
                const int ch = tok / tc; const int rk = atomicAdd(&cnt[ch * 64 + lane], 1);
                tok_e[tok * 6 + jj] = lane; tok_r[tok * 6 + jj] = rk;
                ltok[((size_t)ch * 64 + lane) * tc + rk] = tok; lg[((size_t)ch * 64 + lane) * tc + rk] = 2.5f * score / ssum;
            }
        }
    }
}
struct SegTab { int* cnt; int* off; int* tpre; };
DEVI SegTab build_segtab(const Params& p, int layer, int tc, char* lds_tab) {
    SegTab T; T.cnt = (int*)lds_tab; T.off = T.cnt + 264; T.tpre = T.off + 264;
    const int* cnt = (const int*)(p.ws + OFF_CNT) + layer * NCHUNK * 64;
    const int tid = threadIdx.x;
    if (tid < 260) { const int ch = tid / 65, e = tid % 65; T.cnt[tid] = e < 64 ? cnt[ch * 64 + e] : tc; }
    __syncthreads();
    if (tid < 64) {
        int lc[5], lt_[5]; int sc = 0, st = 0;
#pragma unroll
        for (int j = 0; j < 5; ++j) { const int s = 5 * tid + j; const int v = s < 260 ? T.cnt[s] : 0; lc[j] = sc; lt_[j] = st; sc += v; st += (v + 127) >> 7; }
        int ic = sc, it = st;
        for (int o = 1; o < 64; o <<= 1) { const int a = __shfl_up(ic, o), b2 = __shfl_up(it, o); if (tid >= o) { ic += a; it += b2; } }
        const int bc = ic - sc, bt = it - st;
#pragma unroll
        for (int j = 0; j < 5; ++j) { const int s = 5 * tid + j; if (s <= 260) { T.tpre[s] = bt + lt_[j]; T.off[s] = bc + lc[j]; } }
    }
    __syncthreads();
    return T;
}
DEVI int find_seg(const SegTab& T, int lo_seg, int hi_seg, int mt) {
    int lo = lo_seg, hi = hi_seg;
    while (hi - lo > 1) { const int mid = (lo + hi) >> 1; if (T.tpre[mid] <= mt) lo = mid; else hi = mid; }
    return lo;
}
DEVI void phase_moe_gemm1(const Params& p, int layer, char* lds) {
    const int ntok = layer == 0 ? T0 : TL; const int tc = ntok / NCHUNK;
    char* tabmem = lds + 110592; SegTab T = build_segtab(p, layer, tc, tabmem);
    const u16* n1 = (const u16*)(p.ws + M_N1); u16* act = (u16*)(p.ws + M_ACT);
    const int* ltok = (const int*)(p.ws + OFF_LTOK); const float* lg = (const float*)(p.ws + OFF_LG);
    const int nunits = T.tpre[260] * 2;
    for (int u = blockIdx.x; u < nunits; u += gridDim.x) {
        const int mt = u >> 1, nt = u & 1; const int seg = find_seg(T, 0, 260, mt); const int ch = seg / 65, e = seg % 65;
        const int cntv = T.cnt[seg], row0 = (mt - T.tpre[seg]) * 128; const int n0 = nt * 256;
        const int* lt = ltok + ((size_t)ch * 64 + e) * tc; const float* lgp = lg + ((size_t)ch * 64 + e) * tc;
        const u16* W = e < 64 ? (const u16*)(p.ws + OFF_WGU) + (size_t)e * 512 * 1024 : (const u16*)(p.ws + W_SGU) + (size_t)layer * 512 * 1024;
        auto arow = [&](int r) { int s = row0 + r; if (s >= cntv) s = cntv - 1; const int tok = e < 64 ? lt[s] : ch * tc + s; return n1 + (size_t)tok * DM; };
        const size_t arow0 = (size_t)ch * 7 * tc + (T.off[seg] - T.off[ch * 65]) + row0;
        auto epi = [&](int r, int cw, f32x16 (&t)[2], int h) {
            const int s = row0 + r; if (s >= cntv) return;
            const float gw = e < 64 ? lgp[s] : 1.f;
            u16* dst = act + (arow0 + r) * 256 + ((n0 + cw) >> 1);
#pragma unroll
            for (int g = 0; g < 4; ++g) {
                float o4[4];
#pragma unroll
                for (int i = 0; i < 4; ++i) { const float gt = t[0][4 * g + i], up = t[1][4 * g + i]; o4[i] = gt / (1.f + __expf(-gt)) * up * gw; }
                uint2 v; v.x = pack2(o4[0], o4[1]); v.y = pack2(o4[2], o4[3]); *(uint2*)(dst + 8 * g + 4 * h) = v;
            }
        };
        gemm_tile<128, 256, false>(arow, W + (size_t)n0 * DM, DM, DM, epi, lds);
    }
}
DEVI void phase_moe_gemm2(const Params& p, int layer, int ch, char* lds) {
    const int ntok = layer == 0 ? T0 : TL; const int tc = ntok / NCHUNK;
    char* tabmem = lds + 110592; SegTab T = build_segtab(p, layer, tc, tabmem);
    const u16* act = (const u16*)(p.ws + M_ACT); u16* outr = (u16*)(p.ws + M_OUTR);
    const int t_lo = T.tpre[ch * 65], t_hi = T.tpre[ch * 65 + 65];
    const int nunits = (t_hi - t_lo) * 4;
    for (int u = blockIdx.x; u < nunits; u += gridDim.x) {
        const int mt = t_lo + (u >> 2), nt = u & 3; const int seg = find_seg(T, ch * 65, ch * 65 + 65, mt); const int e = seg % 65;
        const int cntv = T.cnt[seg], row0 = (mt - T.tpre[seg]) * 128; const int n0 = nt * 256;
        const size_t lrow0 = (size_t)(T.off[seg] - T.off[ch * 65]) + row0;
        const u16* A = act + ((size_t)ch * 7 * tc + lrow0) * 256;
        const u16* W = e < 64 ? (const u16*)(p.ws + OFF_WD) + (size_t)e * 1024 * 256 : (const u16*)(p.ws + W_SD) + (size_t)layer * 1024 * 256;
        auto arow = [&](int r) { int s = row0 + r; if (s >= cntv) s = cntv - 1; return A + (size_t)(s - row0) * 256; };
        auto epi = [&](int r, int cw, f32x16 (&t)[2], int h) {
            if (row0 + r >= cntv) return;
            u16* dst = outr + (lrow0 + r) * DM + n0 + cw;
            store_tile_bf16(dst, t[0], h); store_tile_bf16(dst + 32, t[1], h);
        };
        gemm_tile<128, 256, false>(arow, W + (size_t)n0 * 256, 256, 256, epi, lds);
    }
}
DEVI void phase_moe_combine(const Params& p, int layer, int ch, char* lds) {
    const int mode = layer == 0 ? 0 : 1; const int ntok = layer == 0 ? T0 : TL; const int tc = ntok / NCHUNK;
    SegTab T = build_segtab(p, layer, tc, lds);
    const u16* outr = (const u16*)(p.ws + M_OUTR); const int* tok_e = (const int*)(p.ws + OFF_TOKE); const int* tok_r = (const int*)(p.ws + OFF_TOKR);
    float* XC = (float*)(p.ws + OFF_XC); float* XL = p.out;
    const float* mods_l = (const float*)(p.ws + OFF_MODS) + (size_t)layer * 9 * 6144;
    const int lane = threadIdx.x & 63, w = threadIdx.x >> 6;
    for (int tl = blockIdx.x * 8 + w; tl < tc; tl += gridDim.x * 8) {
        const int tok = ch * tc + tl; int bb; float* xr = row_ptr_w(XC, XL, mode, tok, bb);
        const float* mg = mods_l + (size_t)bb * 6144 + 5 * 1024;
        int rows[7];
#pragma unroll
        for (int j = 0; j < 6; ++j) rows[j] = T.off[ch * 65 + tok_e[tok * 6 + j]] - T.off[ch * 65] + tok_r[tok * 6 + j];
        rows[6] = 6 * tc + tl;
#pragma unroll
        for (int i = 0; i < 2; ++i) {
            const int c = (lane + 64 * i) * 8;
            float acc[8];
#pragma unroll
            for (int q = 0; q < 8; ++q) acc[q] = 0.f;
#pragma unroll
            for (int j = 0; j < 7; ++j) {
                const uint4 v = *(const uint4*)(outr + (size_t)rows[j] * DM + c);
                acc[0] += bf_lo(v.x); acc[1] += bf_hi(v.x); acc[2] += bf_lo(v.y); acc[3] += bf_hi(v.y); acc[4] += bf_lo(v.z); acc[5] += bf_hi(v.z); acc[6] += bf_lo(v.w); acc[7] += bf_hi(v.w);
            }
            float4 x0 = *(float4*)(xr + c), x1 = *(float4*)(xr + c + 4); const float4 g0 = *(const float4*)(mg + c), g1 = *(const float4*)(mg + c + 4);
            x0.x += g0.x * acc[0]; x0.y += g0.y * acc[1]; x0.z += g0.z * acc[2]; x0.w += g0.w * acc[3]; x1.x += g1.x * acc[4]; x1.y += g1.y * acc[5]; x1.z += g1.z * acc[6]; x1.w += g1.w * acc[7];
            *(float4*)(xr + c) = x0; *(float4*)(xr + c + 4) = x1;
        }
    }
}

DEVI void phase_rwkv_mix(const Params& p, int i0, int i1, int i2) {
    const u16* nn = (const u16*)(p.ws + R_NN); u16* xm = (u16*)(p.ws + R_XM0);
    const float* mu = p.in[I_RMU]; const int idx[3] = {i0, i1, i2};
    const int lane = threadIdx.x & 63, w = threadIdx.x >> 6;
    for (int r = blockIdx.x * 8 + w; r < T0; r += gridDim.x * 8) {
        const int b = r / LT, pp = r - b * LT;
        const bool hasprev = (pp != 0) && (pp != LC), hasnext = (pp != LC - 1) && (pp != LT - 1);
#pragma unroll
        for (int half = 0; half < 2; ++half) {
            const int c = half * 512 + lane * 8;
            const uint4 cur = *(const uint4*)(nn + (size_t)r * DM + c);
            uint4 sh = make_uint4(0, 0, 0, 0);
            if (half == 0) { if (hasprev) sh = *(const uint4*)(nn + (size_t)(r - 1) * DM + c); }
            else { if (hasnext) sh = *(const uint4*)(nn + (size_t)(r + 1) * DM + c); }
            float nv[8], xx[8];
            nv[0] = bf_lo(cur.x); nv[1] = bf_hi(cur.x); nv[2] = bf_lo(cur.y); nv[3] = bf_hi(cur.y); nv[4] = bf_lo(cur.z); nv[5] = bf_hi(cur.z); nv[6] = bf_lo(cur.w); nv[7] = bf_hi(cur.w);
            xx[0] = bf_lo(sh.x) - nv[0]; xx[1] = bf_hi(sh.x) - nv[1]; xx[2] = bf_lo(sh.y) - nv[2]; xx[3] = bf_hi(sh.y) - nv[3]; xx[4] = bf_lo(sh.z) - nv[4]; xx[5] = bf_hi(sh.z) - nv[5]; xx[6] = bf_lo(sh.w) - nv[6]; xx[7] = bf_hi(sh.w) - nv[7];
#pragma unroll
            for (int j = 0; j < 3; ++j) {
                const float4 m0 = *(const float4*)(mu + idx[j] * 1024 + c), m1 = *(const float4*)(mu + idx[j] * 1024 + c + 4);
                uint4 o; o.x = pack2(nv[0] + xx[0] * m0.x, nv[1] + xx[1] * m0.y); o.y = pack2(nv[2] + xx[2] * m0.z, nv[3] + xx[3] * m0.w);
                o.z = pack2(nv[4] + xx[4] * m1.x, nv[5] + xx[5] * m1.y); o.w = pack2(nv[6] + xx[6] * m1.z, nv[7] + xx[7] * m1.w);
                *(uint4*)(xm + (size_t)j * T0 * DM + (size_t)r * DM + c) = o;
            }
        }
    }
}
DEVI void phase_rwkv_gemm_rkv(const Params& p, char* lds) {
    const int MT = T0 / 256;
    for (int u = blockIdx.x; u < 3 * 8 * MT; u += gridDim.x) {
        const int j = u / (8 * MT), v = u % (8 * MT); const int mt = v >> 3, nt = v & 7; const int m0 = mt * 256, n0 = nt * 128;
        const u16* A = (const u16*)(p.ws + R_XM0) + (size_t)j * T0 * DM; const u16* W = (const u16*)(p.ws + W_RR) + (size_t)j * DM * DM; u16* O = (u16*)(p.ws + R_RR) + (size_t)j * T0 * DM;
        auto arow = [&](int r) { return A + (size_t)(m0 + r) * DM; };
        auto epi = [&](int r, int cw, f32x16 (&t)[2], int h) { u16* dst = O + (size_t)(m0 + r) * DM + n0 + cw; store_tile_bf16(dst, t[0], h); store_tile_bf16(dst + 32, t[1], h); };
        gemm_tile<256, 128, false>(arow, W + (size_t)n0 * DM, DM, DM, epi, lds);
    }
}
DEVI void phase_rwkv_gemm_small(const Params& p, char* lds) {
    const int MT = T0 / 256;
    for (int u = blockIdx.x; u < 3 * MT; u += gridDim.x) {
        const int j = u / MT, mt = u % MT; const int m0 = mt * 256;
        const u16* A = (const u16*)(p.ws + R_XM0) + (size_t)j * T0 * DM;
        const u16* W = (const u16*)(p.ws + (j == 0 ? W_W1 : j == 1 ? W_A1 : W_G1)); u16* O = (u16*)(p.ws + (j == 0 ? R_HW : j == 1 ? R_HA : R_HG));
        auto arow = [&](int r) { return A + (size_t)(m0 + r) * DM; };
        auto epi = [&](int r, int cw, f32x16 (&t)[2], int h) {
#pragma unroll
            for (int ni = 0; ni < 2; ++ni) {
#pragma unroll
                for (int i = 0; i < 16; ++i) { const float x = t[ni][i]; t[ni][i] = j == 0 ? tanhf_(x) : j == 1 ? x : sigmoidf_(x); }
                store_tile_bf16(O + (size_t)(m0 + r) * 128 + cw + ni * 32, t[ni], h);
            }
        };
        gemm_tile<256, 128, false>(arow, W, DM, DM, epi, lds);
    }
}
DEVI void phase_rwkv_gemm_g(const Params& p, char* lds) {
    const int MT = T0 / 256; const u16* A = (const u16*)(p.ws + R_HG); const u16* W = (const u16*)(p.ws + W_G2); u16* O = (u16*)(p.ws + R_GG);
    for (int u = blockIdx.x; u < 8 * MT; u += gridDim.x) {
        const int mt = u >> 3, nt = u & 7; const int m0 = mt * 256, n0 = nt * 128;
        auto arow = [&](int r) { return A + (size_t)(m0 + r) * 128; };
        auto epi = [&](int r, int cw, f32x16 (&t)[2], int h) { u16* dst = O + (size_t)(m0 + r) * DM + n0 + cw; store_tile_bf16(dst, t[0], h); store_tile_bf16(dst + 32, t[1], h); };
        gemm_tile<256, 128, false>(arow, W + (size_t)n0 * 128, 128, 128, epi, lds);
    }
}
DEVI void phase_rwkv_scan(const Params& p, char* lds) {
    float* WD = (float*)lds; float* KKA = WD + 4096; float* KK = KKA + 4096; float* KM = KK + 4096; float* RR = KM + 4096; float* VV = RR + 4096; float* YB = VV + 4096;
    const u16* r_g = (const u16*)(p.ws + R_RR); const u16* k_g = (const u16*)(p.ws + R_RK); const u16* v_g = (const u16*)(p.ws + R_RV);
    const u16* hw = (const u16*)(p.ws + R_HW); const u16* ha = (const u16*)(p.ws + R_HA);
    const int tid = threadIdx.x, lane = tid & 63, w = tid >> 6, l31 = lane & 31, hh = lane >> 5;
    for (int u = blockIdx.x; u < 256; u += gridDim.x) {
        const int dir = u & 1, hd = (u >> 1) & 15, b = u >> 5;
        u16* y_g = (u16*)(p.ws + (dir ? R_YB : R_YF)); float* rkb = (float*)(p.ws + R_RKB) + (size_t)dir * T0 * 16;
        const int mat = w >> 2, stt = (w >> 1) & 1, ctt = w & 1;
        const u16* w2t = (const u16*)(p.ws + (mat ? W_A2 : W_W2)) + (size_t)dir * 1024 * 64 + (size_t)(hd * 64 + ctt * 32 + l31) * 64;
        bf16x8 wfr[4];
#pragma unroll
        for (int ks = 0; ks < 4; ++ks) wfr[ks] = *(const bf16x8*)(w2t + ks * 16 + hh * 8);
        const float* bias0 = (mat ? p.in[I_RA0] : p.in[I_RW0]) + dir * 1024 + hd * 64 + ctt * 32;
        const u16* hsrc = mat ? ha : hw;
        const int pst = tid >> 3, oct = tid & 7; const int cg = hd * 64 + oct * 8;
        float kkc[8], kac[8], rkc[8];
#pragma unroll
        for (int i = 0; i < 8; ++i) { kkc[i] = p.in[I_RKK][cg + i]; kac[i] = p.in[I_RKA][cg + i]; rkc[i] = p.in[I_RRK][cg + i]; }
        float S[8];
#pragma unroll
        for (int i = 0; i < 8; ++i) S[i] = 0.f;
        const int vrow = tid >> 3;
        for (int ci = 0; ci < 68; ++ci) {
            int pc; if (ci < 4) pc = dir ? 3 - ci : ci; else pc = 4 + (dir ? 63 - (ci - 4) : ci - 4);
            const size_t row0 = (size_t)b * LT + pc * 64;
            {
                f32x16 acc;
#pragma unroll
                for (int i = 0; i < 16; ++i) acc[i] = 0.f;
                const u16* hp = hsrc + (row0 + stt * 32 + l31) * 128 + dir * 64;
#pragma unroll
                for (int ks = 0; ks < 4; ++ks) { const bf16x8 af = *(const bf16x8*)(hp + ks * 16 + hh * 8); acc = __builtin_amdgcn_mfma_f32_32x32x16_bf16(wfr[ks], af, acc, 0, 0, 0); }
                float* dstm = (mat ? KKA : WD) + (stt * 32 + l31) * 64 + ctt * 32;
#pragma unroll
                for (int g = 0; g < 4; ++g) {
                    const float4 b4 = *(const float4*)(bias0 + 8 * g + 4 * hh);
                    float4 o4; const float x0 = acc[4 * g] + b4.x, x1 = acc[4 * g + 1] + b4.y, x2 = acc[4 * g + 2] + b4.z, x3 = acc[4 * g + 3] + b4.w;
                    if (mat) { o4.x = sigmoidf_(x0); o4.y = sigmoidf_(x1); o4.z = sigmoidf_(x2); o4.w = sigmoidf_(x3); }
                    else { o4.x = __expf(-0.6065306597126334f * sigmoidf_(x0)); o4.y = __expf(-0.6065306597126334f * sigmoidf_(x1)); o4.z = __expf(-0.6065306597126334f * sigmoidf_(x2)); o4.w = __expf(-0.6065306597126334f * sigmoidf_(x3)); }
                    *(float4*)(dstm + 8 * g + 4 * hh) = o4;
                }
            }
            __syncthreads();
            {
                const size_t grow = row0 + pst; const size_t go = grow * DM + cg;
                const uint4 ru = *(const uint4*)(r_g + go), ku = *(const uint4*)(k_g + go), vu = *(const uint4*)(v_g + go);
                float rv[8], kv[8], vv[8];
                rv[0] = bf_lo(ru.x); rv[1] = bf_hi(ru.x); rv[2] = bf_lo(ru.y); rv[3] = bf_hi(ru.y); rv[4] = bf_lo(ru.z); rv[5] = bf_hi(ru.z); rv[6] = bf_lo(ru.w); rv[7] = bf_hi(ru.w);
                kv[0] = bf_lo(ku.x); kv[1] = bf_hi(ku.x); kv[2] = bf_lo(ku.y); kv[3] = bf_hi(ku.y); kv[4] = bf_lo(ku.z); kv[5] = bf_hi(ku.z); kv[6] = bf_lo(ku.w); kv[7] = bf_hi(ku.w);
                vv[0] = bf_lo(vu.x); vv[1] = bf_hi(vu.x); vv[2] = bf_lo(vu.y); vv[3] = bf_hi(vu.y); vv[4] = bf_lo(vu.z); vv[5] = bf_hi(vu.z); vv[6] = bf_lo(vu.w); vv[7] = bf_hi(vu.w);
                float av[8];
                { const float4 a0 = *(const float4*)(KKA + pst * 64 + oct * 8), a1 = *(const float4*)(KKA + pst * 64 + oct * 8 + 4); av[0] = a0.x; av[1] = a0.y; av[2] = a0.z; av[3] = a0.w; av[4] = a1.x; av[5] = a1.y; av[6] = a1.z; av[7] = a1.w; }
                float kk[8], km[8], ssq = 0.f, rks = 0.f;
#pragma unroll
                for (int i = 0; i < 8; ++i) { kk[i] = kv[i] * kkc[i]; ssq += kk[i] * kk[i]; km[i] = kv[i] * (1.f + (av[i] - 1.f) * kac[i]); rks += rv[i] * km[i] * rkc[i]; }
                ssq = red8_sum(ssq); rks = red8_sum(rks);
                const float inv = 1.f / fmaxf(sqrtf(ssq), 1e-12f);
                float* o;
                o = KK + pst * 64 + oct * 8; *(float4*)o = make_float4(kk[0] * inv, kk[1] * inv, kk[2] * inv, kk[3] * inv); *(float4*)(o + 4) = make_float4(kk[4] * inv, kk[5] * inv, kk[6] * inv, kk[7] * inv);
                o = KKA + pst * 64 + oct * 8; *(float4*)o = make_float4(kk[0] * inv * av[0], kk[1] * inv * av[1], kk[2] * inv * av[2], kk[3] * inv * av[3]); *(float4*)(o + 4) = make_float4(kk[4] * inv * av[4], kk[5] * inv * av[5], kk[6] * inv * av[6], kk[7] * inv * av[7]);
                o = KM + pst * 64 + oct * 8; *(float4*)o = make_float4(km[0], km[1], km[2], km[3]); *(float4*)(o + 4) = make_float4(km[4], km[5], km[6], km[7]);
                o = RR + pst * 64 + oct * 8; *(float4*)o = make_float4(rv[0], rv[1], rv[2], rv[3]); *(float4*)(o + 4) = make_float4(rv[4], rv[5], rv[6], rv[7]);
                o = VV + pst * 64 + oct * 8; *(float4*)o = make_float4(vv[0], vv[1], vv[2], vv[3]); *(float4*)(o + 4) = make_float4(vv[4], vv[5], vv[6], vv[7]);
                if (oct == 0) rkb[grow * 16 + hd] = rks;
            }
            __syncthreads();
            for (int st = 0; st < 64; ++st) {
                const int ix = dir ? 63 - st : st;
                const float4 k0 = *(const float4*)(KK + ix * 64 + oct * 8), k1 = *(const float4*)(KK + ix * 64 + oct * 8 + 4);
                const float4 w0 = *(const float4*)(WD + ix * 64 + oct * 8), w1 = *(const float4*)(WD + ix * 64 + oct * 8 + 4);
                const float4 b0 = *(const float4*)(KKA + ix * 64 + oct * 8), b1 = *(const float4*)(KKA + ix * 64 + oct * 8 + 4);
                const float4 m0 = *(const float4*)(KM + ix * 64 + oct * 8), m1 = *(const float4*)(KM + ix * 64 + oct * 8 + 4);
                const float4 r0 = *(const float4*)(RR + ix * 64 + oct * 8), r1 = *(const float4*)(RR + ix * 64 + oct * 8 + 4);
                const float vx = VV[ix * 64 + vrow];
                float sa = S[0] * k0.x + S[1] * k0.y + S[2] * k0.z + S[3] * k0.w + S[4] * k1.x + S[5] * k1.y + S[6] * k1.z + S[7] * k1.w;
                sa = red8_sum(sa);
                S[0] = S[0] * w0.x - sa * b0.x + vx * m0.x; S[1] = S[1] * w0.y - sa * b0.y + vx * m0.y; S[2] = S[2] * w0.z - sa * b0.z + vx * m0.z; S[3] = S[3] * w0.w - sa * b0.w + vx * m0.w;
                S[4] = S[4] * w1.x - sa * b1.x + vx * m1.x; S[5] = S[5] * w1.y - sa * b1.y + vx * m1.y; S[6] = S[6] * w1.z - sa * b1.z + vx * m1.z; S[7] = S[7] * w1.w - sa * b1.w + vx * m1.w;
                float y = S[0] * r0.x + S[1] * r0.y + S[2] * r0.z + S[3] * r0.w + S[4] * r1.x + S[5] * r1.y + S[6] * r1.z + S[7] * r1.w;
                y = red8_sum(y);
                if (oct == 0) YB[ix * 64 + vrow] = y;
            }
            __syncthreads();
            if (pc >= 4) {
                const float4 y0 = *(const float4*)(YB + pst * 64 + oct * 8), y1 = *(const float4*)(YB + pst * 64 + oct * 8 + 4);
                uint4 o; o.x = pack2(y0.x, y0.y); o.y = pack2(y0.z, y0.w); o.z = pack2(y1.x, y1.y); o.w = pack2(y1.z, y1.w);
                *(uint4*)(y_g + (row0 + pst) * DM + cg) = o;
            }
            __syncthreads();
        }
    }
}
DEVI void phase_rwkv_readout(const Params& p) {
    const u16* yf = (const u16*)(p.ws + R_YF); const u16* yb = (const u16*)(p.ws + R_YB); const u16* vg = (const u16*)(p.ws + R_RV); const u16* gg = (const u16*)(p.ws + R_GG);
    const float* rkb = (const float*)(p.ws + R_RKB); u16* rd = (u16*)(p.ws + R_RD);
    const float* lnw = p.in[I_RLNW]; const float* lnb = p.in[I_RLNB];
    const int lane = threadIdx.x & 63, w = threadIdx.x >> 6;
    for (int t = blockIdx.x * 8 + w; t < TL; t += gridDim.x * 8) {
        const int b = t >> 12, s = t & 4095; const size_t row = (size_t)b * LT + LC + s; const int c = lane * 16; const int hd = lane >> 2;
        float y[16], vv[16], gv[16];
#pragma unroll
        for (int q = 0; q < 2; ++q) {
            const uint4 a = *(const uint4*)(yf + row * DM + c + 8 * q), bq = *(const uint4*)(yb + row * DM + c + 8 * q), v4 = *(const uint4*)(vg + row * DM + c + 8 * q), g4 = *(const uint4*)(gg + row * DM + c + 8 * q);
            y[8 * q + 0] = bf_lo(a.x) + bf_lo(bq.x); y[8 * q + 1] = bf_hi(a.x) + bf_hi(bq.x); y[8 * q + 2] = bf_lo(a.y) + bf_lo(bq.y); y[8 * q + 3] = bf_hi(a.y) + bf_hi(bq.y);
            y[8 * q + 4] = bf_lo(a.z) + bf_lo(bq.z); y[8 * q + 5] = bf_hi(a.z) + bf_hi(bq.z); y[8 * q + 6] = bf_lo(a.w) + bf_lo(bq.w); y[8 * q + 7] = bf_hi(a.w) + bf_hi(bq.w);
            vv[8 * q + 0] = bf_lo(v4.x); vv[8 * q + 1] = bf_hi(v4.x); vv[8 * q + 2] = bf_lo(v4.y); vv[8 * q + 3] = bf_hi(v4.y); vv[8 * q + 4] = bf_lo(v4.z); vv[8 * q + 5] = bf_hi(v4.z); vv[8 * q + 6] = bf_lo(v4.w); vv[8 * q + 7] = bf_hi(v4.w);
            gv[8 * q + 0] = bf_lo(g4.x); gv[8 * q + 1] = bf_hi(g4.x); gv[8 * q + 2] = bf_lo(g4.y); gv[8 * q + 3] = bf_hi(g4.y); gv[8 * q + 4] = bf_lo(g4.z); gv[8 * q + 5] = bf_hi(g4.z); gv[8 * q + 6] = bf_lo(g4.w); gv[8 * q + 7] = bf_hi(g4.w);
        }
        float sm = 0.f;
#pragma unroll
        for (int i = 0; i < 16; ++i) sm += y[i];
        sm = red4_sum(sm); const float mean = sm * (1.f / 64.f);
        float vs = 0.f;
#pragma unroll
        for (int i = 0; i < 16; ++i) { const float d = y[i] - mean; vs += d * d; }
        vs = red4_sum(vs); const float rstd = rsqrtf(vs * (1.f / 64.f) + 64e-5f);
        const float bon = rkb[row * 16 + hd] + rkb[(size_t)T0 * 16 + row * 16 + hd];
        unsigned ow[8];
#pragma unroll
        for (int i = 0; i < 8; ++i) {
            const int c0 = c + 2 * i;
            const float o0 = ((y[2 * i] - mean) * rstd * lnw[c0] + lnb[c0] + bon * vv[2 * i]) * gv[2 * i];
            const float o1 = ((y[2 * i + 1] - mean) * rstd * lnw[c0 + 1] + lnb[c0 + 1] + bon * vv[2 * i + 1]) * gv[2 * i + 1];
            ow[i] = pack2(o0, o1);
        }
        *(uint4*)(rd + (size_t)t * DM + c) = make_uint4(ow[0], ow[1], ow[2], ow[3]); *(uint4*)(rd + (size_t)t * DM + c + 8) = make_uint4(ow[4], ow[5], ow[6], ow[7]);
    }
}
DEVI void phase_final_norm(const Params& p) {
    const float* g = p.in[I_NFIN]; float* X = p.out;
    const int lane = threadIdx.x & 63, w = threadIdx.x >> 6;
    for (int r = blockIdx.x * 8 + w; r < TL; r += gridDim.x * 8) {
        float4* xr = (float4*)(X + (size_t)r * DM); float4 v[4]; float ss = 0.f;
#pragma unroll
        for (int i = 0; i < 4; ++i) { v[i] = xr[lane + 64 * i]; ss += v[i].x * v[i].x + v[i].y * v[i].y + v[i].z * v[i].z + v[i].w * v[i].w; }
        ss = wave_sum(ss); const float rs = rsqrtf(ss * (1.f / 1024.f) + 1e-6f);
#pragma unroll
        for (int i = 0; i < 4; ++i) { const float4 gg = ((const float4*)g)[lane + 64 * i]; float4 o; o.x = v[i].x * rs * gg.x; o.y = v[i].y * rs * gg.y; o.z = v[i].z * rs * gg.z; o.w = v[i].w * rs * gg.w; xr[lane + 64 * i] = o; }
    }
}

constexpr int N_PHASES = 36;
template <int PH> DEVI void run_phase(const Params& p, char* lds) {
    const float* mods = (const float*)(p.ws + OFF_MODS);
    RowSrc in_src; in_src.ctx = p.in[I_CTX]; in_src.lat = p.in[I_X];
    RowSrc x_src; x_src.ctx = (const float*)(p.ws + OFF_XC); x_src.lat = p.out;
    if constexpr (PH == 0) phase_prologue(p, lds);
    else if constexpr (PH == 1) norm_rows(in_src, 0, T0, p.in[I_NMIX], mods, 0, 1, (u16*)(p.ws + A_N0));
    else if constexpr (PH == 2) phase_gemm_win(p, lds);
    else if constexpr (PH == 3) phase_gemm_qkv(p, lds);
    else if constexpr (PH == 4) { phase_attention(p, lds); conv_jobs(p, 25, 28, 0, 0, lds); }
    else if constexpr (PH == 5) phase_gemm_wo(p, (const u16*)(p.ws + A_N0), (const u16*)(p.ws + W_OA), in_src, 0, 0, lds);
    else if constexpr (PH == 6) phase_moe_route(p, 0, lds);
    else if constexpr (PH == 7) phase_moe_gemm1(p, 0, lds);
    else if constexpr (PH >= 8 && PH < 16) { if constexpr ((PH & 1) == 0) phase_moe_gemm2(p, 0, (PH - 8) >> 1, lds); else phase_moe_combine(p, 0, (PH - 8) >> 1, lds); }
    else if constexpr (PH == 16) norm_rows(x_src, 0, T0, p.in[I_NMIX] + 1024, mods + 9 * 6144, 0, 1, (u16*)(p.ws + R_NN));
    else if constexpr (PH == 17) phase_rwkv_mix(p, 0, 2, 3);
    else if constexpr (PH == 18) phase_rwkv_gemm_rkv(p, lds);
    else if constexpr (PH == 19) phase_rwkv_mix(p, 1, 4, 5);
    else if constexpr (PH == 20) phase_rwkv_gemm_small(p, lds);
    else if constexpr (PH == 21) phase_rwkv_gemm_g(p, lds);
    else if constexpr (PH == 22) phase_rwkv_scan(p, lds);
    else if constexpr (PH == 23) phase_rwkv_readout(p);
    else if constexpr (PH == 24) { phase_gemm_wo(p, (const u16*)(p.ws + R_RD), (const u16*)(p.ws + W_RO), x_src, 1, 1, lds); conv_jobs(p, 25, 28, 1, 0, lds); }
    else if constexpr (PH == 25) phase_moe_route(p, 1, lds);
    else if constexpr (PH == 26) phase_moe_gemm1(p, 1, lds);
    else if constexpr (PH >= 27 && PH < 35) { if constexpr (((PH - 27) & 1) == 0) phase_moe_gemm2(p, 1, (PH - 27) >> 1, lds); else phase_moe_combine(p, 1, (PH - 27) >> 1, lds); }
    else if constexpr (PH == 35) phase_final_norm(p);
}

#if MEGA
template <int PH, int END> DEVI void run_range(const Params& p, char* lds, const XcdBarrier& bar) {
    run_phase<PH>(p, lds);
    if constexpr (PH + 1 < END) { xcd_barrier(bar); run_range<PH + 1, END>(p, lds, bar); }
}
template <int A, int B> __global__ void __launch_bounds__(512, 2) k_range(Params p, unsigned* barw) {
    extern __shared__ __attribute__((aligned(16))) char smem[];
    if (threadIdx.x == 0) *(uint4*)smem = make_uint4(0u, 0u, 0u, 0u);
    __syncthreads();
    const XcdBarrier bar = xcd_barrier_post(barw, (volatile LAS unsigned*)smem);
    run_range<A, B>(p, smem + 64, bar);
}
template <int A, int B> static void launch_range(const Params& p, unsigned* barw, hipStream_t s) {
    static int grid = 0;
    if (!grid) {
        int dev = 0, cus = 0, per_cu = 0;
        (void)hipGetDevice(&dev);
        (void)hipDeviceGetAttribute(&cus, hipDeviceAttributeMultiprocessorCount, dev);
        (void)hipFuncSetAttribute((const void*)k_range<A, B>, hipFuncAttributeMaxDynamicSharedMemorySize, LDS_BYTES);
        (void)hipOccupancyMaxActiveBlocksPerMultiprocessor(&per_cu, (const void*)k_range<A, B>, 512, LDS_BYTES);
        if (per_cu < 1) fprintf(stderr, "occupancy query says 0 blocks per CU\n");
        grid = cus;
    }
    k_range<A, B><<<grid, 512, LDS_BYTES, s>>>(p, barw);
}
extern "C" void kernel_launch(void* const* d_in, const int* in_sizes, int n_in, void* d_out, int out_size, void* d_ws, size_t ws_size, hipStream_t stream) {
    Params p{};
    for (int i = 0; i < N_IN; ++i) p.in[i] = (const float*)d_in[i];
    p.out = (float*)d_out; p.ws = (char*)d_ws;
    if (ws_size < WS_NEED) { fprintf(stderr, "workspace too small\n"); return; }
    (void)hipMemsetAsync(p.ws + OFF_BAR, 0, XCD_BAR_WORDS * sizeof(unsigned), stream);
    launch_range<0, N_PHASES>(p, (unsigned*)(p.ws + OFF_BAR), stream);
}
#else
template <int PH> __global__ void __launch_bounds__(512, 2) k_phase(Params p) {
    extern __shared__ __attribute__((aligned(16))) char smem[];
    run_phase<PH>(p, smem + 64);
}
template <int PH> static void launch_phase(const Params& p, hipStream_t s) {
    static bool attr = false;
    if (!attr) { hipFuncSetAttribute((const void*)k_phase<PH>, hipFuncAttributeMaxDynamicSharedMemorySize, LDS_BYTES); attr = true; }
    k_phase<PH><<<256, 512, LDS_BYTES, s>>>(p);
}
template <int PH> static void launch_all(const Params& p, hipStream_t s) {
    launch_phase<PH>(p, s);
    if constexpr (PH + 1 < N_PHASES) launch_all<PH + 1>(p, s);
}

extern "C" void kernel_launch(void* const* d_in, const int* in_sizes, int n_in, void* d_out, int out_size, void* d_ws, size_t ws_size, hipStream_t stream) {
    Params p{};
    for (int i = 0; i < N_IN; ++i) p.in[i] = (const float*)d_in[i];
    p.out = (float*)d_out; p.ws = (char*)d_ws;
    if (ws_size < WS_NEED) { fprintf(stderr, "workspace too small: %zu < %zu\n", ws_size, (size_t)WS_NEED); return; }
    launch_all<0>(p, stream);
}
#endif
```

```cpp
#include <hip/hip_runtime.h>
#include <stdint.h>
#include <stdio.h>

#ifndef MEGA
#define MEGA 1
#endif

typedef unsigned short u16;
typedef short bf16x8 __attribute__((ext_vector_type(8)));
typedef short s16x4 __attribute__((ext_vector_type(4)));
typedef float f32x16 __attribute__((ext_vector_type(16)));
typedef float f32x4 __attribute__((ext_vector_type(4)));
typedef float f32x2 __attribute__((ext_vector_type(2)));
typedef unsigned u32x4 __attribute__((ext_vector_type(4)));
typedef __bf16 bf2 __attribute__((ext_vector_type(2)));
#define DEVI __device__ __forceinline__
#define LAS __attribute__((address_space(3)))

constexpr int NB = 8, SEQ = 4096, LC = 256, LT = 4352, DM = 1024, T0 = NB * LT, TL = NB * SEQ;
constexpr int NCHUNK = 4;
constexpr float LOG2E = 1.4426950408889634f;
constexpr float QA_SCALE = 0.07216878364870322f * LOG2E;
constexpr float QS_SCALE = 0.125f * LOG2E;

enum { I_X = 0, I_C, I_CTX, I_CCTX, I_ADAW, I_ADAB, I_NMIX, I_NFFN, I_NFIN, I_AWIN, I_AQN, I_AKVN, I_AWUQ, I_AWUKV, I_ASINK, I_AWO,
       I_RMU, I_RWR, I_RWK, I_RWV, I_RWO, I_RG1, I_RG2, I_RW0, I_RW1, I_RW2, I_RA0, I_RA1, I_RA2, I_RKK, I_RKA, I_RRK, I_RLNW, I_RLNB,
       I_MROUT, I_MBIAS, I_MWG, I_MWU, I_MWD, I_MSG, I_MSU, I_MSD, N_IN };

struct Params { const float* in[N_IN]; float* out; char* ws; };

constexpr size_t OFF_BAR = 0, OFF_CNT = 16384, OFF_ROPE = 20480, OFF_MODS = 32768, OFF_WSTAT = 524288;
constexpr size_t W_IN = OFF_WSTAT, W_UQ = W_IN + 3145728, W_UK = W_UQ + 589824, W_UV = W_UK + 262144, W_OA = W_UV + 262144,
                 W_RR = W_OA + 2097152, W_RK = W_RR + 2097152, W_RV = W_RK + 2097152, W_RO = W_RV + 2097152,
                 W_G1 = W_RO + 2097152, W_W1 = W_G1 + 262144, W_A1 = W_W1 + 262144, W_G2 = W_A1 + 262144, W_W2 = W_G2 + 262144, W_A2 = W_W2 + 262144,
                 W_SGU = W_A2 + 262144, W_SD = W_SGU + 2 * 1048576, W_END = W_SD + 2 * 524288;
constexpr size_t OFF_XC = OFF_WSTAT + 20971520;
constexpr size_t OFF_TOKE = OFF_XC + 8388608, OFF_TOKR = OFF_TOKE + 835584, OFF_LTOK = OFF_TOKR + 835584, OFF_LG = OFF_LTOK + 8912896;
constexpr size_t OFF_D = OFF_XC + 8388608 + 20971520;
constexpr size_t WGU_BYTES = 64ull * 512 * 1024 * 2, WD_BYTES = 64ull * 1024 * 256 * 2;
constexpr size_t OFF_WGU = OFF_D, OFF_WD = OFF_D + WGU_BYTES;
constexpr size_t OFF_G = OFF_D + WGU_BYTES + WD_BYTES;
constexpr size_t SZ_T0D = (size_t)T0 * 1024 * 2;
constexpr size_t A_N0 = OFF_G, A_CQ = A_N0 + SZ_T0D, A_CKV = A_CQ + (size_t)T0 * 384 * 2, A_QA = A_CKV + (size_t)T0 * 256 * 2, A_KA = A_QA + (size_t)T0 * 768 * 2,
                 A_VA = A_KA + (size_t)T0 * 768 * 2, A_QS = A_VA + (size_t)T0 * 512 * 2, A_KS = A_QS + (size_t)T0 * 512 * 2, A_VS = A_KS + (size_t)T0 * 128 * 2, A_END = A_VS + (size_t)T0 * 128 * 2;
constexpr size_t M_N1 = OFF_G, M_ACT = M_N1 + SZ_T0D, M_OUTR = M_ACT + (size_t)7 * T0 * 256 * 2, M_END = M_OUTR + (size_t)7 * 8704 * 1024 * 2;
constexpr size_t R_XM0 = OFF_D, R_XM1 = R_XM0 + SZ_T0D, R_XM2 = R_XM1 + SZ_T0D, R_RR = R_XM2 + SZ_T0D, R_RK = R_RR + SZ_T0D, R_RV = R_RK + SZ_T0D, R_NN = R_RV + SZ_T0D,
                 R_HG = R_NN + SZ_T0D, R_HW = R_HG + (size_t)T0 * 128 * 2, R_HA = R_HW + (size_t)T0 * 128 * 2, R_RKB = R_HA + (size_t)T0 * 128 * 2, R_END = R_RKB + (size_t)2 * T0 * 16 * 4;
constexpr size_t R_GG = R_XM0, R_YF = R_XM1, R_YB = R_XM2, R_RD = R_NN;
constexpr size_t WS_NEED = R_END;

constexpr int LDS_BYTES = 64 + 131072;

DEVI unsigned pack2(float a, float b) { f32x2 v = {a, b}; bf2 r = __builtin_convertvector(v, bf2); return __builtin_bit_cast(unsigned, r); }
DEVI float bf_lo(unsigned u) { return __builtin_bit_cast(float, u << 16); }
DEVI float bf_hi(unsigned u) { return __builtin_bit_cast(float, u & 0xffff0000u); }
DEVI float bf1(u16 u) { return __builtin_bit_cast(float, ((unsigned)u) << 16); }
DEVI float dppf(float x, const int ctrl_sel) {
    int xi = __builtin_bit_cast(int, x), y;
    if (ctrl_sel == 0) y = __builtin_amdgcn_mov_dpp(xi, 0xB1, 0xF, 0xF, true);
    else if (ctrl_sel == 1) y = __builtin_amdgcn_mov_dpp(xi, 0x4E, 0xF, 0xF, true);
    else y = __builtin_amdgcn_mov_dpp(xi, 0x141, 0xF, 0xF, true);
    return __builtin_bit_cast(float, y);
}
DEVI float red8_sum(float x) { x += dppf(x, 0); x += dppf(x, 1); x += dppf(x, 2); return x; }
DEVI float red8_max(float x) { x = fmaxf(x, dppf(x, 0)); x = fmaxf(x, dppf(x, 1)); x = fmaxf(x, dppf(x, 2)); return x; }
DEVI float red4_sum(float x) { x += dppf(x, 0); x += dppf(x, 1); return x; }
DEVI float wave_sum(float x) { for (int o = 32; o > 0; o >>= 1) x += __shfl_xor(x, o); return x; }
DEVI float wave_max(float x) { for (int o = 32; o > 0; o >>= 1) x = fmaxf(x, __shfl_xor(x, o)); return x; }
DEVI float sigmoidf_(float x) { return 1.f / (1.f + __expf(-x)); }
DEVI float siluf_(float x) { return x / (1.f + __expf(-x)); }
DEVI float tanhf_(float x) { float e = __expf(2.f * x); return 1.f - 2.f / (e + 1.f); }

#define XB_TMO      128
#define XB_XCNT(j)  (256  + 64 * (j))
#define XB_XSUB(j)  (1280 + 64 * (j))
#define XB_XGEN(j)  (2304 + 64 * (j))
#define XB_TOP      3328
#define XB_TOPGEN   3392
#define XCD_BAR_WORDS 3456
#define XB_SPIN_CAP (1u << 20)
DEVI unsigned xb_ld(unsigned* p)              { return __hip_atomic_load(p, __ATOMIC_RELAXED, __HIP_MEMORY_SCOPE_AGENT); }
DEVI unsigned xb_add(unsigned* p, unsigned v) { return __hip_atomic_fetch_add(p, v, __ATOMIC_RELAXED, __HIP_MEMORY_SCOPE_AGENT); }
DEVI unsigned xb_xcc_id() { return (unsigned)__builtin_amdgcn_s_getreg((3 << 11) | 20) & 0xFu; }
#define XB_SPIN(cond, bar) do { unsigned _sp = 0; while (cond) { __builtin_amdgcn_s_sleep(1); \
    if ((++_sp & 255u) == 0u) { if (xb_ld(&(bar)[XB_TMO])) break; if (_sp > XB_SPIN_CAP) { atomicAdd(&(bar)[XB_TMO], 1u); break; } } } } while (0)
struct XcdBarrier { unsigned* bar; unsigned x; volatile LAS unsigned* st; };
DEVI XcdBarrier xcd_barrier_post(unsigned* bar, volatile LAS unsigned* st) {
    XcdBarrier b; b.bar = bar; b.x = xb_xcc_id(); b.st = st;
    if (threadIdx.x == 0) (void)xb_add(&bar[XB_XCNT(b.x)], 1u);
    return b;
}
DEVI void xcd_barrier_complete(unsigned* bar, unsigned x, unsigned& nloc, unsigned& nx) {
    const unsigned G = gridDim.x * gridDim.y * gridDim.z;
    unsigned sum, cnt, mine, sp = 0u;
    for (;;) {
        sum = 0u; cnt = 0u; mine = 0u;
#pragma unroll
        for (unsigned j = 0; j < 16; ++j) { const unsigned c = xb_ld(&bar[XB_XCNT(j)]); sum += c; cnt += (c > 0u) ? 1u : 0u; mine = (j == x) ? c : mine; }
        if (sum == G) break;
        __builtin_amdgcn_s_sleep(1);
        if ((++sp & 255u) == 0u) { if (xb_ld(&bar[XB_TMO])) break; if (sp > XB_SPIN_CAP) { atomicAdd(&bar[XB_TMO], 1u); break; } }
    }
    nloc = mine > 0u ? mine : 1u; nx = cnt > 0u ? cnt : 1u;
}
DEVI void xcd_barrier(const XcdBarrier& b) {
    asm volatile("s_waitcnt vmcnt(0)" ::: "memory");
    __syncthreads();
    if (threadIdx.x == 0) {
        unsigned* bar = b.bar;
        __builtin_amdgcn_s_waitcnt(0);
        unsigned nloc = b.st[0], nx = b.st[1];
        if (nloc == 0u) { xcd_barrier_complete(bar, b.x, nloc, nx); b.st[0] = nloc; b.st[1] = nx; }
        const unsigned old = xb_add(&bar[XB_XSUB(b.x)], 1u);
        const unsigned gen = old / nloc;
        if (old + 1u == (gen + 1u) * nloc) {
            __builtin_amdgcn_fence(__ATOMIC_RELEASE, "agent");
            asm volatile("s_waitcnt vmcnt(0)" ::: "memory");
            const unsigned og = xb_add(&bar[XB_TOP], 1u);
            const unsigned tg = og / nx;
            if (og + 1u == (tg + 1u) * nx) xb_add(&bar[XB_TOPGEN], 1u);
            else XB_SPIN(xb_ld(&bar[XB_TOPGEN]) == tg, bar);
            __builtin_amdgcn_fence(__ATOMIC_ACQUIRE, "agent");
            xb_add(&bar[XB_XGEN(b.x)], 1u);
            asm volatile("s_waitcnt vmcnt(0)" ::: "memory");
        } else {
            XB_SPIN(xb_ld(&bar[XB_XGEN(b.x)]) == gen, bar);
            __builtin_amdgcn_fence(__ATOMIC_ACQUIRE, "agent");
            asm volatile("s_waitcnt vmcnt(0)" ::: "memory");
        }
    }
    __syncthreads();
}

struct RowSrc { const float* ctx; const float* lat; };
DEVI const float* row_ptr(const RowSrc& s, int mode, int r, int& bb) {
    if (mode == 0) { int b = r / LT, pp = r - b * LT; if (pp < LC) { bb = 8; return s.ctx + (size_t)(b * LC + pp) * DM; } bb = b; return s.lat + (size_t)(b * SEQ + pp - LC) * DM; }
    bb = r >> 12; return s.lat + (size_t)r * DM;
}
DEVI float* row_ptr_w(float* ctx, float* lat, int mode, int r, int& bb) {
    if (mode == 0) { int b = r / LT, pp = r - b * LT; if (pp < LC) { bb = 8; return ctx + (size_t)(b * LC + pp) * DM; } bb = b; return lat + (size_t)(b * SEQ + pp - LC) * DM; }
    bb = r >> 12; return lat + (size_t)r * DM;
}

DEVI float sumsq8(const bf16x8& v) {
    float s = 0.f;
    const unsigned* u = (const unsigned*)&v;
#pragma unroll
    for (int i = 0; i < 4; ++i) { bf2 b = __builtin_bit_cast(bf2, u[i]); s = __builtin_amdgcn_fdot2_f32_bf16(b, b, s, false); }
    return s;
}
template <int BM, int BN, bool ROWNORM, class ARow, class Epi>
DEVI void gemm_tile(ARow arow, const u16* __restrict__ Bt, int ldb, int K, Epi epi, char* lds) {
    constexpr int WN = BN / 64, NA = BM / 64, NBC = BN / 64, STR = 72;
    const int tid = threadIdx.x, lane = tid & 63, w = tid >> 6, wm = w / WN, wn = w % WN, l31 = lane & 31, h = lane >> 5;
    u16* sA = (u16*)lds; u16* sB = sA + 2 * BM * STR;
    const int crow = tid >> 3, kc = tid & 7;
    const u16* pa[NA]; const u16* pb[NBC];
#pragma unroll
    for (int i = 0; i < NA; ++i) pa[i] = arow(crow + 64 * i) + kc * 8;
#pragma unroll
    for (int i = 0; i < NBC; ++i) pb[i] = Bt + (size_t)(crow + 64 * i) * ldb + kc * 8;
    u32x4 ra[NA], rb[NBC];
#pragma unroll
    for (int i = 0; i < NA; ++i) ra[i] = *(const u32x4*)pa[i];
#pragma unroll
    for (int i = 0; i < NBC; ++i) rb[i] = *(const u32x4*)pb[i];
    f32x16 acc[2][2];
#pragma unroll
    for (int a = 0; a < 2; ++a)
#pragma unroll
        for (int b = 0; b < 2; ++b)
#pragma unroll
            for (int i = 0; i < 16; ++i) acc[a][b][i] = 0.f;
    float ss[2] = {0.f, 0.f};
    const int nk = K >> 6;
    for (int kt = 0; kt < nk; ++kt) {
        u16* a_ = sA + (kt & 1) * BM * STR; u16* b_ = sB + (kt & 1) * BN * STR;
#pragma unroll
        for (int i = 0; i < NA; ++i) *(u32x4*)(a_ + (crow + 64 * i) * STR + kc * 8) = ra[i];
#pragma unroll
        for (int i = 0; i < NBC; ++i) *(u32x4*)(b_ + (crow + 64 * i) * STR + kc * 8) = rb[i];
        __syncthreads();
        {
            const int kn = (kt + 1 < nk) ? kt + 1 : kt;
#pragma unroll
            for (int i = 0; i < NA; ++i) ra[i] = *(const u32x4*)(pa[i] + kn * 64);
#pragma unroll
            for (int i = 0; i < NBC; ++i) rb[i] = *(const u32x4*)(pb[i] + kn * 64);
        }
#pragma unroll
        for (int ks = 0; ks < 4; ++ks) {
            bf16x8 af[2], bfr[2];
#pragma unroll
            for (int mi = 0; mi < 2; ++mi) af[mi] = *(const bf16x8*)(a_ + (wm * 64 + mi * 32 + l31) * STR + ks * 16 + h * 8);
#pragma unroll
            for (int ni = 0; ni < 2; ++ni) bfr[ni] = *(const bf16x8*)(b_ + (wn * 64 + ni * 32 + l31) * STR + ks * 16 + h * 8);
            if (ROWNORM) { ss[0] += sumsq8(af[0]); ss[1] += sumsq8(af[1]); }
#pragma unroll
            for (int mi = 0; mi < 2; ++mi)
#pragma unroll
                for (int ni = 0; ni < 2; ++ni) acc[mi][ni] = __builtin_amdgcn_mfma_f32_32x32x16_bf16(bfr[ni], af[mi], acc[mi][ni], 0, 0, 0);
        }
    }
    if (ROWNORM) {
#pragma unroll
        for (int mi = 0; mi < 2; ++mi) {
            float s = ss[mi] + __shfl_xor(ss[mi], 32);
            float r = rsqrtf(s / (float)K + 1e-6f);
#pragma unroll
            for (int ni = 0; ni < 2; ++ni)
#pragma unroll
                for (int i = 0; i < 16; ++i) acc[mi][ni][i] *= r;
        }
    }
#pragma unroll
    for (int mi = 0; mi < 2; ++mi) epi(wm * 64 + mi * 32 + l31, wn * 64, acc[mi], h);
    __syncthreads();
}
DEVI void store_tile_bf16(u16* dst, const f32x16& t, int h) {
#pragma unroll
    for (int g = 0; g < 4; ++g) { uint2 v; v.x = pack2(t[4 * g], t[4 * g + 1]); v.y = pack2(t[4 * g + 2], t[4 * g + 3]); *(uint2*)(dst + 8 * g + 4 * h) = v; }
}
DEVI void rope_tile(f32x16& t, int axis, int pp, int h, const float2* __restrict__ tab) {
    if (pp < LC) return;
    const int s = pp - LC; const int coord = axis ? (s & 63) : (s >> 6);
#pragma unroll
    for (int g = 0; g < 2; ++g)
#pragma unroll
        for (int i = 0; i < 4; ++i) {
            const float2 cs = tab[coord * 16 + 8 * g + 4 * h + i];
            const float x1 = t[4 * g + i], x2 = t[4 * (g + 2) + i];
            t[4 * g + i] = x1 * cs.x - x2 * cs.y; t[4 * (g + 2) + i] = x2 * cs.x + x1 * cs.y;
        }
}

struct CJob { const float* src; u16* dst; const float* gain; int K, ldsrc, nlog, nvalid, sseg, sstride, soff, dseg, dstride, doff; int nmat; size_t smat, dmat; };
DEVI void get_job(const Params& p, int j, int layer, CJob& J) {
    char* ws = p.ws;
    J.gain = nullptr; J.nmat = 1; J.smat = 0; J.dmat = 0; J.sseg = 1 << 30; J.sstride = 0; J.soff = 0; J.dseg = 1 << 30; J.dstride = 0; J.doff = 0;
    auto plain = [&](const float* src, size_t dstoff, int K, int N) { J.src = src; J.dst = (u16*)(ws + dstoff); J.K = K; J.ldsrc = N; J.nlog = N; J.nvalid = N; };
    switch (j) {
    case 0: plain(p.in[I_AWIN], W_IN, 1024, 1472); J.nlog = 1536; break;
    case 1: plain(p.in[I_AWUQ], W_UQ, 384, 768); J.gain = p.in[I_AQN]; break;
    case 2: plain(p.in[I_AWUKV], W_UK, 256, 1024); J.nlog = 512; J.nvalid = 512; J.sseg = 128; J.sstride = 256; J.soff = 0; J.gain = p.in[I_AKVN]; break;
    case 3: plain(p.in[I_AWUKV], W_UV, 256, 1024); J.nlog = 512; J.nvalid = 512; J.sseg = 128; J.sstride = 256; J.soff = 128; J.gain = p.in[I_AKVN]; break;
    case 4: plain(p.in[I_AWO], W_OA, 1024, 1024); break;
    case 5: plain(p.in[I_RWR], W_RR, 1024, 1024); break;
    case 6: plain(p.in[I_RWK], W_RK, 1024, 1024); break;
    case 7: plain(p.in[I_RWV], W_RV, 1024, 1024); break;
    case 8: plain(p.in[I_RWO], W_RO, 1024, 1024); break;
    case 9: plain(p.in[I_RG1], W_G1, 1024, 128); break;
    case 10: plain(p.in[I_RW1], W_W1, 1024, 64); break;
    case 11: plain(p.in[I_RW1] + 1024 * 64, W_W1 + 64 * 1024 * 2, 1024, 64); break;
    case 12: plain(p.in[I_RA1], W_A1, 1024, 64); break;
    case 13: plain(p.in[I_RA1] + 1024 * 64, W_A1 + 64 * 1024 * 2, 1024, 64); break;
    case 14: plain(p.in[I_RG2], W_G2, 128, 1024); break;
    case 15: plain(p.in[I_RW2], W_W2, 64, 1024); break;
    case 16: plain(p.in[I_RW2] + 64 * 1024, W_W2 + 1024 * 64 * 2, 64, 1024); break;
    case 17: plain(p.in[I_RA2], W_A2, 64, 1024); break;
    case 18: plain(p.in[I_RA2] + 64 * 1024, W_A2 + 1024 * 64 * 2, 64, 1024); break;
    case 19: plain(p.in[I_MSG], W_SGU, 1024, 256); J.dseg = 32; J.dstride = 64; J.doff = 0; break;
    case 20: plain(p.in[I_MSU], W_SGU, 1024, 256); J.dseg = 32; J.dstride = 64; J.doff = 32; break;
    case 21: plain(p.in[I_MSG] + 1024 * 256, W_SGU + 1048576, 1024, 256); J.dseg = 32; J.dstride = 64; J.doff = 0; break;
    case 22: plain(p.in[I_MSU] + 1024 * 256, W_SGU + 1048576, 1024, 256); J.dseg = 32; J.dstride = 64; J.doff = 32; break;
    case 23: plain(p.in[I_MSD], W_SD, 256, 1024); break;
    case 24: plain(p.in[I_MSD] + 256 * 1024, W_SD + 524288, 256, 1024); break;
    case 25: plain(p.in[I_MWG] + (size_t)layer * 64 * 1024 * 256, OFF_WGU, 1024, 256); J.dseg = 32; J.dstride = 64; J.doff = 0; J.nmat = 64; J.smat = 1024 * 256; J.dmat = 512 * 1024; break;
    case 26: plain(p.in[I_MWU] + (size_t)layer * 64 * 1024 * 256, OFF_WGU, 1024, 256); J.dseg = 32; J.dstride = 64; J.doff = 32; J.nmat = 64; J.smat = 1024 * 256; J.dmat = 512 * 1024; break;
    default: plain(p.in[I_MWD] + (size_t)layer * 64 * 256 * 1024, OFF_WD, 256, 1024); J.nmat = 64; J.smat = 256 * 1024; J.dmat = 1024 * 256; break;
    }
}
DEVI int job_tiles(const CJob& J) { return J.nmat * (J.nlog / 64) * ((J.K + 127) / 128); }
DEVI void conv_tile(const CJob& J, int t, char* lds) {
    const int ktiles = (J.K + 127) / 128, ntiles = J.nlog / 64;
    const int mat = t / (ktiles * ntiles); const int r = t - mat * ktiles * ntiles; const int nt = r / ktiles, ktile = r - nt * ktiles;
    const float* src = J.src + (size_t)mat * J.smat; u16* dst = J.dst + (size_t)mat * J.dmat;
    unsigned* sm = (unsigned*)lds;
    const int tid = threadIdx.x, ng = tid & 15, kp = tid >> 4;
    const int n0 = nt * 64 + ng * 4;
    const int scol = (n0 / J.sseg) * J.sstride + J.soff + (n0 % J.sseg);
    const bool nval = n0 < J.nvalid;
#pragma unroll
    for (int pass = 0; pass < 2; ++pass) {
        const int k = ktile * 128 + pass * 64 + kp * 2;
        float4 v0 = make_float4(0.f, 0.f, 0.f, 0.f), v1 = v0;
        if (nval && k < J.K) {
            v0 = *(const float4*)(src + (size_t)k * J.ldsrc + scol); v1 = *(const float4*)(src + (size_t)(k + 1) * J.ldsrc + scol);
            if (J.gain) { const float g0 = J.gain[k], g1 = J.gain[k + 1]; v0.x *= g0; v0.y *= g0; v0.z *= g0; v0.w *= g0; v1.x *= g1; v1.y *= g1; v1.z *= g1; v1.w *= g1; }
        }
        const int kk = pass * 32 + kp;
        sm[(ng * 4 + 0) * 66 + kk] = pack2(v0.x, v1.x); sm[(ng * 4 + 1) * 66 + kk] = pack2(v0.y, v1.y);
        sm[(ng * 4 + 2) * 66 + kk] = pack2(v0.z, v1.z); sm[(ng * 4 + 3) * 66 + kk] = pack2(v0.w, v1.w);
    }
    __syncthreads();
#pragma unroll
    for (int i = 0; i < 2; ++i) {
        const int c = tid + 512 * i, row = c >> 4, ch = c & 15;
        const int n = nt * 64 + row; const int drow = (n / J.dseg) * J.dstride + J.doff + (n % J.dseg);
        const int k = ktile * 128 + ch * 8;
        if (k < J.K) { uint2 lo = *(const uint2*)(sm + row * 66 + ch * 4), hi = *(const uint2*)(sm + row * 66 + ch * 4 + 2); uint4 v = make_uint4(lo.x, lo.y, hi.x, hi.y); *(uint4*)(dst + (size_t)drow * J.K + k) = v; }
    }
    __syncthreads();
}
DEVI void conv_jobs(const Params& p, int jlo, int jhi, int layer, int unit_base, char* lds) {
    const int G = gridDim.x, bid = blockIdx.x;
    int acc = unit_base;
    for (int j = jlo; j < jhi; ++j) {
        CJob J; get_job(p, j, layer, J); const int n = job_tiles(J);
        const int t0 = (bid - (acc % G) + G) % G;
        for (int t = t0; t < n; t += G) conv_tile(J, t, lds);
        acc += n;
    }
}
DEVI void mods_unit(const Params& p, int u, char* lds) {
    const int l = u / 96, cg = u % 96;
    float* sil = (float*)lds;
    float* red = sil + 1024 * 12;
    const int tid = threadIdx.x, lane = tid & 63, w = tid >> 6;
    for (int i = tid; i < 9 * 1024; i += 512) { const int bb = i >> 10, k = i & 1023; const float v = bb < 8 ? p.in[I_C][bb * 1024 + k] : p.in[I_CCTX][k]; sil[k * 12 + bb] = siluf_(v); }
    __syncthreads();
    float acc[9];
#pragma unroll
    for (int i = 0; i < 9; ++i) acc[i] = 0.f;
    const float* wp = p.in[I_ADAW] + (size_t)l * 1024 * 6144 + cg * 64 + lane;
#pragma unroll 4
    for (int kk = 0; kk < 128; ++kk) {
        const int k = w * 128 + kk; const float wv = wp[(size_t)k * 6144];
        const float4 s0 = *(const float4*)(sil + k * 12), s1 = *(const float4*)(sil + k * 12 + 4); const float s2 = sil[k * 12 + 8];
        acc[0] += s0.x * wv; acc[1] += s0.y * wv; acc[2] += s0.z * wv; acc[3] += s0.w * wv; acc[4] += s1.x * wv; acc[5] += s1.y * wv; acc[6] += s1.z * wv; acc[7] += s1.w * wv; acc[8] += s2 * wv;
    }
#pragma unroll
    for (int i = 0; i < 9; ++i) red[(w * 9 + i) * 64 + lane] = acc[i];
    __syncthreads();
    for (int i = tid; i < 9 * 64; i += 512) {
        const int bb = i >> 6, c = i & 63; float s = 0.f;
        for (int ww = 0; ww < 8; ++ww) s += red[(ww * 9 + bb) * 64 + c];
        const int col = cg * 64 + c;
        ((float*)(p.ws + OFF_MODS))[(size_t)(l * 9 + bb) * 6144 + col] = s + p.in[I_ADAB][l * 6144 + col];
    }
    __syncthreads();
}
DEVI void phase_prologue(const Params& p, char* lds) {
    const int bid = blockIdx.x, G = gridDim.x;
    if (bid == G - 1) {
        int* cnt = (int*)(p.ws + OFF_CNT);
        for (int i = threadIdx.x; i < 2 * NCHUNK * 64; i += 512) cnt[i] = 0;
        float2* tab = (float2*)(p.ws + OFF_ROPE);
        for (int i = threadIdx.x; i < 64 * 16; i += 512) { const int coord = i >> 4, f = i & 15; const float inv = exp2f(-(float)f * (13.287712379549449f / 16.f)); const float a = (float)coord * inv; tab[i] = make_float2(cosf(a), sinf(a)); }
    }
    for (int u = bid; u < 192; u += G) mods_unit(p, u, lds);
    conv_jobs(p, 0, 25, 0, 192, lds);
}

DEVI void norm_rows(const RowSrc& src, int mode, int nrows, const float* __restrict__ gain, const float* __restrict__ mods_l, int ishift, int iscale, u16* __restrict__ dst) {
    const int lane = threadIdx.x & 63, w = threadIdx.x >> 6;
    for (int r = blockIdx.x * 8 + w; r < nrows; r += gridDim.x * 8) {
        int bb; const float* xr = row_ptr(src, mode, r, bb);
        float4 v[4]; float ss = 0.f;
#pragma unroll
        for (int i = 0; i < 4; ++i) { v[i] = ((const float4*)xr)[lane + 64 * i]; ss += v[i].x * v[i].x + v[i].y * v[i].y + v[i].z * v[i].z + v[i].w * v[i].w; }
        ss = wave_sum(ss);
        const float rs = rsqrtf(ss * (1.f / 1024.f) + 1e-6f);
        const float* msh = mods_l + (size_t)bb * 6144 + ishift * 1024; const float* msc = mods_l + (size_t)bb * 6144 + iscale * 1024;
#pragma unroll
        for (int i = 0; i < 4; ++i) {
            const int c = (lane + 64 * i) * 4;
            const float4 g = *(const float4*)(gain + c), sh = *(const float4*)(msh + c), sc = *(const float4*)(msc + c);
            uint2 o; o.x = pack2(v[i].x * rs * g.x * (1.f + sc.x) + sh.x, v[i].y * rs * g.y * (1.f + sc.y) + sh.y);
            o.y = pack2(v[i].z * rs * g.z * (1.f + sc.z) + sh.z, v[i].w * rs * g.w * (1.f + sc.w) + sh.w);
            *(uint2*)(dst + (size_t)r * DM + c) = o;
        }
    }
}

DEVI void phase_gemm_win(const Params& p, char* lds) {
    const u16* A = (const u16*)(p.ws + A_N0); const u16* W = (const u16*)(p.ws + W_IN);
    u16* CQ = (u16*)(p.ws + A_CQ); u16* CKV = (u16*)(p.ws + A_CKV); u16* KA = (u16*)(p.ws + A_KA); u16* QS = (u16*)(p.ws + A_QS); u16* KS = (u16*)(p.ws + A_KS); u16* VS = (u16*)(p.ws + A_VS);
    const float2* tab = (const float2*)(p.ws + OFF_ROPE);
    const int NT = 12, MT = T0 / 256;
    for (int u = blockIdx.x; u < NT * MT; u += gridDim.x) {
        const int mt = u / NT, nt = u % NT; const int m0 = mt * 256, n0 = nt * 128;
        auto arow = [&](int r) { return A + (size_t)(m0 + r) * DM; };
        auto epi = [&](int r, int cw, f32x16 (&t)[2], int h) {
            const int row = m0 + r; const int b = row / LT, pp = row - b * LT;
#pragma unroll
            for (int ni = 0; ni < 2; ++ni) {
                const int c32 = n0 + cw + ni * 32;
                if (c32 < 384) store_tile_bf16(CQ + (size_t)row * 384 + c32, t[ni], h);
                else if (c32 < 640) store_tile_bf16(CKV + (size_t)row * 256 + (c32 - 384), t[ni], h);
                else if (c32 < 704) { const int cc = c32 - 640; rope_tile(t[ni], cc >> 5, pp, h, tab);
                    for (int hd = 0; hd < 4; ++hd) store_tile_bf16(KA + ((size_t)(b * 4 + hd) * LT + pp) * 192 + 128 + cc, t[ni], h); }
                else if (c32 < 1216) { const int cc = c32 - 704; rope_tile(t[ni], (cc >> 5) & 1, pp, h, tab);
#pragma unroll
                    for (int i = 0; i < 16; ++i) t[ni][i] *= QS_SCALE;
                    store_tile_bf16(QS + ((size_t)(b * 8 + (cc >> 6)) * LT + pp) * 64 + (cc & 63), t[ni], h); }
                else if (c32 < 1344) { const int cc = c32 - 1216; rope_tile(t[ni], (cc >> 5) & 1, pp, h, tab);
                    store_tile_bf16(KS + ((size_t)(b * 2 + (cc >> 6)) * LT + pp) * 64 + (cc & 63), t[ni], h); }
                else if (c32 < 1472) { const int cc = c32 - 1344; store_tile_bf16(VS + ((size_t)(b * 2 + (cc >> 6)) * LT + pp) * 64 + (cc & 63), t[ni], h); }
            }
        };
        gemm_tile<256, 128, false>(arow, W + (size_t)n0 * DM, DM, DM, epi, lds);
    }
}
DEVI void phase_gemm_qkv(const Params& p, char* lds) {
    const u16* CQ = (const u16*)(p.ws + A_CQ); const u16* CKV = (const u16*)(p.ws + A_CKV);
    u16* QA = (u16*)(p.ws + A_QA); u16* KA = (u16*)(p.ws + A_KA); u16* VA = (u16*)(p.ws + A_VA);
    const float2* tab = (const float2*)(p.ws + OFF_ROPE);
    const int MT = T0 / 256;
    for (int u = blockIdx.x; u < 14 * MT; u += gridDim.x) {
        const int mt = u / 14, j = u % 14; const int m0 = mt * 256;
        if (j < 6) {
            const int n0 = j * 128;
            auto arow = [&](int r) { return CQ + (size_t)(m0 + r) * 384; };
            auto epi = [&](int r, int cw, f32x16 (&t)[2], int h) {
                const int row = m0 + r; const int b = row / LT, pp = row - b * LT;
#pragma unroll
                for (int ni = 0; ni < 2; ++ni) {
                    const int c32 = n0 + cw + ni * 32; const int hd = c32 / 192, wi = c32 - hd * 192;
                    if (wi >= 128) rope_tile(t[ni], (wi - 128) >> 5, pp, h, tab);
#pragma unroll
                    for (int i = 0; i < 16; ++i) t[ni][i] *= QA_SCALE;
                    store_tile_bf16(QA + ((size_t)(b * 4 + hd) * LT + pp) * 192 + wi, t[ni], h);
                }
            };
            gemm_tile<256, 128, true>(arow, (const u16*)(p.ws + W_UQ) + (size_t)n0 * 384, 384, 384, epi, lds);
        } else {
            const bool isv = j >= 10; const int n0 = (isv ? j - 10 : j - 6) * 128;
            auto arow = [&](int r) { return CKV + (size_t)(m0 + r) * 256; };
            auto epi = [&](int r, int cw, f32x16 (&t)[2], int h) {
                const int row = m0 + r; const int b = row / LT, pp = row - b * LT;
#pragma unroll
                for (int ni = 0; ni < 2; ++ni) {
                    const int c32 = n0 + cw + ni * 32; const int hd = c32 >> 7, wi = c32 & 127;
                    if (isv) store_tile_bf16(VA + ((size_t)(b * 4 + hd) * LT + pp) * 128 + wi, t[ni], h);
                    else store_tile_bf16(KA + ((size_t)(b * 4 + hd) * LT + pp) * 192 + wi, t[ni], h);
                }
            };
            gemm_tile<256, 128, true>(arow, (const u16*)(p.ws + (isv ? W_UV : W_UK)) + (size_t)n0 * 256, 256, 256, epi, lds);
        }
    }
}

template <int DQK, int DV, bool SWA>
DEVI void attn_unit(const u16* __restrict__ Q, const u16* __restrict__ Kp, const u16* __restrict__ Vp, int q0, int a0, int na, int b0, int nb2,
                    float m_init, u16* __restrict__ outp  , char* lds) {
    constexpr int KSTR = DQK + 8, VSTR = DV + 32, KCH = DQK / 8, VCH = DV / 8, NKC = 64 * KCH / 512, NVC = 64 * VCH / 512, NS = DQK / 16, NDT = DV / 32;
    const int tid = threadIdx.x, lane = tid & 63, w = tid >> 6, l31 = lane & 31, h = lane >> 5;
    u16* sK = (u16*)lds; u16* sV = sK + 2 * 64 * KSTR;
    const int qpos = q0 + w * 32 + l31;
    bf16x8 qf[NS];
#pragma unroll
    for (int s = 0; s < NS; ++s) qf[s] = *(const bf16x8*)(Q + (size_t)qpos * DQK + s * 16 + h * 8);
    f32x16 o[NDT];
#pragma unroll
    for (int d = 0; d < NDT; ++d)
#pragma unroll
        for (int i = 0; i < 16; ++i) o[d][i] = 0.f;
    float m = m_init, lsum = 0.f;
    const int nt = na + nb2;
    u32x4 rk[NKC], rv[NVC];
    auto tile_pos = [&](int t) { return t < na ? a0 + 64 * t : b0 + 64 * (t - na); };
    auto gload = [&](int t) {
        const int kp0 = tile_pos(t);
        const u16* kb_ = Kp + (size_t)kp0 * DQK + tid * 8; const u16* vb_ = Vp + (size_t)kp0 * DV + tid * 8;
#pragma unroll
        for (int i = 0; i < NKC; ++i) rk[i] = *(const u32x4*)(kb_ + 4096 * i);
#pragma unroll
        for (int i = 0; i < NVC; ++i) rv[i] = *(const u32x4*)(vb_ + 4096 * i);
    };
    gload(0);
    const int tr_row = 4 * h + ((lane & 15) >> 2), tr_col = 16 * ((lane >> 4) & 1) + 4 * (lane & 3);
    for (int t = 0; t < nt; ++t) {
        u16* k_ = sK + (t & 1) * 64 * KSTR; u16* v_ = sV + (t & 1) * 64 * VSTR;
#pragma unroll
        for (int i = 0; i < NKC; ++i) { const int c = tid + 512 * i, row = c / KCH, ch = c % KCH; *(u32x4*)(k_ + row * KSTR + ch * 8) = rk[i]; }
#pragma unroll
        for (int i = 0; i < NVC; ++i) { const int c = tid + 512 * i, row = c / VCH, ch = c % VCH; *(u32x4*)(v_ + row * VSTR + ch * 8) = rv[i]; }
        __syncthreads();
        if (t + 1 < nt) gload(t + 1);
        f32x16 st[2];
#pragma unroll
        for (int k2 = 0; k2 < 2; ++k2) {
#pragma unroll
            for (int i = 0; i < 16; ++i) st[k2][i] = 0.f;
#pragma unroll
            for (int s = 0; s < NS; ++s) {
                const bf16x8 kf = *(const bf16x8*)(k_ + (k2 * 32 + l31) * KSTR + s * 16 + h * 8);
                st[k2] = __builtin_amdgcn_mfma_f32_32x32x16_bf16(kf, qf[s], st[k2], 0, 0, 0);
            }
        }
        if (SWA && t >= na) {
            const int kp0 = tile_pos(t);
#pragma unroll
            for (int k2 = 0; k2 < 2; ++k2)
#pragma unroll
                for (int i = 0; i < 16; ++i) {
                    const int key = kp0 + k2 * 32 + (i & 3) + 8 * (i >> 2) + 4 * h; const int d = qpos - key;
                    if (d > 128 || d < -128) st[k2][i] = -1e30f;
                }
        }
        float mx = st[0][0];
#pragma unroll
        for (int k2 = 0; k2 < 2; ++k2)
#pragma unroll
            for (int i = 0; i < 16; ++i) mx = fmaxf(mx, st[k2][i]);
        mx = fmaxf(mx, __shfl_xor(mx, 32));
        const float mn = fmaxf(m, mx); const float alpha = __builtin_amdgcn_exp2f(m - mn); m = mn;
        float ps = 0.f;
#pragma unroll
        for (int k2 = 0; k2 < 2; ++k2)
#pragma unroll
            for (int i = 0; i < 16; ++i) { const float pv = __builtin_amdgcn_exp2f(st[k2][i] - mn); st[k2][i] = pv; ps += pv; }
        lsum = lsum * alpha + ps;
#pragma unroll
        for (int d = 0; d < NDT; ++d)
#pragma unroll
            for (int i = 0; i < 16; ++i) o[d][i] *= alpha;
#pragma unroll
        for (int s16 = 0; s16 < 4; ++s16) {
            bf16x8 pf; unsigned* pu = (unsigned*)&pf;
#pragma unroll
            for (int jj = 0; jj < 4; ++jj) pu[jj] = pack2(st[s16 >> 1][8 * (s16 & 1) + 2 * jj], st[s16 >> 1][8 * (s16 & 1) + 2 * jj + 1]);
#pragma unroll
            for (int d = 0; d < NDT; ++d) {
                const u16* base = v_ + (16 * s16 + tr_row) * VSTR + d * 32 + tr_col;
                const s16x4 lo = __builtin_amdgcn_ds_read_tr16_b64_v4i16((LAS s16x4*)(base));
                const s16x4 hi = __builtin_amdgcn_ds_read_tr16_b64_v4i16((LAS s16x4*)(base + 8 * VSTR));
                bf16x8 vf; vf[0] = lo[0]; vf[1] = lo[1]; vf[2] = lo[2]; vf[3] = lo[3]; vf[4] = hi[0]; vf[5] = hi[1]; vf[6] = hi[2]; vf[7] = hi[3];
                o[d] = __builtin_amdgcn_mfma_f32_32x32x16_bf16(vf, pf, o[d], 0, 0, 0);
            }
        }
    }
    float lt = lsum + __shfl_xor(lsum, 32);
    if (SWA) lt += __builtin_amdgcn_exp2f(m_init - m);
    const float inv = 1.f / lt;
    u16* orow = outp + (size_t)qpos * DM;
#pragma unroll
    for (int d = 0; d < NDT; ++d)
#pragma unroll
        for (int g = 0; g < 4; ++g) { uint2 v; v.x = pack2(o[d][4 * g] * inv, o[d][4 * g + 1] * inv); v.y = pack2(o[d][4 * g + 2] * inv, o[d][4 * g + 3] * inv); *(uint2*)(orow + d * 32 + 8 * g + 4 * h) = v; }
    __syncthreads();
}
DEVI void phase_attention(const Params& p, char* lds) {
    const u16* QA = (const u16*)(p.ws + A_QA); const u16* KA = (const u16*)(p.ws + A_KA); const u16* VA = (const u16*)(p.ws + A_VA);
    const u16* QS = (const u16*)(p.ws + A_QS); const u16* KS = (const u16*)(p.ws + A_KS); const u16* VS = (const u16*)(p.ws + A_VS);
    u16* mix = (u16*)(p.ws + A_N0);
    for (int u = blockIdx.x; u < 1632; u += gridDim.x) {
        if (u < 544) {
            int b, hd, q0, na;
            if (u < 512) { b = u >> 6; hd = (u >> 4) & 3; q0 = LC + (u & 15) * 256; na = 68; }
            else { const int v = u - 512; b = v >> 2; hd = v & 3; q0 = 0; na = 4; }
            const size_t bh = (size_t)(b * 4 + hd) * LT;
            attn_unit<192, 128, false>(QA + bh * 192, KA + bh * 192, VA + bh * 128, q0, 0, na, 0, 0, -1e30f, mix + (size_t)b * LT * DM + hd * 128, lds);
        } else {
            int b, hd, q0, b0 = 0, nb2 = 0;
            if (u < 1568) { const int v = u - 544; b = v >> 7; hd = (v >> 4) & 7; const int s0 = (v & 15) * 256; q0 = LC + s0;
                int lo = s0 - 128; if (lo < 0) lo = 0; int hi = s0 + 256 + 128; if (hi > SEQ) hi = SEQ; b0 = LC + lo; nb2 = (hi - lo) >> 6; }
            else { const int v = u - 1568; b = v >> 3; hd = v & 7; q0 = 0; }
            const int kvh = hd >> 2; const size_t qb = (size_t)(b * 8 + hd) * LT, kb = (size_t)(b * 2 + kvh) * LT;
            attn_unit<64, 64, true>(QS + qb * 64, KS + kb * 64, VS + kb * 64, q0, 0, 4, b0, nb2, p.in[I_ASINK][hd] * LOG2E, mix + (size_t)b * LT * DM + 512 + hd * 64, lds);
        }
    }
}
DEVI void phase_gemm_wo(const Params& p, const u16* A, const u16* W, const RowSrc& resid, int mode, int layer, char* lds) {
    float* XC = (float*)(p.ws + OFF_XC); float* XL = p.out;
    const float* mods_l = (const float*)(p.ws + OFF_MODS) + (size_t)layer * 9 * 6144;
    const int MT = (mode == 0 ? T0 : TL) / 256;
    for (int u = blockIdx.x; u < 8 * MT; u += gridDim.x) {
        const int mt = u >> 3, nt = u & 7; const int m0 = mt * 256, n0 = nt * 128;
        auto arow = [&](int r) { return A + (size_t)(m0 + r) * DM; };
        auto epi = [&](int r, int cw, f32x16 (&t)[2], int h) {
            int bb; const float* rs = row_ptr(resid, mode, m0 + r, bb); int bb2; float* xo = row_ptr_w(XC, XL, mode, m0 + r, bb2);
            const float* mg = mods_l + (size_t)bb * 6144 + 2 * 1024;
#pragma unroll
            for (int ni = 0; ni < 2; ++ni)
#pragma unroll
                for (int g = 0; g < 4; ++g) {
                    const int c = n0 + cw + ni * 32 + 8 * g + 4 * h;
                    const float4 rv = *(const float4*)(rs + c), gv = *(const float4*)(mg + c);
                    float4 ov; ov.x = rv.x + gv.x * t[ni][4 * g]; ov.y = rv.y + gv.y * t[ni][4 * g + 1]; ov.z = rv.z + gv.z * t[ni][4 * g + 2]; ov.w = rv.w + gv.w * t[ni][4 * g + 3];
                    *(float4*)(xo + c) = ov;
                }
        };
        gemm_tile<256, 128, false>(arow, W + (size_t)n0 * DM, DM, DM, epi, lds);
    }
}

DEVI void phase_moe_route(const Params& p, int layer, char* lds) {
    const int mode = layer == 0 ? 0 : 1; const int ntok = layer == 0 ? T0 : TL; const int tc = ntok / NCHUNK;
    RowSrc src; src.ctx = (const float*)(p.ws + OFF_XC); src.lat = p.out;
    const float* gain = p.in[I_NFFN] + layer * 1024; const float* mods_l = (const float*)(p.ws + OFF_MODS) + (size_t)layer * 9 * 6144;
    const float* wr = p.in[I_MROUT] + (size_t)layer * 1024 * 64; const float ebias = p.in[I_MBIAS][layer * 64 + (threadIdx.x & 63)];
    u16* n1 = (u16*)(p.ws + M_N1);
    int* cnt = (int*)(p.ws + OFF_CNT) + layer * NCHUNK * 64;
    int* tok_e = (int*)(p.ws + OFF_TOKE); int* tok_r = (int*)(p.ws + OFF_TOKR); int* ltok = (int*)(p.ws + OFF_LTOK); float* lg = (float*)(p.ws + OFF_LG);
    const int lane = threadIdx.x & 63, w = threadIdx.x >> 6;
    float* sn = (float*)lds + w * 4096;
    for (int t0 = (blockIdx.x * 8 + w) * 4; t0 < ntok; t0 += gridDim.x * 32) {
#pragma unroll
        for (int j = 0; j < 4; ++j) {
            const int r = t0 + j; int bb; const float* xr = row_ptr(src, mode, r, bb);
            float4 v[4]; float ss = 0.f;
#pragma unroll
            for (int i = 0; i < 4; ++i) { v[i] = ((const float4*)xr)[lane + 64 * i]; ss += v[i].x * v[i].x + v[i].y * v[i].y + v[i].z * v[i].z + v[i].w * v[i].w; }
            ss = wave_sum(ss);
            const float rs = rsqrtf(ss * (1.f / 1024.f) + 1e-6f);
            const float* msh = mods_l + (size_t)bb * 6144 + 3 * 1024; const float* msc = mods_l + (size_t)bb * 6144 + 4 * 1024;
#pragma unroll
            for (int i = 0; i < 4; ++i) {
                const int c = (lane + 64 * i) * 4;
                const float4 g = *(const float4*)(gain + c), sh = *(const float4*)(msh + c), sc = *(const float4*)(msc + c);
                const float y0 = v[i].x * rs * g.x * (1.f + sc.x) + sh.x, y1 = v[i].y * rs * g.y * (1.f + sc.y) + sh.y, y2 = v[i].z * rs * g.z * (1.f + sc.z) + sh.z, y3 = v[i].w * rs * g.w * (1.f + sc.w) + sh.w;
                uint2 o; o.x = pack2(y0, y1); o.y = pack2(y2, y3);
                *(uint2*)(n1 + (size_t)r * DM + c) = o;
                sn[(c + 0) * 4 + j] = y0; sn[(c + 1) * 4 + j] = y1; sn[(c + 2) * 4 + j] = y2; sn[(c + 3) * 4 + j] = y3;
            }
        }
        __builtin_amdgcn_s_waitcnt(0xc07f);
        __builtin_amdgcn_wave_barrier();
        float a0 = 0.f, a1 = 0.f, a2 = 0.f, a3 = 0.f;
#pragma unroll 8
        for (int k = 0; k < 1024; ++k) { const float wv = wr[k * 64 + lane]; const float4 s = *(const float4*)(sn + k * 4); a0 += s.x * wv; a1 += s.y * wv; a2 += s.z * wv; a3 += s.w * wv; }
        __builtin_amdgcn_wave_barrier();
        const float lgt[4] = {a0, a1, a2, a3};
#pragma unroll
        for (int j = 0; j < 4; ++j) {
            const int tok = t0 + j;
            const float score = 1.f / (1.f + expf(-lgt[j])); const float choice = score + ebias;
            const float m1 = red8_max(choice);
            const unsigned long long bm = __ballot(choice == m1);
            const unsigned gm = (unsigned)(bm >> (lane & 56)) & 0xffu; const int first = __ffs(gm) - 1;
            const float m2 = red8_max(((lane & 7) == first) ? -INFINITY : choice);
            const float gs = m1 + m2;
            int rank = 0;
#pragma unroll
            for (int g2 = 0; g2 < 8; ++g2) { const float og = __shfl(gs, g2 * 8); rank += (og > gs || (og == gs && g2 < (lane >> 3))) ? 1 : 0; }
            float cm = rank < 4 ? choice : -INFINITY;
            unsigned long long sel = 0ull; float ssum = 0.f;
#pragma unroll
            for (int it = 0; it < 6; ++it) {
                const float mxv = wave_max(cm);
                const unsigned long long bmm = __ballot(cm == mxv);
                const int win = __ffsll((long long)bmm) - 1;
                sel |= 1ull << win; ssum += __shfl(score, win);
                if (lane == win) cm = -INFINITY;
            }
            if ((sel >> lane) & 1ull) {
                const int jj = __popcll(sel & ((1ull << lane) - 1ull));
                const int ch = tok / tc; const int rk = atomicAdd(&cnt[ch * 64 + lane], 1);
                tok_e[tok * 6 + jj] = lane; tok_r[tok * 6 + jj] = rk;
                ltok[((size_t)ch * 64 + lane) * tc + rk] = tok; lg[((size_t)ch * 64 + lane) * tc + rk] = 2.5f * score / ssum;
            }
        }
    }
}
struct SegTab { int* cnt; int* off; int* tpre; };
DEVI SegTab build_segtab(const Params& p, int layer, int tc, char* lds_tab) {
    SegTab T; T.cnt = (int*)lds_tab; T.off = T.cnt + 264; T.tpre = T.off + 264;
    const int* cnt = (const int*)(p.ws + OFF_CNT) + layer * NCHUNK * 64;
    const int tid = threadIdx.x;
    if (tid < 260) { const int ch = tid / 65, e = tid % 65; T.cnt[tid] = e < 64 ? cnt[ch * 64 + e] : tc; }
    __syncthreads();
    if (tid < 64) {
        int lc[5], lt_[5]; int sc = 0, st = 0;
#pragma unroll
        for (int j = 0; j < 5; ++j) { const int s = 5 * tid + j; const int v = s < 260 ? T.cnt[s] : 0; lc[j] = sc; lt_[j] = st; sc += v; st += (v + 127) >> 7; }
        int ic = sc, it = st;
        for (int o = 1; o < 64; o <<= 1) { const int a = __shfl_up(ic, o), b2 = __shfl_up(it, o); if (tid >= o) { ic += a; it += b2; } }
        const int bc = ic - sc, bt = it - st;
#pragma unroll
        for (int j = 0; j < 5; ++j) { const int s = 5 * tid + j; if (s <= 260) { T.tpre[s] = bt + lt_[j]; T.off[s] = bc + lc[j]; } }
    }
    __syncthreads();
    return T;
}
DEVI int find_seg(const SegTab& T, int lo_seg, int hi_seg, int mt) {
    int lo = lo_seg, hi = hi_seg;
    while (hi - lo > 1) { const int mid = (lo + hi) >> 1; if (T.tpre[mid] <= mt) lo = mid; else hi = mid; }
    return lo;
}
DEVI void phase_moe_gemm1(const Params& p, int layer, char* lds) {
    const int ntok = layer == 0 ? T0 : TL; const int tc = ntok / NCHUNK;
    char* tabmem = lds + 110592; SegTab T = build_segtab(p, layer, tc, tabmem);
    const u16* n1 = (const u16*)(p.ws + M_N1); u16* act = (u16*)(p.ws + M_ACT);
    const int* ltok = (const int*)(p.ws + OFF_LTOK); const float* lg = (const float*)(p.ws + OFF_LG);
    const int nunits = T.tpre[260] * 2;
    for (int u = blockIdx.x; u < nunits; u += gridDim.x) {
        const int mt = u >> 1, nt = u & 1; const int seg = find_seg(T, 0, 260, mt); const int ch = seg / 65, e = seg % 65;
        const int cntv = T.cnt[seg], row0 = (mt - T.tpre[seg]) * 128; const int n0 = nt * 256;
        const int* lt = ltok + ((size_t)ch * 64 + e) * tc; const float* lgp = lg + ((size_t)ch * 64 + e) * tc;
        const u16* W = e < 64 ? (const u16*)(p.ws + OFF_WGU) + (size_t)e * 512 * 1024 : (const u16*)(p.ws + W_SGU) + (size_t)layer * 512 * 1024;
        auto arow = [&](int r) { int s = row0 + r; if (s >= cntv) s = cntv - 1; const int tok = e < 64 ? lt[s] : ch * tc + s; return n1 + (size_t)tok * DM; };
        const size_t arow0 = (size_t)ch * 7 * tc + (T.off[seg] - T.off[ch * 65]) + row0;
        auto epi = [&](int r, int cw, f32x16 (&t)[2], int h) {
            const int s = row0 + r; if (s >= cntv) return;
            const float gw = e < 64 ? lgp[s] : 1.f;
            u16* dst = act + (arow0 + r) * 256 + ((n0 + cw) >> 1);
#pragma unroll
            for (int g = 0; g < 4; ++g) {
                float o4[4];
#pragma unroll
                for (int i = 0; i < 4; ++i) { const float gt = t[0][4 * g + i], up = t[1][4 * g + i]; o4[i] = gt / (1.f + __expf(-gt)) * up * gw; }
                uint2 v; v.x = pack2(o4[0], o4[1]); v.y = pack2(o4[2], o4[3]); *(uint2*)(dst + 8 * g + 4 * h) = v;
            }
        };
        gemm_tile<128, 256, false>(arow, W + (size_t)n0 * DM, DM, DM, epi, lds);
    }
}
DEVI void phase_moe_gemm2(const Params& p, int layer, int ch, char* lds) {
    const int ntok = layer == 0 ? T0 : TL; const int tc = ntok / NCHUNK;
    char* tabmem = lds + 110592; SegTab T = build_segtab(p, layer, tc, tabmem);
    const u16* act = (const u16*)(p.ws + M_ACT); u16* outr = (u16*)(p.ws + M_OUTR);
    const int t_lo = T.tpre[ch * 65], t_hi = T.tpre[ch * 65 + 65];
    const int nunits = (t_hi - t_lo) * 4;
    for (int u = blockIdx.x; u < nunits; u += gridDim.x) {
        const int mt = t_lo + (u >> 2), nt = u & 3; const int seg = find_seg(T, ch * 65, ch * 65 + 65, mt); const int e = seg % 65;
        const int cntv = T.cnt[seg], row0 = (mt - T.tpre[seg]) * 128; const int n0 = nt * 256;
        const size_t lrow0 = (size_t)(T.off[seg] - T.off[ch * 65]) + row0;
        const u16* A = act + ((size_t)ch * 7 * tc + lrow0) * 256;
        const u16* W = e < 64 ? (const u16*)(p.ws + OFF_WD) + (size_t)e * 1024 * 256 : (const u16*)(p.ws + W_SD) + (size_t)layer * 1024 * 256;
        auto arow = [&](int r) { int s = row0 + r; if (s >= cntv) s = cntv - 1; return A + (size_t)(s - row0) * 256; };
        auto epi = [&](int r, int cw, f32x16 (&t)[2], int h) {
            if (row0 + r >= cntv) return;
            u16* dst = outr + (lrow0 + r) * DM + n0 + cw;
            store_tile_bf16(dst, t[0], h); store_tile_bf16(dst + 32, t[1], h);
        };
        gemm_tile<128, 256, false>(arow, W + (size_t)n0 * 256, 256, 256, epi, lds);
    }
}
DEVI void phase_moe_combine(const Params& p, int layer, int ch, char* lds) {
    const int mode = layer == 0 ? 0 : 1; const int ntok = layer == 0 ? T0 : TL; const int tc = ntok / NCHUNK;
    SegTab T = build_segtab(p, layer, tc, lds);
    const u16* outr = (const u16*)(p.ws + M_OUTR); const int* tok_e = (const int*)(p.ws + OFF_TOKE); const int* tok_r = (const int*)(p.ws + OFF_TOKR);
    float* XC = (float*)(p.ws + OFF_XC); float* XL = p.out;
    const float* mods_l = (const float*)(p.ws + OFF_MODS) + (size_t)layer * 9 * 6144;
    const int lane = threadIdx.x & 63, w = threadIdx.x >> 6;
    for (int tl = blockIdx.x * 8 + w; tl < tc; tl += gridDim.x * 8) {
        const int tok = ch * tc + tl; int bb; float* xr = row_ptr_w(XC, XL, mode, tok, bb);
        const float* mg = mods_l + (size_t)bb * 6144 + 5 * 1024;
        int rows[7];
#pragma unroll
        for (int j = 0; j < 6; ++j) rows[j] = T.off[ch * 65 + tok_e[tok * 6 + j]] - T.off[ch * 65] + tok_r[tok * 6 + j];
        rows[6] = 6 * tc + tl;
#pragma unroll
        for (int i = 0; i < 2; ++i) {
            const int c = (lane + 64 * i) * 8;
            float acc[8];
#pragma unroll
            for (int q = 0; q < 8; ++q) acc[q] = 0.f;
#pragma unroll
            for (int j = 0; j < 7; ++j) {
                const uint4 v = *(const uint4*)(outr + (size_t)rows[j] * DM + c);
                acc[0] += bf_lo(v.x); acc[1] += bf_hi(v.x); acc[2] += bf_lo(v.y); acc[3] += bf_hi(v.y); acc[4] += bf_lo(v.z); acc[5] += bf_hi(v.z); acc[6] += bf_lo(v.w); acc[7] += bf_hi(v.w);
            }
            float4 x0 = *(float4*)(xr + c), x1 = *(float4*)(xr + c + 4); const float4 g0 = *(const float4*)(mg + c), g1 = *(const float4*)(mg + c + 4);
            x0.x += g0.x * acc[0]; x0.y += g0.y * acc[1]; x0.z += g0.z * acc[2]; x0.w += g0.w * acc[3]; x1.x += g1.x * acc[4]; x1.y += g1.y * acc[5]; x1.z += g1.z * acc[6]; x1.w += g1.w * acc[7];
            *(float4*)(xr + c) = x0; *(float4*)(xr + c + 4) = x1;
        }
    }
}

DEVI void phase_rwkv_mix(const Params& p, int i0, int i1, int i2) {
    const u16* nn = (const u16*)(p.ws + R_NN); u16* xm = (u16*)(p.ws + R_XM0);
    const float* mu = p.in[I_RMU]; const int idx[3] = {i0, i1, i2};
    const int lane = threadIdx.x & 63, w = threadIdx.x >> 6;
    for (int r = blockIdx.x * 8 + w; r < T0; r += gridDim.x * 8) {
        const int b = r / LT, pp = r - b * LT;
        const bool hasprev = (pp != 0) && (pp != LC), hasnext = (pp != LC - 1) && (pp != LT - 1);
#pragma unroll
        for (int half = 0; half < 2; ++half) {
            const int c = half * 512 + lane * 8;
            const uint4 cur = *(const uint4*)(nn + (size_t)r * DM + c);
            uint4 sh = make_uint4(0, 0, 0, 0);
            if (half == 0) { if (hasprev) sh = *(const uint4*)(nn + (size_t)(r - 1) * DM + c); }
            else { if (hasnext) sh = *(const uint4*)(nn + (size_t)(r + 1) * DM + c); }
            float nv[8], xx[8];
            nv[0] = bf_lo(cur.x); nv[1] = bf_hi(cur.x); nv[2] = bf_lo(cur.y); nv[3] = bf_hi(cur.y); nv[4] = bf_lo(cur.z); nv[5] = bf_hi(cur.z); nv[6] = bf_lo(cur.w); nv[7] = bf_hi(cur.w);
            xx[0] = bf_lo(sh.x) - nv[0]; xx[1] = bf_hi(sh.x) - nv[1]; xx[2] = bf_lo(sh.y) - nv[2]; xx[3] = bf_hi(sh.y) - nv[3]; xx[4] = bf_lo(sh.z) - nv[4]; xx[5] = bf_hi(sh.z) - nv[5]; xx[6] = bf_lo(sh.w) - nv[6]; xx[7] = bf_hi(sh.w) - nv[7];
#pragma unroll
            for (int j = 0; j < 3; ++j) {
                const float4 m0 = *(const float4*)(mu + idx[j] * 1024 + c), m1 = *(const float4*)(mu + idx[j] * 1024 + c + 4);
                uint4 o; o.x = pack2(nv[0] + xx[0] * m0.x, nv[1] + xx[1] * m0.y); o.y = pack2(nv[2] + xx[2] * m0.z, nv[3] + xx[3] * m0.w);
                o.z = pack2(nv[4] + xx[4] * m1.x, nv[5] + xx[5] * m1.y); o.w = pack2(nv[6] + xx[6] * m1.z, nv[7] + xx[7] * m1.w);
                *(uint4*)(xm + (size_t)j * T0 * DM + (size_t)r * DM + c) = o;
            }
        }
    }
}
DEVI void phase_rwkv_gemm_rkv(const Params& p, char* lds) {
    const int MT = T0 / 256;
    for (int u = blockIdx.x; u < 3 * 8 * MT; u += gridDim.x) {
        const int j = u / (8 * MT), v = u % (8 * MT); const int mt = v >> 3, nt = v & 7; const int m0 = mt * 256, n0 = nt * 128;
        const u16* A = (const u16*)(p.ws + R_XM0) + (size_t)j * T0 * DM; const u16* W = (const u16*)(p.ws + W_RR) + (size_t)j * DM * DM; u16* O = (u16*)(p.ws + R_RR) + (size_t)j * T0 * DM;
        auto arow = [&](int r) { return A + (size_t)(m0 + r) * DM; };
        auto epi = [&](int r, int cw, f32x16 (&t)[2], int h) { u16* dst = O + (size_t)(m0 + r) * DM + n0 + cw; store_tile_bf16(dst, t[0], h); store_tile_bf16(dst + 32, t[1], h); };
        gemm_tile<256, 128, false>(arow, W + (size_t)n0 * DM, DM, DM, epi, lds);
    }
}
DEVI void phase_rwkv_gemm_small(const Params& p, char* lds) {
    const int MT = T0 / 256;
    for (int u = blockIdx.x; u < 3 * MT; u += gridDim.x) {
        const int j = u / MT, mt = u % MT; const int m0 = mt * 256;
        const u16* A = (const u16*)(p.ws + R_XM0) + (size_t)j * T0 * DM;
        const u16* W = (const u16*)(p.ws + (j == 0 ? W_W1 : j == 1 ? W_A1 : W_G1)); u16* O = (u16*)(p.ws + (j == 0 ? R_HW : j == 1 ? R_HA : R_HG));
        auto arow = [&](int r) { return A + (size_t)(m0 + r) * DM; };
        auto epi = [&](int r, int cw, f32x16 (&t)[2], int h) {
#pragma unroll
            for (int ni = 0; ni < 2; ++ni) {
#pragma unroll
                for (int i = 0; i < 16; ++i) { const float x = t[ni][i]; t[ni][i] = j == 0 ? tanhf_(x) : j == 1 ? x : sigmoidf_(x); }
                store_tile_bf16(O + (size_t)(m0 + r) * 128 + cw + ni * 32, t[ni], h);
            }
        };
        gemm_tile<256, 128, false>(arow, W, DM, DM, epi, lds);
    }
}
DEVI void phase_rwkv_gemm_g(const Params& p, char* lds) {
    const int MT = T0 / 256; const u16* A = (const u16*)(p.ws + R_HG); const u16* W = (const u16*)(p.ws + W_G2); u16* O = (u16*)(p.ws + R_GG);
    for (int u = blockIdx.x; u < 8 * MT; u += gridDim.x) {
        const int mt = u >> 3, nt = u & 7; const int m0 = mt * 256, n0 = nt * 128;
        auto arow = [&](int r) { return A + (size_t)(m0 + r) * 128; };
        auto epi = [&](int r, int cw, f32x16 (&t)[2], int h) { u16* dst = O + (size_t)(m0 + r) * DM + n0 + cw; store_tile_bf16(dst, t[0], h); store_tile_bf16(dst + 32, t[1], h); };
        gemm_tile<256, 128, false>(arow, W + (size_t)n0 * 128, 128, 128, epi, lds);
    }
}
DEVI float red16_sum(float x) { x += dppf(x, 0); x += dppf(x, 1); x += dppf(x, 2); int xi = __builtin_bit_cast(int, x); x += __builtin_bit_cast(float, __builtin_amdgcn_mov_dpp(xi, 0x140, 0xF, 0xF, true)); return x; }
DEVI bf16x8 frag_perm(const u16* rowp, int ks, int h) {
    const uint2 lo = *(const uint2*)(rowp + 16 * ks + 4 * h), hi = *(const uint2*)(rowp + 16 * ks + 8 + 4 * h);
    u32x4 v = {lo.x, lo.y, hi.x, hi.y}; return __builtin_bit_cast(bf16x8, v);
}
DEVI bf16x8 frag_plain(const u16* rowp, int ks, int h) { return *(const bf16x8*)(rowp + 16 * ks + 8 * h); }
DEVI bf16x8 acc_to_b(const f32x16& t, int s) {
    u32x4 v = {pack2(t[8 * s], t[8 * s + 1]), pack2(t[8 * s + 2], t[8 * s + 3]), pack2(t[8 * s + 4], t[8 * s + 5]), pack2(t[8 * s + 6], t[8 * s + 7])};
    return __builtin_bit_cast(bf16x8, v);
}
#define MFMA(a, b, c) __builtin_amdgcn_mfma_f32_32x32x16_bf16(a, b, c, 0, 0, 0)
DEVI void phase_rwkv_scan(const Params& p, char* lds) {
    float* LW = (float*)lds; float* AA = LW + 2048; float* CP = AA + 2048;
    u16* At = (u16*)(lds + 24576); u16* Bt = At + 2304; u16* Kt = Bt + 2304; u16* Rt = Kt + 2304;
    u16* VT = (u16*)(lds + 43008); u16* KhT = VT + 2560; u16* BhT = KhT + 2560;
    float* Lf = (float*)(lds + 58368);
    u16* Lo = (u16*)(lds + 62976); u16* Lak = Lo + 1280; u16* Mrb = Lak + 1280; u16* Mrk = Mrb + 1280; u16* Td = Mrk + 1280;
    float* PC = (float*)(lds + 75776); u16* YS = (u16*)(lds + 76032);
    const u16* r_g = (const u16*)(p.ws + R_RR); const u16* k_g = (const u16*)(p.ws + R_RK); const u16* v_g = (const u16*)(p.ws + R_RV);
    const u16* hw = (const u16*)(p.ws + R_HW); const u16* ha = (const u16*)(p.ws + R_HA);
    const int tid = threadIdx.x, lane = tid & 63, w = tid >> 6, l31 = lane & 31, hh = lane >> 5;
    for (int u = blockIdx.x; u < 256; u += gridDim.x) {
        const int dir = u & 1, hd = (u >> 1) & 15, b = u >> 5;
        u16* y_g = (u16*)(p.ws + (dir ? R_YB : R_YF)); float* rkb = (float*)(p.ws + R_RKB) + (size_t)dir * T0 * 16;
        const int mat = (w >> 1) & 1, ctt = w & 1;
        const u16* w2t = (const u16*)(p.ws + (mat ? W_A2 : W_W2)) + (size_t)dir * 1024 * 64 + (size_t)(hd * 64 + ctt * 32 + l31) * 64;
        bf16x8 wfr[4];
#pragma unroll
        for (int ks = 0; ks < 4; ++ks) wfr[ks] = *(const bf16x8*)(w2t + ks * 16 + hh * 8);
        const float* bias0 = (mat ? p.in[I_RA0] : p.in[I_RW0]) + dir * 1024 + hd * 64 + ctt * 32;
        const u16* hsrc = mat ? ha : hw;
        const int t2 = tid >> 4, c4 = (tid & 15) * 4; const int cg = hd * 64 + c4;
        const float4 kkc = *(const float4*)(p.in[I_RKK] + cg), kac = *(const float4*)(p.in[I_RKA] + cg), rkc = *(const float4*)(p.in[I_RRK] + cg);
        for (int i = tid; i < 1280; i += 512) Td[i] = 0;
        f32x16 Z[2];
#pragma unroll
        for (int a = 0; a < 2; ++a)
#pragma unroll
            for (int i = 0; i < 16; ++i) Z[a][i] = 0.f;
        __syncthreads();
        for (int ci = 0; ci < 136; ++ci) {
            int pc, p0;
            if (ci < 8) { pc = dir ? 7 - ci : ci; p0 = 32 * pc; } else { pc = dir ? 135 - ci : ci - 8; p0 = LC + 32 * pc; }
            const size_t rowb = (size_t)b * LT;
            if (w < 4) {
                f32x16 acc;
#pragma unroll
                for (int i = 0; i < 16; ++i) acc[i] = 0.f;
                const int pos = dir ? p0 + 31 - l31 : p0 + l31;
                const u16* hp = hsrc + (rowb + pos) * 128 + dir * 64;
#pragma unroll
                for (int ks = 0; ks < 4; ++ks) { const bf16x8 af = *(const bf16x8*)(hp + ks * 16 + hh * 8); acc = MFMA(wfr[ks], af, acc); }
                float* dstm = (mat ? AA : LW) + l31 * 64 + ctt * 32;
#pragma unroll
                for (int g = 0; g < 4; ++g) {
                    const float4 b4 = *(const float4*)(bias0 + 8 * g + 4 * hh);
                    const float s0 = sigmoidf_(acc[4 * g] + b4.x), s1 = sigmoidf_(acc[4 * g + 1] + b4.y), s2 = sigmoidf_(acc[4 * g + 2] + b4.z), s3 = sigmoidf_(acc[4 * g + 3] + b4.w);
                    float4 o4; if (mat) o4 = make_float4(s0, s1, s2, s3); else o4 = make_float4(-0.6065306597126334f * s0, -0.6065306597126334f * s1, -0.6065306597126334f * s2, -0.6065306597126334f * s3);
                    *(float4*)(dstm + 8 * g + 4 * hh) = o4;
                }
            }
            const int pos2 = dir ? p0 + 31 - t2 : p0 + t2; const size_t go = (rowb + pos2) * DM + cg;
            const uint2 ru = *(const uint2*)(r_g + go), ku = *(const uint2*)(k_g + go), vu = *(const uint2*)(v_g + go);
            __syncthreads();
            if (tid < 64) { float cp = 0.f;
#pragma unroll 8
                for (int t = 0; t < 32; ++t) { cp += LW[t * 64 + tid]; CP[t * 64 + tid] = cp; } }
            __syncthreads();
            {
                const float rv[4] = {bf_lo(ru.x), bf_hi(ru.x), bf_lo(ru.y), bf_hi(ru.y)}, kv[4] = {bf_lo(ku.x), bf_hi(ku.x), bf_lo(ku.y), bf_hi(ku.y)};
                const float4 a4 = *(const float4*)(AA + t2 * 64 + c4), cp4 = *(const float4*)(CP + t2 * 64 + c4), ce4 = *(const float4*)(CP + 31 * 64 + c4);
                float4 cq4 = make_float4(0.f, 0.f, 0.f, 0.f); if (t2 > 0) cq4 = *(const float4*)(CP + (t2 - 1) * 64 + c4);
                const float av[4] = {a4.x, a4.y, a4.z, a4.w}, cpv[4] = {cp4.x, cp4.y, cp4.z, cp4.w}, cev[4] = {ce4.x, ce4.y, ce4.z, ce4.w}, cqv[4] = {cq4.x, cq4.y, cq4.z, cq4.w};
                const float kkcv[4] = {kkc.x, kkc.y, kkc.z, kkc.w}, kacv[4] = {kac.x, kac.y, kac.z, kac.w}, rkcv[4] = {rkc.x, rkc.y, rkc.z, rkc.w};
                float kk[4], km[4], ssq = 0.f, rks = 0.f;
#pragma unroll
                for (int i = 0; i < 4; ++i) { kk[i] = kv[i] * kkcv[i]; ssq += kk[i] * kk[i]; km[i] = kv[i] * (1.f + (av[i] - 1.f) * kacv[i]); rks += rv[i] * km[i] * rkcv[i]; }
                ssq = red16_sum(ssq); rks = red16_sum(rks);
                const float inv = 1.f / fmaxf(sqrtf(ssq), 1e-12f);
                float at[4], bt[4], kt[4], rt[4], bh[4], kh[4];
#pragma unroll
                for (int i = 0; i < 4; ++i) {
                    const float kn = kk[i] * inv, bb = kn * av[i];
                    const float en = __expf(-cpv[i]), eh = __expf(cev[i] - cpv[i]);
                    at[i] = -kn * __expf(cqv[i]); bt[i] = bb * en; kt[i] = km[i] * en; rt[i] = rv[i] * __expf(cpv[i]); bh[i] = bb * eh; kh[i] = km[i] * eh;
                }
                uint2 o;
                o.x = pack2(at[0], at[1]); o.y = pack2(at[2], at[3]); *(uint2*)(At + t2 * 72 + c4) = o;
                o.x = pack2(bt[0], bt[1]); o.y = pack2(bt[2], bt[3]); *(uint2*)(Bt + t2 * 72 + c4) = o;
                o.x = pack2(kt[0], kt[1]); o.y = pack2(kt[2], kt[3]); *(uint2*)(Kt + t2 * 72 + c4) = o;
                o.x = pack2(rt[0], rt[1]); o.y = pack2(rt[2], rt[3]); *(uint2*)(Rt + t2 * 72 + c4) = o;
                const unsigned kh01 = pack2(kh[0], kh[1]), kh23 = pack2(kh[2], kh[3]), bh01 = pack2(bh[0], bh[1]), bh23 = pack2(bh[2], bh[3]);
                KhT[(c4 + 0) * 40 + t2] = (u16)kh01; KhT[(c4 + 1) * 40 + t2] = (u16)(kh01 >> 16); KhT[(c4 + 2) * 40 + t2] = (u16)kh23; KhT[(c4 + 3) * 40 + t2] = (u16)(kh23 >> 16);
                BhT[(c4 + 0) * 40 + t2] = (u16)bh01; BhT[(c4 + 1) * 40 + t2] = (u16)(bh01 >> 16); BhT[(c4 + 2) * 40 + t2] = (u16)bh23; BhT[(c4 + 3) * 40 + t2] = (u16)(bh23 >> 16);
                VT[(c4 + 0) * 40 + t2] = (u16)vu.x; VT[(c4 + 1) * 40 + t2] = (u16)(vu.x >> 16); VT[(c4 + 2) * 40 + t2] = (u16)vu.y; VT[(c4 + 3) * 40 + t2] = (u16)(vu.y >> 16);
                if (t2 == 0) *(float4*)(PC + c4) = make_float4(__expf(cev[0]), __expf(cev[1]), __expf(cev[2]), __expf(cev[3]));
                if ((tid & 15) == 0) rkb[(rowb + pos2) * 16 + hd] = rks;
            }
            __syncthreads();
            if (w < 4) {
                const u16* X1 = (w < 2) ? At : Rt; const u16* X2 = (w & 1) ? Kt : Bt;
                f32x16 acc;
#pragma unroll
                for (int i = 0; i < 16; ++i) acc[i] = 0.f;
#pragma unroll
                for (int ks = 0; ks < 4; ++ks) acc = MFMA(frag_plain(X2 + l31 * 72, ks, hh), frag_plain(X1 + l31 * 72, ks, hh), acc);
#pragma unroll
                for (int i = 0; i < 16; ++i) { const int s = (i & 3) + 8 * (i >> 2) + 4 * hh; const bool keep = (w < 2) ? (s < l31) : (s <= l31); if (!keep) acc[i] = 0.f; }
                if (w == 0) {
#pragma unroll
                    for (int g = 0; g < 4; ++g) {
                        *(float4*)(Lf + l31 * 36 + 8 * g + 4 * hh) = make_float4(acc[4 * g], acc[4 * g + 1], acc[4 * g + 2], acc[4 * g + 3]);
                        const bool lo = (l31 >= 16) && (8 * g + 4 * hh < 16);
                        uint2 o; o.x = lo ? pack2(acc[4 * g], acc[4 * g + 1]) : 0u; o.y = lo ? pack2(acc[4 * g + 2], acc[4 * g + 3]) : 0u; *(uint2*)(Lo + l31 * 40 + 8 * g + 4 * hh) = o;
                    }
                } else {
                    u16* dst = (w == 1) ? Lak : (w == 2) ? Mrb : Mrk;
#pragma unroll
                    for (int g = 0; g < 4; ++g) { uint2 o; o.x = pack2(acc[4 * g], acc[4 * g + 1]); o.y = pack2(acc[4 * g + 2], acc[4 * g + 3]); *(uint2*)(dst + l31 * 40 + 8 * g + 4 * hh) = o; }
                }
            }
            __syncthreads();
            f32x16 XZ, Ya; bf16x8 zf[4];
            if (w == 7) {
                const int blk = (lane >> 4) & 1, j = lane & 15; const float* Lb = Lf + (16 * blk) * 36 + 16 * blk;
                float x[16];
#pragma unroll
                for (int t = 0; t < 16; ++t) {
                    float acc = (j == t) ? 1.f : 0.f;
#pragma unroll
                    for (int s4 = 0; s4 < (t + 3) / 4; ++s4) {
                        const float4 l4 = *(const float4*)(Lb + t * 36 + 4 * s4);
                        if (4 * s4 + 0 < t) acc += l4.x * x[4 * s4 + 0];
                        if (4 * s4 + 1 < t) acc += l4.y * x[4 * s4 + 1];
                        if (4 * s4 + 2 < t) acc += l4.z * x[4 * s4 + 2];
                        if (4 * s4 + 3 < t) acc += l4.w * x[4 * s4 + 3];
                    }
                    x[t] = acc;
                }
                if (lane < 32) {
#pragma unroll
                    for (int t = 0; t < 16; t += 2) { Td[(16 * blk + t) * 40 + 16 * blk + j] = (u16)(pack2(x[t], 0.f)); Td[(16 * blk + t + 1) * 40 + 16 * blk + j] = (u16)(pack2(x[t + 1], 0.f)); }
                }
            } else if (w < 2) {
#pragma unroll
                for (int s = 0; s < 4; ++s) zf[s] = acc_to_b(Z[s >> 1], s & 1);
                const int vcol = 32 * w + l31;
#pragma unroll
                for (int i = 0; i < 16; ++i) { XZ[i] = 0.f; Ya[i] = 0.f; }
#pragma unroll
                for (int s = 0; s < 4; ++s) { XZ = MFMA(frag_perm(At + l31 * 72, s, hh), zf[s], XZ); Ya = MFMA(frag_perm(Rt + l31 * 72, s, hh), zf[s], Ya); }
#pragma unroll
                for (int ks = 0; ks < 2; ++ks) {
                    const bf16x8 vf = frag_plain(VT + vcol * 40, ks, hh);
                    XZ = MFMA(frag_plain(Lak + l31 * 40, ks, hh), vf, XZ); Ya = MFMA(frag_plain(Mrk + l31 * 40, ks, hh), vf, Ya);
                }
#pragma unroll
                for (int kt = 0; kt < 2; ++kt) {
#pragma unroll
                    for (int g = 0; g < 4; ++g) { const float4 pc4 = *(const float4*)(PC + 32 * kt + 8 * g + 4 * hh);
                        Z[kt][4 * g] *= pc4.x; Z[kt][4 * g + 1] *= pc4.y; Z[kt][4 * g + 2] *= pc4.z; Z[kt][4 * g + 3] *= pc4.w; }
#pragma unroll
                    for (int ks = 0; ks < 2; ++ks) Z[kt] = MFMA(frag_plain(KhT + (32 * kt + l31) * 40, ks, hh), frag_plain(VT + vcol * 40, ks, hh), Z[kt]);
                }
            }
            __syncthreads();
            if (w < 2) {
                f32x16 U1 = {}, W = {};
#pragma unroll
                for (int i = 0; i < 16; ++i) { U1[i] = 0.f; W[i] = 0.f; }
#pragma unroll
                for (int ks = 0; ks < 2; ++ks) U1 = MFMA(frag_perm(Td + l31 * 40, ks, hh), acc_to_b(XZ, ks), U1);
#pragma unroll
                for (int ks = 0; ks < 2; ++ks) W = MFMA(frag_perm(Lo + l31 * 40, ks, hh), acc_to_b(U1, ks), W);
#pragma unroll
                for (int ks = 0; ks < 2; ++ks) U1 = MFMA(frag_perm(Td + l31 * 40, ks, hh), acc_to_b(W, ks), U1);
                const bf16x8 uf0 = acc_to_b(U1, 0), uf1 = acc_to_b(U1, 1);
                Ya = MFMA(frag_perm(Mrb + l31 * 40, 0, hh), uf0, Ya); Ya = MFMA(frag_perm(Mrb + l31 * 40, 1, hh), uf1, Ya);
#pragma unroll
                for (int kt = 0; kt < 2; ++kt) { Z[kt] = MFMA(frag_perm(BhT + (32 * kt + l31) * 40, 0, hh), uf0, Z[kt]); Z[kt] = MFMA(frag_perm(BhT + (32 * kt + l31) * 40, 1, hh), uf1, Z[kt]); }
#pragma unroll
                for (int i = 0; i < 16; ++i) { const int t = (i & 3) + 8 * (i >> 2) + 4 * hh; YS[t * 72 + 32 * w + l31] = (u16)pack2(Ya[i], 0.f); }
            }
            __syncthreads();
            if (ci >= 8) { const uint2 yv = *(const uint2*)(YS + t2 * 72 + c4); *(uint2*)(y_g + (rowb + pos2) * DM + cg) = yv; }
        }
        __syncthreads();
    }
}
DEVI void phase_rwkv_readout(const Params& p) {
    const u16* yf = (const u16*)(p.ws + R_YF); const u16* yb = (const u16*)(p.ws + R_YB); const u16* vg = (const u16*)(p.ws + R_RV); const u16* gg = (const u16*)(p.ws + R_GG);
    const float* rkb = (const float*)(p.ws + R_RKB); u16* rd = (u16*)(p.ws + R_RD);
    const float* lnw = p.in[I_RLNW]; const float* lnb = p.in[I_RLNB];
    const int lane = threadIdx.x & 63, w = threadIdx.x >> 6;
    for (int t = blockIdx.x * 8 + w; t < TL; t += gridDim.x * 8) {
        const int b = t >> 12, s = t & 4095; const size_t row = (size_t)b * LT + LC + s; const int c = lane * 16; const int hd = lane >> 2;
        float y[16], vv[16], gv[16];
#pragma unroll
        for (int q = 0; q < 2; ++q) {
            const uint4 a = *(const uint4*)(yf + row * DM + c + 8 * q), bq = *(const uint4*)(yb + row * DM + c + 8 * q), v4 = *(const uint4*)(vg + row * DM + c + 8 * q), g4 = *(const uint4*)(gg + row * DM + c + 8 * q);
            y[8 * q + 0] = bf_lo(a.x) + bf_lo(bq.x); y[8 * q + 1] = bf_hi(a.x) + bf_hi(bq.x); y[8 * q + 2] = bf_lo(a.y) + bf_lo(bq.y); y[8 * q + 3] = bf_hi(a.y) + bf_hi(bq.y);
            y[8 * q + 4] = bf_lo(a.z) + bf_lo(bq.z); y[8 * q + 5] = bf_hi(a.z) + bf_hi(bq.z); y[8 * q + 6] = bf_lo(a.w) + bf_lo(bq.w); y[8 * q + 7] = bf_hi(a.w) + bf_hi(bq.w);
            vv[8 * q + 0] = bf_lo(v4.x); vv[8 * q + 1] = bf_hi(v4.x); vv[8 * q + 2] = bf_lo(v4.y); vv[8 * q + 3] = bf_hi(v4.y); vv[8 * q + 4] = bf_lo(v4.z); vv[8 * q + 5] = bf_hi(v4.z); vv[8 * q + 6] = bf_lo(v4.w); vv[8 * q + 7] = bf_hi(v4.w);
            gv[8 * q + 0] = bf_lo(g4.x); gv[8 * q + 1] = bf_hi(g4.x); gv[8 * q + 2] = bf_lo(g4.y); gv[8 * q + 3] = bf_hi(g4.y); gv[8 * q + 4] = bf_lo(g4.z); gv[8 * q + 5] = bf_hi(g4.z); gv[8 * q + 6] = bf_lo(g4.w); gv[8 * q + 7] = bf_hi(g4.w);
        }
        float sm = 0.f;
#pragma unroll
        for (int i = 0; i < 16; ++i) sm += y[i];
        sm = red4_sum(sm); const float mean = sm * (1.f / 64.f);
        float vs = 0.f;
#pragma unroll
        for (int i = 0; i < 16; ++i) { const float d = y[i] - mean; vs += d * d; }
        vs = red4_sum(vs); const float rstd = rsqrtf(vs * (1.f / 64.f) + 64e-5f);
        const float bon = rkb[row * 16 + hd] + rkb[(size_t)T0 * 16 + row * 16 + hd];
        unsigned ow[8];
#pragma unroll
        for (int i = 0; i < 8; ++i) {
            const int c0 = c + 2 * i;
            const float o0 = ((y[2 * i] - mean) * rstd * lnw[c0] + lnb[c0] + bon * vv[2 * i]) * gv[2 * i];
            const float o1 = ((y[2 * i + 1] - mean) * rstd * lnw[c0 + 1] + lnb[c0 + 1] + bon * vv[2 * i + 1]) * gv[2 * i + 1];
            ow[i] = pack2(o0, o1);
        }
        *(uint4*)(rd + (size_t)t * DM + c) = make_uint4(ow[0], ow[1], ow[2], ow[3]); *(uint4*)(rd + (size_t)t * DM + c + 8) = make_uint4(ow[4], ow[5], ow[6], ow[7]);
    }
}
DEVI void phase_final_norm(const Params& p) {
    const float* g = p.in[I_NFIN]; float* X = p.out;
    const int lane = threadIdx.x & 63, w = threadIdx.x >> 6;
    for (int r = blockIdx.x * 8 + w; r < TL; r += gridDim.x * 8) {
        float4* xr = (float4*)(X + (size_t)r * DM); float4 v[4]; float ss = 0.f;
#pragma unroll
        for (int i = 0; i < 4; ++i) { v[i] = xr[lane + 64 * i]; ss += v[i].x * v[i].x + v[i].y * v[i].y + v[i].z * v[i].z + v[i].w * v[i].w; }
        ss = wave_sum(ss); const float rs = rsqrtf(ss * (1.f / 1024.f) + 1e-6f);
#pragma unroll
        for (int i = 0; i < 4; ++i) { const float4 gg = ((const float4*)g)[lane + 64 * i]; float4 o; o.x = v[i].x * rs * gg.x; o.y = v[i].y * rs * gg.y; o.z = v[i].z * rs * gg.z; o.w = v[i].w * rs * gg.w; xr[lane + 64 * i] = o; }
    }
}

constexpr int N_PHASES = 36;
template <int PH> DEVI void run_phase(const Params& p, char* lds) {
    const float* mods = (const float*)(p.ws + OFF_MODS);
    RowSrc in_src; in_src.ctx = p.in[I_CTX]; in_src.lat = p.in[I_X];
    RowSrc x_src; x_src.ctx = (const float*)(p.ws + OFF_XC); x_src.lat = p.out;
    if constexpr (PH == 0) phase_prologue(p, lds);
    else if constexpr (PH == 1) norm_rows(in_src, 0, T0, p.in[I_NMIX], mods, 0, 1, (u16*)(p.ws + A_N0));
    else if constexpr (PH == 2) phase_gemm_win(p, lds);
    else if constexpr (PH == 3) phase_gemm_qkv(p, lds);
    else if constexpr (PH == 4) { phase_attention(p, lds); conv_jobs(p, 25, 28, 0, 0, lds); }
    else if constexpr (PH == 5) phase_gemm_wo(p, (const u16*)(p.ws + A_N0), (const u16*)(p.ws + W_OA), in_src, 0, 0, lds);
    else if constexpr (PH == 6) phase_moe_route(p, 0, lds);
    else if constexpr (PH == 7) phase_moe_gemm1(p, 0, lds);
    else if constexpr (PH >= 8 && PH < 16) { if constexpr ((PH & 1) == 0) phase_moe_gemm2(p, 0, (PH - 8) >> 1, lds); else phase_moe_combine(p, 0, (PH - 8) >> 1, lds); }
    else if constexpr (PH == 16) norm_rows(x_src, 0, T0, p.in[I_NMIX] + 1024, mods + 9 * 6144, 0, 1, (u16*)(p.ws + R_NN));
    else if constexpr (PH == 17) phase_rwkv_mix(p, 0, 2, 3);
    else if constexpr (PH == 18) phase_rwkv_gemm_rkv(p, lds);
    else if constexpr (PH == 19) phase_rwkv_mix(p, 1, 4, 5);
    else if constexpr (PH == 20) phase_rwkv_gemm_small(p, lds);
    else if constexpr (PH == 21) phase_rwkv_gemm_g(p, lds);
    else if constexpr (PH == 22) phase_rwkv_scan(p, lds);
    else if constexpr (PH == 23) phase_rwkv_readout(p);
    else if constexpr (PH == 24) { phase_gemm_wo(p, (const u16*)(p.ws + R_RD), (const u16*)(p.ws + W_RO), x_src, 1, 1, lds); conv_jobs(p, 25, 28, 1, 0, lds); }
    else if constexpr (PH == 25) phase_moe_route(p, 1, lds);
    else if constexpr (PH == 26) phase_moe_gemm1(p, 1, lds);
    else if constexpr (PH >= 27 && PH < 35) { if constexpr (((PH - 27) & 1) == 0) phase_moe_gemm2(p, 1, (PH - 27) >> 1, lds); else phase_moe_combine(p, 1, (PH - 27) >> 1, lds); }
    else if constexpr (PH == 35) phase_final_norm(p);
}

#if MEGA
template <int PH, int END> DEVI void run_range(const Params& p, char* lds, const XcdBarrier& bar) {
    run_phase<PH>(p, lds);
    if constexpr (PH + 1 < END) { xcd_barrier(bar); run_range<PH + 1, END>(p, lds, bar); }
}
template <int A, int B> __global__ void __launch_bounds__(512, 2) k_range(Params p, unsigned* barw) {
    extern __shared__ __attribute__((aligned(16))) char smem[];
    if (threadIdx.x == 0) *(uint4*)smem = make_uint4(0u, 0u, 0u, 0u);
    __syncthreads();
    const XcdBarrier bar = xcd_barrier_post(barw, (volatile LAS unsigned*)smem);
    run_range<A, B>(p, smem + 64, bar);
}
template <int A, int B> static void launch_range(const Params& p, unsigned* barw, hipStream_t s) {
    static int grid = 0;
    if (!grid) {
        int dev = 0, cus = 0, per_cu = 0;
        (void)hipGetDevice(&dev);
        (void)hipDeviceGetAttribute(&cus, hipDeviceAttributeMultiprocessorCount, dev);
        (void)hipFuncSetAttribute((const void*)k_range<A, B>, hipFuncAttributeMaxDynamicSharedMemorySize, LDS_BYTES);
        (void)hipOccupancyMaxActiveBlocksPerMultiprocessor(&per_cu, (const void*)k_range<A, B>, 512, LDS_BYTES);
        if (per_cu < 1) fprintf(stderr, "occupancy query says 0 blocks per CU\n");
        grid = cus;
    }
    k_range<A, B><<<grid, 512, LDS_BYTES, s>>>(p, barw);
}
extern "C" void kernel_launch(void* const* d_in, const int* in_sizes, int n_in, void* d_out, int out_size, void* d_ws, size_t ws_size, hipStream_t stream) {
    Params p{};
    for (int i = 0; i < N_IN; ++i) p.in[i] = (const float*)d_in[i];
    p.out = (float*)d_out; p.ws = (char*)d_ws;
    if (ws_size < WS_NEED) { fprintf(stderr, "workspace too small\n"); return; }
    (void)hipMemsetAsync(p.ws + OFF_BAR, 0, XCD_BAR_WORDS * sizeof(unsigned), stream);
    launch_range<0, N_PHASES>(p, (unsigned*)(p.ws + OFF_BAR), stream);
}
#else
template <int PH> __global__ void __launch_bounds__(512, 2) k_phase(Params p) {
    extern __shared__ __attribute__((aligned(16))) char smem[];
    run_phase<PH>(p, smem + 64);
}
template <int PH> static void launch_phase(const Params& p, hipStream_t s) {
    static bool attr = false;
    if (!attr) { hipFuncSetAttribute((const void*)k_phase<PH>, hipFuncAttributeMaxDynamicSharedMemorySize, LDS_BYTES); attr = true; }
    k_phase<PH><<<256, 512, LDS_BYTES, s>>>(p);
}
template <int PH> static void launch_all(const Params& p, hipStream_t s) {
    launch_phase<PH>(p, s);
    if constexpr (PH + 1 < N_PHASES) launch_all<PH + 1>(p, s);
}

extern "C" void kernel_launch(void* const* d_in, const int* in_sizes, int n_in, void* d_out, int out_size, void* d_ws, size_t ws_size, hipStream_t stream) {
    Params p{};
    for (int i = 0; i < N_IN; ++i) p.in[i] = (const float*)d_in[i];
    p.out = (float*)d_out; p.ws = (char*)d_ws;
    if (ws_size < WS_NEED) { fprintf(stderr, "workspace too small: %zu < %zu\n", ws_size, (size_t)WS_NEED); return; }
    launch_all<0>(p, stream);
}
#endif
```

```cpp
#include <hip/hip_runtime.h>
#include <stdint.h>
#include <stdio.h>

#ifndef MEGA
#define MEGA 1
#endif

typedef unsigned short u16;
typedef short bf16x8 __attribute__((ext_vector_type(8)));
typedef short s16x4 __attribute__((ext_vector_type(4)));
typedef float f32x16 __attribute__((ext_vector_type(16)));
typedef float f32x4 __attribute__((ext_vector_type(4)));
typedef float f32x2 __attribute__((ext_vector_type(2)));
typedef unsigned u32x4 __attribute__((ext_vector_type(4)));
typedef __bf16 bf2 __attribute__((ext_vector_type(2)));
#define DEVI __device__ __forceinline__
#define LAS __attribute__((address_space(3)))
__device__ __forceinline__ int tidx() { int t = threadIdx.x; asm volatile("" : "+v"(t)); return t; }

constexpr int NB = 8, SEQ = 4096, LC = 256, LT = 4352, DM = 1024, T0 = NB * LT, TL = NB * SEQ;
constexpr int NCHUNK = 4;
constexpr float LOG2E = 1.4426950408889634f;
constexpr float QA_SCALE = 0.07216878364870322f * LOG2E;
constexpr float QS_SCALE = 0.125f * LOG2E;

enum { I_X = 0, I_C, I_CTX, I_CCTX, I_ADAW, I_ADAB, I_NMIX, I_NFFN, I_NFIN, I_AWIN, I_AQN, I_AKVN, I_AWUQ, I_AWUKV, I_ASINK, I_AWO,
       I_RMU, I_RWR, I_RWK, I_RWV, I_RWO, I_RG1, I_RG2, I_RW0, I_RW1, I_RW2, I_RA0, I_RA1, I_RA2, I_RKK, I_RKA, I_RRK, I_RLNW, I_RLNB,
       I_MROUT, I_MBIAS, I_MWG, I_MWU, I_MWD, I_MSG, I_MSU, I_MSD, N_IN };

struct Params { const float* in[N_IN]; float* out; char* ws; };

constexpr size_t OFF_BAR = 0, OFF_CNT = 16384, OFF_ROPE = 20480, OFF_MODS = 32768, OFF_WSTAT = 524288;
constexpr size_t W_IN = OFF_WSTAT, W_UQ = W_IN + 3145728, W_UK = W_UQ + 589824, W_UV = W_UK + 262144, W_OA = W_UV + 262144,
                 W_RR = W_OA + 2097152, W_RK = W_RR + 2097152, W_RV = W_RK + 2097152, W_RO = W_RV + 2097152,
                 W_G1 = W_RO + 2097152, W_W1 = W_G1 + 262144, W_A1 = W_W1 + 262144, W_G2 = W_A1 + 262144, W_W2 = W_G2 + 262144, W_A2 = W_W2 + 262144,
                 W_SGU = W_A2 + 262144, W_SD = W_SGU + 2 * 1048576, W_END = W_SD + 2 * 524288;
constexpr size_t OFF_XC = OFF_WSTAT + 20971520;
constexpr size_t OFF_TOKE = OFF_XC + 8388608, OFF_TOKR = OFF_TOKE + 835584, OFF_LTOK = OFF_TOKR + 835584, OFF_LG = OFF_LTOK + 8912896;
constexpr size_t OFF_D = OFF_XC + 8388608 + 20971520;
constexpr size_t WGU_BYTES = 64ull * 512 * 1024 * 2, WD_BYTES = 64ull * 1024 * 256 * 2;
constexpr size_t OFF_WGU = OFF_D, OFF_WD = OFF_D + WGU_BYTES;
constexpr size_t OFF_G = OFF_D + WGU_BYTES + WD_BYTES;
constexpr size_t SZ_T0D = (size_t)T0 * 1024 * 2;
constexpr size_t A_N0 = OFF_G, A_CQ = A_N0 + SZ_T0D, A_CKV = A_CQ + (size_t)T0 * 384 * 2, A_QA = A_CKV + (size_t)T0 * 256 * 2, A_KA = A_QA + (size_t)T0 * 768 * 2,
                 A_VA = A_KA + (size_t)T0 * 768 * 2, A_QS = A_VA + (size_t)T0 * 512 * 2, A_KS = A_QS + (size_t)T0 * 512 * 2, A_VS = A_KS + (size_t)T0 * 128 * 2, A_END = A_VS + (size_t)T0 * 128 * 2;
constexpr size_t M_N1 = OFF_G, M_ACT = M_N1 + SZ_T0D, M_OUTR = M_ACT + (size_t)7 * T0 * 256 * 2, M_END = M_OUTR + (size_t)7 * 8704 * 1024 * 2;
constexpr size_t R_XM0 = OFF_D, R_XM1 = R_XM0 + SZ_T0D, R_XM2 = R_XM1 + SZ_T0D, R_RR = R_XM2 + SZ_T0D, R_RK = R_RR + SZ_T0D, R_RV = R_RK + SZ_T0D, R_NN = R_RV + SZ_T0D,
                 R_HG = R_NN + SZ_T0D, R_HW = R_HG + (size_t)T0 * 128 * 2, R_HA = R_HW + (size_t)T0 * 128 * 2, R_RKB = R_HA + (size_t)T0 * 128 * 2, R_END = R_RKB + (size_t)2 * T0 * 16 * 4;
constexpr size_t R_GG = R_XM0, R_YF = R_XM1, R_YB = R_XM2, R_RD = R_NN;
constexpr size_t WS_NEED = R_END;

constexpr int LDS_BYTES = 64 + 131072;

DEVI unsigned pack2(float a, float b) { f32x2 v = {a, b}; bf2 r = __builtin_convertvector(v, bf2); return __builtin_bit_cast(unsigned, r); }
DEVI float bf_lo(unsigned u) { return __builtin_bit_cast(float, u << 16); }
DEVI float bf_hi(unsigned u) { return __builtin_bit_cast(float, u & 0xffff0000u); }
DEVI float bf1(u16 u) { return __builtin_bit_cast(float, ((unsigned)u) << 16); }
DEVI float dppf(float x, const int ctrl_sel) {
    int xi = __builtin_bit_cast(int, x), y;
    if (ctrl_sel == 0) y = __builtin_amdgcn_mov_dpp(xi, 0xB1, 0xF, 0xF, true);
    else if (ctrl_sel == 1) y = __builtin_amdgcn_mov_dpp(xi, 0x4E, 0xF, 0xF, true);
    else y = __builtin_amdgcn_mov_dpp(xi, 0x141, 0xF, 0xF, true);
    return __builtin_bit_cast(float, y);
}
DEVI float red8_sum(float x) { x += dppf(x, 0); x += dppf(x, 1); x += dppf(x, 2); return x; }
DEVI float red8_max(float x) { x = fmaxf(x, dppf(x, 0)); x = fmaxf(x, dppf(x, 1)); x = fmaxf(x, dppf(x, 2)); return x; }
DEVI float red4_sum(float x) { x += dppf(x, 0); x += dppf(x, 1); return x; }
DEVI float wave_sum(float x) { for (int o = 32; o > 0; o >>= 1) x += __shfl_xor(x, o); return x; }
DEVI float wave_max(float x) { for (int o = 32; o > 0; o >>= 1) x = fmaxf(x, __shfl_xor(x, o)); return x; }
DEVI float xhalf(float x) {
    int l = (int)__builtin_amdgcn_mbcnt_hi(~0u, __builtin_amdgcn_mbcnt_lo(~0u, 0u)); asm volatile("" : "+v"(l));
    return __builtin_bit_cast(float, __builtin_amdgcn_ds_bpermute((l ^ 32) << 2, __builtin_bit_cast(int, x)));
}
DEVI void lds_barrier() { asm volatile("s_waitcnt lgkmcnt(0)\n\ts_barrier" ::: "memory"); }
DEVI float sigmoidf_(float x) { return 1.f / (1.f + __expf(-x)); }
DEVI float siluf_(float x) { return x / (1.f + __expf(-x)); }
DEVI float tanhf_(float x) { float e = __expf(2.f * x); return 1.f - 2.f / (e + 1.f); }

#define XB_TMO      128
#define XB_XCNT(j)  (256  + 64 * (j))
#define XB_XSUB(j)  (1280 + 64 * (j))
#define XB_XGEN(j)  (2304 + 64 * (j))
#define XB_TOP      3328
#define XB_TOPGEN   3392
#define XCD_BAR_WORDS 3456
#define XB_SPIN_CAP (1u << 20)
DEVI unsigned xb_ld(unsigned* p)              { return __hip_atomic_load(p, __ATOMIC_RELAXED, __HIP_MEMORY_SCOPE_AGENT); }
DEVI unsigned xb_add(unsigned* p, unsigned v) { return __hip_atomic_fetch_add(p, v, __ATOMIC_RELAXED, __HIP_MEMORY_SCOPE_AGENT); }
DEVI unsigned xb_xcc_id() { return (unsigned)__builtin_amdgcn_s_getreg((3 << 11) | 20) & 0xFu; }
#define XB_SPIN(cond, bar) do { unsigned _sp = 0; while (cond) { __builtin_amdgcn_s_sleep(1); \
    if ((++_sp & 255u) == 0u) { if (xb_ld(&(bar)[XB_TMO])) break; if (_sp > XB_SPIN_CAP) { atomicAdd(&(bar)[XB_TMO], 1u); break; } } } } while (0)
struct XcdBarrier { unsigned* bar; unsigned x; volatile LAS unsigned* st; };
DEVI XcdBarrier xcd_barrier_post(unsigned* bar, volatile LAS unsigned* st) {
    XcdBarrier b; b.bar = bar; b.x = xb_xcc_id(); b.st = st;
    if (threadIdx.x == 0) (void)xb_add(&bar[XB_XCNT(b.x)], 1u);
    return b;
}
DEVI void xcd_barrier_complete(unsigned* bar, unsigned x, unsigned& nloc, unsigned& nx) {
    const unsigned G = gridDim.x * gridDim.y * gridDim.z;
    unsigned sum, cnt, mine, sp = 0u;
    for (;;) {
        sum = 0u; cnt = 0u; mine = 0u;
#pragma unroll
        for (unsigned j = 0; j < 16; ++j) { const unsigned c = xb_ld(&bar[XB_XCNT(j)]); sum += c; cnt += (c > 0u) ? 1u : 0u; mine = (j == x) ? c : mine; }
        if (sum == G) break;
        __builtin_amdgcn_s_sleep(1);
        if ((++sp & 255u) == 0u) { if (xb_ld(&bar[XB_TMO])) break; if (sp > XB_SPIN_CAP) { atomicAdd(&bar[XB_TMO], 1u); break; } }
    }
    nloc = mine > 0u ? mine : 1u; nx = cnt > 0u ? cnt : 1u;
}
DEVI void xcd_barrier(const XcdBarrier& b) {
    asm volatile("s_waitcnt vmcnt(0)" ::: "memory");
    __syncthreads();
    if (threadIdx.x == 0) {
        unsigned* bar = b.bar;
        __builtin_amdgcn_s_waitcnt(0);
        unsigned nloc = b.st[0], nx = b.st[1];
        if (nloc == 0u) { xcd_barrier_complete(bar, b.x, nloc, nx); b.st[0] = nloc; b.st[1] = nx; }
        const unsigned old = xb_add(&bar[XB_XSUB(b.x)], 1u);
        const unsigned gen = old / nloc;
        if (old + 1u == (gen + 1u) * nloc) {
            __builtin_amdgcn_fence(__ATOMIC_RELEASE, "agent");
            asm volatile("s_waitcnt vmcnt(0)" ::: "memory");
            const unsigned og = xb_add(&bar[XB_TOP], 1u);
            const unsigned tg = og / nx;
            if (og + 1u == (tg + 1u) * nx) xb_add(&bar[XB_TOPGEN], 1u);
            else XB_SPIN(xb_ld(&bar[XB_TOPGEN]) == tg, bar);
            __builtin_amdgcn_fence(__ATOMIC_ACQUIRE, "agent");
            xb_add(&bar[XB_XGEN(b.x)], 1u);
            asm volatile("s_waitcnt vmcnt(0)" ::: "memory");
        } else {
            XB_SPIN(xb_ld(&bar[XB_XGEN(b.x)]) == gen, bar);
            __builtin_amdgcn_fence(__ATOMIC_ACQUIRE, "agent");
            asm volatile("s_waitcnt vmcnt(0)" ::: "memory");
        }
    }
    __syncthreads();
}

struct RowSrc { const float* ctx; const float* lat; };
DEVI const float* row_ptr(const RowSrc& s, int mode, int r, int& bb) {
    if (mode == 0) { int b = r / LT, pp = r - b * LT; if (pp < LC) { bb = 8; return s.ctx + (size_t)(b * LC + pp) * DM; } bb = b; return s.lat + (size_t)(b * SEQ + pp - LC) * DM; }
    bb = r >> 12; return s.lat + (size_t)r * DM;
}
DEVI float* row_ptr_w(float* ctx, float* lat, int mode, int r, int& bb) {
    if (mode == 0) { int b = r / LT, pp = r - b * LT; if (pp < LC) { bb = 8; return ctx + (size_t)(b * LC + pp) * DM; } bb = b; return lat + (size_t)(b * SEQ + pp - LC) * DM; }
    bb = r >> 12; return lat + (size_t)r * DM;
}

DEVI float sumsq8(const bf16x8& v) {
    float s = 0.f;
    const unsigned* u = (const unsigned*)&v;
#pragma unroll
    for (int i = 0; i < 4; ++i) { bf2 b = __builtin_bit_cast(bf2, u[i]); s = __builtin_amdgcn_fdot2_f32_bf16(b, b, s, false); }
    return s;
}
template <int BM, int BN, bool ROWNORM, class ARow, class XF, class ST>
DEVI void gemm_tile(ARow arow, const u16* __restrict__ Bt, int ldb, int K, XF xf, ST st, char* lds) {
    constexpr int WN = BN / 64, NA = BM / 64, NBC = BN / 64, STR = 72;
    const int tid = tidx(), lane = tid & 63, w = tid >> 6, wm = w / WN, wn = w % WN, l31 = lane & 31, h = lane >> 5;
    u16* sA = (u16*)lds; u16* sB = sA + 2 * BM * STR;
    const int crow = tid >> 3, kc = tid & 7;
    const u16* pa[NA]; const u16* pb[NBC];
#pragma unroll
    for (int i = 0; i < NA; ++i) pa[i] = arow(crow + 64 * i) + kc * 8;
#pragma unroll
    for (int i = 0; i < NBC; ++i) pb[i] = Bt + (size_t)(crow + 64 * i) * ldb + kc * 8;
    u32x4 ra[2][NA], rb[2][NBC];
    const int nk = K >> 6;
#pragma unroll
    for (int st_ = 0; st_ < 2; ++st_) {
        const int kq = st_ < nk ? st_ : nk - 1;
#pragma unroll
        for (int i = 0; i < NA; ++i) ra[st_][i] = *(const u32x4*)(pa[i] + kq * 64);
#pragma unroll
        for (int i = 0; i < NBC; ++i) rb[st_][i] = *(const u32x4*)(pb[i] + kq * 64);
    }
    f32x16 acc[2][2];
#pragma unroll
    for (int a = 0; a < 2; ++a)
#pragma unroll
        for (int b = 0; b < 2; ++b)
#pragma unroll
            for (int i = 0; i < 16; ++i) acc[a][b][i] = 0.f;
    float ss[2] = {0.f, 0.f};
#pragma unroll
    for (int i = 0; i < NA; ++i) *(u32x4*)(sA + (crow + 64 * i) * STR + kc * 8) = ra[0][i];
#pragma unroll
    for (int i = 0; i < NBC; ++i) *(u32x4*)(sB + (crow + 64 * i) * STR + kc * 8) = rb[0][i];
    lds_barrier();
    {
        const int kn = 2 < nk ? 2 : nk - 1;
#pragma unroll
        for (int i = 0; i < NA; ++i) ra[0][i] = *(const u32x4*)(pa[i] + kn * 64);
#pragma unroll
        for (int i = 0; i < NBC; ++i) rb[0][i] = *(const u32x4*)(pb[i] + kn * 64);
    }
#pragma unroll 2
    for (int kt = 0; kt < nk; ++kt) {
        const int cur = kt & 1, nxt = cur ^ 1;
        const u16* a_ = sA + cur * BM * STR; const u16* b_ = sB + cur * BN * STR;
        u16* an = sA + nxt * BM * STR; u16* bn = sB + nxt * BN * STR;
#pragma unroll
        for (int ks = 0; ks < 4; ++ks) {
            bf16x8 af[2], bfr[2];
#pragma unroll
            for (int mi = 0; mi < 2; ++mi) af[mi] = *(const bf16x8*)(a_ + (wm * 64 + mi * 32 + l31) * STR + ks * 16 + h * 8);
#pragma unroll
            for (int ni = 0; ni < 2; ++ni) bfr[ni] = *(const bf16x8*)(b_ + (wn * 64 + ni * 32 + l31) * STR + ks * 16 + h * 8);
            if (ROWNORM) { ss[0] += sumsq8(af[0]); ss[1] += sumsq8(af[1]); }
#pragma unroll
            for (int mi = 0; mi < 2; ++mi)
#pragma unroll
                for (int ni = 0; ni < 2; ++ni) acc[mi][ni] = __builtin_amdgcn_mfma_f32_32x32x16_bf16(bfr[ni], af[mi], acc[mi][ni], 0, 0, 0);
            if (ks == 1) {
#pragma unroll
                for (int i = 0; i < NA; ++i) *(u32x4*)(an + (crow + 64 * i) * STR + kc * 8) = ra[nxt][i];
#pragma unroll
                for (int i = 0; i < NBC; ++i) *(u32x4*)(bn + (crow + 64 * i) * STR + kc * 8) = rb[nxt][i];
            }
        }
        lds_barrier();
        {
            const int kn = (kt + 3 < nk) ? kt + 3 : nk - 1;
#pragma unroll
            for (int i = 0; i < NA; ++i) ra[nxt][i] = *(const u32x4*)(pa[i] + kn * 64);
#pragma unroll
            for (int i = 0; i < NBC; ++i) rb[nxt][i] = *(const u32x4*)(pb[i] + kn * 64);
        }
    }
    if (ROWNORM) {
#pragma unroll
        for (int mi = 0; mi < 2; ++mi) {
            float s = ss[mi] + __shfl_xor(ss[mi], 32);
            float r = rsqrtf(s / (float)K + 1e-6f);
#pragma unroll
            for (int ni = 0; ni < 2; ++ni)
#pragma unroll
                for (int i = 0; i < 16; ++i) acc[mi][ni][i] *= r;
        }
    }
    constexpr int TS = BN + 4;
    u16* sT = (u16*)lds;
    lds_barrier();
#pragma unroll
    for (int mi = 0; mi < 2; ++mi) {
        const int r = wm * 64 + mi * 32 + l31;
        xf(r, wn * 64, acc[mi], h);
#pragma unroll
        for (int ni = 0; ni < 2; ++ni)
#pragma unroll
            for (int g = 0; g < 4; ++g) { uint2 v; v.x = pack2(acc[mi][ni][4 * g], acc[mi][ni][4 * g + 1]); v.y = pack2(acc[mi][ni][4 * g + 2], acc[mi][ni][4 * g + 3]);
                *(uint2*)(sT + r * TS + wn * 64 + ni * 32 + 8 * g + 4 * h) = v; }
    }
    lds_barrier();
#pragma unroll 2
    for (int q = tid; q < BM * BN / 8; q += 512) {
        const int r = q / (BN / 8), c8 = (q % (BN / 8)) * 8;
        const uint2 lo = *(const uint2*)(sT + r * TS + c8), hi = *(const uint2*)(sT + r * TS + c8 + 4);
        u32x4 v = {lo.x, lo.y, hi.x, hi.y};
        st(r, c8, v);
    }
    lds_barrier();
}
DEVI void store_tile_bf16(u16* dst, const f32x16& t, int h) {
#pragma unroll
    for (int g = 0; g < 4; ++g) { uint2 v; v.x = pack2(t[4 * g], t[4 * g + 1]); v.y = pack2(t[4 * g + 2], t[4 * g + 3]); *(uint2*)(dst + 8 * g + 4 * h) = v; }
}
DEVI void rope_tile(f32x16& t, int axis, int pp, int h, const float2* __restrict__ tab) {
    if (pp < LC) return;
    const int s = pp - LC; const int coord = axis ? (s & 63) : (s >> 6);
#pragma unroll
    for (int g = 0; g < 2; ++g)
#pragma unroll
        for (int i = 0; i < 4; ++i) {
            const float2 cs = tab[coord * 16 + 8 * g + 4 * h + i];
            const float x1 = t[4 * g + i], x2 = t[4 * (g + 2) + i];
            t[4 * g + i] = x1 * cs.x - x2 * cs.y; t[4 * (g + 2) + i] = x2 * cs.x + x1 * cs.y;
        }
}

struct CJob { const float* src; u16* dst; const float* gain; int K, ldsrc, nlog, nvalid, sseg, sstride, soff, dseg, dstride, doff; int nmat; size_t smat, dmat; };
DEVI void get_job(const Params& p, int j, int layer, CJob& J) {
    char* ws = p.ws;
    J.gain = nullptr; J.nmat = 1; J.smat = 0; J.dmat = 0; J.sseg = 1 << 30; J.sstride = 0; J.soff = 0; J.dseg = 1 << 30; J.dstride = 0; J.doff = 0;
    auto plain = [&](const float* src, size_t dstoff, int K, int N) { J.src = src; J.dst = (u16*)(ws + dstoff); J.K = K; J.ldsrc = N; J.nlog = N; J.nvalid = N; };
    switch (j) {
    case 0: plain(p.in[I_AWIN], W_IN, 1024, 1472); J.nlog = 1536; break;
    case 1: plain(p.in[I_AWUQ], W_UQ, 384, 768); J.gain = p.in[I_AQN]; break;
    case 2: plain(p.in[I_AWUKV], W_UK, 256, 1024); J.nlog = 512; J.nvalid = 512; J.sseg = 128; J.sstride = 256; J.soff = 0; J.gain = p.in[I_AKVN]; break;
    case 3: plain(p.in[I_AWUKV], W_UV, 256, 1024); J.nlog = 512; J.nvalid = 512; J.sseg = 128; J.sstride = 256; J.soff = 128; J.gain = p.in[I_AKVN]; break;
    case 4: plain(p.in[I_AWO], W_OA, 1024, 1024); break;
    case 5: plain(p.in[I_RWR], W_RR, 1024, 1024); break;
    case 6: plain(p.in[I_RWK], W_RK, 1024, 1024); break;
    case 7: plain(p.in[I_RWV], W_RV, 1024, 1024); break;
    case 8: plain(p.in[I_RWO], W_RO, 1024, 1024); break;
    case 9: plain(p.in[I_RG1], W_G1, 1024, 128); break;
    case 10: plain(p.in[I_RW1], W_W1, 1024, 64); break;
    case 11: plain(p.in[I_RW1] + 1024 * 64, W_W1 + 64 * 1024 * 2, 1024, 64); break;
    case 12: plain(p.in[I_RA1], W_A1, 1024, 64); break;
    case 13: plain(p.in[I_RA1] + 1024 * 64, W_A1 + 64 * 1024 * 2, 1024, 64); break;
    case 14: plain(p.in[I_RG2], W_G2, 128, 1024); break;
    case 15: plain(p.in[I_RW2], W_W2, 64, 1024); break;
    case 16: plain(p.in[I_RW2] + 64 * 1024, W_W2 + 1024 * 64 * 2, 64, 1024); break;
    case 17: plain(p.in[I_RA2], W_A2, 64, 1024); break;
    case 18: plain(p.in[I_RA2] + 64 * 1024, W_A2 + 1024 * 64 * 2, 64, 1024); break;
    case 19: plain(p.in[I_MSG], W_SGU, 1024, 256); J.dseg = 32; J.dstride = 64; J.doff = 0; break;
    case 20: plain(p.in[I_MSU], W_SGU, 1024, 256); J.dseg = 32; J.dstride = 64; J.doff = 32; break;
    case 21: plain(p.in[I_MSG] + 1024 * 256, W_SGU + 1048576, 1024, 256); J.dseg = 32; J.dstride = 64; J.doff = 0; break;
    case 22: plain(p.in[I_MSU] + 1024 * 256, W_SGU + 1048576, 1024, 256); J.dseg = 32; J.dstride = 64; J.doff = 32; break;
    case 23: plain(p.in[I_MSD], W_SD, 256, 1024); break;
    case 24: plain(p.in[I_MSD] + 256 * 1024, W_SD + 524288, 256, 1024); break;
    case 25: plain(p.in[I_MWG] + (size_t)layer * 64 * 1024 * 256, OFF_WGU, 1024, 256); J.dseg = 32; J.dstride = 64; J.doff = 0; J.nmat = 64; J.smat = 1024 * 256; J.dmat = 512 * 1024; break;
    case 26: plain(p.in[I_MWU] + (size_t)layer * 64 * 1024 * 256, OFF_WGU, 1024, 256); J.dseg = 32; J.dstride = 64; J.doff = 32; J.nmat = 64; J.smat = 1024 * 256; J.dmat = 512 * 1024; break;
    default: plain(p.in[I_MWD] + (size_t)layer * 64 * 256 * 1024, OFF_WD, 256, 1024); J.nmat = 64; J.smat = 256 * 1024; J.dmat = 1024 * 256; break;
    }
}
DEVI int job_tiles(const CJob& J) { return J.nmat * (J.nlog / 64) * ((J.K + 127) / 128); }
DEVI void conv_tile(const CJob& J, int t, char* lds) {
    const int ktiles = (J.K + 127) / 128, ntiles = J.nlog / 64;
    const int mat = t / (ktiles * ntiles); const int r = t - mat * ktiles * ntiles; const int nt = r / ktiles, ktile = r - nt * ktiles;
    const float* src = J.src + (size_t)mat * J.smat; u16* dst = J.dst + (size_t)mat * J.dmat;
    unsigned* sm = (unsigned*)lds;
    const int tid = tidx(), ng = tid & 15, kp = tid >> 4;
    const int n0 = nt * 64 + ng * 4;
    const int scol = (n0 / J.sseg) * J.sstride + J.soff + (n0 % J.sseg);
    const bool nval = n0 < J.nvalid;
#pragma unroll
    for (int pass = 0; pass < 2; ++pass) {
        const int k = ktile * 128 + pass * 64 + kp * 2;
        float4 v0 = make_float4(0.f, 0.f, 0.f, 0.f), v1 = v0;
        if (nval && k < J.K) {
            v0 = *(const float4*)(src + (size_t)k * J.ldsrc + scol); v1 = *(const float4*)(src + (size_t)(k + 1) * J.ldsrc + scol);
            if (J.gain) { const float g0 = J.gain[k], g1 = J.gain[k + 1]; v0.x *= g0; v0.y *= g0; v0.z *= g0; v0.w *= g0; v1.x *= g1; v1.y *= g1; v1.z *= g1; v1.w *= g1; }
        }
        const int kk = pass * 32 + kp;
        sm[(ng * 4 + 0) * 66 + kk] = pack2(v0.x, v1.x); sm[(ng * 4 + 1) * 66 + kk] = pack2(v0.y, v1.y);
        sm[(ng * 4 + 2) * 66 + kk] = pack2(v0.z, v1.z); sm[(ng * 4 + 3) * 66 + kk] = pack2(v0.w, v1.w);
    }
    __syncthreads();
#pragma unroll
    for (int i = 0; i < 2; ++i) {
        const int c = tid + 512 * i, row = c >> 4, ch = c & 15;
        const int n = nt * 64 + row; const int drow = (n / J.dseg) * J.dstride + J.doff + (n % J.dseg);
        const int k = ktile * 128 + ch * 8;
        if (k < J.K) { uint2 lo = *(const uint2*)(sm + row * 66 + ch * 4), hi = *(const uint2*)(sm + row * 66 + ch * 4 + 2); uint4 v = make_uint4(lo.x, lo.y, hi.x, hi.y); *(uint4*)(dst + (size_t)drow * J.K + k) = v; }
    }
    __syncthreads();
}
DEVI void conv_jobs(const Params& p, int jlo, int jhi, int layer, int unit_base, char* lds) {
    const int G = gridDim.x, bid = blockIdx.x;
    int acc = unit_base;
    for (int j = jlo; j < jhi; ++j) {
        CJob J; get_job(p, j, layer, J); const int n = job_tiles(J);
        const int t0 = (bid - (acc % G) + G) % G;
        for (int t = t0; t < n; t += G) conv_tile(J, t, lds);
        acc += n;
    }
}
DEVI void mods_unit(const Params& p, int u, char* lds) {
    const int l = u / 96, cg = u % 96;
    float* sil = (float*)lds;
    float* red = sil + 1024 * 12;
    const int tid = tidx(), lane = tid & 63, w = tid >> 6;
    for (int i = tid; i < 9 * 1024; i += 512) { const int bb = i >> 10, k = i & 1023; const float v = bb < 8 ? p.in[I_C][bb * 1024 + k] : p.in[I_CCTX][k]; sil[k * 12 + bb] = siluf_(v); }
    __syncthreads();
    float acc[9];
#pragma unroll
    for (int i = 0; i < 9; ++i) acc[i] = 0.f;
    const float* wp = p.in[I_ADAW] + (size_t)l * 1024 * 6144 + cg * 64 + lane;
#pragma unroll 4
    for (int kk = 0; kk < 128; ++kk) {
        const int k = w * 128 + kk; const float wv = wp[(size_t)k * 6144];
        const float4 s0 = *(const float4*)(sil + k * 12), s1 = *(const float4*)(sil + k * 12 + 4); const float s2 = sil[k * 12 + 8];
        acc[0] += s0.x * wv; acc[1] += s0.y * wv; acc[2] += s0.z * wv; acc[3] += s0.w * wv; acc[4] += s1.x * wv; acc[5] += s1.y * wv; acc[6] += s1.z * wv; acc[7] += s1.w * wv; acc[8] += s2 * wv;
    }
#pragma unroll
    for (int i = 0; i < 9; ++i) red[(w * 9 + i) * 64 + lane] = acc[i];
    __syncthreads();
    for (int i = tid; i < 9 * 64; i += 512) {
        const int bb = i >> 6, c = i & 63; float s = 0.f;
        for (int ww = 0; ww < 8; ++ww) s += red[(ww * 9 + bb) * 64 + c];
        const int col = cg * 64 + c;
        ((float*)(p.ws + OFF_MODS))[(size_t)(l * 9 + bb) * 6144 + col] = s + p.in[I_ADAB][l * 6144 + col];
    }
    __syncthreads();
}
DEVI void phase_prologue(const Params& p, char* lds) {
    const int bid = blockIdx.x, G = gridDim.x;
    if (bid == G - 1) {
        int* cnt = (int*)(p.ws + OFF_CNT);
        for (int i = tidx(); i < 2 * NCHUNK * 64; i += 512) cnt[i] = 0;
        float2* tab = (float2*)(p.ws + OFF_ROPE);
        for (int i = tidx(); i < 64 * 16; i += 512) { const int coord = i >> 4, f = i & 15; const float inv = exp2f(-(float)f * (13.287712379549449f / 16.f)); const float a = (float)coord * inv; tab[i] = make_float2(cosf(a), sinf(a)); }
    }
    for (int u = bid; u < 192; u += G) mods_unit(p, u, lds);
    conv_jobs(p, 0, 25, 0, 192, lds);
}

DEVI void norm_rows(const RowSrc& src, int mode, int nrows, const float* __restrict__ gain, const float* __restrict__ mods_l, int ishift, int iscale, u16* __restrict__ dst) {
    const int lane = tidx() & 63, w = tidx() >> 6;
    for (int r = blockIdx.x * 8 + w; r < nrows; r += gridDim.x * 8) {
        int bb; const float* xr = row_ptr(src, mode, r, bb);
        float4 v[4]; float ss = 0.f;
#pragma unroll
        for (int i = 0; i < 4; ++i) { v[i] = ((const float4*)xr)[lane + 64 * i]; ss += v[i].x * v[i].x + v[i].y * v[i].y + v[i].z * v[i].z + v[i].w * v[i].w; }
        ss = wave_sum(ss);
        const float rs = rsqrtf(ss * (1.f / 1024.f) + 1e-6f);
        const float* msh = mods_l + (size_t)bb * 6144 + ishift * 1024; const float* msc = mods_l + (size_t)bb * 6144 + iscale * 1024;
#pragma unroll
        for (int i = 0; i < 4; ++i) {
            const int c = (lane + 64 * i) * 4;
            const float4 g = *(const float4*)(gain + c), sh = *(const float4*)(msh + c), sc = *(const float4*)(msc + c);
            uint2 o; o.x = pack2(v[i].x * rs * g.x * (1.f + sc.x) + sh.x, v[i].y * rs * g.y * (1.f + sc.y) + sh.y);
            o.y = pack2(v[i].z * rs * g.z * (1.f + sc.z) + sh.z, v[i].w * rs * g.w * (1.f + sc.w) + sh.w);
            *(uint2*)(dst + (size_t)r * DM + c) = o;
        }
    }
}

DEVI void phase_gemm_win(const Params& p, char* lds) {
    const u16* A = (const u16*)(p.ws + A_N0); const u16* W = (const u16*)(p.ws + W_IN);
    u16* CQ = (u16*)(p.ws + A_CQ); u16* CKV = (u16*)(p.ws + A_CKV); u16* KA = (u16*)(p.ws + A_KA); u16* QS = (u16*)(p.ws + A_QS); u16* KS = (u16*)(p.ws + A_KS); u16* VS = (u16*)(p.ws + A_VS);
    const float2* tab = (const float2*)(p.ws + OFF_ROPE);
    const int NT = 12, MT = T0 / 256;
    for (int u = blockIdx.x; u < NT * MT; u += gridDim.x) {
        const int mt = u / NT, nt = u % NT; const int m0 = mt * 256, n0 = nt * 128;
        auto arow = [&](int r) { return A + (size_t)(m0 + r) * DM; };
        auto xf = [&](int r, int cw, f32x16 (&t)[2], int h) {
            const int row = m0 + r; const int b = row / LT, pp = row - b * LT;
#pragma unroll
            for (int ni = 0; ni < 2; ++ni) {
                const int c32 = n0 + cw + ni * 32;
                if (c32 >= 640 && c32 < 1344) {
                    const int cc = c32 - 640; rope_tile(t[ni], (cc >> 5) & 1, pp, h, tab);
                    if (c32 >= 704 && c32 < 1216) {
#pragma unroll
                        for (int i = 0; i < 16; ++i) t[ni][i] *= QS_SCALE;
                    }
                }
            }
        };
        auto st = [&](int r, int c8, u32x4 v) {
            const int row = m0 + r; const int b = row / LT, pp = row - b * LT; const int c = n0 + c8;
            if (c < 384) *(u32x4*)(CQ + (size_t)row * 384 + c) = v;
            else if (c < 640) *(u32x4*)(CKV + (size_t)row * 256 + (c - 384)) = v;
            else if (c < 704) { for (int hd = 0; hd < 4; ++hd) *(u32x4*)(KA + ((size_t)(b * 4 + hd) * LT + pp) * 192 + 128 + (c - 640)) = v; }
            else if (c < 1216) { const int cc = c - 704; *(u32x4*)(QS + ((size_t)(b * 8 + (cc >> 6)) * LT + pp) * 64 + (cc & 63)) = v; }
            else if (c < 1344) { const int cc = c - 1216; *(u32x4*)(KS + ((size_t)(b * 2 + (cc >> 6)) * LT + pp) * 64 + (cc & 63)) = v; }
            else if (c < 1472) { const int cc = c - 1344; *(u32x4*)(VS + ((size_t)(b * 2 + (cc >> 6)) * LT + pp) * 64 + (cc & 63)) = v; }
        };
        gemm_tile<256, 128, false>(arow, W + (size_t)n0 * DM, DM, DM, xf, st, lds);
    }
}
DEVI void phase_gemm_qkv(const Params& p, char* lds) {
    const u16* CQ = (const u16*)(p.ws + A_CQ); const u16* CKV = (const u16*)(p.ws + A_CKV);
    u16* QA = (u16*)(p.ws + A_QA); u16* KA = (u16*)(p.ws + A_KA); u16* VA = (u16*)(p.ws + A_VA);
    const float2* tab = (const float2*)(p.ws + OFF_ROPE);
    const int MT = T0 / 256;
    for (int u = blockIdx.x; u < 14 * MT; u += gridDim.x) {
        const int mt = u / 14, j = u % 14; const int m0 = mt * 256;
        if (j < 6) {
            const int n0 = j * 128;
            auto arow = [&](int r) { return CQ + (size_t)(m0 + r) * 384; };
            auto xf = [&](int r, int cw, f32x16 (&t)[2], int h) {
                const int row = m0 + r; const int pp = row % LT;
#pragma unroll
                for (int ni = 0; ni < 2; ++ni) {
                    const int c32 = n0 + cw + ni * 32; const int wi = c32 % 192;
                    if (wi >= 128) rope_tile(t[ni], (wi - 128) >> 5, pp, h, tab);
#pragma unroll
                    for (int i = 0; i < 16; ++i) t[ni][i] *= QA_SCALE;
                }
            };
            auto st = [&](int r, int c8, u32x4 v) {
                const int row = m0 + r; const int b = row / LT, pp = row - b * LT; const int c = n0 + c8; const int hd = c / 192, wi = c - hd * 192;
                *(u32x4*)(QA + ((size_t)(b * 4 + hd) * LT + pp) * 192 + wi) = v;
            };
            gemm_tile<256, 128, true>(arow, (const u16*)(p.ws + W_UQ) + (size_t)n0 * 384, 384, 384, xf, st, lds);
        } else {
            const bool isv = j >= 10; const int n0 = (isv ? j - 10 : j - 6) * 128;
            auto arow = [&](int r) { return CKV + (size_t)(m0 + r) * 256; };
            auto xf = [&](int, int, f32x16 (&)[2], int) {};
            auto st = [&](int r, int c8, u32x4 v) {
                const int row = m0 + r; const int b = row / LT, pp = row - b * LT; const int c = n0 + c8; const int hd = c >> 7, wi = c & 127;
                if (isv) *(u32x4*)(VA + ((size_t)(b * 4 + hd) * LT + pp) * 128 + wi) = v;
                else *(u32x4*)(KA + ((size_t)(b * 4 + hd) * LT + pp) * 192 + wi) = v;
            };
            gemm_tile<256, 128, true>(arow, (const u16*)(p.ws + (isv ? W_UV : W_UK)) + (size_t)n0 * 256, 256, 256, xf, st, lds);
        }
    }
}

template <int DQK, int DV, bool SWA>
DEVI void attn_unit(const u16* __restrict__ Q, const u16* __restrict__ Kp, const u16* __restrict__ Vp, int q0, int a0, int na, int b0, int nb2,
                    float m_init, u16* __restrict__ outp  , char* lds) {
    constexpr int KSTR = DQK + 8, VSTR = DV + 32, KCH = DQK / 8, VCH = DV / 8, NKC = 64 * KCH / 512, NVC = 64 * VCH / 512, NS = DQK / 16, NDT = DV / 32;
    const int tid = tidx(), lane = tid & 63, w = tid >> 6, l31 = lane & 31, h = lane >> 5;
    u16* sK = (u16*)lds; u16* sV = sK + 2 * 64 * KSTR;
    const int qpos = q0 + w * 32 + l31;
    bf16x8 qf[NS];
#pragma unroll
    for (int s = 0; s < NS; ++s) qf[s] = *(const bf16x8*)(Q + (size_t)qpos * DQK + s * 16 + h * 8);
    f32x16 o[NDT];
#pragma unroll
    for (int d = 0; d < NDT; ++d)
#pragma unroll
        for (int i = 0; i < 16; ++i) o[d][i] = 0.f;
    float m = m_init, lsum = 0.f;
    const int nt = na + nb2;
    u32x4 rk[NKC], rv[NVC];
    auto tile_pos = [&](int t) { return t < na ? a0 + 64 * t : b0 + 64 * (t - na); };
    auto gload = [&](int t) {
        const int kp0 = tile_pos(t);
        const u16* kb_ = Kp + (size_t)kp0 * DQK + tid * 8; const u16* vb_ = Vp + (size_t)kp0 * DV + tid * 8;
#pragma unroll
        for (int i = 0; i < NKC; ++i) rk[i] = *(const u32x4*)(kb_ + 4096 * i);
#pragma unroll
        for (int i = 0; i < NVC; ++i) rv[i] = *(const u32x4*)(vb_ + 4096 * i);
    };
    gload(0);
    const int tr_row = 4 * h + ((lane & 15) >> 2), tr_col = 16 * ((lane >> 4) & 1) + 4 * (lane & 3);
    for (int t = 0; t < nt; ++t) {
        u16* k_ = sK + (t & 1) * 64 * KSTR; u16* v_ = sV + (t & 1) * 64 * VSTR;
#pragma unroll
        for (int i = 0; i < NKC; ++i) { const int c = tid + 512 * i, row = c / KCH, ch = c % KCH; *(u32x4*)(k_ + row * KSTR + ch * 8) = rk[i]; }
#pragma unroll
        for (int i = 0; i < NVC; ++i) { const int c = tid + 512 * i, row = c / VCH, ch = c % VCH; *(u32x4*)(v_ + row * VSTR + ch * 8) = rv[i]; }
        __syncthreads();
        if (t + 1 < nt) gload(t + 1);
        f32x16 st[2];
#pragma unroll
        for (int k2 = 0; k2 < 2; ++k2) {
#pragma unroll
            for (int i = 0; i < 16; ++i) st[k2][i] = 0.f;
#pragma unroll
            for (int s = 0; s < NS; ++s) {
                const bf16x8 kf = *(const bf16x8*)(k_ + (k2 * 32 + l31) * KSTR + s * 16 + h * 8);
                st[k2] = __builtin_amdgcn_mfma_f32_32x32x16_bf16(kf, qf[s], st[k2], 0, 0, 0);
            }
        }
        __builtin_amdgcn_sched_barrier(0);
        if (SWA && t >= na) {
            const int kp0 = tile_pos(t);
#pragma unroll
            for (int k2 = 0; k2 < 2; ++k2)
#pragma unroll
                for (int i = 0; i < 16; ++i) {
                    const int key = kp0 + k2 * 32 + (i & 3) + 8 * (i >> 2) + 4 * h; const int d = qpos - key;
                    if (d > 128 || d < -128) st[k2][i] = -1e30f;
                }
        }
        float mx = st[0][0];
#pragma unroll
        for (int k2 = 0; k2 < 2; ++k2)
#pragma unroll
            for (int i = 0; i < 16; ++i) mx = fmaxf(mx, st[k2][i]);
        mx = fmaxf(mx, xhalf(mx));
        const float mn = fmaxf(m, mx); const float alpha = __builtin_amdgcn_exp2f(m - mn); m = mn;
        float ps = 0.f;
#pragma unroll
        for (int k2 = 0; k2 < 2; ++k2)
#pragma unroll
            for (int i = 0; i < 16; ++i) { const float pv = __builtin_amdgcn_exp2f(st[k2][i] - mn); st[k2][i] = pv; ps += pv; }
        lsum = lsum * alpha + ps;
#pragma unroll
        for (int d = 0; d < NDT; ++d)
#pragma unroll
            for (int i = 0; i < 16; ++i) o[d][i] *= alpha;
#pragma unroll
        for (int s16 = 0; s16 < 4; ++s16) {
            __builtin_amdgcn_sched_barrier(0);
            bf16x8 pf; unsigned* pu = (unsigned*)&pf;
#pragma unroll
            for (int jj = 0; jj < 4; ++jj) pu[jj] = pack2(st[s16 >> 1][8 * (s16 & 1) + 2 * jj], st[s16 >> 1][8 * (s16 & 1) + 2 * jj + 1]);
#pragma unroll
            for (int d = 0; d < NDT; ++d) {
                const u16* base = v_ + (16 * s16 + tr_row) * VSTR + d * 32 + tr_col;
                const s16x4 lo = __builtin_amdgcn_ds_read_tr16_b64_v4i16((LAS s16x4*)(base));
                const s16x4 hi = __builtin_amdgcn_ds_read_tr16_b64_v4i16((LAS s16x4*)(base + 8 * VSTR));
                bf16x8 vf; vf[0] = lo[0]; vf[1] = lo[1]; vf[2] = lo[2]; vf[3] = lo[3]; vf[4] = hi[0]; vf[5] = hi[1]; vf[6] = hi[2]; vf[7] = hi[3];
                o[d] = __builtin_amdgcn_mfma_f32_32x32x16_bf16(vf, pf, o[d], 0, 0, 0);
            }
        }
    }
    float lt = lsum + xhalf(lsum);
    if (SWA) lt += __builtin_amdgcn_exp2f(m_init - m);
    const float inv = 1.f / lt;
    u16* orow = outp + (size_t)qpos * DM;
#pragma unroll
    for (int d = 0; d < NDT; ++d)
#pragma unroll
        for (int g = 0; g < 4; ++g) { uint2 v; v.x = pack2(o[d][4 * g] * inv, o[d][4 * g + 1] * inv); v.y = pack2(o[d][4 * g + 2] * inv, o[d][4 * g + 3] * inv); *(uint2*)(orow + d * 32 + 8 * g + 4 * h) = v; }
    __syncthreads();
}
DEVI void phase_attention(const Params& p, char* lds) {
    const u16* QA = (const u16*)(p.ws + A_QA); const u16* KA = (const u16*)(p.ws + A_KA); const u16* VA = (const u16*)(p.ws + A_VA);
    const u16* QS = (const u16*)(p.ws + A_QS); const u16* KS = (const u16*)(p.ws + A_KS); const u16* VS = (const u16*)(p.ws + A_VS);
    u16* mix = (u16*)(p.ws + A_N0);
    for (int u = blockIdx.x; u < 1632; u += gridDim.x) {
        if (u < 544) {
            int b, hd, q0, na;
            if (u < 512) { b = u >> 6; hd = (u >> 4) & 3; q0 = LC + (u & 15) * 256; na = 68; }
            else { const int v = u - 512; b = v >> 2; hd = v & 3; q0 = 0; na = 4; }
            const size_t bh = (size_t)(b * 4 + hd) * LT;
            attn_unit<192, 128, false>(QA + bh * 192, KA + bh * 192, VA + bh * 128, q0, 0, na, 0, 0, -1e30f, mix + (size_t)b * LT * DM + hd * 128, lds);
        } else {
            int b, hd, q0, b0 = 0, nb2 = 0;
            if (u < 1568) { const int v = u - 544; b = v >> 7; hd = (v >> 4) & 7; const int s0 = (v & 15) * 256; q0 = LC + s0;
                int lo = s0 - 128; if (lo < 0) lo = 0; int hi = s0 + 256 + 128; if (hi > SEQ) hi = SEQ; b0 = LC + lo; nb2 = (hi - lo) >> 6; }
            else { const int v = u - 1568; b = v >> 3; hd = v & 7; q0 = 0; }
            const int kvh = hd >> 2; const size_t qb = (size_t)(b * 8 + hd) * LT, kb = (size_t)(b * 2 + kvh) * LT;
            attn_unit<64, 64, true>(QS + qb * 64, KS + kb * 64, VS + kb * 64, q0, 0, 4, b0, nb2, p.in[I_ASINK][hd] * LOG2E, mix + (size_t)b * LT * DM + 512 + hd * 64, lds);
        }
    }
}
DEVI void phase_gemm_wo(const Params& p, const u16* A, const u16* W, const RowSrc& resid, int mode, int layer, char* lds) {
    float* XC = (float*)(p.ws + OFF_XC); float* XL = p.out;
    const float* mods_l = (const float*)(p.ws + OFF_MODS) + (size_t)layer * 9 * 6144;
    const int MT = (mode == 0 ? T0 : TL) / 256;
    for (int u = blockIdx.x; u < 8 * MT; u += gridDim.x) {
        const int mt = u >> 3, nt = u & 7; const int m0 = mt * 256, n0 = nt * 128;
        auto arow = [&](int r) { return A + (size_t)(m0 + r) * DM; };
        auto xf = [&](int, int, f32x16 (&)[2], int) {};
        auto st = [&](int r, int c8, u32x4 v) {
            int bb; const float* rs = row_ptr(resid, mode, m0 + r, bb); int bb2; float* xo = row_ptr_w(XC, XL, mode, m0 + r, bb2);
            const float* mg = mods_l + (size_t)bb * 6144 + 2 * 1024; const int c = n0 + c8;
            const float4 r0 = *(const float4*)(rs + c), r1 = *(const float4*)(rs + c + 4), g0 = *(const float4*)(mg + c), g1 = *(const float4*)(mg + c + 4);
            float4 o0, o1;
            o0.x = r0.x + g0.x * bf_lo(v[0]); o0.y = r0.y + g0.y * bf_hi(v[0]); o0.z = r0.z + g0.z * bf_lo(v[1]); o0.w = r0.w + g0.w * bf_hi(v[1]);
            o1.x = r1.x + g1.x * bf_lo(v[2]); o1.y = r1.y + g1.y * bf_hi(v[2]); o1.z = r1.z + g1.z * bf_lo(v[3]); o1.w = r1.w + g1.w * bf_hi(v[3]);
            *(float4*)(xo + c) = o0; *(float4*)(xo + c + 4) = o1;
        };
        gemm_tile<256, 128, false>(arow, W + (size_t)n0 * DM, DM, DM, xf, st, lds);
    }
}

DEVI void phase_moe_route(const Params& p, int layer, char* lds) {
    const int mode = layer == 0 ? 0 : 1; const int ntok = layer == 0 ? T0 : TL; const int tc = ntok / NCHUNK;
    RowSrc src; src.ctx = (const float*)(p.ws + OFF_XC); src.lat = p.out;
    const float* gain = p.in[I_NFFN] + layer * 1024; const float* mods_l = (const float*)(p.ws + OFF_MODS) + (size_t)layer * 9 * 6144;
    const float* wr = p.in[I_MROUT] + (size_t)layer * 1024 * 64; const float ebias = p.in[I_MBIAS][layer * 64 + (tidx() & 63)];
    u16* n1 = (u16*)(p.ws + M_N1);
    int* cnt = (int*)(p.ws + OFF_CNT) + layer * NCHUNK * 64;
    int* tok_e = (int*)(p.ws + OFF_TOKE); int* tok_r = (int*)(p.ws + OFF_TOKR); int* ltok = (int*)(p.ws + OFF_LTOK); float* lg = (float*)(p.ws + OFF_LG);
    const int lane = tidx() & 63, w = tidx() >> 6;
    float* sn = (float*)lds + w * 4096;
    for (int t0 = (blockIdx.x * 8 + w) * 4; t0 < ntok; t0 += gridDim.x * 32) {
#pragma unroll
        for (int j = 0; j < 4; ++j) {
            const int r = t0 + j; int bb; const float* xr = row_ptr(src, mode, r, bb);
            float4 v[4]; float ss = 0.f;
#pragma unroll
            for (int i = 0; i < 4; ++i) { v[i] = ((const float4*)xr)[lane + 64 * i]; ss += v[i].x * v[i].x + v[i].y * v[i].y + v[i].z * v[i].z + v[i].w * v[i].w; }
            ss = wave_sum(ss);
            const float rs = rsqrtf(ss * (1.f / 1024.f) + 1e-6f);
            const float* msh = mods_l + (size_t)bb * 6144 + 3 * 1024; const float* msc = mods_l + (size_t)bb * 6144 + 4 * 1024;
#pragma unroll
            for (int i = 0; i < 4; ++i) {
                const int c = (lane + 64 * i) * 4;
                const float4 g = *(const float4*)(gain + c), sh = *(const float4*)(msh + c), sc = *(const float4*)(msc + c);
                const float y0 = v[i].x * rs * g.x * (1.f + sc.x) + sh.x, y1 = v[i].y * rs * g.y * (1.f + sc.y) + sh.y, y2 = v[i].z * rs * g.z * (1.f + sc.z) + sh.z, y3 = v[i].w * rs * g.w * (1.f + sc.w) + sh.w;
                uint2 o; o.x = pack2(y0, y1); o.y = pack2(y2, y3);
                *(uint2*)(n1 + (size_t)r * DM + c) = o;
                sn[(c + 0) * 4 + j] = y0; sn[(c + 1) * 4 + j] = y1; sn[(c + 2) * 4 + j] = y2; sn[(c + 3) * 4 + j] = y3;
            }
        }
        __builtin_amdgcn_s_waitcnt(0xc07f);
        __builtin_amdgcn_wave_barrier();
        float a0 = 0.f, a1 = 0.f, a2 = 0.f, a3 = 0.f;
#pragma unroll 8
        for (int k = 0; k < 1024; ++k) { const float wv = wr[k * 64 + lane]; const float4 s = *(const float4*)(sn + k * 4); a0 += s.x * wv; a1 += s.y * wv; a2 += s.z * wv; a3 += s.w * wv; }
        __builtin_amdgcn_wave_barrier();
        const float lgt[4] = {a0, a1, a2, a3};
#pragma unroll
        for (int j = 0; j < 4; ++j) {
            const int tok = t0 + j;
            const float score = 1.f / (1.f + expf(-lgt[j])); const float choice = score + ebias;
            const float m1 = red8_max(choice);
            const unsigned long long bm = __ballot(choice == m1);
            const unsigned gm = (unsigned)(bm >> (lane & 56)) & 0xffu; const int first = __ffs(gm) - 1;
            const float m2 = red8_max(((lane & 7) == first) ? -INFINITY : choice);
            const float gs = m1 + m2;
            int rank = 0;
#pragma unroll
            for (int g2 = 0; g2 < 8; ++g2) { const float og = __shfl(gs, g2 * 8); rank += (og > gs || (og == gs && g2 < (lane >> 3))) ? 1 : 0; }
            float cm = rank < 4 ? choice : -INFINITY;
            unsigned long long sel = 0ull; float ssum = 0.f;
#pragma unroll
            for (int it = 0; it < 6; ++it) {
                const float mxv = wave_max(cm);
                const unsigned long long bmm = __ballot(cm == mxv);
                const int win = __ffsll((long long)bmm) - 1;
                sel |= 1ull << win; ssum += __shfl(score, win);
                if (lane == win) cm = -INFINITY;
            }
            if ((sel >> lane) & 1ull) {
                const int jj = __popcll(sel & ((1ull << lane) - 1ull));
                const int ch = tok / tc; const int rk = atomicAdd(&cnt[ch * 64 + lane], 1);
                tok_e[tok * 6 + jj] = lane; tok_r[tok * 6 + jj] = rk;
                ltok[((size_t)ch * 64 + lane) * tc + rk] = tok; lg[((size_t)ch * 64 + lane) * tc + rk] = 2.5f * score / ssum;
            }
        }
    }
}
struct SegTab { int* cnt; int* off; int* tpre; };
DEVI SegTab build_segtab(const Params& p, int layer, int tc, char* lds_tab) {
    SegTab T; T.cnt = (int*)lds_tab; T.off = T.cnt + 264; T.tpre = T.off + 264;
    const int* cnt = (const int*)(p.ws + OFF_CNT) + layer * NCHUNK * 64;
    const int tid = tidx();
    if (tid < 260) { const int ch = tid / 65, e = tid % 65; T.cnt[tid] = e < 64 ? cnt[ch * 64 + e] : tc; }
    __syncthreads();
    if (tid < 64) {
        int lc[5], lt_[5]; int sc = 0, st = 0;
#pragma unroll
        for (int j = 0; j < 5; ++j) { const int s = 5 * tid + j; const int v = s < 260 ? T.cnt[s] : 0; lc[j] = sc; lt_[j] = st; sc += v; st += (v + 127) >> 7; }
        int ic = sc, it = st;
        for (int o = 1; o < 64; o <<= 1) { const int a = __shfl_up(ic, o), b2 = __shfl_up(it, o); if (tid >= o) { ic += a; it += b2; } }
        const int bc = ic - sc, bt = it - st;
#pragma unroll
        for (int j = 0; j < 5; ++j) { const int s = 5 * tid + j; if (s <= 260) { T.tpre[s] = bt + lt_[j]; T.off[s] = bc + lc[j]; } }
    }
    __syncthreads();
    return T;
}
DEVI int find_seg(const SegTab& T, int lo_seg, int hi_seg, int mt) {
    int lo = lo_seg, hi = hi_seg;
    while (hi - lo > 1) { const int mid = (lo + hi) >> 1; if (T.tpre[mid] <= mt) lo = mid; else hi = mid; }
    return lo;
}
DEVI void phase_moe_gemm1(const Params& p, int layer, char* lds) {
    const int ntok = layer == 0 ? T0 : TL; const int tc = ntok / NCHUNK;
    char* tabmem = lds + 110592; SegTab T = build_segtab(p, layer, tc, tabmem);
    const u16* n1 = (const u16*)(p.ws + M_N1); u16* act = (u16*)(p.ws + M_ACT);
    const int* ltok = (const int*)(p.ws + OFF_LTOK); const float* lg = (const float*)(p.ws + OFF_LG);
    const int nunits = T.tpre[260] * 2;
    for (int u = blockIdx.x; u < nunits; u += gridDim.x) {
        const int mt = u >> 1, nt = u & 1; const int seg = find_seg(T, 0, 260, mt); const int ch = seg / 65, e = seg % 65;
        const int cntv = T.cnt[seg], row0 = (mt - T.tpre[seg]) * 128; const int n0 = nt * 256;
        const int* lt = ltok + ((size_t)ch * 64 + e) * tc; const float* lgp = lg + ((size_t)ch * 64 + e) * tc;
        const u16* W = e < 64 ? (const u16*)(p.ws + OFF_WGU) + (size_t)e * 512 * 1024 : (const u16*)(p.ws + W_SGU) + (size_t)layer * 512 * 1024;
        auto arow = [&](int r) { int s = row0 + r; if (s >= cntv) s = cntv - 1; const int tok = e < 64 ? lt[s] : ch * tc + s; return n1 + (size_t)tok * DM; };
        const size_t arow0 = (size_t)ch * 7 * tc + (T.off[seg] - T.off[ch * 65]) + row0;
        auto xf = [&](int r, int cw, f32x16 (&t)[2], int h) {
            int s2 = row0 + r; if (s2 >= cntv) s2 = cntv - 1;
            const float gw = e < 64 ? lgp[s2] : 1.f;
#pragma unroll
            for (int i = 0; i < 16; ++i) { const float gt = t[0][i], up = t[1][i]; t[0][i] = gt / (1.f + __expf(-gt)) * up * gw; }
        };
        auto st = [&](int r, int c8, u32x4 v) {
            if (row0 + r >= cntv || (c8 & 32)) return;
            *(u32x4*)(act + (arow0 + r) * 256 + ((n0 + (c8 & ~63)) >> 1) + (c8 & 31)) = v;
        };
        gemm_tile<128, 256, false>(arow, W + (size_t)n0 * DM, DM, DM, xf, st, lds);
    }
}
DEVI void phase_moe_gemm2(const Params& p, int layer, int ch, char* lds) {
    const int ntok = layer == 0 ? T0 : TL; const int tc = ntok / NCHUNK;
    char* tabmem = lds + 110592; SegTab T = build_segtab(p, layer, tc, tabmem);
    const u16* act = (const u16*)(p.ws + M_ACT); u16* outr = (u16*)(p.ws + M_OUTR);
    const int t_lo = T.tpre[ch * 65], t_hi = T.tpre[ch * 65 + 65];
    const int nunits = (t_hi - t_lo) * 4;
    for (int u = blockIdx.x; u < nunits; u += gridDim.x) {
        const int mt = t_lo + (u >> 2), nt = u & 3; const int seg = find_seg(T, ch * 65, ch * 65 + 65, mt); const int e = seg % 65;
        const int cntv = T.cnt[seg], row0 = (mt - T.tpre[seg]) * 128; const int n0 = nt * 256;
        const size_t lrow0 = (size_t)(T.off[seg] - T.off[ch * 65]) + row0;
        const u16* A = act + ((size_t)ch * 7 * tc + lrow0) * 256;
        const u16* W = e < 64 ? (const u16*)(p.ws + OFF_WD) + (size_t)e * 1024 * 256 : (const u16*)(p.ws + W_SD) + (size_t)layer * 1024 * 256;
        auto arow = [&](int r) { int s = row0 + r; if (s >= cntv) s = cntv - 1; return A + (size_t)(s - row0) * 256; };
        auto xf = [&](int, int, f32x16 (&)[2], int) {};
        auto st = [&](int r, int c8, u32x4 v) { if (row0 + r < cntv) *(u32x4*)(outr + (lrow0 + r) * DM + n0 + c8) = v; };
        gemm_tile<128, 256, false>(arow, W + (size_t)n0 * 256, 256, 256, xf, st, lds);
    }
}
DEVI void phase_moe_combine(const Params& p, int layer, int ch, char* lds) {
    const int mode = layer == 0 ? 0 : 1; const int ntok = layer == 0 ? T0 : TL; const int tc = ntok / NCHUNK;
    SegTab T = build_segtab(p, layer, tc, lds);
    const u16* outr = (const u16*)(p.ws + M_OUTR); const int* tok_e = (const int*)(p.ws + OFF_TOKE); const int* tok_r = (const int*)(p.ws + OFF_TOKR);
    float* XC = (float*)(p.ws + OFF_XC); float* XL = p.out;
    const float* mods_l = (const float*)(p.ws + OFF_MODS) + (size_t)layer * 9 * 6144;
    const int lane = tidx() & 63, w = tidx() >> 6;
    for (int tl = blockIdx.x * 8 + w; tl < tc; tl += gridDim.x * 8) {
        const int tok = ch * tc + tl; int bb; float* xr = row_ptr_w(XC, XL, mode, tok, bb);
        const float* mg = mods_l + (size_t)bb * 6144 + 5 * 1024;
        int rows[7];
#pragma unroll
        for (int j = 0; j < 6; ++j) rows[j] = T.off[ch * 65 + tok_e[tok * 6 + j]] - T.off[ch * 65] + tok_r[tok * 6 + j];
        rows[6] = 6 * tc + tl;
#pragma unroll
        for (int i = 0; i < 2; ++i) {
            const int c = (lane + 64 * i) * 8;
            float acc[8];
#pragma unroll
            for (int q = 0; q < 8; ++q) acc[q] = 0.f;
#pragma unroll
            for (int j = 0; j < 7; ++j) {
                const uint4 v = *(const uint4*)(outr + (size_t)rows[j] * DM + c);
                acc[0] += bf_lo(v.x); acc[1] += bf_hi(v.x); acc[2] += bf_lo(v.y); acc[3] += bf_hi(v.y); acc[4] += bf_lo(v.z); acc[5] += bf_hi(v.z); acc[6] += bf_lo(v.w); acc[7] += bf_hi(v.w);
            }
            float4 x0 = *(float4*)(xr + c), x1 = *(float4*)(xr + c + 4); const float4 g0 = *(const float4*)(mg + c), g1 = *(const float4*)(mg + c + 4);
            x0.x += g0.x * acc[0]; x0.y += g0.y * acc[1]; x0.z += g0.z * acc[2]; x0.w += g0.w * acc[3]; x1.x += g1.x * acc[4]; x1.y += g1.y * acc[5]; x1.z += g1.z * acc[6]; x1.w += g1.w * acc[7];
            *(float4*)(xr + c) = x0; *(float4*)(xr + c + 4) = x1;
        }
    }
}

DEVI void phase_rwkv_mix(const Params& p, int i0, int i1, int i2) {
    const u16* nn = (const u16*)(p.ws + R_NN); u16* xm = (u16*)(p.ws + R_XM0);
    const float* mu = p.in[I_RMU]; const int idx[3] = {i0, i1, i2};
    const int lane = tidx() & 63, w = tidx() >> 6;
    for (int r = blockIdx.x * 8 + w; r < T0; r += gridDim.x * 8) {
        const int b = r / LT, pp = r - b * LT;
        const bool hasprev = (pp != 0) && (pp != LC), hasnext = (pp != LC - 1) && (pp != LT - 1);
#pragma unroll
        for (int half = 0; half < 2; ++half) {
            const int c = half * 512 + lane * 8;
            const uint4 cur = *(const uint4*)(nn + (size_t)r * DM + c);
            uint4 sh = make_uint4(0, 0, 0, 0);
            if (half == 0) { if (hasprev) sh = *(const uint4*)(nn + (size_t)(r - 1) * DM + c); }
            else { if (hasnext) sh = *(const uint4*)(nn + (size_t)(r + 1) * DM + c); }
            float nv[8], xx[8];
            nv[0] = bf_lo(cur.x); nv[1] = bf_hi(cur.x); nv[2] = bf_lo(cur.y); nv[3] = bf_hi(cur.y); nv[4] = bf_lo(cur.z); nv[5] = bf_hi(cur.z); nv[6] = bf_lo(cur.w); nv[7] = bf_hi(cur.w);
            xx[0] = bf_lo(sh.x) - nv[0]; xx[1] = bf_hi(sh.x) - nv[1]; xx[2] = bf_lo(sh.y) - nv[2]; xx[3] = bf_hi(sh.y) - nv[3]; xx[4] = bf_lo(sh.z) - nv[4]; xx[5] = bf_hi(sh.z) - nv[5]; xx[6] = bf_lo(sh.w) - nv[6]; xx[7] = bf_hi(sh.w) - nv[7];
#pragma unroll
            for (int j = 0; j < 3; ++j) {
                const float4 m0 = *(const float4*)(mu + idx[j] * 1024 + c), m1 = *(const float4*)(mu + idx[j] * 1024 + c + 4);
                uint4 o; o.x = pack2(nv[0] + xx[0] * m0.x, nv[1] + xx[1] * m0.y); o.y = pack2(nv[2] + xx[2] * m0.z, nv[3] + xx[3] * m0.w);
                o.z = pack2(nv[4] + xx[4] * m1.x, nv[5] + xx[5] * m1.y); o.w = pack2(nv[6] + xx[6] * m1.z, nv[7] + xx[7] * m1.w);
                *(uint4*)(xm + (size_t)j * T0 * DM + (size_t)r * DM + c) = o;
            }
        }
    }
}
DEVI void phase_rwkv_gemm_rkv(const Params& p, char* lds) {
    const int MT = T0 / 256;
    for (int u = blockIdx.x; u < 3 * 8 * MT; u += gridDim.x) {
        const int j = u / (8 * MT), v = u % (8 * MT); const int mt = v >> 3, nt = v & 7; const int m0 = mt * 256, n0 = nt * 128;
        const u16* A = (const u16*)(p.ws + R_XM0) + (size_t)j * T0 * DM; const u16* W = (const u16*)(p.ws + W_RR) + (size_t)j * DM * DM; u16* O = (u16*)(p.ws + R_RR) + (size_t)j * T0 * DM;
        auto arow = [&](int r) { return A + (size_t)(m0 + r) * DM; };
        auto xf = [&](int, int, f32x16 (&)[2], int) {};
        auto st = [&](int r, int c8, u32x4 v) { *(u32x4*)(O + (size_t)(m0 + r) * DM + n0 + c8) = v; };
        gemm_tile<256, 128, false>(arow, W + (size_t)n0 * DM, DM, DM, xf, st, lds);
    }
}
DEVI void phase_rwkv_gemm_small(const Params& p, char* lds) {
    const int MT = T0 / 256;
    for (int u = blockIdx.x; u < 3 * MT; u += gridDim.x) {
        const int j = u / MT, mt = u % MT; const int m0 = mt * 256;
        const u16* A = (const u16*)(p.ws + R_XM0) + (size_t)j * T0 * DM;
        const u16* W = (const u16*)(p.ws + (j == 0 ? W_W1 : j == 1 ? W_A1 : W_G1)); u16* O = (u16*)(p.ws + (j == 0 ? R_HW : j == 1 ? R_HA : R_HG));
        auto arow = [&](int r) { return A + (size_t)(m0 + r) * DM; };
        auto xf = [&](int, int, f32x16 (&t)[2], int) {
#pragma unroll
            for (int ni = 0; ni < 2; ++ni)
#pragma unroll
                for (int i = 0; i < 16; ++i) { const float x = t[ni][i]; t[ni][i] = j == 0 ? tanhf_(x) : j == 1 ? x : sigmoidf_(x); }
        };
        auto st = [&](int r, int c8, u32x4 v) { *(u32x4*)(O + (size_t)(m0 + r) * 128 + c8) = v; };
        gemm_tile<256, 128, false>(arow, W, DM, DM, xf, st, lds);
    }
}
DEVI void phase_rwkv_gemm_g(const Params& p, char* lds) {
    const int MT = T0 / 256; const u16* A = (const u16*)(p.ws + R_HG); const u16* W = (const u16*)(p.ws + W_G2); u16* O = (u16*)(p.ws + R_GG);
    for (int u = blockIdx.x; u < 8 * MT; u += gridDim.x) {
        const int mt = u >> 3, nt = u & 7; const int m0 = mt * 256, n0 = nt * 128;
        auto arow = [&](int r) { return A + (size_t)(m0 + r) * 128; };
        auto xf = [&](int, int, f32x16 (&)[2], int) {};
        auto st = [&](int r, int c8, u32x4 v) { *(u32x4*)(O + (size_t)(m0 + r) * DM + n0 + c8) = v; };
        gemm_tile<256, 128, false>(arow, W + (size_t)n0 * 128, 128, 128, xf, st, lds);
    }
}
DEVI float red16_sum(float x) { x += dppf(x, 0); x += dppf(x, 1); x += dppf(x, 2); int xi = __builtin_bit_cast(int, x); x += __builtin_bit_cast(float, __builtin_amdgcn_mov_dpp(xi, 0x140, 0xF, 0xF, true)); return x; }
DEVI bf16x8 frag_perm(const u16* rowp, int ks, int h) {
    const uint2 lo = *(const uint2*)(rowp + 16 * ks + 4 * h), hi = *(const uint2*)(rowp + 16 * ks + 8 + 4 * h);
    u32x4 v = {lo.x, lo.y, hi.x, hi.y}; return __builtin_bit_cast(bf16x8, v);
}
DEVI bf16x8 tr_frag(const u16* base, int stride, int lane) {
    const u16* q = base + (4 * (lane >> 5) + ((lane & 15) >> 2)) * stride + 16 * ((lane >> 4) & 1) + 4 * (lane & 3);
    const s16x4 lo = __builtin_amdgcn_ds_read_tr16_b64_v4i16((LAS s16x4*)q), hi = __builtin_amdgcn_ds_read_tr16_b64_v4i16((LAS s16x4*)(q + 8 * stride));
    bf16x8 v; v[0] = lo[0]; v[1] = lo[1]; v[2] = lo[2]; v[3] = lo[3]; v[4] = hi[0]; v[5] = hi[1]; v[6] = hi[2]; v[7] = hi[3]; return v;
}
DEVI bf16x8 frag_plain(const u16* rowp, int ks, int h) { return *(const bf16x8*)(rowp + 16 * ks + 8 * h); }
DEVI bf16x8 acc_to_b(const f32x16& t, int s) {
    u32x4 v = {pack2(t[8 * s], t[8 * s + 1]), pack2(t[8 * s + 2], t[8 * s + 3]), pack2(t[8 * s + 4], t[8 * s + 5]), pack2(t[8 * s + 6], t[8 * s + 7])};
    return __builtin_bit_cast(bf16x8, v);
}
#define MFMA(a, b, c) __builtin_amdgcn_mfma_f32_32x32x16_bf16(a, b, c, 0, 0, 0)
DEVI void phase_rwkv_scan(const Params& p, char* lds) {
    float* LW = (float*)lds; float* AA = LW + 2048; float* CP = AA + 2048;
    u16* At = (u16*)(lds + 24576); u16* Bt = At + 2304; u16* Kt = Bt + 2304; u16* Rt = Kt + 2304;
    u16* Vr = (u16*)(lds + 43008); u16* Khr = Vr + 3072; u16* Bhr = Khr + 3072;
    float* Lf = (float*)(lds + 61440);
    u16* Lo = (u16*)(lds + 66048); u16* Lak = Lo + 1280; u16* Mrb = Lak + 1280; u16* Mrk = Mrb + 1280; u16* Td = Mrk + 1280;
    float* PC = (float*)(lds + 78848); u16* YS = (u16*)(lds + 79104);
    const u16* r_g = (const u16*)(p.ws + R_RR); const u16* k_g = (const u16*)(p.ws + R_RK); const u16* v_g = (const u16*)(p.ws + R_RV);
    const u16* hw = (const u16*)(p.ws + R_HW); const u16* ha = (const u16*)(p.ws + R_HA);
    const int tid = tidx(), lane = tid & 63, w = tid >> 6, l31 = lane & 31, hh = lane >> 5;
    for (int u = blockIdx.x; u < 256; u += gridDim.x) {
        const int dir = u & 1, hd = (u >> 1) & 15, b = u >> 5;
        u16* y_g = (u16*)(p.ws + (dir ? R_YB : R_YF)); float* rkb = (float*)(p.ws + R_RKB) + (size_t)dir * T0 * 16;
        const int mat = (w >> 1) & 1, ctt = w & 1;
        u16* W2L = (u16*)(lds + 86016);
        float* KC = (float*)(lds + 86016 + 18432);
        for (int i = tid; i < 2 * 64 * 8; i += 512) { const int m = i >> 9, c = (i >> 3) & 63, ch = i & 7;
            *(u32x4*)(W2L + (m * 64 + c) * 72 + ch * 8) = *(const u32x4*)((const u16*)(p.ws + (m ? W_A2 : W_W2)) + (size_t)dir * 1024 * 64 + (size_t)(hd * 64 + c) * 64 + ch * 8); }
        if (tid < 64) { KC[tid] = p.in[I_RKK][hd * 64 + tid]; KC[64 + tid] = p.in[I_RKA][hd * 64 + tid]; KC[128 + tid] = p.in[I_RRK][hd * 64 + tid]; }
        const u16* w2l = W2L + (mat * 64 + ctt * 32 + l31) * 72;
        const float* bias0 = (mat ? p.in[I_RA0] : p.in[I_RW0]) + dir * 1024 + hd * 64 + ctt * 32;
        const u16* hsrc = mat ? ha : hw;
        const int t2 = tid >> 4, c4 = (tid & 15) * 4; const int cg = hd * 64 + c4;
        for (int i = tid; i < 1280; i += 512) Td[i] = 0;
        f32x16 Z[2];
#pragma unroll
        for (int a = 0; a < 2; ++a)
#pragma unroll
            for (int i = 0; i < 16; ++i) Z[a][i] = 0.f;
        __syncthreads();
        const size_t rowb = (size_t)b * LT;
        auto chunk_p0 = [&](int ci) { int pc; if (ci < 8) { pc = dir ? 7 - ci : ci; return 32 * pc; } pc = dir ? 135 - ci : ci - 8; return LC + 32 * pc; };
        bf16x8 hfr[4]; uint2 ru, ku, vu;
        {
            const int p0 = chunk_p0(0);
            const int pos = dir ? p0 + 31 - l31 : p0 + l31; const u16* hp = hsrc + (rowb + pos) * 128 + dir * 64;
#pragma unroll
            for (int ks = 0; ks < 4; ++ks) hfr[ks] = *(const bf16x8*)(hp + ks * 16 + hh * 8);
            const int pos2 = dir ? p0 + 31 - t2 : p0 + t2; const size_t go = (rowb + pos2) * DM + cg;
            ru = *(const uint2*)(r_g + go); ku = *(const uint2*)(k_g + go); vu = *(const uint2*)(v_g + go);
        }
        for (int ci = 0; ci < 136; ++ci) {
            const int p0 = chunk_p0(ci); const int p0n = chunk_p0(ci < 135 ? ci + 1 : ci);
            if (w < 4) {
                f32x16 acc;
#pragma unroll
                for (int i = 0; i < 16; ++i) acc[i] = 0.f;
#pragma unroll
                for (int ks = 0; ks < 4; ++ks) acc = MFMA(hfr[ks], frag_plain(w2l, ks, hh), acc);
                {
                    const int pos = dir ? p0n + 31 - l31 : p0n + l31; const u16* hp = hsrc + (rowb + pos) * 128 + dir * 64;
#pragma unroll
                    for (int ks = 0; ks < 4; ++ks) hfr[ks] = *(const bf16x8*)(hp + ks * 16 + hh * 8);
                }
                const float bv = bias0[l31];
                float* dstm = (mat ? AA : CP) + ctt * 32 + l31;
                if (mat) {
#pragma unroll
                    for (int i = 0; i < 16; ++i) dstm[((i & 3) + 8 * (i >> 2) + 4 * hh) * 64] = sigmoidf_(acc[i] + bv);
                } else {
                    f32x16 lo, cp;
#pragma unroll
                    for (int i = 0; i < 16; ++i) { const float lw = -0.6065306597126334f * sigmoidf_(acc[i] + bv); const float hi = bf1((u16)(pack2(lw, 0.f))); acc[i] = hi; lo[i] = lw - hi; cp[i] = 0.f; }
#pragma unroll
                    for (int ks = 0; ks < 2; ++ks) {
                        u32x4 tv;
#pragma unroll
                        for (int q = 0; q < 4; ++q) { const int ta = 16 * ks + 8 * (q >> 1) + 4 * hh + 2 * (q & 1); tv[q] = ((ta <= l31) ? 0x3F80u : 0u) | ((ta + 1 <= l31) ? 0x3F800000u : 0u); }
                        const bf16x8 tri = __builtin_bit_cast(bf16x8, tv);
                        cp = MFMA(tri, acc_to_b(acc, ks), cp); cp = MFMA(tri, acc_to_b(lo, ks), cp);
                    }
#pragma unroll
                    for (int i = 0; i < 16; ++i) dstm[((i & 3) + 8 * (i >> 2) + 4 * hh) * 64] = cp[i];
                }
            }
            const int pos2 = dir ? p0 + 31 - t2 : p0 + t2;
            lds_barrier();
            {
                const float rv[4] = {bf_lo(ru.x), bf_hi(ru.x), bf_lo(ru.y), bf_hi(ru.y)}, kv[4] = {bf_lo(ku.x), bf_hi(ku.x), bf_lo(ku.y), bf_hi(ku.y)};
                const float4 a4 = *(const float4*)(AA + t2 * 64 + c4), cp4 = *(const float4*)(CP + t2 * 64 + c4), ce4 = *(const float4*)(CP + 31 * 64 + c4);
                float4 cq4 = make_float4(0.f, 0.f, 0.f, 0.f); if (t2 > 0) cq4 = *(const float4*)(CP + (t2 - 1) * 64 + c4);
                const float av[4] = {a4.x, a4.y, a4.z, a4.w}, cpv[4] = {cp4.x, cp4.y, cp4.z, cp4.w}, cev[4] = {ce4.x, ce4.y, ce4.z, ce4.w}, cqv[4] = {cq4.x, cq4.y, cq4.z, cq4.w};
                const float4 kkc = *(const float4*)(KC + c4), kac = *(const float4*)(KC + 64 + c4), rkc = *(const float4*)(KC + 128 + c4);
                const float kkcv[4] = {kkc.x, kkc.y, kkc.z, kkc.w}, kacv[4] = {kac.x, kac.y, kac.z, kac.w}, rkcv[4] = {rkc.x, rkc.y, rkc.z, rkc.w};
                float kk[4], km[4], ssq = 0.f, rks = 0.f;
#pragma unroll
                for (int i = 0; i < 4; ++i) { kk[i] = kv[i] * kkcv[i]; ssq += kk[i] * kk[i]; km[i] = kv[i] * (1.f + (av[i] - 1.f) * kacv[i]); rks += rv[i] * km[i] * rkcv[i]; }
                ssq = red16_sum(ssq); rks = red16_sum(rks);
                const float inv = 1.f / fmaxf(sqrtf(ssq), 1e-12f);
                float at[4], bt[4], kt[4], rt[4], bh[4], kh[4];
#pragma unroll
                for (int i = 0; i < 4; ++i) {
                    const float kn = kk[i] * inv, bb = kn * av[i];
                    const float en = __expf(-cpv[i]), eh = __expf(cev[i] - cpv[i]);
                    at[i] = -kn * __expf(cqv[i]); bt[i] = bb * en; kt[i] = km[i] * en; rt[i] = rv[i] * __expf(cpv[i]); bh[i] = bb * eh; kh[i] = km[i] * eh;
                }
                uint2 o;
                o.x = pack2(at[0], at[1]); o.y = pack2(at[2], at[3]); *(uint2*)(At + t2 * 72 + c4) = o;
                o.x = pack2(bt[0], bt[1]); o.y = pack2(bt[2], bt[3]); *(uint2*)(Bt + t2 * 72 + c4) = o;
                o.x = pack2(kt[0], kt[1]); o.y = pack2(kt[2], kt[3]); *(uint2*)(Kt + t2 * 72 + c4) = o;
                o.x = pack2(rt[0], rt[1]); o.y = pack2(rt[2], rt[3]); *(uint2*)(Rt + t2 * 72 + c4) = o;
                o.x = pack2(kh[0], kh[1]); o.y = pack2(kh[2], kh[3]); *(uint2*)(Khr + t2 * 96 + c4) = o;
                o.x = pack2(bh[0], bh[1]); o.y = pack2(bh[2], bh[3]); *(uint2*)(Bhr + t2 * 96 + c4) = o;
                *(uint2*)(Vr + t2 * 96 + c4) = vu;
                if (t2 == 0) *(float4*)(PC + c4) = make_float4(__expf(cev[0]), __expf(cev[1]), __expf(cev[2]), __expf(cev[3]));
                if ((tid & 15) == 0) rkb[(rowb + pos2) * 16 + hd] = rks;
                const int pos2n = dir ? p0n + 31 - t2 : p0n + t2; const size_t gon = (rowb + pos2n) * DM + cg;
                ru = *(const uint2*)(r_g + gon); ku = *(const uint2*)(k_g + gon); vu = *(const uint2*)(v_g + gon);
            }
            lds_barrier();
            if (w < 4) {
                const u16* X1 = (w < 2) ? At : Rt; const u16* X2 = (w & 1) ? Kt : Bt;
                f32x16 acc;
#pragma unroll
                for (int i = 0; i < 16; ++i) acc[i] = 0.f;
#pragma unroll
                for (int ks = 0; ks < 4; ++ks) acc = MFMA(frag_plain(X2 + l31 * 72, ks, hh), frag_plain(X1 + l31 * 72, ks, hh), acc);
#pragma unroll
                for (int i = 0; i < 16; ++i) { const int s = (i & 3) + 8 * (i >> 2) + 4 * hh; const bool keep = (w < 2) ? (s < l31) : (s <= l31); if (!keep) acc[i] = 0.f; }
                if (w == 0) {
#pragma unroll
                    for (int g = 0; g < 4; ++g) {
                        *(float4*)(Lf + l31 * 36 + 8 * g + 4 * hh) = make_float4(acc[4 * g], acc[4 * g + 1], acc[4 * g + 2], acc[4 * g + 3]);
                        const bool lo = (l31 >= 16) && (8 * g + 4 * hh < 16);
                        uint2 o; o.x = lo ? pack2(acc[4 * g], acc[4 * g + 1]) : 0u; o.y = lo ? pack2(acc[4 * g + 2], acc[4 * g + 3]) : 0u; *(uint2*)(Lo + l31 * 40 + 8 * g + 4 * hh) = o;
                    }
                } else {
                    u16* dst = (w == 1) ? Lak : (w == 2) ? Mrb : Mrk;
#pragma unroll
                    for (int g = 0; g < 4; ++g) { uint2 o; o.x = pack2(acc[4 * g], acc[4 * g + 1]); o.y = pack2(acc[4 * g + 2], acc[4 * g + 3]); *(uint2*)(dst + l31 * 40 + 8 * g + 4 * hh) = o; }
                }
            }
            lds_barrier();
            f32x16 XZ, Ya; bf16x8 zf[4];
            if (w >= 6) {
                const int blk = w - 6, j = lane & 15; const float* Lb = Lf + (16 * blk) * 36 + 16 * blk;
                const float4 l4 = *(const float4*)(Lb + (lane >> 2) * 36 + 4 * (lane & 3));
                const int li[4] = {__builtin_bit_cast(int, l4.x), __builtin_bit_cast(int, l4.y), __builtin_bit_cast(int, l4.z), __builtin_bit_cast(int, l4.w)};
                float x[16];
#pragma unroll
                for (int t = 0; t < 16; ++t) {
                    float a0 = (j == t) ? 1.f : 0.f, a1 = 0.f;
#pragma unroll
                    for (int s2 = 0; s2 < t; ++s2) {
                        const float lv = __builtin_bit_cast(float, __builtin_amdgcn_readlane(li[s2 & 3], 4 * t + (s2 >> 2)));
                        if (s2 & 1) a1 += lv * x[s2]; else a0 += lv * x[s2];
                    }
                    x[t] = a0 + a1;
                }
                if (lane < 16) {
#pragma unroll
                    for (int t = 0; t < 16; ++t) Td[(16 * blk + t) * 40 + 16 * blk + j] = (u16)(pack2(x[t], 0.f));
                }
            } else if (w < 2) {
#pragma unroll
                for (int s = 0; s < 4; ++s) zf[s] = acc_to_b(Z[s >> 1], s & 1);
#pragma unroll
                for (int i = 0; i < 16; ++i) { XZ[i] = 0.f; Ya[i] = 0.f; }
#pragma unroll
                for (int s = 0; s < 4; ++s) { XZ = MFMA(frag_perm(At + l31 * 72, s, hh), zf[s], XZ); Ya = MFMA(frag_perm(Rt + l31 * 72, s, hh), zf[s], Ya); }
                bf16x8 vf[2];
#pragma unroll
                for (int ks = 0; ks < 2; ++ks) {
                    vf[ks] = tr_frag(Vr + (16 * ks) * 96 + 32 * w, 96, lane);
                    XZ = MFMA(frag_perm(Lak + l31 * 40, ks, hh), vf[ks], XZ); Ya = MFMA(frag_perm(Mrk + l31 * 40, ks, hh), vf[ks], Ya);
                }
#pragma unroll
                for (int kt = 0; kt < 2; ++kt) {
#pragma unroll
                    for (int g = 0; g < 4; ++g) { const float4 pc4 = *(const float4*)(PC + 32 * kt + 8 * g + 4 * hh);
                        Z[kt][4 * g] *= pc4.x; Z[kt][4 * g + 1] *= pc4.y; Z[kt][4 * g + 2] *= pc4.z; Z[kt][4 * g + 3] *= pc4.w; }
#pragma unroll
                    for (int ks = 0; ks < 2; ++ks) Z[kt] = MFMA(tr_frag(Khr + (16 * ks) * 96 + 32 * kt, 96, lane), vf[ks], Z[kt]);
                }
            }
            lds_barrier();
            if (w < 2) {
                f32x16 U1 = {}, W = {};
#pragma unroll
                for (int i = 0; i < 16; ++i) { U1[i] = 0.f; W[i] = 0.f; }
#pragma unroll
                for (int ks = 0; ks < 2; ++ks) U1 = MFMA(frag_perm(Td + l31 * 40, ks, hh), acc_to_b(XZ, ks), U1);
#pragma unroll
                for (int ks = 0; ks < 2; ++ks) W = MFMA(frag_perm(Lo + l31 * 40, ks, hh), acc_to_b(U1, ks), W);
#pragma unroll
                for (int ks = 0; ks < 2; ++ks) U1 = MFMA(frag_perm(Td + l31 * 40, ks, hh), acc_to_b(W, ks), U1);
                const bf16x8 uf0 = acc_to_b(U1, 0), uf1 = acc_to_b(U1, 1);
                Ya = MFMA(frag_perm(Mrb + l31 * 40, 0, hh), uf0, Ya); Ya = MFMA(frag_perm(Mrb + l31 * 40, 1, hh), uf1, Ya);
#pragma unroll
                for (int kt = 0; kt < 2; ++kt) { Z[kt] = MFMA(tr_frag(Bhr + 32 * kt, 96, lane), uf0, Z[kt]); Z[kt] = MFMA(tr_frag(Bhr + 16 * 96 + 32 * kt, 96, lane), uf1, Z[kt]); }
#pragma unroll
                for (int i = 0; i < 16; ++i) { const int t = (i & 3) + 8 * (i >> 2) + 4 * hh; YS[t * 72 + 32 * w + l31] = (u16)pack2(Ya[i], 0.f); }
            }
            lds_barrier();
            if (ci >= 8) { const uint2 yv = *(const uint2*)(YS + t2 * 72 + c4); *(uint2*)(y_g + (rowb + pos2) * DM + cg) = yv; }
        }
        __syncthreads();
    }
}
DEVI void phase_rwkv_readout(const Params& p) {
    const u16* yf = (const u16*)(p.ws + R_YF); const u16* yb = (const u16*)(p.ws + R_YB); const u16* vg = (const u16*)(p.ws + R_RV); const u16* gg = (const u16*)(p.ws + R_GG);
    const float* rkb = (const float*)(p.ws + R_RKB); u16* rd = (u16*)(p.ws + R_RD);
    const float* lnw = p.in[I_RLNW]; const float* lnb = p.in[I_RLNB];
    const int lane = tidx() & 63, w = tidx() >> 6;
    for (int t = blockIdx.x * 8 + w; t < TL; t += gridDim.x * 8) {
        const int b = t >> 12, s = t & 4095; const size_t row = (size_t)b * LT + LC + s; const int c = lane * 16; const int hd = lane >> 2;
        float y[16], vv[16], gv[16];
#pragma unroll
        for (int q = 0; q < 2; ++q) {
            const uint4 a = *(const uint4*)(yf + row * DM + c + 8 * q), bq = *(const uint4*)(yb + row * DM + c + 8 * q), v4 = *(const uint4*)(vg + row * DM + c + 8 * q), g4 = *(const uint4*)(gg + row * DM + c + 8 * q);
            y[8 * q + 0] = bf_lo(a.x) + bf_lo(bq.x); y[8 * q + 1] = bf_hi(a.x) + bf_hi(bq.x); y[8 * q + 2] = bf_lo(a.y) + bf_lo(bq.y); y[8 * q + 3] = bf_hi(a.y) + bf_hi(bq.y);
            y[8 * q + 4] = bf_lo(a.z) + bf_lo(bq.z); y[8 * q + 5] = bf_hi(a.z) + bf_hi(bq.z); y[8 * q + 6] = bf_lo(a.w) + bf_lo(bq.w); y[8 * q + 7] = bf_hi(a.w) + bf_hi(bq.w);
            vv[8 * q + 0] = bf_lo(v4.x); vv[8 * q + 1] = bf_hi(v4.x); vv[8 * q + 2] = bf_lo(v4.y); vv[8 * q + 3] = bf_hi(v4.y); vv[8 * q + 4] = bf_lo(v4.z); vv[8 * q + 5] = bf_hi(v4.z); vv[8 * q + 6] = bf_lo(v4.w); vv[8 * q + 7] = bf_hi(v4.w);
            gv[8 * q + 0] = bf_lo(g4.x); gv[8 * q + 1] = bf_hi(g4.x); gv[8 * q + 2] = bf_lo(g4.y); gv[8 * q + 3] = bf_hi(g4.y); gv[8 * q + 4] = bf_lo(g4.z); gv[8 * q + 5] = bf_hi(g4.z); gv[8 * q + 6] = bf_lo(g4.w); gv[8 * q + 7] = bf_hi(g4.w);
        }
        float sm = 0.f;
#pragma unroll
        for (int i = 0; i < 16; ++i) sm += y[i];
        sm = red4_sum(sm); const float mean = sm * (1.f / 64.f);
        float vs = 0.f;
#pragma unroll
        for (int i = 0; i < 16; ++i) { const float d = y[i] - mean; vs += d * d; }
        vs = red4_sum(vs); const float rstd = rsqrtf(vs * (1.f / 64.f) + 64e-5f);
        const float bon = rkb[row * 16 + hd] + rkb[(size_t)T0 * 16 + row * 16 + hd];
        unsigned ow[8];
#pragma unroll
        for (int i = 0; i < 8; ++i) {
            const int c0 = c + 2 * i;
            const float o0 = ((y[2 * i] - mean) * rstd * lnw[c0] + lnb[c0] + bon * vv[2 * i]) * gv[2 * i];
            const float o1 = ((y[2 * i + 1] - mean) * rstd * lnw[c0 + 1] + lnb[c0 + 1] + bon * vv[2 * i + 1]) * gv[2 * i + 1];
            ow[i] = pack2(o0, o1);
        }
        *(uint4*)(rd + (size_t)t * DM + c) = make_uint4(ow[0], ow[1], ow[2], ow[3]); *(uint4*)(rd + (size_t)t * DM + c + 8) = make_uint4(ow[4], ow[5], ow[6], ow[7]);
    }
}
DEVI void phase_final_norm(const Params& p) {
    const float* g = p.in[I_NFIN]; float* X = p.out;
    const int lane = tidx() & 63, w = tidx() >> 6;
    for (int r = blockIdx.x * 8 + w; r < TL; r += gridDim.x * 8) {
        float4* xr = (float4*)(X + (size_t)r * DM); float4 v[4]; float ss = 0.f;
#pragma unroll
        for (int i = 0; i < 4; ++i) { v[i] = xr[lane + 64 * i]; ss += v[i].x * v[i].x + v[i].y * v[i].y + v[i].z * v[i].z + v[i].w * v[i].w; }
        ss = wave_sum(ss); const float rs = rsqrtf(ss * (1.f / 1024.f) + 1e-6f);
#pragma unroll
        for (int i = 0; i < 4; ++i) { const float4 gg = ((const float4*)g)[lane + 64 * i]; float4 o; o.x = v[i].x * rs * gg.x; o.y = v[i].y * rs * gg.y; o.z = v[i].z * rs * gg.z; o.w = v[i].w * rs * gg.w; xr[lane + 64 * i] = o; }
    }
}

constexpr int N_PHASES = 36;
template <int PH> DEVI void run_phase(const Params& p, char* lds) {
    const float* mods = (const float*)(p.ws + OFF_MODS);
    RowSrc in_src; in_src.ctx = p.in[I_CTX]; in_src.lat = p.in[I_X];
    RowSrc x_src; x_src.ctx = (const float*)(p.ws + OFF_XC); x_src.lat = p.out;
    if constexpr (PH == 0) phase_prologue(p, lds);
    else if constexpr (PH == 1) norm_rows(in_src, 0, T0, p.in[I_NMIX], mods, 0, 1, (u16*)(p.ws + A_N0));
    else if constexpr (PH == 2) phase_gemm_win(p, lds);
    else if constexpr (PH == 3) phase_gemm_qkv(p, lds);
    else if constexpr (PH == 4) { phase_attention(p, lds); conv_jobs(p, 25, 28, 0, 0, lds); }
    else if constexpr (PH == 5) phase_gemm_wo(p, (const u16*)(p.ws + A_N0), (const u16*)(p.ws + W_OA), in_src, 0, 0, lds);
    else if constexpr (PH == 6) phase_moe_route(p, 0, lds);
    else if constexpr (PH == 7) phase_moe_gemm1(p, 0, lds);
    else if constexpr (PH >= 8 && PH < 16) { if constexpr ((PH & 1) == 0) phase_moe_gemm2(p, 0, (PH - 8) >> 1, lds); else phase_moe_combine(p, 0, (PH - 8) >> 1, lds); }
    else if constexpr (PH == 16) norm_rows(x_src, 0, T0, p.in[I_NMIX] + 1024, mods + 9 * 6144, 0, 1, (u16*)(p.ws + R_NN));
    else if constexpr (PH == 17) phase_rwkv_mix(p, 0, 2, 3);
    else if constexpr (PH == 18) phase_rwkv_gemm_rkv(p, lds);
    else if constexpr (PH == 19) phase_rwkv_mix(p, 1, 4, 5);
    else if constexpr (PH == 20) phase_rwkv_gemm_small(p, lds);
    else if constexpr (PH == 21) phase_rwkv_gemm_g(p, lds);
    else if constexpr (PH == 22) phase_rwkv_scan(p, lds);
    else if constexpr (PH == 23) phase_rwkv_readout(p);
    else if constexpr (PH == 24) { phase_gemm_wo(p, (const u16*)(p.ws + R_RD), (const u16*)(p.ws + W_RO), x_src, 1, 1, lds); conv_jobs(p, 25, 28, 1, 0, lds); }
    else if constexpr (PH == 25) phase_moe_route(p, 1, lds);
    else if constexpr (PH == 26) phase_moe_gemm1(p, 1, lds);
    else if constexpr (PH >= 27 && PH < 35) { if constexpr (((PH - 27) & 1) == 0) phase_moe_gemm2(p, 1, (PH - 27) >> 1, lds); else phase_moe_combine(p, 1, (PH - 27) >> 1, lds); }
    else if constexpr (PH == 35) phase_final_norm(p);
}

#if MEGA
template <int PH, int END> DEVI void run_range(const Params& p_, char* lds, const XcdBarrier& bar) {
    const Params& p = *(const Params*)__builtin_amdgcn_kernarg_segment_ptr();
    run_phase<PH>(p, lds);
    if constexpr (PH + 1 < END) { xcd_barrier(bar); run_range<PH + 1, END>(p_, lds, bar); }
}
template <int A, int B> __global__ void __launch_bounds__(512, 2) k_range(Params p, unsigned* barw) {
    extern __shared__ __attribute__((aligned(16))) char smem[];
    if (threadIdx.x == 0) *(uint4*)smem = make_uint4(0u, 0u, 0u, 0u);
    __syncthreads();
    const XcdBarrier bar = xcd_barrier_post(barw, (volatile LAS unsigned*)smem);
    run_range<A, B>(p, smem + 64, bar);
}
template <int A, int B> static void launch_range(const Params& p, unsigned* barw, hipStream_t s) {
    static int grid = 0;
    if (!grid) {
        int dev = 0, cus = 0, per_cu = 0;
        (void)hipGetDevice(&dev);
        (void)hipDeviceGetAttribute(&cus, hipDeviceAttributeMultiprocessorCount, dev);
        (void)hipFuncSetAttribute((const void*)k_range<A, B>, hipFuncAttributeMaxDynamicSharedMemorySize, LDS_BYTES);
        (void)hipOccupancyMaxActiveBlocksPerMultiprocessor(&per_cu, (const void*)k_range<A, B>, 512, LDS_BYTES);
        if (per_cu < 1) fprintf(stderr, "occupancy query says 0 blocks per CU\n");
        grid = cus;
    }
    k_range<A, B><<<grid, 512, LDS_BYTES, s>>>(p, barw);
}
extern "C" void kernel_launch(void* const* d_in, const int* in_sizes, int n_in, void* d_out, int out_size, void* d_ws, size_t ws_size, hipStream_t stream) {
    Params p{};
    for (int i = 0; i < N_IN; ++i) p.in[i] = (const float*)d_in[i];
    p.out = (float*)d_out; p.ws = (char*)d_ws;
    if (ws_size < WS_NEED) { fprintf(stderr, "workspace too small\n"); return; }
    (void)hipMemsetAsync(p.ws + OFF_BAR, 0, XCD_BAR_WORDS * sizeof(unsigned), stream);
    launch_range<0, N_PHASES>(p, (unsigned*)(p.ws + OFF_BAR), stream);
}
#else
template <int PH> __global__ void __launch_bounds__(512, 2) k_phase(Params p) {
    extern __shared__ __attribute__((aligned(16))) char smem[];
    run_phase<PH>(p, smem + 64);
}
template <int PH> static void launch_phase(const Params& p, hipStream_t s) {
    static bool attr = false;
    if (!attr) { hipFuncSetAttribute((const void*)k_phase<PH>, hipFuncAttributeMaxDynamicSharedMemorySize, LDS_BYTES); attr = true; }
    k_phase<PH><<<256, 512, LDS_BYTES, s>>>(p);
}
template <int PH> static void launch_all(const Params& p, hipStream_t s) {
    launch_phase<PH>(p, s);
    if constexpr (PH + 1 < N_PHASES) launch_all<PH + 1>(p, s);
}

extern "C" void kernel_launch(void* const* d_in, const int* in_sizes, int n_in, void* d_out, int out_size, void* d_ws, size_t ws_size, hipStream_t stream) {
    Params p{};
    for (int i = 0; i < N_IN; ++i) p.in[i] = (const float*)d_in[i];
    p.out = (float*)d_out; p.ws = (char*)d_ws;
    if (ws_size < WS_NEED) { fprintf(stderr, "workspace too small: %zu < %zu\n", ws_size, (size_t)WS_NEED); return; }
    launch_all<0>(p, stream);
}
#endif
```

```cpp
#include <hip/hip_runtime.h>
#include <stdint.h>
#include <stdio.h>

#ifndef MEGA
#define MEGA 1
#endif

typedef unsigned short u16;
typedef short bf16x8 __attribute__((ext_vector_type(8)));
typedef short s16x4 __attribute__((ext_vector_type(4)));
typedef float f32x16 __attribute__((ext_vector_type(16)));
typedef float f32x4 __attribute__((ext_vector_type(4)));
typedef float f32x2 __attribute__((ext_vector_type(2)));
typedef unsigned u32x4 __attribute__((ext_vector_type(4)));
typedef __bf16 bf2 __attribute__((ext_vector_type(2)));
#define DEVI __device__ __forceinline__
#define LAS __attribute__((address_space(3)))
__device__ __forceinline__ int tidx() { int t = threadIdx.x; asm volatile("" : "+v"(t)); return t; }

constexpr int NB = 8, SEQ = 4096, LC = 256, LT = 4352, DM = 1024, T0 = NB * LT, TL = NB * SEQ;
constexpr int NCHUNK = 4;
constexpr float LOG2E = 1.4426950408889634f;
constexpr float QA_SCALE = 0.07216878364870322f * LOG2E;
constexpr float QS_SCALE = 0.125f * LOG2E;

enum { I_X = 0, I_C, I_CTX, I_CCTX, I_ADAW, I_ADAB, I_NMIX, I_NFFN, I_NFIN, I_AWIN, I_AQN, I_AKVN, I_AWUQ, I_AWUKV, I_ASINK, I_AWO,
       I_RMU, I_RWR, I_RWK, I_RWV, I_RWO, I_RG1, I_RG2, I_RW0, I_RW1, I_RW2, I_RA0, I_RA1, I_RA2, I_RKK, I_RKA, I_RRK, I_RLNW, I_RLNB,
       I_MROUT, I_MBIAS, I_MWG, I_MWU, I_MWD, I_MSG, I_MSU, I_MSD, N_IN };

struct Params { const float* in[N_IN]; float* out; char* ws; };

constexpr size_t OFF_BAR = 0, OFF_CNT = 16384, OFF_ROPE = 20480, OFF_MODS = 32768, OFF_WSTAT = 524288;
constexpr size_t W_IN = OFF_WSTAT, W_UQ = W_IN + 3145728, W_UK = W_UQ + 589824, W_UV = W_UK + 262144, W_OA = W_UV + 262144,
                 W_RR = W_OA + 2097152, W_RK = W_RR + 2097152, W_RV = W_RK + 2097152, W_RO = W_RV + 2097152,
                 W_G1 = W_RO + 2097152, W_W1 = W_G1 + 262144, W_A1 = W_W1 + 262144, W_G2 = W_A1 + 262144, W_W2 = W_G2 + 262144, W_A2 = W_W2 + 262144,
                 W_SGU = W_A2 + 262144, W_SD = W_SGU + 2 * 1048576, W_END = W_SD + 2 * 524288;
constexpr size_t OFF_XC = OFF_WSTAT + 20971520;
constexpr size_t OFF_TOKE = OFF_XC + 8388608, OFF_TOKR = OFF_TOKE + 835584, OFF_LTOK = OFF_TOKR + 835584, OFF_LG = OFF_LTOK + 8912896;
constexpr size_t OFF_WROUT = OFF_LG + 8912896;
constexpr size_t OFF_D = OFF_XC + 8388608 + 20971520;
static_assert(OFF_WROUT + 2 * 64 * 3072 * 2 <= OFF_D, "router weights overflow");
constexpr size_t WGU_BYTES = 64ull * 512 * 1024 * 2, WD_BYTES = 64ull * 1024 * 256 * 2;
constexpr size_t OFF_WGU = OFF_D, OFF_WD = OFF_D + WGU_BYTES;
constexpr size_t OFF_G = OFF_D + WGU_BYTES + WD_BYTES;
constexpr size_t SZ_T0D = (size_t)T0 * 1024 * 2;
constexpr size_t A_N0 = OFF_G, A_CQ = A_N0 + SZ_T0D, A_CKV = A_CQ + (size_t)T0 * 384 * 2, A_QA = A_CKV + (size_t)T0 * 256 * 2, A_KA = A_QA + (size_t)T0 * 768 * 2,
                 A_VA = A_KA + (size_t)T0 * 768 * 2, A_QS = A_VA + (size_t)T0 * 512 * 2, A_KS = A_QS + (size_t)T0 * 512 * 2, A_VS = A_KS + (size_t)T0 * 128 * 2, A_END = A_VS + (size_t)T0 * 128 * 2;
constexpr size_t M_N1 = OFF_G, M_ACT = M_N1 + SZ_T0D, M_OUTR = M_ACT + (size_t)7 * T0 * 256 * 2, SZ_OUTR = (size_t)7 * 8704 * 1024 * 2, M_END = M_OUTR + 2 * SZ_OUTR;
constexpr size_t R_XM0 = OFF_D, R_XM1 = R_XM0 + SZ_T0D, R_XM2 = R_XM1 + SZ_T0D, R_RR = R_XM2 + SZ_T0D, R_RK = R_RR + SZ_T0D, R_RV = R_RK + SZ_T0D, R_NN = R_RV + SZ_T0D,
                 R_HG = R_NN + SZ_T0D, R_HW = R_HG + (size_t)T0 * 128 * 2, R_HA = R_HW + (size_t)T0 * 128 * 2, R_RKB = R_HA + (size_t)T0 * 128 * 2, R_END = R_RKB + (size_t)2 * T0 * 16 * 4;
constexpr size_t R_GG = R_XM0, R_YF = R_XM1, R_YB = R_XM2, R_RD = R_NN;
constexpr size_t WS_NEED = R_END > M_END ? R_END : M_END;

constexpr int LDS_BYTES = 64 + 131072;

DEVI unsigned pack2(float a, float b) { f32x2 v = {a, b}; bf2 r = __builtin_convertvector(v, bf2); return __builtin_bit_cast(unsigned, r); }
DEVI float bf_lo(unsigned u) { return __builtin_bit_cast(float, u << 16); }
DEVI float bf_hi(unsigned u) { return __builtin_bit_cast(float, u & 0xffff0000u); }
DEVI float bf1(u16 u) { return __builtin_bit_cast(float, ((unsigned)u) << 16); }
DEVI float dppf(float x, const int ctrl_sel) {
    int xi = __builtin_bit_cast(int, x), y;
    if (ctrl_sel == 0) y = __builtin_amdgcn_mov_dpp(xi, 0xB1, 0xF, 0xF, true);
    else if (ctrl_sel == 1) y = __builtin_amdgcn_mov_dpp(xi, 0x4E, 0xF, 0xF, true);
    else y = __builtin_amdgcn_mov_dpp(xi, 0x141, 0xF, 0xF, true);
    return __builtin_bit_cast(float, y);
}
DEVI float red8_sum(float x) { x += dppf(x, 0); x += dppf(x, 1); x += dppf(x, 2); return x; }
DEVI float red8_max(float x) { x = fmaxf(x, dppf(x, 0)); x = fmaxf(x, dppf(x, 1)); x = fmaxf(x, dppf(x, 2)); return x; }
DEVI float red4_sum(float x) { x += dppf(x, 0); x += dppf(x, 1); return x; }
DEVI float wave_sum(float x) { for (int o = 32; o > 0; o >>= 1) x += __shfl_xor(x, o); return x; }
DEVI float wave_max(float x) { for (int o = 32; o > 0; o >>= 1) x = fmaxf(x, __shfl_xor(x, o)); return x; }
DEVI float xhalf(float x) {
    int l = (int)__builtin_amdgcn_mbcnt_hi(~0u, __builtin_amdgcn_mbcnt_lo(~0u, 0u)); asm volatile("" : "+v"(l));
    return __builtin_bit_cast(float, __builtin_amdgcn_ds_bpermute((l ^ 32) << 2, __builtin_bit_cast(int, x)));
}
DEVI void lds_barrier() { asm volatile("s_waitcnt lgkmcnt(0)\n\ts_barrier" ::: "memory"); }
DEVI float sigmoidf_(float x) { return 1.f / (1.f + __expf(-x)); }
DEVI float siluf_(float x) { return x / (1.f + __expf(-x)); }
DEVI float tanhf_(float x) { float e = __expf(2.f * x); return 1.f - 2.f / (e + 1.f); }

#define XB_TMO      128
#define XB_XCNT(j)  (256  + 64 * (j))
#define XB_XSUB(j)  (1280 + 64 * (j))
#define XB_XGEN(j)  (2304 + 64 * (j))
#define XB_TOP      3328
#define XB_TOPGEN   3392
#define XCD_BAR_WORDS 3456
#define XB_SPIN_CAP (1u << 20)
DEVI unsigned xb_ld(unsigned* p)              { return __hip_atomic_load(p, __ATOMIC_RELAXED, __HIP_MEMORY_SCOPE_AGENT); }
DEVI unsigned xb_add(unsigned* p, unsigned v) { return __hip_atomic_fetch_add(p, v, __ATOMIC_RELAXED, __HIP_MEMORY_SCOPE_AGENT); }
DEVI unsigned xb_xcc_id() { return (unsigned)__builtin_amdgcn_s_getreg((3 << 11) | 20) & 0xFu; }
#define XB_SPIN(cond, bar) do { unsigned _sp = 0; while (cond) { __builtin_amdgcn_s_sleep(1); \
    if ((++_sp & 255u) == 0u) { if (xb_ld(&(bar)[XB_TMO])) break; if (_sp > XB_SPIN_CAP) { atomicAdd(&(bar)[XB_TMO], 1u); break; } } } } while (0)
struct XcdBarrier { unsigned* bar; unsigned x; volatile LAS unsigned* st; };
DEVI XcdBarrier xcd_barrier_post(unsigned* bar, volatile LAS unsigned* st) {
    XcdBarrier b; b.bar = bar; b.x = xb_xcc_id(); b.st = st;
    if (threadIdx.x == 0) (void)xb_add(&bar[XB_XCNT(b.x)], 1u);
    return b;
}
DEVI void xcd_barrier_complete(unsigned* bar, unsigned x, unsigned& nloc, unsigned& nx) {
    const unsigned G = gridDim.x * gridDim.y * gridDim.z;
    unsigned sum, cnt, mine, sp = 0u;
    for (;;) {
        sum = 0u; cnt = 0u; mine = 0u;
#pragma unroll
        for (unsigned j = 0; j < 16; ++j) { const unsigned c = xb_ld(&bar[XB_XCNT(j)]); sum += c; cnt += (c > 0u) ? 1u : 0u; mine = (j == x) ? c : mine; }
        if (sum == G) break;
        __builtin_amdgcn_s_sleep(1);
        if ((++sp & 255u) == 0u) { if (xb_ld(&bar[XB_TMO])) break; if (sp > XB_SPIN_CAP) { atomicAdd(&bar[XB_TMO], 1u); break; } }
    }
    nloc = mine > 0u ? mine : 1u; nx = cnt > 0u ? cnt : 1u;
}
DEVI void xcd_barrier(const XcdBarrier& b) {
    asm volatile("s_waitcnt vmcnt(0)" ::: "memory");
    __syncthreads();
    if (threadIdx.x == 0) {
        unsigned* bar = b.bar;
        __builtin_amdgcn_s_waitcnt(0);
        unsigned nloc = b.st[0], nx = b.st[1];
        if (nloc == 0u) { xcd_barrier_complete(bar, b.x, nloc, nx); b.st[0] = nloc; b.st[1] = nx; }
        const unsigned old = xb_add(&bar[XB_XSUB(b.x)], 1u);
        const unsigned gen = old / nloc;
        if (old + 1u == (gen + 1u) * nloc) {
            __builtin_amdgcn_fence(__ATOMIC_RELEASE, "agent");
            asm volatile("s_waitcnt vmcnt(0)" ::: "memory");
            const unsigned og = xb_add(&bar[XB_TOP], 1u);
            const unsigned tg = og / nx;
            if (og + 1u == (tg + 1u) * nx) xb_add(&bar[XB_TOPGEN], 1u);
            else XB_SPIN(xb_ld(&bar[XB_TOPGEN]) == tg, bar);
            __builtin_amdgcn_fence(__ATOMIC_ACQUIRE, "agent");
            xb_add(&bar[XB_XGEN(b.x)], 1u);
            asm volatile("s_waitcnt vmcnt(0)" ::: "memory");
        } else {
            XB_SPIN(xb_ld(&bar[XB_XGEN(b.x)]) == gen, bar);
            __builtin_amdgcn_fence(__ATOMIC_ACQUIRE, "agent");
            asm volatile("s_waitcnt vmcnt(0)" ::: "memory");
        }
    }
    __syncthreads();
}

struct RowSrc { const float* ctx; const float* lat; };
DEVI const float* row_ptr(const RowSrc& s, int mode, int r, int& bb) {
    if (mode == 0) { int b = r / LT, pp = r - b * LT; if (pp < LC) { bb = 8; return s.ctx + (size_t)(b * LC + pp) * DM; } bb = b; return s.lat + (size_t)(b * SEQ + pp - LC) * DM; }
    bb = r >> 12; return s.lat + (size_t)r * DM;
}
DEVI float* row_ptr_w(float* ctx, float* lat, int mode, int r, int& bb) {
    if (mode == 0) { int b = r / LT, pp = r - b * LT; if (pp < LC) { bb = 8; return ctx + (size_t)(b * LC + pp) * DM; } bb = b; return lat + (size_t)(b * SEQ + pp - LC) * DM; }
    bb = r >> 12; return lat + (size_t)r * DM;
}

DEVI float sumsq8(const bf16x8& v) {
    float s = 0.f;
    const unsigned* u = (const unsigned*)&v;
#pragma unroll
    for (int i = 0; i < 4; ++i) { bf2 b = __builtin_bit_cast(bf2, u[i]); s = __builtin_amdgcn_fdot2_f32_bf16(b, b, s, false); }
    return s;
}
template <int BM, int BN, bool ROWNORM, class ARow, class XF, class ST>
DEVI void gemm_tile(ARow arow, const u16* __restrict__ Bt, int ldb, int K, XF xf, ST st, char* lds) {
    constexpr int WN = BN / 64, NA = BM / 64, NBC = BN / 64, STR = 72;
    const int tid = tidx(), lane = tid & 63, w = tid >> 6, wm = w / WN, wn = w % WN, l31 = lane & 31, h = lane >> 5;
    u16* sA = (u16*)lds; u16* sB = sA + 2 * BM * STR;
    const int crow = tid >> 3, kc = tid & 7;
    const u16* pa[NA]; const u16* pb[NBC];
#pragma unroll
    for (int i = 0; i < NA; ++i) pa[i] = arow(crow + 64 * i) + kc * 8;
#pragma unroll
    for (int i = 0; i < NBC; ++i) pb[i] = Bt + (size_t)(crow + 64 * i) * ldb + kc * 8;
    u32x4 ra[2][NA], rb[2][NBC];
    const int nk = K >> 6;
#pragma unroll
    for (int st_ = 0; st_ < 2; ++st_) {
        const int kq = st_ < nk ? st_ : nk - 1;
#pragma unroll
        for (int i = 0; i < NA; ++i) ra[st_][i] = *(const u32x4*)(pa[i] + kq * 64);
#pragma unroll
        for (int i = 0; i < NBC; ++i) rb[st_][i] = *(const u32x4*)(pb[i] + kq * 64);
    }
    f32x16 acc[2][2];
#pragma unroll
    for (int a = 0; a < 2; ++a)
#pragma unroll
        for (int b = 0; b < 2; ++b)
#pragma unroll
            for (int i = 0; i < 16; ++i) acc[a][b][i] = 0.f;
    float ss[2] = {0.f, 0.f};
#pragma unroll
    for (int i = 0; i < NA; ++i) *(u32x4*)(sA + (crow + 64 * i) * STR + kc * 8) = ra[0][i];
#pragma unroll
    for (int i = 0; i < NBC; ++i) *(u32x4*)(sB + (crow + 64 * i) * STR + kc * 8) = rb[0][i];
    lds_barrier();
    {
        const int kn = 2 < nk ? 2 : nk - 1;
#pragma unroll
        for (int i = 0; i < NA; ++i) ra[0][i] = *(const u32x4*)(pa[i] + kn * 64);
#pragma unroll
        for (int i = 0; i < NBC; ++i) rb[0][i] = *(const u32x4*)(pb[i] + kn * 64);
    }
#pragma unroll 2
    for (int kt = 0; kt < nk; ++kt) {
        const int cur = kt & 1, nxt = cur ^ 1;
        const u16* a_ = sA + cur * BM * STR; const u16* b_ = sB + cur * BN * STR;
        u16* an = sA + nxt * BM * STR; u16* bn = sB + nxt * BN * STR;
#pragma unroll
        for (int ks = 0; ks < 4; ++ks) {
            bf16x8 af[2], bfr[2];
#pragma unroll
            for (int mi = 0; mi < 2; ++mi) af[mi] = *(const bf16x8*)(a_ + (wm * 64 + mi * 32 + l31) * STR + ks * 16 + h * 8);
#pragma unroll
            for (int ni = 0; ni < 2; ++ni) bfr[ni] = *(const bf16x8*)(b_ + (wn * 64 + ni * 32 + l31) * STR + ks * 16 + h * 8);
            if (ROWNORM) { ss[0] += sumsq8(af[0]); ss[1] += sumsq8(af[1]); }
#pragma unroll
            for (int mi = 0; mi < 2; ++mi)
#pragma unroll
                for (int ni = 0; ni < 2; ++ni) acc[mi][ni] = __builtin_amdgcn_mfma_f32_32x32x16_bf16(bfr[ni], af[mi], acc[mi][ni], 0, 0, 0);
            if (ks == 1) {
#pragma unroll
                for (int i = 0; i < NA; ++i) *(u32x4*)(an + (crow + 64 * i) * STR + kc * 8) = ra[nxt][i];
#pragma unroll
                for (int i = 0; i < NBC; ++i) *(u32x4*)(bn + (crow + 64 * i) * STR + kc * 8) = rb[nxt][i];
            }
        }
        lds_barrier();
        {
            const int kn = (kt + 3 < nk) ? kt + 3 : nk - 1;
#pragma unroll
            for (int i = 0; i < NA; ++i) ra[nxt][i] = *(const u32x4*)(pa[i] + kn * 64);
#pragma unroll
            for (int i = 0; i < NBC; ++i) rb[nxt][i] = *(const u32x4*)(pb[i] + kn * 64);
        }
    }
    if (ROWNORM) {
#pragma unroll
        for (int mi = 0; mi < 2; ++mi) {
            float s = ss[mi] + __shfl_xor(ss[mi], 32);
            float r = rsqrtf(s / (float)K + 1e-6f);
#pragma unroll
            for (int ni = 0; ni < 2; ++ni)
#pragma unroll
                for (int i = 0; i < 16; ++i) acc[mi][ni][i] *= r;
        }
    }
    constexpr int TS = BN + 4;
    u16* sT = (u16*)lds;
    lds_barrier();
#pragma unroll
    for (int mi = 0; mi < 2; ++mi) {
        const int r = wm * 64 + mi * 32 + l31;
        xf(r, wn * 64, acc[mi], h);
#pragma unroll
        for (int ni = 0; ni < 2; ++ni)
#pragma unroll
            for (int g = 0; g < 4; ++g) { uint2 v; v.x = pack2(acc[mi][ni][4 * g], acc[mi][ni][4 * g + 1]); v.y = pack2(acc[mi][ni][4 * g + 2], acc[mi][ni][4 * g + 3]);
                *(uint2*)(sT + r * TS + wn * 64 + ni * 32 + 8 * g + 4 * h) = v; }
    }
    lds_barrier();
#pragma unroll 2
    for (int q = tid; q < BM * BN / 8; q += 512) {
        const int r = q / (BN / 8), c8 = (q % (BN / 8)) * 8;
        const uint2 lo = *(const uint2*)(sT + r * TS + c8), hi = *(const uint2*)(sT + r * TS + c8 + 4);
        u32x4 v = {lo.x, lo.y, hi.x, hi.y};
        st(r, c8, v);
    }
    lds_barrier();
}
DEVI void store_tile_bf16(u16* dst, const f32x16& t, int h) {
#pragma unroll
    for (int g = 0; g < 4; ++g) { uint2 v; v.x = pack2(t[4 * g], t[4 * g + 1]); v.y = pack2(t[4 * g + 2], t[4 * g + 3]); *(uint2*)(dst + 8 * g + 4 * h) = v; }
}
DEVI void rope_tile(f32x16& t, int axis, int pp, int h, const float2* __restrict__ tab) {
    if (pp < LC) return;
    const int s = pp - LC; const int coord = axis ? (s & 63) : (s >> 6);
#pragma unroll
    for (int g = 0; g < 2; ++g)
#pragma unroll
        for (int i = 0; i < 4; ++i) {
            const float2 cs = tab[coord * 16 + 8 * g + 4 * h + i];
            const float x1 = t[4 * g + i], x2 = t[4 * (g + 2) + i];
            t[4 * g + i] = x1 * cs.x - x2 * cs.y; t[4 * (g + 2) + i] = x2 * cs.x + x1 * cs.y;
        }
}

struct CJob { const float* src; u16* dst; const float* gain; int K, ldsrc, nlog, nvalid, sseg, sstride, soff, dseg, dstride, doff; int nmat; size_t smat, dmat; };
DEVI void get_job(const Params& p, int j, int layer, CJob& J) {
    char* ws = p.ws;
    J.gain = nullptr; J.nmat = 1; J.smat = 0; J.dmat = 0; J.sseg = 1 << 30; J.sstride = 0; J.soff = 0; J.dseg = 1 << 30; J.dstride = 0; J.doff = 0;
    auto plain = [&](const float* src, size_t dstoff, int K, int N) { J.src = src; J.dst = (u16*)(ws + dstoff); J.K = K; J.ldsrc = N; J.nlog = N; J.nvalid = N; };
    switch (j) {
    case 0: plain(p.in[I_AWIN], W_IN, 1024, 1472); J.nlog = 1536; break;
    case 1: plain(p.in[I_AWUQ], W_UQ, 384, 768); J.gain = p.in[I_AQN]; break;
    case 2: plain(p.in[I_AWUKV], W_UK, 256, 1024); J.nlog = 512; J.nvalid = 512; J.sseg = 128; J.sstride = 256; J.soff = 0; J.gain = p.in[I_AKVN]; break;
    case 3: plain(p.in[I_AWUKV], W_UV, 256, 1024); J.nlog = 512; J.nvalid = 512; J.sseg = 128; J.sstride = 256; J.soff = 128; J.gain = p.in[I_AKVN]; break;
    case 4: plain(p.in[I_AWO], W_OA, 1024, 1024); break;
    case 5: plain(p.in[I_RWR], W_RR, 1024, 1024); break;
    case 6: plain(p.in[I_RWK], W_RK, 1024, 1024); break;
    case 7: plain(p.in[I_RWV], W_RV, 1024, 1024); break;
    case 8: plain(p.in[I_RWO], W_RO, 1024, 1024); break;
    case 9: plain(p.in[I_RG1], W_G1, 1024, 128); break;
    case 10: plain(p.in[I_RW1], W_W1, 1024, 64); break;
    case 11: plain(p.in[I_RW1] + 1024 * 64, W_W1 + 64 * 1024 * 2, 1024, 64); break;
    case 12: plain(p.in[I_RA1], W_A1, 1024, 64); break;
    case 13: plain(p.in[I_RA1] + 1024 * 64, W_A1 + 64 * 1024 * 2, 1024, 64); break;
    case 14: plain(p.in[I_RG2], W_G2, 128, 1024); break;
    case 15: plain(p.in[I_RW2], W_W2, 64, 1024); break;
    case 16: plain(p.in[I_RW2] + 64 * 1024, W_W2 + 1024 * 64 * 2, 64, 1024); break;
    case 17: plain(p.in[I_RA2], W_A2, 64, 1024); break;
    case 18: plain(p.in[I_RA2] + 64 * 1024, W_A2 + 1024 * 64 * 2, 64, 1024); break;
    case 19: plain(p.in[I_MSG], W_SGU, 1024, 256); J.dseg = 32; J.dstride = 64; J.doff = 0; break;
    case 20: plain(p.in[I_MSU], W_SGU, 1024, 256); J.dseg = 32; J.dstride = 64; J.doff = 32; break;
    case 21: plain(p.in[I_MSG] + 1024 * 256, W_SGU + 1048576, 1024, 256); J.dseg = 32; J.dstride = 64; J.doff = 0; break;
    case 22: plain(p.in[I_MSU] + 1024 * 256, W_SGU + 1048576, 1024, 256); J.dseg = 32; J.dstride = 64; J.doff = 32; break;
    case 23: plain(p.in[I_MSD], W_SD, 256, 1024); break;
    case 24: plain(p.in[I_MSD] + 256 * 1024, W_SD + 524288, 256, 1024); break;
    case 25: plain(p.in[I_MWG] + (size_t)layer * 64 * 1024 * 256, OFF_WGU, 1024, 256); J.dseg = 32; J.dstride = 64; J.doff = 0; J.nmat = 64; J.smat = 1024 * 256; J.dmat = 512 * 1024; break;
    case 26: plain(p.in[I_MWU] + (size_t)layer * 64 * 1024 * 256, OFF_WGU, 1024, 256); J.dseg = 32; J.dstride = 64; J.doff = 32; J.nmat = 64; J.smat = 1024 * 256; J.dmat = 512 * 1024; break;
    default: plain(p.in[I_MWD] + (size_t)layer * 64 * 256 * 1024, OFF_WD, 256, 1024); J.nmat = 64; J.smat = 256 * 1024; J.dmat = 1024 * 256; break;
    }
}
DEVI int job_tiles(const CJob& J) { return J.nmat * (J.nlog / 64) * ((J.K + 127) / 128); }
DEVI void conv_tile(const CJob& J, int t, char* lds) {
    const int ktiles = (J.K + 127) / 128, ntiles = J.nlog / 64;
    const int mat = t / (ktiles * ntiles); const int r = t - mat * ktiles * ntiles; const int nt = r / ktiles, ktile = r - nt * ktiles;
    const float* src = J.src + (size_t)mat * J.smat; u16* dst = J.dst + (size_t)mat * J.dmat;
    unsigned* sm = (unsigned*)lds;
    const int tid = tidx(), ng = tid & 15, kp = tid >> 4;
    const int n0 = nt * 64 + ng * 4;
    const int scol = (n0 / J.sseg) * J.sstride + J.soff + (n0 % J.sseg);
    const bool nval = n0 < J.nvalid;
#pragma unroll
    for (int pass = 0; pass < 2; ++pass) {
        const int k = ktile * 128 + pass * 64 + kp * 2;
        float4 v0 = make_float4(0.f, 0.f, 0.f, 0.f), v1 = v0;
        if (nval && k < J.K) {
            v0 = *(const float4*)(src + (size_t)k * J.ldsrc + scol); v1 = *(const float4*)(src + (size_t)(k + 1) * J.ldsrc + scol);
            if (J.gain) { const float g0 = J.gain[k], g1 = J.gain[k + 1]; v0.x *= g0; v0.y *= g0; v0.z *= g0; v0.w *= g0; v1.x *= g1; v1.y *= g1; v1.z *= g1; v1.w *= g1; }
        }
        const int kk = pass * 32 + kp;
        sm[(ng * 4 + 0) * 66 + kk] = pack2(v0.x, v1.x); sm[(ng * 4 + 1) * 66 + kk] = pack2(v0.y, v1.y);
        sm[(ng * 4 + 2) * 66 + kk] = pack2(v0.z, v1.z); sm[(ng * 4 + 3) * 66 + kk] = pack2(v0.w, v1.w);
    }
    __syncthreads();
#pragma unroll
    for (int i = 0; i < 2; ++i) {
        const int c = tid + 512 * i, row = c >> 4, ch = c & 15;
        const int n = nt * 64 + row; const int drow = (n / J.dseg) * J.dstride + J.doff + (n % J.dseg);
        const int k = ktile * 128 + ch * 8;
        if (k < J.K) { uint2 lo = *(const uint2*)(sm + row * 66 + ch * 4), hi = *(const uint2*)(sm + row * 66 + ch * 4 + 2); uint4 v = make_uint4(lo.x, lo.y, hi.x, hi.y); *(uint4*)(dst + (size_t)drow * J.K + k) = v; }
    }
    __syncthreads();
}
DEVI void conv_jobs(const Params& p, int jlo, int jhi, int layer, int unit_base, char* lds) {
    const int G = gridDim.x, bid = blockIdx.x;
    int acc = unit_base;
    for (int j = jlo; j < jhi; ++j) {
        CJob J; get_job(p, j, layer, J); const int n = job_tiles(J);
        const int t0 = (bid - (acc % G) + G) % G;
        for (int t = t0; t < n; t += G) conv_tile(J, t, lds);
        acc += n;
    }
}
DEVI void mods_unit(const Params& p, int u, char* lds) {
    const int l = u / 96, cg = u % 96;
    float* sil = (float*)lds;
    float* red = sil + 1024 * 12;
    const int tid = tidx(), lane = tid & 63, w = tid >> 6;
    for (int i = tid; i < 9 * 1024; i += 512) { const int bb = i >> 10, k = i & 1023; const float v = bb < 8 ? p.in[I_C][bb * 1024 + k] : p.in[I_CCTX][k]; sil[k * 12 + bb] = siluf_(v); }
    __syncthreads();
    float acc[9];
#pragma unroll
    for (int i = 0; i < 9; ++i) acc[i] = 0.f;
    const float* wp = p.in[I_ADAW] + (size_t)l * 1024 * 6144 + cg * 64 + lane;
#pragma unroll 4
    for (int kk = 0; kk < 128; ++kk) {
        const int k = w * 128 + kk; const float wv = wp[(size_t)k * 6144];
        const float4 s0 = *(const float4*)(sil + k * 12), s1 = *(const float4*)(sil + k * 12 + 4); const float s2 = sil[k * 12 + 8];
        acc[0] += s0.x * wv; acc[1] += s0.y * wv; acc[2] += s0.z * wv; acc[3] += s0.w * wv; acc[4] += s1.x * wv; acc[5] += s1.y * wv; acc[6] += s1.z * wv; acc[7] += s1.w * wv; acc[8] += s2 * wv;
    }
#pragma unroll
    for (int i = 0; i < 9; ++i) red[(w * 9 + i) * 64 + lane] = acc[i];
    __syncthreads();
    for (int i = tid; i < 9 * 64; i += 512) {
        const int bb = i >> 6, c = i & 63; float s = 0.f;
        for (int ww = 0; ww < 8; ++ww) s += red[(ww * 9 + bb) * 64 + c];
        const int col = cg * 64 + c;
        ((float*)(p.ws + OFF_MODS))[(size_t)(l * 9 + bb) * 6144 + col] = s + p.in[I_ADAB][l * 6144 + col];
    }
    __syncthreads();
}
DEVI void phase_prologue(const Params& p, char* lds) {
    const int bid = blockIdx.x, G = gridDim.x;
    if (bid == G - 1) {
        int* cnt = (int*)(p.ws + OFF_CNT);
        for (int i = tidx(); i < 2 * NCHUNK * 64; i += 512) cnt[i] = 0;
        float2* tab = (float2*)(p.ws + OFF_ROPE);
        for (int i = tidx(); i < 64 * 16; i += 512) { const int coord = i >> 4, f = i & 15; const float inv = exp2f(-(float)f * (13.287712379549449f / 16.f)); const float a = (float)coord * inv; tab[i] = make_float2(cosf(a), sinf(a)); }
    }
    {
        u16* wro = (u16*)(p.ws + OFF_WROUT);
        for (int i = bid * 512 + tidx(); i < 2 * 1024 * 64; i += G * 512) {
            const int l = i >> 16, k = (i >> 6) & 1023, e = i & 63;
            const float wv = p.in[I_MROUT][i]; const u16 hi = (u16)pack2(wv, 0.f); const u16 lo = (u16)pack2(wv - bf1(hi), 0.f);
            u16* row = wro + ((size_t)l * 64 + e) * 3072; row[k] = hi; row[1024 + k] = hi; row[2048 + k] = lo;
        }
    }
    for (int u = bid; u < 192; u += G) mods_unit(p, u, lds);
    conv_jobs(p, 0, 25, 0, 192, lds);
}

DEVI void norm_rows(const RowSrc& src, int mode, int nrows, const float* __restrict__ gain, const float* __restrict__ mods_l, int ishift, int iscale, u16* __restrict__ dst) {
    const int lane = tidx() & 63, w = tidx() >> 6;
    for (int r = blockIdx.x * 8 + w; r < nrows; r += gridDim.x * 8) {
        int bb; const float* xr = row_ptr(src, mode, r, bb);
        float4 v[4]; float ss = 0.f;
#pragma unroll
        for (int i = 0; i < 4; ++i) { v[i] = ((const float4*)xr)[lane + 64 * i]; ss += v[i].x * v[i].x + v[i].y * v[i].y + v[i].z * v[i].z + v[i].w * v[i].w; }
        ss = wave_sum(ss);
        const float rs = rsqrtf(ss * (1.f / 1024.f) + 1e-6f);
        const float* msh = mods_l + (size_t)bb * 6144 + ishift * 1024; const float* msc = mods_l + (size_t)bb * 6144 + iscale * 1024;
#pragma unroll
        for (int i = 0; i < 4; ++i) {
            const int c = (lane + 64 * i) * 4;
            const float4 g = *(const float4*)(gain + c), sh = *(const float4*)(msh + c), sc = *(const float4*)(msc + c);
            uint2 o; o.x = pack2(v[i].x * rs * g.x * (1.f + sc.x) + sh.x, v[i].y * rs * g.y * (1.f + sc.y) + sh.y);
            o.y = pack2(v[i].z * rs * g.z * (1.f + sc.z) + sh.z, v[i].w * rs * g.w * (1.f + sc.w) + sh.w);
            *(uint2*)(dst + (size_t)r * DM + c) = o;
        }
    }
}

DEVI void phase_gemm_win(const Params& p, char* lds) {
    const u16* A = (const u16*)(p.ws + A_N0); const u16* W = (const u16*)(p.ws + W_IN);
    u16* CQ = (u16*)(p.ws + A_CQ); u16* CKV = (u16*)(p.ws + A_CKV); u16* KA = (u16*)(p.ws + A_KA); u16* QS = (u16*)(p.ws + A_QS); u16* KS = (u16*)(p.ws + A_KS); u16* VS = (u16*)(p.ws + A_VS);
    const float2* tab = (const float2*)(p.ws + OFF_ROPE);
    const int NT = 12, MT = T0 / 256;
    for (int u = blockIdx.x; u < NT * MT; u += gridDim.x) {
        const int mt = u / NT, nt = u % NT; const int m0 = mt * 256, n0 = nt * 128;
        auto arow = [&](int r) { return A + (size_t)(m0 + r) * DM; };
        auto xf = [&](int r, int cw, f32x16 (&t)[2], int h) {
            const int row = m0 + r; const int b = row / LT, pp = row - b * LT;
#pragma unroll
            for (int ni = 0; ni < 2; ++ni) {
                const int c32 = n0 + cw + ni * 32;
                if (c32 >= 640 && c32 < 1344) {
                    const int cc = c32 - 640; rope_tile(t[ni], (cc >> 5) & 1, pp, h, tab);
                    if (c32 >= 704 && c32 < 1216) {
#pragma unroll
                        for (int i = 0; i < 16; ++i) t[ni][i] *= QS_SCALE;
                    }
                }
            }
        };
        auto st = [&](int r, int c8, u32x4 v) {
            const int row = m0 + r; const int b = row / LT, pp = row - b * LT; const int c = n0 + c8;
            if (c < 384) *(u32x4*)(CQ + (size_t)row * 384 + c) = v;
            else if (c < 640) *(u32x4*)(CKV + (size_t)row * 256 + (c - 384)) = v;
            else if (c < 704) { for (int hd = 0; hd < 4; ++hd) *(u32x4*)(KA + ((size_t)(b * 4 + hd) * LT + pp) * 192 + 128 + (c - 640)) = v; }
            else if (c < 1216) { const int cc = c - 704; *(u32x4*)(QS + ((size_t)(b * 8 + (cc >> 6)) * LT + pp) * 64 + (cc & 63)) = v; }
            else if (c < 1344) { const int cc = c - 1216; *(u32x4*)(KS + ((size_t)(b * 2 + (cc >> 6)) * LT + pp) * 64 + (cc & 63)) = v; }
            else if (c < 1472) { const int cc = c - 1344; *(u32x4*)(VS + ((size_t)(b * 2 + (cc >> 6)) * LT + pp) * 64 + (cc & 63)) = v; }
        };
        gemm_tile<256, 128, false>(arow, W + (size_t)n0 * DM, DM, DM, xf, st, lds);
    }
}
DEVI void phase_gemm_qkv(const Params& p, char* lds) {
    const u16* CQ = (const u16*)(p.ws + A_CQ); const u16* CKV = (const u16*)(p.ws + A_CKV);
    u16* QA = (u16*)(p.ws + A_QA); u16* KA = (u16*)(p.ws + A_KA); u16* VA = (u16*)(p.ws + A_VA);
    const float2* tab = (const float2*)(p.ws + OFF_ROPE);
    const int MT = T0 / 256;
    for (int u = blockIdx.x; u < 14 * MT; u += gridDim.x) {
        const int mt = u / 14, j = u % 14; const int m0 = mt * 256;
        if (j < 6) {
            const int n0 = j * 128;
            auto arow = [&](int r) { return CQ + (size_t)(m0 + r) * 384; };
            auto xf = [&](int r, int cw, f32x16 (&t)[2], int h) {
                const int row = m0 + r; const int pp = row % LT;
#pragma unroll
                for (int ni = 0; ni < 2; ++ni) {
                    const int c32 = n0 + cw + ni * 32; const int wi = c32 % 192;
                    if (wi >= 128) rope_tile(t[ni], (wi - 128) >> 5, pp, h, tab);
#pragma unroll
                    for (int i = 0; i < 16; ++i) t[ni][i] *= QA_SCALE;
                }
            };
            auto st = [&](int r, int c8, u32x4 v) {
                const int row = m0 + r; const int b = row / LT, pp = row - b * LT; const int c = n0 + c8; const int hd = c / 192, wi = c - hd * 192;
                *(u32x4*)(QA + ((size_t)(b * 4 + hd) * LT + pp) * 192 + wi) = v;
            };
            gemm_tile<256, 128, true>(arow, (const u16*)(p.ws + W_UQ) + (size_t)n0 * 384, 384, 384, xf, st, lds);
        } else {
            const bool isv = j >= 10; const int n0 = (isv ? j - 10 : j - 6) * 128;
            auto arow = [&](int r) { return CKV + (size_t)(m0 + r) * 256; };
            auto xf = [&](int, int, f32x16 (&)[2], int) {};
            auto st = [&](int r, int c8, u32x4 v) {
                const int row = m0 + r; const int b = row / LT, pp = row - b * LT; const int c = n0 + c8; const int hd = c >> 7, wi = c & 127;
                if (isv) *(u32x4*)(VA + ((size_t)(b * 4 + hd) * LT + pp) * 128 + wi) = v;
                else *(u32x4*)(KA + ((size_t)(b * 4 + hd) * LT + pp) * 192 + wi) = v;
            };
            gemm_tile<256, 128, true>(arow, (const u16*)(p.ws + (isv ? W_UV : W_UK)) + (size_t)n0 * 256, 256, 256, xf, st, lds);
        }
    }
}

template <int DQK, int DV, bool SWA>
DEVI void attn_unit(const u16* __restrict__ Q, const u16* __restrict__ Kp, const u16* __restrict__ Vp, int q0, int a0, int na, int b0, int nb2,
                    float m_init, u16* __restrict__ outp  , char* lds) {
    constexpr int KSTR = DQK + 8, VSTR = DV + 32, KCH = DQK / 8, VCH = DV / 8, NKC = 64 * KCH / 512, NVC = 64 * VCH / 512, NS = DQK / 16, NDT = DV / 32;
    const int tid = tidx(), lane = tid & 63, w = tid >> 6, l31 = lane & 31, h = lane >> 5;
    u16* sK = (u16*)lds; u16* sV = sK + 2 * 64 * KSTR;
    const int qpos = q0 + w * 32 + l31;
    bf16x8 qf[NS];
#pragma unroll
    for (int s = 0; s < NS; ++s) qf[s] = *(const bf16x8*)(Q + (size_t)qpos * DQK + s * 16 + h * 8);
    f32x16 o[NDT];
#pragma unroll
    for (int d = 0; d < NDT; ++d)
#pragma unroll
        for (int i = 0; i < 16; ++i) o[d][i] = 0.f;
    float m = m_init, lsum = 0.f;
    const int nt = na + nb2;
    u32x4 rk[NKC], rv[NVC];
    auto tile_pos = [&](int t) { return t < na ? a0 + 64 * t : b0 + 64 * (t - na); };
    auto gload = [&](int t) {
        const int kp0 = tile_pos(t);
        const u16* kb_ = Kp + (size_t)kp0 * DQK + tid * 8; const u16* vb_ = Vp + (size_t)kp0 * DV + tid * 8;
#pragma unroll
        for (int i = 0; i < NKC; ++i) rk[i] = *(const u32x4*)(kb_ + 4096 * i);
#pragma unroll
        for (int i = 0; i < NVC; ++i) rv[i] = *(const u32x4*)(vb_ + 4096 * i);
    };
    gload(0);
    const int tr_row = 4 * h + ((lane & 15) >> 2), tr_col = 16 * ((lane >> 4) & 1) + 4 * (lane & 3);
    for (int t = 0; t < nt; ++t) {
        u16* k_ = sK + (t & 1) * 64 * KSTR; u16* v_ = sV + (t & 1) * 64 * VSTR;
#pragma unroll
        for (int i = 0; i < NKC; ++i) { const int c = tid + 512 * i, row = c / KCH, ch = c % KCH; *(u32x4*)(k_ + row * KSTR + ch * 8) = rk[i]; }
#pragma unroll
        for (int i = 0; i < NVC; ++i) { const int c = tid + 512 * i, row = c / VCH, ch = c % VCH; *(u32x4*)(v_ + row * VSTR + ch * 8) = rv[i]; }
        __syncthreads();
        if (t + 1 < nt) gload(t + 1);
        f32x16 st[2];
#pragma unroll
        for (int k2 = 0; k2 < 2; ++k2) {
#pragma unroll
            for (int i = 0; i < 16; ++i) st[k2][i] = 0.f;
#pragma unroll
            for (int s = 0; s < NS; ++s) {
                const bf16x8 kf = *(const bf16x8*)(k_ + (k2 * 32 + l31) * KSTR + s * 16 + h * 8);
                st[k2] = __builtin_amdgcn_mfma_f32_32x32x16_bf16(kf, qf[s], st[k2], 0, 0, 0);
            }
        }
        __builtin_amdgcn_sched_barrier(0);
        if (SWA && t >= na) {
            const int kp0 = tile_pos(t);
#pragma unroll
            for (int k2 = 0; k2 < 2; ++k2)
#pragma unroll
                for (int i = 0; i < 16; ++i) {
                    const int key = kp0 + k2 * 32 + (i & 3) + 8 * (i >> 2) + 4 * h; const int d = qpos - key;
                    if (d > 128 || d < -128) st[k2][i] = -1e30f;
                }
        }
        float mx = st[0][0];
#pragma unroll
        for (int k2 = 0; k2 < 2; ++k2)
#pragma unroll
            for (int i = 0; i < 16; ++i) mx = fmaxf(mx, st[k2][i]);
        mx = fmaxf(mx, xhalf(mx));
        const float mn = fmaxf(m, mx); const float alpha = __builtin_amdgcn_exp2f(m - mn); m = mn;
        float ps = 0.f;
#pragma unroll
        for (int k2 = 0; k2 < 2; ++k2)
#pragma unroll
            for (int i = 0; i < 16; ++i) { const float pv = __builtin_amdgcn_exp2f(st[k2][i] - mn); st[k2][i] = pv; ps += pv; }
        lsum = lsum * alpha + ps;
#pragma unroll
        for (int d = 0; d < NDT; ++d)
#pragma unroll
            for (int i = 0; i < 16; ++i) o[d][i] *= alpha;
#pragma unroll
        for (int s16 = 0; s16 < 4; ++s16) {
            __builtin_amdgcn_sched_barrier(0);
            bf16x8 pf; unsigned* pu = (unsigned*)&pf;
#pragma unroll
            for (int jj = 0; jj < 4; ++jj) pu[jj] = pack2(st[s16 >> 1][8 * (s16 & 1) + 2 * jj], st[s16 >> 1][8 * (s16 & 1) + 2 * jj + 1]);
#pragma unroll
            for (int d = 0; d < NDT; ++d) {
                const u16* base = v_ + (16 * s16 + tr_row) * VSTR + d * 32 + tr_col;
                const s16x4 lo = __builtin_amdgcn_ds_read_tr16_b64_v4i16((LAS s16x4*)(base));
                const s16x4 hi = __builtin_amdgcn_ds_read_tr16_b64_v4i16((LAS s16x4*)(base + 8 * VSTR));
                bf16x8 vf; vf[0] = lo[0]; vf[1] = lo[1]; vf[2] = lo[2]; vf[3] = lo[3]; vf[4] = hi[0]; vf[5] = hi[1]; vf[6] = hi[2]; vf[7] = hi[3];
                o[d] = __builtin_amdgcn_mfma_f32_32x32x16_bf16(vf, pf, o[d], 0, 0, 0);
            }
        }
    }
    float lt = lsum + xhalf(lsum);
    if (SWA) lt += __builtin_amdgcn_exp2f(m_init - m);
    const float inv = 1.f / lt;
    u16* orow = outp + (size_t)qpos * DM;
#pragma unroll
    for (int d = 0; d < NDT; ++d)
#pragma unroll
        for (int g = 0; g < 4; ++g) { uint2 v; v.x = pack2(o[d][4 * g] * inv, o[d][4 * g + 1] * inv); v.y = pack2(o[d][4 * g + 2] * inv, o[d][4 * g + 3] * inv); *(uint2*)(orow + d * 32 + 8 * g + 4 * h) = v; }
    __syncthreads();
}
DEVI void phase_attention(const Params& p, char* lds) {
    const u16* QA = (const u16*)(p.ws + A_QA); const u16* KA = (const u16*)(p.ws + A_KA); const u16* VA = (const u16*)(p.ws + A_VA);
    const u16* QS = (const u16*)(p.ws + A_QS); const u16* KS = (const u16*)(p.ws + A_KS); const u16* VS = (const u16*)(p.ws + A_VS);
    u16* mix = (u16*)(p.ws + A_N0);
    for (int u = blockIdx.x; u < 1632; u += gridDim.x) {
        if (u < 544) {
            int b, hd, q0, na;
            if (u < 512) { b = u >> 6; hd = (u >> 4) & 3; q0 = LC + (u & 15) * 256; na = 68; }
            else { const int v = u - 512; b = v >> 2; hd = v & 3; q0 = 0; na = 4; }
            const size_t bh = (size_t)(b * 4 + hd) * LT;
            attn_unit<192, 128, false>(QA + bh * 192, KA + bh * 192, VA + bh * 128, q0, 0, na, 0, 0, -1e30f, mix + (size_t)b * LT * DM + hd * 128, lds);
        } else {
            int b, hd, q0, b0 = 0, nb2 = 0;
            if (u < 1568) { const int v = u - 544; b = v >> 7; hd = (v >> 4) & 7; const int s0 = (v & 15) * 256; q0 = LC + s0;
                int lo = s0 - 128; if (lo < 0) lo = 0; int hi = s0 + 256 + 128; if (hi > SEQ) hi = SEQ; b0 = LC + lo; nb2 = (hi - lo) >> 6; }
            else { const int v = u - 1568; b = v >> 3; hd = v & 7; q0 = 0; }
            const int kvh = hd >> 2; const size_t qb = (size_t)(b * 8 + hd) * LT, kb = (size_t)(b * 2 + kvh) * LT;
            attn_unit<64, 64, true>(QS + qb * 64, KS + kb * 64, VS + kb * 64, q0, 0, 4, b0, nb2, p.in[I_ASINK][hd] * LOG2E, mix + (size_t)b * LT * DM + 512 + hd * 64, lds);
        }
    }
}
DEVI void phase_gemm_wo(const Params& p, const u16* A, const u16* W, const RowSrc& resid, int mode, int layer, char* lds) {
    float* XC = (float*)(p.ws + OFF_XC); float* XL = p.out;
    const float* mods_l = (const float*)(p.ws + OFF_MODS) + (size_t)layer * 9 * 6144;
    const int MT = (mode == 0 ? T0 : TL) / 256;
    for (int u = blockIdx.x; u < 8 * MT; u += gridDim.x) {
        const int mt = u >> 3, nt = u & 7; const int m0 = mt * 256, n0 = nt * 128;
        auto arow = [&](int r) { return A + (size_t)(m0 + r) * DM; };
        auto xf = [&](int, int, f32x16 (&)[2], int) {};
        auto st = [&](int r, int c8, u32x4 v) {
            int bb; const float* rs = row_ptr(resid, mode, m0 + r, bb); int bb2; float* xo = row_ptr_w(XC, XL, mode, m0 + r, bb2);
            const float* mg = mods_l + (size_t)bb * 6144 + 2 * 1024; const int c = n0 + c8;
            const float4 r0 = *(const float4*)(rs + c), r1 = *(const float4*)(rs + c + 4), g0 = *(const float4*)(mg + c), g1 = *(const float4*)(mg + c + 4);
            float4 o0, o1;
            o0.x = r0.x + g0.x * bf_lo(v[0]); o0.y = r0.y + g0.y * bf_hi(v[0]); o0.z = r0.z + g0.z * bf_lo(v[1]); o0.w = r0.w + g0.w * bf_hi(v[1]);
            o1.x = r1.x + g1.x * bf_lo(v[2]); o1.y = r1.y + g1.y * bf_hi(v[2]); o1.z = r1.z + g1.z * bf_lo(v[3]); o1.w = r1.w + g1.w * bf_hi(v[3]);
            *(float4*)(xo + c) = o0; *(float4*)(xo + c + 4) = o1;
        };
        gemm_tile<256, 128, false>(arow, W + (size_t)n0 * DM, DM, DM, xf, st, lds);
    }
}

DEVI void phase_moe_norm(const Params& p, int layer) {
    const int mode = layer == 0 ? 0 : 1; const int ntok = layer == 0 ? T0 : TL;
    RowSrc src; src.ctx = (const float*)(p.ws + OFF_XC); src.lat = p.out;
    const float* gain = p.in[I_NFFN] + layer * 1024; const float* mods_l = (const float*)(p.ws + OFF_MODS) + (size_t)layer * 9 * 6144;
    u16* n1 = (u16*)(p.ws + M_N1); u16* nlo = (u16*)(p.ws + M_ACT);
    const int lane = tidx() & 63, w = tidx() >> 6;
    for (int r = blockIdx.x * 8 + w; r < ntok; r += gridDim.x * 8) {
        int bb; const float* xr = row_ptr(src, mode, r, bb);
        float4 v[4]; float ss = 0.f;
#pragma unroll
        for (int i = 0; i < 4; ++i) { v[i] = ((const float4*)xr)[lane + 64 * i]; ss += v[i].x * v[i].x + v[i].y * v[i].y + v[i].z * v[i].z + v[i].w * v[i].w; }
        ss = wave_sum(ss);
        const float rs = rsqrtf(ss * (1.f / 1024.f) + 1e-6f);
        const float* msh = mods_l + (size_t)bb * 6144 + 3 * 1024; const float* msc = mods_l + (size_t)bb * 6144 + 4 * 1024;
#pragma unroll
        for (int i = 0; i < 4; ++i) {
            const int c = (lane + 64 * i) * 4;
            const float4 g = *(const float4*)(gain + c), sh = *(const float4*)(msh + c), sc = *(const float4*)(msc + c);
            const float y0 = v[i].x * rs * g.x * (1.f + sc.x) + sh.x, y1 = v[i].y * rs * g.y * (1.f + sc.y) + sh.y, y2 = v[i].z * rs * g.z * (1.f + sc.z) + sh.z, y3 = v[i].w * rs * g.w * (1.f + sc.w) + sh.w;
            uint2 o; o.x = pack2(y0, y1); o.y = pack2(y2, y3);
            *(uint2*)(n1 + (size_t)r * DM + c) = o;
            uint2 ol; ol.x = pack2(y0 - bf_lo(o.x), y1 - bf_hi(o.x)); ol.y = pack2(y2 - bf_lo(o.y), y3 - bf_hi(o.y));
            *(uint2*)(nlo + (size_t)r * DM + c) = ol;
        }
    }
}
DEVI void router_tile(const u16* __restrict__ H, const u16* __restrict__ L, const u16* __restrict__ Wt, int m0, char* lds) {
    constexpr int BM = 256, BN = 128, WN = 2, NA = 4, NBC = 2, STR = 72;
    const int tid = tidx(), lane = tid & 63, w = tid >> 6, wm = w / WN, wn = w % WN, l31 = lane & 31, h = lane >> 5;
    u16* sA = (u16*)lds; u16* sB = sA + 2 * BM * STR;
    const int crow = tid >> 3, kc = tid & 7;
    const u16* ph[NA]; const u16* pl[NA]; const u16* pb[NBC];
#pragma unroll
    for (int i = 0; i < NA; ++i) { ph[i] = H + (size_t)(m0 + crow + 64 * i) * DM + kc * 8; pl[i] = L + (size_t)(m0 + crow + 64 * i) * DM + kc * 8; }
#pragma unroll
    for (int i = 0; i < NBC; ++i) pb[i] = Wt + (size_t)((crow + 64 * i) & 63) * 3072 + kc * 8;
    u32x4 ra[NA], rb[NBC];
    auto gload = [&](int kt) {
        const int seg = kt >> 4, kk = (kt & 15) * 64;
#pragma unroll
        for (int i = 0; i < NA; ++i) ra[i] = *(const u32x4*)((seg == 1 ? pl[i] : ph[i]) + kk);
#pragma unroll
        for (int i = 0; i < NBC; ++i) rb[i] = *(const u32x4*)(pb[i] + kt * 64);
    };
    gload(0);
    f32x16 acc[2][2];
#pragma unroll
    for (int a = 0; a < 2; ++a)
#pragma unroll
        for (int b = 0; b < 2; ++b)
#pragma unroll
            for (int i = 0; i < 16; ++i) acc[a][b][i] = 0.f;
    for (int kt = 0; kt < 48; ++kt) {
        u16* a_ = sA + (kt & 1) * BM * STR; u16* b_ = sB + (kt & 1) * BN * STR;
#pragma unroll
        for (int i = 0; i < NA; ++i) *(u32x4*)(a_ + (crow + 64 * i) * STR + kc * 8) = ra[i];
#pragma unroll
        for (int i = 0; i < NBC; ++i) *(u32x4*)(b_ + (crow + 64 * i) * STR + kc * 8) = rb[i];
        lds_barrier();
        gload(kt + 1 < 48 ? kt + 1 : 47);
#pragma unroll
        for (int ks = 0; ks < 4; ++ks) {
            bf16x8 af[2], bfr[2];
#pragma unroll
            for (int mi = 0; mi < 2; ++mi) af[mi] = *(const bf16x8*)(a_ + (wm * 64 + mi * 32 + l31) * STR + ks * 16 + h * 8);
#pragma unroll
            for (int ni = 0; ni < 2; ++ni) bfr[ni] = *(const bf16x8*)(b_ + (wn * 64 + ni * 32 + l31) * STR + ks * 16 + h * 8);
#pragma unroll
            for (int mi = 0; mi < 2; ++mi)
#pragma unroll
                for (int ni = 0; ni < 2; ++ni) acc[mi][ni] = __builtin_amdgcn_mfma_f32_32x32x16_bf16(bfr[ni], af[mi], acc[mi][ni], 0, 0, 0);
        }
    }
    lds_barrier();
    float* LG = (float*)lds;
    if (wn == 0) {
#pragma unroll
        for (int mi = 0; mi < 2; ++mi)
#pragma unroll
            for (int ni = 0; ni < 2; ++ni)
#pragma unroll
                for (int g = 0; g < 4; ++g)
                    *(float4*)(LG + (wm * 64 + mi * 32 + l31) * 64 + ni * 32 + 8 * g + 4 * h) = make_float4(acc[mi][ni][4 * g], acc[mi][ni][4 * g + 1], acc[mi][ni][4 * g + 2], acc[mi][ni][4 * g + 3]);
    }
    lds_barrier();
}
DEVI void phase_moe_route(const Params& p, int layer, char* lds) {
    const int ntok = layer == 0 ? T0 : TL; const int tc = ntok / NCHUNK;
    const float ebias = p.in[I_MBIAS][layer * 64 + (tidx() & 63)];
    int* cnt = (int*)(p.ws + OFF_CNT) + layer * NCHUNK * 64;
    int* tok_e = (int*)(p.ws + OFF_TOKE); int* tok_r = (int*)(p.ws + OFF_TOKR); int* ltok = (int*)(p.ws + OFF_LTOK); float* lg = (float*)(p.ws + OFF_LG);
    const u16* H = (const u16*)(p.ws + M_N1); const u16* L = (const u16*)(p.ws + M_ACT); const u16* Wt = (const u16*)(p.ws + OFF_WROUT) + (size_t)layer * 64 * 3072;
    const int lane = tidx() & 63, w = tidx() >> 6;
    const float* LG = (const float*)lds;
    for (int u = blockIdx.x; u < ntok / 256; u += gridDim.x) {
        router_tile(H, L, Wt, u * 256, lds);
        for (int j = 0; j < 32; ++j) {
            const int rl = w * 32 + j; const int tok = u * 256 + rl;
            const float lgt = LG[rl * 64 + lane];
            const float score = 1.f / (1.f + expf(-lgt)); const float choice = score + ebias;
            const float m1 = red8_max(choice);
            const unsigned long long bm = __ballot(choice == m1);
            const unsigned gm = (unsigned)(bm >> (lane & 56)) & 0xffu; const int first = __ffs(gm) - 1;
            const float m2 = red8_max(((lane & 7) == first) ? -INFINITY : choice);
            const float gs = m1 + m2;
            int rank = 0;
#pragma unroll
            for (int g2 = 0; g2 < 8; ++g2) { const float og = __shfl(gs, g2 * 8); rank += (og > gs || (og == gs && g2 < (lane >> 3))) ? 1 : 0; }
            float cm = rank < 4 ? choice : -INFINITY;
            unsigned long long sel = 0ull; float ssum = 0.f;
#pragma unroll
            for (int it = 0; it < 6; ++it) {
                const float mxv = wave_max(cm);
                const unsigned long long bmm = __ballot(cm == mxv);
                const int win = __ffsll((long long)bmm) - 1;
                sel |= 1ull << win; ssum += __shfl(score, win);
                if (lane == win) cm = -INFINITY;
            }
            if ((sel >> lane) & 1ull) {
                const int jj = __popcll(sel & ((1ull << lane) - 1ull));
                const int ch = tok / tc; const int rk = atomicAdd(&cnt[ch * 64 + lane], 1);
                tok_e[tok * 6 + jj] = lane; tok_r[tok * 6 + jj] = rk;
                ltok[((size_t)ch * 64 + lane) * tc + rk] = tok; lg[((size_t)ch * 64 + lane) * tc + rk] = 2.5f * score / ssum;
            }
        }
        lds_barrier();
    }
}
struct SegTab { int* cnt; int* off; int* tpre; };
DEVI SegTab build_segtab(const Params& p, int layer, int tc, char* lds_tab) {
    SegTab T; T.cnt = (int*)lds_tab; T.off = T.cnt + 264; T.tpre = T.off + 264;
    const int* cnt = (const int*)(p.ws + OFF_CNT) + layer * NCHUNK * 64;
    const int tid = tidx();
    if (tid < 260) { const int ch = tid / 65, e = tid % 65; T.cnt[tid] = e < 64 ? cnt[ch * 64 + e] : tc; }
    __syncthreads();
    if (tid < 64) {
        int lc[5], lt_[5]; int sc = 0, st = 0;
#pragma unroll
        for (int j = 0; j < 5; ++j) { const int s = 5 * tid + j; const int v = s < 260 ? T.cnt[s] : 0; lc[j] = sc; lt_[j] = st; sc += v; st += (v + 127) >> 7; }
        int ic = sc, it = st;
        for (int o = 1; o < 64; o <<= 1) { const int a = __shfl_up(ic, o), b2 = __shfl_up(it, o); if (tid >= o) { ic += a; it += b2; } }
        const int bc = ic - sc, bt = it - st;
#pragma unroll
        for (int j = 0; j < 5; ++j) { const int s = 5 * tid + j; if (s <= 260) { T.tpre[s] = bt + lt_[j]; T.off[s] = bc + lc[j]; } }
    }
    __syncthreads();
    return T;
}
DEVI int find_seg(const SegTab& T, int lo_seg, int hi_seg, int mt) {
    int lo = lo_seg, hi = hi_seg;
    while (hi - lo > 1) { const int mid = (lo + hi) >> 1; if (T.tpre[mid] <= mt) lo = mid; else hi = mid; }
    return lo;
}
DEVI void phase_moe_gemm1(const Params& p, int layer, char* lds) {
    const int ntok = layer == 0 ? T0 : TL; const int tc = ntok / NCHUNK;
    char* tabmem = lds + 110592; SegTab T = build_segtab(p, layer, tc, tabmem);
    const u16* n1 = (const u16*)(p.ws + M_N1); u16* act = (u16*)(p.ws + M_ACT);
    const int* ltok = (const int*)(p.ws + OFF_LTOK); const float* lg = (const float*)(p.ws + OFF_LG);
    const int nunits = T.tpre[260] * 2;
    for (int u = blockIdx.x; u < nunits; u += gridDim.x) {
        const int mt = u >> 1, nt = u & 1; const int seg = find_seg(T, 0, 260, mt); const int ch = seg / 65, e = seg % 65;
        const int cntv = T.cnt[seg], row0 = (mt - T.tpre[seg]) * 128; const int n0 = nt * 256;
        const int* lt = ltok + ((size_t)ch * 64 + e) * tc; const float* lgp = lg + ((size_t)ch * 64 + e) * tc;
        const u16* W = e < 64 ? (const u16*)(p.ws + OFF_WGU) + (size_t)e * 512 * 1024 : (const u16*)(p.ws + W_SGU) + (size_t)layer * 512 * 1024;
        auto arow = [&](int r) { int s = row0 + r; if (s >= cntv) s = cntv - 1; const int tok = e < 64 ? lt[s] : ch * tc + s; return n1 + (size_t)tok * DM; };
        const size_t arow0 = (size_t)ch * 7 * tc + (T.off[seg] - T.off[ch * 65]) + row0;
        auto xf = [&](int r, int cw, f32x16 (&t)[2], int h) {
            int s2 = row0 + r; if (s2 >= cntv) s2 = cntv - 1;
            const float gw = e < 64 ? lgp[s2] : 1.f;
#pragma unroll
            for (int i = 0; i < 16; ++i) { const float gt = t[0][i], up = t[1][i]; t[0][i] = gt / (1.f + __expf(-gt)) * up * gw; }
        };
        auto st = [&](int r, int c8, u32x4 v) {
            if (row0 + r >= cntv || (c8 & 32)) return;
            *(u32x4*)(act + (arow0 + r) * 256 + ((n0 + (c8 & ~63)) >> 1) + (c8 & 31)) = v;
        };
        gemm_tile<128, 256, false>(arow, W + (size_t)n0 * DM, DM, DM, xf, st, lds);
    }
}
DEVI void phase_moe_g2c(const Params& p, int layer, int chg, int chc, char* lds) {
    const int mode = layer == 0 ? 0 : 1; const int ntok = layer == 0 ? T0 : TL; const int tc = ntok / NCHUNK;
    char* tabmem = lds + 110592; SegTab T = build_segtab(p, layer, tc, tabmem);
    const u16* act = (const u16*)(p.ws + M_ACT);
    const int* tok_e = (const int*)(p.ws + OFF_TOKE); const int* tok_r = (const int*)(p.ws + OFF_TOKR);
    float* XC = (float*)(p.ws + OFF_XC); float* XL = p.out;
    const float* mods_l = (const float*)(p.ws + OFF_MODS) + (size_t)layer * 9 * 6144;
    const int lane = tidx() & 63, w = tidx() >> 6;
    int nunits = 0, t_lo = 0;
    if (chg >= 0) { t_lo = T.tpre[chg * 65]; nunits = (T.tpre[chg * 65 + 65] - t_lo) * 4; }
    const int G = gridDim.x; const int my_units = nunits > (int)blockIdx.x ? (nunits - (int)blockIdx.x + G - 1) / G : 0;
    const int crounds = chc >= 0 ? (tc + G * 8 - 1) / (G * 8) : 0;
    int cdone = 0;
    auto combine_rounds = [&](int upto) {
        const u16* outr = (const u16*)(p.ws + M_OUTR + (size_t)(chc & 1) * SZ_OUTR);
        for (; cdone < upto; ++cdone) {
            const int tl = (cdone * G + (int)blockIdx.x) * 8 + w; if (tl >= tc) continue;
            const int tok = chc * tc + tl; int bb; float* xr = row_ptr_w(XC, XL, mode, tok, bb);
            const float* mg = mods_l + (size_t)bb * 6144 + 5 * 1024;
            int rows[7];
#pragma unroll
            for (int j = 0; j < 6; ++j) rows[j] = T.off[chc * 65 + tok_e[tok * 6 + j]] - T.off[chc * 65] + tok_r[tok * 6 + j];
            rows[6] = 6 * tc + tl;
#pragma unroll
            for (int i = 0; i < 2; ++i) {
                const int c = (lane + 64 * i) * 8;
                float acc[8];
#pragma unroll
                for (int q = 0; q < 8; ++q) acc[q] = 0.f;
#pragma unroll
                for (int j = 0; j < 7; ++j) {
                    const uint4 v = *(const uint4*)(outr + (size_t)rows[j] * DM + c);
                    acc[0] += bf_lo(v.x); acc[1] += bf_hi(v.x); acc[2] += bf_lo(v.y); acc[3] += bf_hi(v.y); acc[4] += bf_lo(v.z); acc[5] += bf_hi(v.z); acc[6] += bf_lo(v.w); acc[7] += bf_hi(v.w);
                }
                float4 x0 = *(float4*)(xr + c), x1 = *(float4*)(xr + c + 4); const float4 g0 = *(const float4*)(mg + c), g1 = *(const float4*)(mg + c + 4);
                x0.x += g0.x * acc[0]; x0.y += g0.y * acc[1]; x0.z += g0.z * acc[2]; x0.w += g0.w * acc[3]; x1.x += g1.x * acc[4]; x1.y += g1.y * acc[5]; x1.z += g1.z * acc[6]; x1.w += g1.w * acc[7];
                *(float4*)(xr + c) = x0; *(float4*)(xr + c + 4) = x1;
            }
        }
    };
    int ui = 0;
    for (int u = blockIdx.x; u < nunits; u += G, ++ui) {
        u16* outw = (u16*)(p.ws + M_OUTR + (size_t)(chg & 1) * SZ_OUTR);
        const int mt = t_lo + (u >> 2), nt = u & 3; const int seg = find_seg(T, chg * 65, chg * 65 + 65, mt); const int e = seg % 65;
        const int cntv = T.cnt[seg], row0 = (mt - T.tpre[seg]) * 128; const int n0 = nt * 256;
        const size_t lrow0 = (size_t)(T.off[seg] - T.off[chg * 65]) + row0;
        const u16* A = act + ((size_t)chg * 7 * tc + lrow0) * 256;
        const u16* W = e < 64 ? (const u16*)(p.ws + OFF_WD) + (size_t)e * 1024 * 256 : (const u16*)(p.ws + W_SD) + (size_t)layer * 1024 * 256;
        auto arow = [&](int r) { int s2 = row0 + r; if (s2 >= cntv) s2 = cntv - 1; return A + (size_t)(s2 - row0) * 256; };
        auto xf = [&](int, int, f32x16 (&)[2], int) {};
        auto st = [&](int r, int c8, u32x4 v) { if (row0 + r < cntv) *(u32x4*)(outw + (lrow0 + r) * DM + n0 + c8) = v; };
        gemm_tile<128, 256, false>(arow, W + (size_t)n0 * 256, 256, 256, xf, st, lds);
        combine_rounds((int)(((long)crounds * (ui + 1)) / my_units));
    }
    combine_rounds(crounds);
}

DEVI void phase_rwkv_mix(const Params& p, int i0, int i1, int i2) {
    const u16* nn = (const u16*)(p.ws + R_NN); u16* xm = (u16*)(p.ws + R_XM0);
    const float* mu = p.in[I_RMU]; const int idx[3] = {i0, i1, i2};
    const int lane = tidx() & 63, w = tidx() >> 6;
    for (int r = blockIdx.x * 8 + w; r < T0; r += gridDim.x * 8) {
        const int b = r / LT, pp = r - b * LT;
        const bool hasprev = (pp != 0) && (pp != LC), hasnext = (pp != LC - 1) && (pp != LT - 1);
#pragma unroll
        for (int half = 0; half < 2; ++half) {
            const int c = half * 512 + lane * 8;
            const uint4 cur = *(const uint4*)(nn + (size_t)r * DM + c);
            uint4 sh = make_uint4(0, 0, 0, 0);
            if (half == 0) { if (hasprev) sh = *(const uint4*)(nn + (size_t)(r - 1) * DM + c); }
            else { if (hasnext) sh = *(const uint4*)(nn + (size_t)(r + 1) * DM + c); }
            float nv[8], xx[8];
            nv[0] = bf_lo(cur.x); nv[1] = bf_hi(cur.x); nv[2] = bf_lo(cur.y); nv[3] = bf_hi(cur.y); nv[4] = bf_lo(cur.z); nv[5] = bf_hi(cur.z); nv[6] = bf_lo(cur.w); nv[7] = bf_hi(cur.w);
            xx[0] = bf_lo(sh.x) - nv[0]; xx[1] = bf_hi(sh.x) - nv[1]; xx[2] = bf_lo(sh.y) - nv[2]; xx[3] = bf_hi(sh.y) - nv[3]; xx[4] = bf_lo(sh.z) - nv[4]; xx[5] = bf_hi(sh.z) - nv[5]; xx[6] = bf_lo(sh.w) - nv[6]; xx[7] = bf_hi(sh.w) - nv[7];
#pragma unroll
            for (int j = 0; j < 3; ++j) {
                const float4 m0 = *(const float4*)(mu + idx[j] * 1024 + c), m1 = *(const float4*)(mu + idx[j] * 1024 + c + 4);
                uint4 o; o.x = pack2(nv[0] + xx[0] * m0.x, nv[1] + xx[1] * m0.y); o.y = pack2(nv[2] + xx[2] * m0.z, nv[3] + xx[3] * m0.w);
                o.z = pack2(nv[4] + xx[4] * m1.x, nv[5] + xx[5] * m1.y); o.w = pack2(nv[6] + xx[6] * m1.z, nv[7] + xx[7] * m1.w);
                *(uint4*)(xm + (size_t)j * T0 * DM + (size_t)r * DM + c) = o;
            }
        }
    }
}
DEVI void phase_rwkv_gemm_rkv(const Params& p, char* lds) {
    const int MT = T0 / 256;
    for (int u = blockIdx.x; u < 3 * 8 * MT; u += gridDim.x) {
        const int j = u / (8 * MT), v = u % (8 * MT); const int mt = v >> 3, nt = v & 7; const int m0 = mt * 256, n0 = nt * 128;
        const u16* A = (const u16*)(p.ws + R_XM0) + (size_t)j * T0 * DM; const u16* W = (const u16*)(p.ws + W_RR) + (size_t)j * DM * DM; u16* O = (u16*)(p.ws + R_RR) + (size_t)j * T0 * DM;
        auto arow = [&](int r) { return A + (size_t)(m0 + r) * DM; };
        auto xf = [&](int, int, f32x16 (&)[2], int) {};
        auto st = [&](int r, int c8, u32x4 v) { *(u32x4*)(O + (size_t)(m0 + r) * DM + n0 + c8) = v; };
        gemm_tile<256, 128, false>(arow, W + (size_t)n0 * DM, DM, DM, xf, st, lds);
    }
}
DEVI void phase_rwkv_gemm_small(const Params& p, char* lds) {
    const int MT = T0 / 256;
    for (int u = blockIdx.x; u < 3 * MT; u += gridDim.x) {
        const int j = u / MT, mt = u % MT; const int m0 = mt * 256;
        const u16* A = (const u16*)(p.ws + R_XM0) + (size_t)j * T0 * DM;
        const u16* W = (const u16*)(p.ws + (j == 0 ? W_W1 : j == 1 ? W_A1 : W_G1)); u16* O = (u16*)(p.ws + (j == 0 ? R_HW : j == 1 ? R_HA : R_HG));
        auto arow = [&](int r) { return A + (size_t)(m0 + r) * DM; };
        auto xf = [&](int, int, f32x16 (&t)[2], int) {
#pragma unroll
            for (int ni = 0; ni < 2; ++ni)
#pragma unroll
                for (int i = 0; i < 16; ++i) { const float x = t[ni][i]; t[ni][i] = j == 0 ? tanhf_(x) : j == 1 ? x : sigmoidf_(x); }
        };
        auto st = [&](int r, int c8, u32x4 v) { *(u32x4*)(O + (size_t)(m0 + r) * 128 + c8) = v; };
        gemm_tile<256, 128, false>(arow, W, DM, DM, xf, st, lds);
    }
}
DEVI void phase_rwkv_gemm_g(const Params& p, char* lds) {
    const int MT = T0 / 256; const u16* A = (const u16*)(p.ws + R_HG); const u16* W = (const u16*)(p.ws + W_G2); u16* O = (u16*)(p.ws + R_GG);
    for (int u = blockIdx.x; u < 8 * MT; u += gridDim.x) {
        const int mt = u >> 3, nt = u & 7; const int m0 = mt * 256, n0 = nt * 128;
        auto arow = [&](int r) { return A + (size_t)(m0 + r) * 128; };
        auto xf = [&](int, int, f32x16 (&)[2], int) {};
        auto st = [&](int r, int c8, u32x4 v) { *(u32x4*)(O + (size_t)(m0 + r) * DM + n0 + c8) = v; };
        gemm_tile<256, 128, false>(arow, W + (size_t)n0 * 128, 128, 128, xf, st, lds);
    }
}
DEVI float red16_sum(float x) { x += dppf(x, 0); x += dppf(x, 1); x += dppf(x, 2); int xi = __builtin_bit_cast(int, x); x += __builtin_bit_cast(float, __builtin_amdgcn_mov_dpp(xi, 0x140, 0xF, 0xF, true)); return x; }
DEVI bf16x8 frag_perm(const u16* rowp, int ks, int h) {
    const uint2 lo = *(const uint2*)(rowp + 16 * ks + 4 * h), hi = *(const uint2*)(rowp + 16 * ks + 8 + 4 * h);
    u32x4 v = {lo.x, lo.y, hi.x, hi.y}; return __builtin_bit_cast(bf16x8, v);
}
DEVI bf16x8 tr_frag(const u16* base, int stride, int lane) {
    const u16* q = base + (4 * (lane >> 5) + ((lane & 15) >> 2)) * stride + 16 * ((lane >> 4) & 1) + 4 * (lane & 3);
    const s16x4 lo = __builtin_amdgcn_ds_read_tr16_b64_v4i16((LAS s16x4*)q), hi = __builtin_amdgcn_ds_read_tr16_b64_v4i16((LAS s16x4*)(q + 8 * stride));
    bf16x8 v; v[0] = lo[0]; v[1] = lo[1]; v[2] = lo[2]; v[3] = lo[3]; v[4] = hi[0]; v[5] = hi[1]; v[6] = hi[2]; v[7] = hi[3]; return v;
}
DEVI bf16x8 frag_plain(const u16* rowp, int ks, int h) { return *(const bf16x8*)(rowp + 16 * ks + 8 * h); }
DEVI bf16x8 acc_to_b(const f32x16& t, int s) {
    u32x4 v = {pack2(t[8 * s], t[8 * s + 1]), pack2(t[8 * s + 2], t[8 * s + 3]), pack2(t[8 * s + 4], t[8 * s + 5]), pack2(t[8 * s + 6], t[8 * s + 7])};
    return __builtin_bit_cast(bf16x8, v);
}
#define MFMA(a, b, c) __builtin_amdgcn_mfma_f32_32x32x16_bf16(a, b, c, 0, 0, 0)
DEVI void phase_rwkv_scan(const Params& p, char* lds) {
    float* LW = (float*)lds; float* AA = LW + 2048; float* CP = AA + 2048;
    u16* At = (u16*)(lds + 24576); u16* Bt = At + 2304; u16* Kt = Bt + 2304; u16* Rt = Kt + 2304;
    u16* Vr = (u16*)(lds + 43008); u16* Khr = Vr + 3072; u16* Bhr = Khr + 3072;
    float* Lf = (float*)(lds + 61440);
    u16* Lo = (u16*)(lds + 66048); u16* Lak = Lo + 1280; u16* Mrb = Lak + 1280; u16* Mrk = Mrb + 1280; u16* Td = Mrk + 1280;
    float* PC = (float*)(lds + 78848); u16* YS = (u16*)(lds + 79104);
    const u16* r_g = (const u16*)(p.ws + R_RR); const u16* k_g = (const u16*)(p.ws + R_RK); const u16* v_g = (const u16*)(p.ws + R_RV);
    const u16* hw = (const u16*)(p.ws + R_HW); const u16* ha = (const u16*)(p.ws + R_HA);
    const int tid = tidx(), lane = tid & 63, w = tid >> 6, l31 = lane & 31, hh = lane >> 5;
    for (int u = blockIdx.x; u < 256; u += gridDim.x) {
        const int dir = u & 1, hd = (u >> 1) & 15, b = u >> 5;
        u16* y_g = (u16*)(p.ws + (dir ? R_YB : R_YF)); float* rkb = (float*)(p.ws + R_RKB) + (size_t)dir * T0 * 16;
        const int mat = (w >> 1) & 1, ctt = w & 1;
        u16* W2L = (u16*)(lds + 86016);
        float* KC = (float*)(lds + 86016 + 18432);
        for (int i = tid; i < 2 * 64 * 8; i += 512) { const int m = i >> 9, c = (i >> 3) & 63, ch = i & 7;
            *(u32x4*)(W2L + (m * 64 + c) * 72 + ch * 8) = *(const u32x4*)((const u16*)(p.ws + (m ? W_A2 : W_W2)) + (size_t)dir * 1024 * 64 + (size_t)(hd * 64 + c) * 64 + ch * 8); }
        if (tid < 64) { KC[tid] = p.in[I_RKK][hd * 64 + tid]; KC[64 + tid] = p.in[I_RKA][hd * 64 + tid]; KC[128 + tid] = p.in[I_RRK][hd * 64 + tid]; }
        const u16* w2l = W2L + (mat * 64 + ctt * 32 + l31) * 72;
        const float* bias0 = (mat ? p.in[I_RA0] : p.in[I_RW0]) + dir * 1024 + hd * 64 + ctt * 32;
        const u16* hsrc = mat ? ha : hw;
        const int t2 = tid >> 4, c4 = (tid & 15) * 4; const int cg = hd * 64 + c4;
        for (int i = tid; i < 1280; i += 512) Td[i] = 0;
        f32x16 Z[2];
#pragma unroll
        for (int a = 0; a < 2; ++a)
#pragma unroll
            for (int i = 0; i < 16; ++i) Z[a][i] = 0.f;
        __syncthreads();
        const size_t rowb = (size_t)b * LT;
        auto chunk_p0 = [&](int ci) { int pc; if (ci < 8) { pc = dir ? 7 - ci : ci; return 32 * pc; } pc = dir ? 135 - ci : ci - 8; return LC + 32 * pc; };
        bf16x8 hfr[4]; uint2 ru, ku, vu;
        {
            const int p0 = chunk_p0(0);
            const int pos = dir ? p0 + 31 - l31 : p0 + l31; const u16* hp = hsrc + (rowb + pos) * 128 + dir * 64;
#pragma unroll
            for (int ks = 0; ks < 4; ++ks) hfr[ks] = *(const bf16x8*)(hp + ks * 16 + hh * 8);
            const int pos2 = dir ? p0 + 31 - t2 : p0 + t2; const size_t go = (rowb + pos2) * DM + cg;
            ru = *(const uint2*)(r_g + go); ku = *(const uint2*)(k_g + go); vu = *(const uint2*)(v_g + go);
        }
        for (int ci = 0; ci < 136; ++ci) {
            const int p0 = chunk_p0(ci); const int p0n = chunk_p0(ci < 135 ? ci + 1 : ci);
            if (w < 4) {
                f32x16 acc;
#pragma unroll
                for (int i = 0; i < 16; ++i) acc[i] = 0.f;
#pragma unroll
                for (int ks = 0; ks < 4; ++ks) acc = MFMA(hfr[ks], frag_plain(w2l, ks, hh), acc);
                {
                    const int pos = dir ? p0n + 31 - l31 : p0n + l31; const u16* hp = hsrc + (rowb + pos) * 128 + dir * 64;
#pragma unroll
                    for (int ks = 0; ks < 4; ++ks) hfr[ks] = *(const bf16x8*)(hp + ks * 16 + hh * 8);
                }
                const float bv = bias0[l31];
                float* dstm = (mat ? AA : CP) + ctt * 32 + l31;
                if (mat) {
#pragma unroll
                    for (int i = 0; i < 16; ++i) dstm[((i & 3) + 8 * (i >> 2) + 4 * hh) * 64] = sigmoidf_(acc[i] + bv);
                } else {
                    f32x16 lo, cp;
#pragma unroll
                    for (int i = 0; i < 16; ++i) { const float lw = -0.6065306597126334f * sigmoidf_(acc[i] + bv); const float hi = bf1((u16)(pack2(lw, 0.f))); acc[i] = hi; lo[i] = lw - hi; cp[i] = 0.f; }
#pragma unroll
                    for (int ks = 0; ks < 2; ++ks) {
                        u32x4 tv;
#pragma unroll
                        for (int q = 0; q < 4; ++q) { const int ta = 16 * ks + 8 * (q >> 1) + 4 * hh + 2 * (q & 1); tv[q] = ((ta <= l31) ? 0x3F80u : 0u) | ((ta + 1 <= l31) ? 0x3F800000u : 0u); }
                        const bf16x8 tri = __builtin_bit_cast(bf16x8, tv);
                        cp = MFMA(tri, acc_to_b(acc, ks), cp); cp = MFMA(tri, acc_to_b(lo, ks), cp);
                    }
#pragma unroll
                    for (int i = 0; i < 16; ++i) dstm[((i & 3) + 8 * (i >> 2) + 4 * hh) * 64] = cp[i];
                }
            }
            const int pos2 = dir ? p0 + 31 - t2 : p0 + t2;
            lds_barrier();
            {
                const float rv[4] = {bf_lo(ru.x), bf_hi(ru.x), bf_lo(ru.y), bf_hi(ru.y)}, kv[4] = {bf_lo(ku.x), bf_hi(ku.x), bf_lo(ku.y), bf_hi(ku.y)};
                const float4 a4 = *(const float4*)(AA + t2 * 64 + c4), cp4 = *(const float4*)(CP + t2 * 64 + c4), ce4 = *(const float4*)(CP + 31 * 64 + c4);
                float4 cq4 = make_float4(0.f, 0.f, 0.f, 0.f); if (t2 > 0) cq4 = *(const float4*)(CP + (t2 - 1) * 64 + c4);
                const float av[4] = {a4.x, a4.y, a4.z, a4.w}, cpv[4] = {cp4.x, cp4.y, cp4.z, cp4.w}, cev[4] = {ce4.x, ce4.y, ce4.z, ce4.w}, cqv[4] = {cq4.x, cq4.y, cq4.z, cq4.w};
                const float4 kkc = *(const float4*)(KC + c4), kac = *(const float4*)(KC + 64 + c4), rkc = *(const float4*)(KC + 128 + c4);
                const float kkcv[4] = {kkc.x, kkc.y, kkc.z, kkc.w}, kacv[4] = {kac.x, kac.y, kac.z, kac.w}, rkcv[4] = {rkc.x, rkc.y, rkc.z, rkc.w};
                float kk[4], km[4], ssq = 0.f, rks = 0.f;
#pragma unroll
                for (int i = 0; i < 4; ++i) { kk[i] = kv[i] * kkcv[i]; ssq += kk[i] * kk[i]; km[i] = kv[i] * (1.f + (av[i] - 1.f) * kacv[i]); rks += rv[i] * km[i] * rkcv[i]; }
                ssq = red16_sum(ssq); rks = red16_sum(rks);
                const float inv = 1.f / fmaxf(sqrtf(ssq), 1e-12f);
                float at[4], bt[4], kt[4], rt[4], bh[4], kh[4];
#pragma unroll
                for (int i = 0; i < 4; ++i) {
                    const float kn = kk[i] * inv, bb = kn * av[i];
                    const float en = __expf(-cpv[i]), eh = __expf(cev[i] - cpv[i]);
                    at[i] = -kn * __expf(cqv[i]); bt[i] = bb * en; kt[i] = km[i] * en; rt[i] = rv[i] * __expf(cpv[i]); bh[i] = bb * eh; kh[i] = km[i] * eh;
                }
                uint2 o;
                o.x = pack2(at[0], at[1]); o.y = pack2(at[2], at[3]); *(uint2*)(At + t2 * 72 + c4) = o;
                o.x = pack2(bt[0], bt[1]); o.y = pack2(bt[2], bt[3]); *(uint2*)(Bt + t2 * 72 + c4) = o;
                o.x = pack2(kt[0], kt[1]); o.y = pack2(kt[2], kt[3]); *(uint2*)(Kt + t2 * 72 + c4) = o;
                o.x = pack2(rt[0], rt[1]); o.y = pack2(rt[2], rt[3]); *(uint2*)(Rt + t2 * 72 + c4) = o;
                o.x = pack2(kh[0], kh[1]); o.y = pack2(kh[2], kh[3]); *(uint2*)(Khr + t2 * 96 + c4) = o;
                o.x = pack2(bh[0], bh[1]); o.y = pack2(bh[2], bh[3]); *(uint2*)(Bhr + t2 * 96 + c4) = o;
                *(uint2*)(Vr + t2 * 96 + c4) = vu;
                if (t2 == 0) *(float4*)(PC + c4) = make_float4(__expf(cev[0]), __expf(cev[1]), __expf(cev[2]), __expf(cev[3]));
                if ((tid & 15) == 0) rkb[(rowb + pos2) * 16 + hd] = rks;
                const int pos2n = dir ? p0n + 31 - t2 : p0n + t2; const size_t gon = (rowb + pos2n) * DM + cg;
                ru = *(const uint2*)(r_g + gon); ku = *(const uint2*)(k_g + gon); vu = *(const uint2*)(v_g + gon);
            }
            lds_barrier();
            if (w < 4) {
                const u16* X1 = (w < 2) ? At : Rt; const u16* X2 = (w & 1) ? Kt : Bt;
                f32x16 acc;
#pragma unroll
                for (int i = 0; i < 16; ++i) acc[i] = 0.f;
#pragma unroll
                for (int ks = 0; ks < 4; ++ks) acc = MFMA(frag_plain(X2 + l31 * 72, ks, hh), frag_plain(X1 + l31 * 72, ks, hh), acc);
#pragma unroll
                for (int i = 0; i < 16; ++i) { const int s = (i & 3) + 8 * (i >> 2) + 4 * hh; const bool keep = (w < 2) ? (s < l31) : (s <= l31); if (!keep) acc[i] = 0.f; }
                if (w == 0) {
#pragma unroll
                    for (int g = 0; g < 4; ++g) {
                        *(float4*)(Lf + l31 * 36 + 8 * g + 4 * hh) = make_float4(acc[4 * g], acc[4 * g + 1], acc[4 * g + 2], acc[4 * g + 3]);
                        const bool lo = (l31 >= 16) && (8 * g + 4 * hh < 16);
                        uint2 o; o.x = lo ? pack2(acc[4 * g], acc[4 * g + 1]) : 0u; o.y = lo ? pack2(acc[4 * g + 2], acc[4 * g + 3]) : 0u; *(uint2*)(Lo + l31 * 40 + 8 * g + 4 * hh) = o;
                    }
                } else {
                    u16* dst = (w == 1) ? Lak : (w == 2) ? Mrb : Mrk;
#pragma unroll
                    for (int g = 0; g < 4; ++g) { uint2 o; o.x = pack2(acc[4 * g], acc[4 * g + 1]); o.y = pack2(acc[4 * g + 2], acc[4 * g + 3]); *(uint2*)(dst + l31 * 40 + 8 * g + 4 * hh) = o; }
                }
            }
            lds_barrier();
            f32x16 XZ, Ya; bf16x8 zf[4];
            if (w >= 6) {
                const int blk = w - 6, j = lane & 15; const float* Lb = Lf + (16 * blk) * 36 + 16 * blk;
                const float4 l4 = *(const float4*)(Lb + (lane >> 2) * 36 + 4 * (lane & 3));
                const int li[4] = {__builtin_bit_cast(int, l4.x), __builtin_bit_cast(int, l4.y), __builtin_bit_cast(int, l4.z), __builtin_bit_cast(int, l4.w)};
                float x[16];
#pragma unroll
                for (int t = 0; t < 16; ++t) {
                    float a0 = (j == t) ? 1.f : 0.f, a1 = 0.f;
#pragma unroll
                    for (int s2 = 0; s2 < t; ++s2) {
                        const float lv = __builtin_bit_cast(float, __builtin_amdgcn_readlane(li[s2 & 3], 4 * t + (s2 >> 2)));
                        if (s2 & 1) a1 += lv * x[s2]; else a0 += lv * x[s2];
                    }
                    x[t] = a0 + a1;
                }
                if (lane < 16) {
#pragma unroll
                    for (int t = 0; t < 16; ++t) Td[(16 * blk + t) * 40 + 16 * blk + j] = (u16)(pack2(x[t], 0.f));
                }
            } else if (w < 2) {
#pragma unroll
                for (int s = 0; s < 4; ++s) zf[s] = acc_to_b(Z[s >> 1], s & 1);
#pragma unroll
                for (int i = 0; i < 16; ++i) { XZ[i] = 0.f; Ya[i] = 0.f; }
#pragma unroll
                for (int s = 0; s < 4; ++s) { XZ = MFMA(frag_perm(At + l31 * 72, s, hh), zf[s], XZ); Ya = MFMA(frag_perm(Rt + l31 * 72, s, hh), zf[s], Ya); }
                bf16x8 vf[2];
#pragma unroll
                for (int ks = 0; ks < 2; ++ks) {
                    vf[ks] = tr_frag(Vr + (16 * ks) * 96 + 32 * w, 96, lane);
                    XZ = MFMA(frag_perm(Lak + l31 * 40, ks, hh), vf[ks], XZ); Ya = MFMA(frag_perm(Mrk + l31 * 40, ks, hh), vf[ks], Ya);
                }
#pragma unroll
                for (int kt = 0; kt < 2; ++kt) {
#pragma unroll
                    for (int g = 0; g < 4; ++g) { const float4 pc4 = *(const float4*)(PC + 32 * kt + 8 * g + 4 * hh);
                        Z[kt][4 * g] *= pc4.x; Z[kt][4 * g + 1] *= pc4.y; Z[kt][4 * g + 2] *= pc4.z; Z[kt][4 * g + 3] *= pc4.w; }
#pragma unroll
                    for (int ks = 0; ks < 2; ++ks) Z[kt] = MFMA(tr_frag(Khr + (16 * ks) * 96 + 32 * kt, 96, lane), vf[ks], Z[kt]);
                }
            }
            lds_barrier();
            if (w < 2) {
                f32x16 U1 = {}, W = {};
#pragma unroll
                for (int i = 0; i < 16; ++i) { U1[i] = 0.f; W[i] = 0.f; }
#pragma unroll
                for (int ks = 0; ks < 2; ++ks) U1 = MFMA(frag_perm(Td + l31 * 40, ks, hh), acc_to_b(XZ, ks), U1);
#pragma unroll
                for (int ks = 0; ks < 2; ++ks) W = MFMA(frag_perm(Lo + l31 * 40, ks, hh), acc_to_b(U1, ks), W);
#pragma unroll
                for (int ks = 0; ks < 2; ++ks) U1 = MFMA(frag_perm(Td + l31 * 40, ks, hh), acc_to_b(W, ks), U1);
                const bf16x8 uf0 = acc_to_b(U1, 0), uf1 = acc_to_b(U1, 1);
                Ya = MFMA(frag_perm(Mrb + l31 * 40, 0, hh), uf0, Ya); Ya = MFMA(frag_perm(Mrb + l31 * 40, 1, hh), uf1, Ya);
#pragma unroll
                for (int kt = 0; kt < 2; ++kt) { Z[kt] = MFMA(tr_frag(Bhr + 32 * kt, 96, lane), uf0, Z[kt]); Z[kt] = MFMA(tr_frag(Bhr + 16 * 96 + 32 * kt, 96, lane), uf1, Z[kt]); }
#pragma unroll
                for (int i = 0; i < 16; ++i) { const int t = (i & 3) + 8 * (i >> 2) + 4 * hh; YS[t * 72 + 32 * w + l31] = (u16)pack2(Ya[i], 0.f); }
            }
            lds_barrier();
            if (ci >= 8) { const uint2 yv = *(const uint2*)(YS + t2 * 72 + c4); *(uint2*)(y_g + (rowb + pos2) * DM + cg) = yv; }
        }
        __syncthreads();
    }
}
DEVI void phase_rwkv_readout(const Params& p) {
    const u16* yf = (const u16*)(p.ws + R_YF); const u16* yb = (const u16*)(p.ws + R_YB); const u16* vg = (const u16*)(p.ws + R_RV); const u16* gg = (const u16*)(p.ws + R_GG);
    const float* rkb = (const float*)(p.ws + R_RKB); u16* rd = (u16*)(p.ws + R_RD);
    const float* lnw = p.in[I_RLNW]; const float* lnb = p.in[I_RLNB];
    const int lane = tidx() & 63, w = tidx() >> 6;
    for (int t = blockIdx.x * 8 + w; t < TL; t += gridDim.x * 8) {
        const int b = t >> 12, s = t & 4095; const size_t row = (size_t)b * LT + LC + s; const int c = lane * 16; const int hd = lane >> 2;
        float y[16], vv[16], gv[16];
#pragma unroll
        for (int q = 0; q < 2; ++q) {
            const uint4 a = *(const uint4*)(yf + row * DM + c + 8 * q), bq = *(const uint4*)(yb + row * DM + c + 8 * q), v4 = *(const uint4*)(vg + row * DM + c + 8 * q), g4 = *(const uint4*)(gg + row * DM + c + 8 * q);
            y[8 * q + 0] = bf_lo(a.x) + bf_lo(bq.x); y[8 * q + 1] = bf_hi(a.x) + bf_hi(bq.x); y[8 * q + 2] = bf_lo(a.y) + bf_lo(bq.y); y[8 * q + 3] = bf_hi(a.y) + bf_hi(bq.y);
            y[8 * q + 4] = bf_lo(a.z) + bf_lo(bq.z); y[8 * q + 5] = bf_hi(a.z) + bf_hi(bq.z); y[8 * q + 6] = bf_lo(a.w) + bf_lo(bq.w); y[8 * q + 7] = bf_hi(a.w) + bf_hi(bq.w);
            vv[8 * q + 0] = bf_lo(v4.x); vv[8 * q + 1] = bf_hi(v4.x); vv[8 * q + 2] = bf_lo(v4.y); vv[8 * q + 3] = bf_hi(v4.y); vv[8 * q + 4] = bf_lo(v4.z); vv[8 * q + 5] = bf_hi(v4.z); vv[8 * q + 6] = bf_lo(v4.w); vv[8 * q + 7] = bf_hi(v4.w);
            gv[8 * q + 0] = bf_lo(g4.x); gv[8 * q + 1] = bf_hi(g4.x); gv[8 * q + 2] = bf_lo(g4.y); gv[8 * q + 3] = bf_hi(g4.y); gv[8 * q + 4] = bf_lo(g4.z); gv[8 * q + 5] = bf_hi(g4.z); gv[8 * q + 6] = bf_lo(g4.w); gv[8 * q + 7] = bf_hi(g4.w);
        }
        float sm = 0.f;
#pragma unroll
        for (int i = 0; i < 16; ++i) sm += y[i];
        sm = red4_sum(sm); const float mean = sm * (1.f / 64.f);
        float vs = 0.f;
#pragma unroll
        for (int i = 0; i < 16; ++i) { const float d = y[i] - mean; vs += d * d; }
        vs = red4_sum(vs); const float rstd = rsqrtf(vs * (1.f / 64.f) + 64e-5f);
        const float bon = rkb[row * 16 + hd] + rkb[(size_t)T0 * 16 + row * 16 + hd];
        unsigned ow[8];
#pragma unroll
        for (int i = 0; i < 8; ++i) {
            const int c0 = c + 2 * i;
            const float o0 = ((y[2 * i] - mean) * rstd * lnw[c0] + lnb[c0] + bon * vv[2 * i]) * gv[2 * i];
            const float o1 = ((y[2 * i + 1] - mean) * rstd * lnw[c0 + 1] + lnb[c0 + 1] + bon * vv[2 * i + 1]) * gv[2 * i + 1];
            ow[i] = pack2(o0, o1);
        }
        *(uint4*)(rd + (size_t)t * DM + c) = make_uint4(ow[0], ow[1], ow[2], ow[3]); *(uint4*)(rd + (size_t)t * DM + c + 8) = make_uint4(ow[4], ow[5], ow[6], ow[7]);
    }
}
DEVI void phase_final_norm(const Params& p) {
    const float* g = p.in[I_NFIN]; float* X = p.out;
    const int lane = tidx() & 63, w = tidx() >> 6;
    for (int r = blockIdx.x * 8 + w; r < TL; r += gridDim.x * 8) {
        float4* xr = (float4*)(X + (size_t)r * DM); float4 v[4]; float ss = 0.f;
#pragma unroll
        for (int i = 0; i < 4; ++i) { v[i] = xr[lane + 64 * i]; ss += v[i].x * v[i].x + v[i].y * v[i].y + v[i].z * v[i].z + v[i].w * v[i].w; }
        ss = wave_sum(ss); const float rs = rsqrtf(ss * (1.f / 1024.f) + 1e-6f);
#pragma unroll
        for (int i = 0; i < 4; ++i) { const float4 gg = ((const float4*)g)[lane + 64 * i]; float4 o; o.x = v[i].x * rs * gg.x; o.y = v[i].y * rs * gg.y; o.z = v[i].z * rs * gg.z; o.w = v[i].w * rs * gg.w; xr[lane + 64 * i] = o; }
    }
}

constexpr int N_PHASES = 32;
template <int PH> DEVI void run_phase(const Params& p, char* lds) {
    const float* mods = (const float*)(p.ws + OFF_MODS);
    RowSrc in_src; in_src.ctx = p.in[I_CTX]; in_src.lat = p.in[I_X];
    RowSrc x_src; x_src.ctx = (const float*)(p.ws + OFF_XC); x_src.lat = p.out;
    if constexpr (PH == 0) phase_prologue(p, lds);
    else if constexpr (PH == 1) norm_rows(in_src, 0, T0, p.in[I_NMIX], mods, 0, 1, (u16*)(p.ws + A_N0));
    else if constexpr (PH == 2) phase_gemm_win(p, lds);
    else if constexpr (PH == 3) phase_gemm_qkv(p, lds);
    else if constexpr (PH == 4) { phase_attention(p, lds); conv_jobs(p, 25, 28, 0, 0, lds); }
    else if constexpr (PH == 5) phase_gemm_wo(p, (const u16*)(p.ws + A_N0), (const u16*)(p.ws + W_OA), in_src, 0, 0, lds);
    else if constexpr (PH == 6) phase_moe_norm(p, 0);
    else if constexpr (PH == 7) phase_moe_route(p, 0, lds);
    else if constexpr (PH == 8) phase_moe_gemm1(p, 0, lds);
    else if constexpr (PH >= 9 && PH <= 13) phase_moe_g2c(p, 0, PH - 9 < NCHUNK ? PH - 9 : -1, PH - 10, lds);
    else if constexpr (PH == 14) norm_rows(x_src, 0, T0, p.in[I_NMIX] + 1024, mods + 9 * 6144, 0, 1, (u16*)(p.ws + R_NN));
    else if constexpr (PH == 15) phase_rwkv_mix(p, 0, 2, 3);
    else if constexpr (PH == 16) phase_rwkv_gemm_rkv(p, lds);
    else if constexpr (PH == 17) phase_rwkv_mix(p, 1, 4, 5);
    else if constexpr (PH == 18) phase_rwkv_gemm_small(p, lds);
    else if constexpr (PH == 19) phase_rwkv_gemm_g(p, lds);
    else if constexpr (PH == 20) phase_rwkv_scan(p, lds);
    else if constexpr (PH == 21) phase_rwkv_readout(p);
    else if constexpr (PH == 22) { phase_gemm_wo(p, (const u16*)(p.ws + R_RD), (const u16*)(p.ws + W_RO), x_src, 1, 1, lds); conv_jobs(p, 25, 28, 1, 0, lds); }
    else if constexpr (PH == 23) phase_moe_norm(p, 1);
    else if constexpr (PH == 24) phase_moe_route(p, 1, lds);
    else if constexpr (PH == 25) phase_moe_gemm1(p, 1, lds);
    else if constexpr (PH >= 26 && PH <= 30) phase_moe_g2c(p, 1, PH - 26 < NCHUNK ? PH - 26 : -1, PH - 27, lds);
    else if constexpr (PH == 31) phase_final_norm(p);
}

#if MEGA
template <int PH, int END> DEVI void run_range(const Params& p_, char* lds, const XcdBarrier& bar) {
    const Params& p = *(const Params*)__builtin_amdgcn_kernarg_segment_ptr();
    run_phase<PH>(p, lds);
    if constexpr (PH + 1 < END) { xcd_barrier(bar); run_range<PH + 1, END>(p_, lds, bar); }
}
template <int A, int B> __global__ void __launch_bounds__(512, 2) k_range(Params p, unsigned* barw) {
    extern __shared__ __attribute__((aligned(16))) char smem[];
    if (threadIdx.x == 0) *(uint4*)smem = make_uint4(0u, 0u, 0u, 0u);
    __syncthreads();
    const XcdBarrier bar = xcd_barrier_post(barw, (volatile LAS unsigned*)smem);
    run_range<A, B>(p, smem + 64, bar);
}
template <int A, int B> static void launch_range(const Params& p, unsigned* barw, hipStream_t s) {
    static int grid = 0;
    if (!grid) {
        int dev = 0, cus = 0, per_cu = 0;
        (void)hipGetDevice(&dev);
        (void)hipDeviceGetAttribute(&cus, hipDeviceAttributeMultiprocessorCount, dev);
        (void)hipFuncSetAttribute((const void*)k_range<A, B>, hipFuncAttributeMaxDynamicSharedMemorySize, LDS_BYTES);
        (void)hipOccupancyMaxActiveBlocksPerMultiprocessor(&per_cu, (const void*)k_range<A, B>, 512, LDS_BYTES);
        if (per_cu < 1) fprintf(stderr, "occupancy query says 0 blocks per CU\n");
        grid = cus;
    }
    k_range<A, B><<<grid, 512, LDS_BYTES, s>>>(p, barw);
}
extern "C" void kernel_launch(void* const* d_in, const int* in_sizes, int n_in, void* d_out, int out_size, void* d_ws, size_t ws_size, hipStream_t stream) {
    Params p{};
    for (int i = 0; i < N_IN; ++i) p.in[i] = (const float*)d_in[i];
    p.out = (float*)d_out; p.ws = (char*)d_ws;
    if (ws_size < WS_NEED) { fprintf(stderr, "workspace too small\n"); return; }
    (void)hipMemsetAsync(p.ws + OFF_BAR, 0, XCD_BAR_WORDS * sizeof(unsigned), stream);
    launch_range<0, N_PHASES>(p, (unsigned*)(p.ws + OFF_BAR), stream);
}
#else
template <int PH> __global__ void __launch_bounds__(512, 2) k_phase(Params p) {
    extern __shared__ __attribute__((aligned(16))) char smem[];
    run_phase<PH>(p, smem + 64);
}
template <int PH> static void launch_phase(const Params& p, hipStream_t s) {
    static bool attr = false;
    if (!attr) { hipFuncSetAttribute((const void*)k_phase<PH>, hipFuncAttributeMaxDynamicSharedMemorySize, LDS_BYTES); attr = true; }
    k_phase<PH><<<256, 512, LDS_BYTES, s>>>(p);
}
template <int PH> static void launch_all(const Params& p, hipStream_t s) {
    launch_phase<PH>(p, s);
    if constexpr (PH + 1 < N_PHASES) launch_all<PH + 1>(p, s);
}

extern "C" void kernel_launch(void* const* d_in, const int* in_sizes, int n_in, void* d_out, int out_size, void* d_ws, size_t ws_size, hipStream_t stream) {
    Params p{};
    for (int i = 0; i < N_IN; ++i) p.in[i] = (const float*)d_in[i];
    p.out = (float*)d_out; p.ws = (char*)d_ws;
    if (ws_size < WS_NEED) { fprintf(stderr, "workspace too small: %zu < %zu\n", ws_size, (size_t)WS_NEED); return; }
    launch_all<0>(p, stream);
}
#endif
```

```cpp
#include <hip/hip_runtime.h>
#include <stdint.h>
#include <stdio.h>
#include <type_traits>

#ifndef MEGA
#define MEGA 1
#endif

typedef unsigned short u16;
typedef short bf16x8 __attribute__((ext_vector_type(8)));
typedef short s16x4 __attribute__((ext_vector_type(4)));
typedef float f32x16 __attribute__((ext_vector_type(16)));
typedef float f32x4 __attribute__((ext_vector_type(4)));
typedef float f32x2 __attribute__((ext_vector_type(2)));
typedef unsigned u32x4 __attribute__((ext_vector_type(4)));
typedef __bf16 bf2 __attribute__((ext_vector_type(2)));
#define DEVI __device__ __forceinline__
#define LAS __attribute__((address_space(3)))
__device__ __forceinline__ int tidx() { int t = threadIdx.x; asm volatile("" : "+v"(t)); return t; }

constexpr int NB = 8, SEQ = 4096, LC = 256, LT = 4352, DM = 1024, T0 = NB * LT, TL = NB * SEQ;
constexpr int NCHUNK = 4;
constexpr float LOG2E = 1.4426950408889634f;
constexpr float QA_SCALE = 0.07216878364870322f * LOG2E;
constexpr float QS_SCALE = 0.125f * LOG2E;

enum { I_X = 0, I_C, I_CTX, I_CCTX, I_ADAW, I_ADAB, I_NMIX, I_NFFN, I_NFIN, I_AWIN, I_AQN, I_AKVN, I_AWUQ, I_AWUKV, I_ASINK, I_AWO,
       I_RMU, I_RWR, I_RWK, I_RWV, I_RWO, I_RG1, I_RG2, I_RW0, I_RW1, I_RW2, I_RA0, I_RA1, I_RA2, I_RKK, I_RKA, I_RRK, I_RLNW, I_RLNB,
       I_MROUT, I_MBIAS, I_MWG, I_MWU, I_MWD, I_MSG, I_MSU, I_MSD, N_IN };

struct Params { const float* in[N_IN]; float* out; char* ws; };

constexpr size_t OFF_BAR = 0, OFF_CNT = 16384, OFF_ROPE = 20480, OFF_MODS = 32768, OFF_WSTAT = 524288;
constexpr size_t W_IN = OFF_WSTAT, W_UQ = W_IN + 3145728, W_UK = W_UQ + 589824, W_UV = W_UK + 262144, W_OA = W_UV + 262144,
                 W_RR = W_OA + 2097152, W_RK = W_RR + 2097152, W_RV = W_RK + 2097152, W_RO = W_RV + 2097152,
                 W_G1 = W_RO + 2097152, W_W1 = W_G1 + 262144, W_A1 = W_W1 + 262144, W_G2 = W_A1 + 262144, W_W2 = W_G2 + 262144, W_A2 = W_W2 + 262144,
                 W_SGU = W_A2 + 262144, W_SD = W_SGU + 2 * 1048576, W_END = W_SD + 2 * 524288;
constexpr size_t OFF_XC = OFF_WSTAT + 20971520;
constexpr size_t OFF_TOKE = OFF_XC + 8388608, OFF_TOKR = OFF_TOKE + 835584, OFF_LTOK = OFF_TOKR + 835584, OFF_LG = OFF_LTOK + 8912896;
constexpr size_t OFF_WROUT = OFF_LG + 8912896;
constexpr size_t OFF_D = OFF_XC + 8388608 + 20971520;
static_assert(OFF_WROUT + 2 * 64 * 3072 * 2 <= OFF_D, "router weights overflow");
constexpr size_t WGU_BYTES = 64ull * 512 * 1024 * 2, WD_BYTES = 64ull * 1024 * 256 * 2;
constexpr size_t OFF_WGU = OFF_D, OFF_WD = OFF_D + WGU_BYTES;
constexpr size_t OFF_G = OFF_D + WGU_BYTES + WD_BYTES;
constexpr size_t SZ_T0D = (size_t)T0 * 1024 * 2;
constexpr size_t A_N0 = OFF_G, A_CQ = A_N0 + SZ_T0D, A_CKV = A_CQ + (size_t)T0 * 384 * 2, A_QA = A_CKV + (size_t)T0 * 256 * 2, A_KA = A_QA + (size_t)T0 * 768 * 2,
                 A_VA = A_KA + (size_t)T0 * 768 * 2, A_QS = A_VA + (size_t)T0 * 512 * 2, A_KS = A_QS + (size_t)T0 * 512 * 2, A_VS = A_KS + (size_t)T0 * 128 * 2, A_END = A_VS + (size_t)T0 * 128 * 2;
constexpr size_t M_N1 = OFF_G, M_ACT = M_N1 + SZ_T0D, M_OUTR = M_ACT + (size_t)7 * T0 * 256 * 2, SZ_OUTR = (size_t)7 * 8704 * 1024 * 2, M_END = M_OUTR + 2 * SZ_OUTR;
constexpr size_t R_XM0 = OFF_D, R_XM1 = R_XM0 + SZ_T0D, R_XM2 = R_XM1 + SZ_T0D, R_RR = R_XM2 + SZ_T0D, R_RK = R_RR + SZ_T0D, R_RV = R_RK + SZ_T0D, R_NN = R_RV + SZ_T0D,
                 R_HG = R_NN + SZ_T0D, R_HW = R_HG + (size_t)T0 * 128 * 2, R_HA = R_HW + (size_t)T0 * 128 * 2, R_RKB = R_HA + (size_t)T0 * 128 * 2, R_END = R_RKB + (size_t)2 * T0 * 16 * 4;
constexpr size_t R_GG = R_XM0, R_YF = R_XM1, R_YB = R_XM2, R_RD = R_NN;
constexpr size_t WS_NEED = R_END > M_END ? R_END : M_END;

constexpr int LDS_BYTES = 64 + 131072;

DEVI unsigned pack2(float a, float b) { f32x2 v = {a, b}; bf2 r = __builtin_convertvector(v, bf2); return __builtin_bit_cast(unsigned, r); }
DEVI float bf_lo(unsigned u) { return __builtin_bit_cast(float, u << 16); }
DEVI float bf_hi(unsigned u) { return __builtin_bit_cast(float, u & 0xffff0000u); }
DEVI float bf1(u16 u) { return __builtin_bit_cast(float, ((unsigned)u) << 16); }
DEVI float dppf(float x, const int ctrl_sel) {
    int xi = __builtin_bit_cast(int, x), y;
    if (ctrl_sel == 0) y = __builtin_amdgcn_mov_dpp(xi, 0xB1, 0xF, 0xF, true);
    else if (ctrl_sel == 1) y = __builtin_amdgcn_mov_dpp(xi, 0x4E, 0xF, 0xF, true);
    else y = __builtin_amdgcn_mov_dpp(xi, 0x141, 0xF, 0xF, true);
    return __builtin_bit_cast(float, y);
}
DEVI float red8_sum(float x) { x += dppf(x, 0); x += dppf(x, 1); x += dppf(x, 2); return x; }
DEVI float red8_max(float x) { x = fmaxf(x, dppf(x, 0)); x = fmaxf(x, dppf(x, 1)); x = fmaxf(x, dppf(x, 2)); return x; }
DEVI float red4_sum(float x) { x += dppf(x, 0); x += dppf(x, 1); return x; }
DEVI float wave_sum(float x) { for (int o = 32; o > 0; o >>= 1) x += __shfl_xor(x, o); return x; }
DEVI float wave_max(float x) { for (int o = 32; o > 0; o >>= 1) x = fmaxf(x, __shfl_xor(x, o)); return x; }
DEVI float xhalf(float x) {
    int l = (int)__builtin_amdgcn_mbcnt_hi(~0u, __builtin_amdgcn_mbcnt_lo(~0u, 0u)); asm volatile("" : "+v"(l));
    return __builtin_bit_cast(float, __builtin_amdgcn_ds_bpermute((l ^ 32) << 2, __builtin_bit_cast(int, x)));
}
DEVI void lds_barrier() { asm volatile("s_waitcnt lgkmcnt(0)\n\ts_barrier" ::: "memory"); }
DEVI float sigmoidf_(float x) { return 1.f / (1.f + __expf(-x)); }
DEVI float siluf_(float x) { return x / (1.f + __expf(-x)); }
DEVI float tanhf_(float x) { float e = __expf(2.f * x); return 1.f - 2.f / (e + 1.f); }

#define XB_TMO      128
#define XB_XCNT(j)  (256  + 64 * (j))
#define XB_XSUB(j)  (1280 + 64 * (j))
#define XB_XGEN(j)  (2304 + 64 * (j))
#define XB_TOP      3328
#define XB_TOPGEN   3392
#define XCD_BAR_WORDS 3456
#define XB_SPIN_CAP (1u << 20)
DEVI unsigned xb_ld(unsigned* p)              { return __hip_atomic_load(p, __ATOMIC_RELAXED, __HIP_MEMORY_SCOPE_AGENT); }
DEVI unsigned xb_add(unsigned* p, unsigned v) { return __hip_atomic_fetch_add(p, v, __ATOMIC_RELAXED, __HIP_MEMORY_SCOPE_AGENT); }
DEVI unsigned xb_xcc_id() { return (unsigned)__builtin_amdgcn_s_getreg((3 << 11) | 20) & 0xFu; }
#define XB_SPIN(cond, bar) do { unsigned _sp = 0; while (cond) { __builtin_amdgcn_s_sleep(1); \
    if ((++_sp & 255u) == 0u) { if (xb_ld(&(bar)[XB_TMO])) break; if (_sp > XB_SPIN_CAP) { atomicAdd(&(bar)[XB_TMO], 1u); break; } } } } while (0)
struct XcdBarrier { unsigned* bar; unsigned x; volatile LAS unsigned* st; };
DEVI XcdBarrier xcd_barrier_post(unsigned* bar, volatile LAS unsigned* st) {
    XcdBarrier b; b.bar = bar; b.x = xb_xcc_id(); b.st = st;
    if (threadIdx.x == 0) (void)xb_add(&bar[XB_XCNT(b.x)], 1u);
    return b;
}
DEVI void xcd_barrier_complete(unsigned* bar, unsigned x, unsigned& nloc, unsigned& nx) {
    const unsigned G = gridDim.x * gridDim.y * gridDim.z;
    unsigned sum, cnt, mine, sp = 0u;
    for (;;) {
        sum = 0u; cnt = 0u; mine = 0u;
#pragma unroll
        for (unsigned j = 0; j < 16; ++j) { const unsigned c = xb_ld(&bar[XB_XCNT(j)]); sum += c; cnt += (c > 0u) ? 1u : 0u; mine = (j == x) ? c : mine; }
        if (sum == G) break;
        __builtin_amdgcn_s_sleep(1);
        if ((++sp & 255u) == 0u) { if (xb_ld(&bar[XB_TMO])) break; if (sp > XB_SPIN_CAP) { atomicAdd(&bar[XB_TMO], 1u); break; } }
    }
    nloc = mine > 0u ? mine : 1u; nx = cnt > 0u ? cnt : 1u;
}
DEVI void xcd_barrier(const XcdBarrier& b) {
    asm volatile("s_waitcnt vmcnt(0)" ::: "memory");
    __syncthreads();
    if (threadIdx.x == 0) {
        unsigned* bar = b.bar;
        __builtin_amdgcn_s_waitcnt(0);
        unsigned nloc = b.st[0], nx = b.st[1];
        if (nloc == 0u) { xcd_barrier_complete(bar, b.x, nloc, nx); b.st[0] = nloc; b.st[1] = nx; }
        const unsigned old = xb_add(&bar[XB_XSUB(b.x)], 1u);
        const unsigned gen = old / nloc;
        if (old + 1u == (gen + 1u) * nloc) {
            __builtin_amdgcn_fence(__ATOMIC_RELEASE, "agent");
            asm volatile("s_waitcnt vmcnt(0)" ::: "memory");
            const unsigned og = xb_add(&bar[XB_TOP], 1u);
            const unsigned tg = og / nx;
            if (og + 1u == (tg + 1u) * nx) xb_add(&bar[XB_TOPGEN], 1u);
            else XB_SPIN(xb_ld(&bar[XB_TOPGEN]) == tg, bar);
            __builtin_amdgcn_fence(__ATOMIC_ACQUIRE, "agent");
            xb_add(&bar[XB_XGEN(b.x)], 1u);
            asm volatile("s_waitcnt vmcnt(0)" ::: "memory");
        } else {
            XB_SPIN(xb_ld(&bar[XB_XGEN(b.x)]) == gen, bar);
            __builtin_amdgcn_fence(__ATOMIC_ACQUIRE, "agent");
            asm volatile("s_waitcnt vmcnt(0)" ::: "memory");
        }
    }
    __syncthreads();
}

DEVI int swz(int u) { return (u & ~255) | ((u & 7) << 5) | ((u >> 3) & 31); }
struct RowSrc { const float* ctx; const float* lat; };
DEVI const float* row_ptr(const RowSrc& s, int mode, int r, int& bb) {
    if (mode == 0) { int b = r / LT, pp = r - b * LT; if (pp < LC) { bb = 8; return s.ctx + (size_t)(b * LC + pp) * DM; } bb = b; return s.lat + (size_t)(b * SEQ + pp - LC) * DM; }
    bb = r >> 12; return s.lat + (size_t)r * DM;
}
DEVI float* row_ptr_w(float* ctx, float* lat, int mode, int r, int& bb) {
    if (mode == 0) { int b = r / LT, pp = r - b * LT; if (pp < LC) { bb = 8; return ctx + (size_t)(b * LC + pp) * DM; } bb = b; return lat + (size_t)(b * SEQ + pp - LC) * DM; }
    bb = r >> 12; return lat + (size_t)r * DM;
}

DEVI float sumsq8(const bf16x8& v) {
    float s = 0.f;
    const unsigned* u = (const unsigned*)&v;
#pragma unroll
    for (int i = 0; i < 4; ++i) { bf2 b = __builtin_bit_cast(bf2, u[i]); s = __builtin_amdgcn_fdot2_f32_bf16(b, b, s, false); }
    return s;
}
template <int NA, int NBC> struct GemmRegs { u32x4 ra[2][NA], rb[2][NBC]; };
template <int BM, int BN, bool ROWNORM, class ARow, class ARowN, class XF, class ST>
DEVI void gemm_tile(GemmRegs<BM / 64, BN / 64>& R, bool primed, ARow arow, const u16* __restrict__ Bt, ARowN arow_n, const u16* __restrict__ Bt_n, int ldb, int K, XF xf, ST st, char* lds) {
    constexpr int WN = BN / 64, NA = BM / 64, NBC = BN / 64, STR = 72;
    const int tid = tidx(), lane = tid & 63, w = tid >> 6, wm = w / WN, wn = w % WN, l31 = lane & 31, h = lane >> 5;
    u16* sA = (u16*)lds; u16* sB = sA + 2 * BM * STR;
    const int crow = tid >> 3, kc = tid & 7;
    const u16* pa[NA]; const u16* pb[NBC]; const u16* pan[NA]; const u16* pbn[NBC];
#pragma unroll
    for (int i = 0; i < NA; ++i) { pa[i] = arow(crow + 64 * i) + kc * 8; pan[i] = pa[i]; }
#pragma unroll
    for (int i = 0; i < NBC; ++i) { pb[i] = Bt + (size_t)(crow + 64 * i) * ldb + kc * 8; pbn[i] = pb[i]; }
    const bool chain = Bt_n != nullptr;
    if (chain) {
#pragma unroll
        for (int i = 0; i < NA; ++i) pan[i] = arow_n(crow + 64 * i) + kc * 8;
#pragma unroll
        for (int i = 0; i < NBC; ++i) pbn[i] = Bt_n + (size_t)(crow + 64 * i) * ldb + kc * 8;
    }
    const int nk = K >> 6;
    auto load_tile = [&](int g, auto setc) {
        constexpr int set = decltype(setc)::value;
        if (g < nk) {
#pragma unroll
            for (int i = 0; i < NA; ++i) R.ra[set][i] = *(const u32x4*)(pa[i] + g * 64);
#pragma unroll
            for (int i = 0; i < NBC; ++i) R.rb[set][i] = *(const u32x4*)(pb[i] + g * 64);
        } else if (chain && g < nk + 2) {
#pragma unroll
            for (int i = 0; i < NA; ++i) R.ra[set][i] = *(const u32x4*)(pan[i] + (g - nk) * 64);
#pragma unroll
            for (int i = 0; i < NBC; ++i) R.rb[set][i] = *(const u32x4*)(pbn[i] + (g - nk) * 64);
        }
    };
    using I0 = std::integral_constant<int, 0>; using I1 = std::integral_constant<int, 1>;
    if (!primed) { load_tile(0, I0{}); load_tile(1, I1{}); }
    f32x16 acc[2][2];
#pragma unroll
    for (int a = 0; a < 2; ++a)
#pragma unroll
        for (int b = 0; b < 2; ++b)
#pragma unroll
            for (int i = 0; i < 16; ++i) acc[a][b][i] = 0.f;
    float ss[2] = {0.f, 0.f};
#pragma unroll
    for (int i = 0; i < NA; ++i) *(u32x4*)(sA + (crow + 64 * i) * STR + kc * 8) = R.ra[0][i];
#pragma unroll
    for (int i = 0; i < NBC; ++i) *(u32x4*)(sB + (crow + 64 * i) * STR + kc * 8) = R.rb[0][i];
    lds_barrier();
    load_tile(2, I0{});
    auto ktile = [&](int kt, auto curc) {
        constexpr int cur = decltype(curc)::value, nxt = cur ^ 1;
        const u16* a_ = sA + cur * BM * STR; const u16* b_ = sB + cur * BN * STR;
        u16* an = sA + nxt * BM * STR; u16* bn = sB + nxt * BN * STR;
#pragma unroll
        for (int ks = 0; ks < 4; ++ks) {
            bf16x8 af[2], bfr[2];
#pragma unroll
            for (int mi = 0; mi < 2; ++mi) af[mi] = *(const bf16x8*)(a_ + (wm * 64 + mi * 32 + l31) * STR + ks * 16 + h * 8);
#pragma unroll
            for (int ni = 0; ni < 2; ++ni) bfr[ni] = *(const bf16x8*)(b_ + (wn * 64 + ni * 32 + l31) * STR + ks * 16 + h * 8);
            if (ROWNORM) { ss[0] += sumsq8(af[0]); ss[1] += sumsq8(af[1]); }
#pragma unroll
            for (int mi = 0; mi < 2; ++mi)
#pragma unroll
                for (int ni = 0; ni < 2; ++ni) acc[mi][ni] = __builtin_amdgcn_mfma_f32_32x32x16_bf16(bfr[ni], af[mi], acc[mi][ni], 0, 0, 0);
            if (ks == 1 && kt + 1 < nk) {
#pragma unroll
                for (int i = 0; i < NA; ++i) *(u32x4*)(an + (crow + 64 * i) * STR + kc * 8) = R.ra[nxt][i];
#pragma unroll
                for (int i = 0; i < NBC; ++i) *(u32x4*)(bn + (crow + 64 * i) * STR + kc * 8) = R.rb[nxt][i];
            }
        }
        lds_barrier();
        load_tile(kt + 3, std::integral_constant<int, nxt>{});
    };
    for (int kt = 0; kt < nk; kt += 2) { ktile(kt, I0{}); ktile(kt + 1, I1{}); }
    if (ROWNORM) {
#pragma unroll
        for (int mi = 0; mi < 2; ++mi) {
            float s = ss[mi] + __shfl_xor(ss[mi], 32);
            float r = rsqrtf(s / (float)K + 1e-6f);
#pragma unroll
            for (int ni = 0; ni < 2; ++ni)
#pragma unroll
                for (int i = 0; i < 16; ++i) acc[mi][ni][i] *= r;
        }
    }
    constexpr int TS = BN + 4;
    u16* sT = (u16*)lds;
    lds_barrier();
#pragma unroll
    for (int mi = 0; mi < 2; ++mi) {
        const int r = wm * 64 + mi * 32 + l31;
        xf(r, wn * 64, acc[mi], h);
#pragma unroll
        for (int ni = 0; ni < 2; ++ni)
#pragma unroll
            for (int g = 0; g < 4; ++g) { uint2 v; v.x = pack2(acc[mi][ni][4 * g], acc[mi][ni][4 * g + 1]); v.y = pack2(acc[mi][ni][4 * g + 2], acc[mi][ni][4 * g + 3]);
                *(uint2*)(sT + r * TS + wn * 64 + ni * 32 + 8 * g + 4 * h) = v; }
    }
    lds_barrier();
#pragma unroll 2
    for (int q = tid; q < BM * BN / 8; q += 512) {
        const int r = q / (BN / 8), c8 = (q % (BN / 8)) * 8;
        const uint2 lo = *(const uint2*)(sT + r * TS + c8), hi = *(const uint2*)(sT + r * TS + c8 + 4);
        u32x4 v = {lo.x, lo.y, hi.x, hi.y};
        st(r, c8, v);
    }
    lds_barrier();
}
DEVI void store_tile_bf16(u16* dst, const f32x16& t, int h) {
#pragma unroll
    for (int g = 0; g < 4; ++g) { uint2 v; v.x = pack2(t[4 * g], t[4 * g + 1]); v.y = pack2(t[4 * g + 2], t[4 * g + 3]); *(uint2*)(dst + 8 * g + 4 * h) = v; }
}
DEVI void rope_tile(f32x16& t, int axis, int pp, int h, const float2* __restrict__ tab) {
    if (pp < LC) return;
    const int s = pp - LC; const int coord = axis ? (s & 63) : (s >> 6);
#pragma unroll
    for (int g = 0; g < 2; ++g)
#pragma unroll
        for (int i = 0; i < 4; ++i) {
            const float2 cs = tab[coord * 16 + 8 * g + 4 * h + i];
            const float x1 = t[4 * g + i], x2 = t[4 * (g + 2) + i];
            t[4 * g + i] = x1 * cs.x - x2 * cs.y; t[4 * (g + 2) + i] = x2 * cs.x + x1 * cs.y;
        }
}

struct CJob { const float* src; u16* dst; const float* gain; int K, ldsrc, nlog, nvalid, sseg, sstride, soff, dseg, dstride, doff; int nmat; size_t smat, dmat; };
DEVI void get_job(const Params& p, int j, int layer, CJob& J) {
    char* ws = p.ws;
    J.gain = nullptr; J.nmat = 1; J.smat = 0; J.dmat = 0; J.sseg = 1 << 30; J.sstride = 0; J.soff = 0; J.dseg = 1 << 30; J.dstride = 0; J.doff = 0;
    auto plain = [&](const float* src, size_t dstoff, int K, int N) { J.src = src; J.dst = (u16*)(ws + dstoff); J.K = K; J.ldsrc = N; J.nlog = N; J.nvalid = N; };
    switch (j) {
    case 0: plain(p.in[I_AWIN], W_IN, 1024, 1472); J.nlog = 1536; break;
    case 1: plain(p.in[I_AWUQ], W_UQ, 384, 768); J.gain = p.in[I_AQN]; break;
    case 2: plain(p.in[I_AWUKV], W_UK, 256, 1024); J.nlog = 512; J.nvalid = 512; J.sseg = 128; J.sstride = 256; J.soff = 0; J.gain = p.in[I_AKVN]; break;
    case 3: plain(p.in[I_AWUKV], W_UV, 256, 1024); J.nlog = 512; J.nvalid = 512; J.sseg = 128; J.sstride = 256; J.soff = 128; J.gain = p.in[I_AKVN]; break;
    case 4: plain(p.in[I_AWO], W_OA, 1024, 1024); break;
    case 5: plain(p.in[I_RWR], W_RR, 1024, 1024); break;
    case 6: plain(p.in[I_RWK], W_RK, 1024, 1024); break;
    case 7: plain(p.in[I_RWV], W_RV, 1024, 1024); break;
    case 8: plain(p.in[I_RWO], W_RO, 1024, 1024); break;
    case 9: plain(p.in[I_RG1], W_G1, 1024, 128); break;
    case 10: plain(p.in[I_RW1], W_W1, 1024, 64); break;
    case 11: plain(p.in[I_RW1] + 1024 * 64, W_W1 + 64 * 1024 * 2, 1024, 64); break;
    case 12: plain(p.in[I_RA1], W_A1, 1024, 64); break;
    case 13: plain(p.in[I_RA1] + 1024 * 64, W_A1 + 64 * 1024 * 2, 1024, 64); break;
    case 14: plain(p.in[I_RG2], W_G2, 128, 1024); break;
    case 15: plain(p.in[I_RW2], W_W2, 64, 1024); break;
    case 16: plain(p.in[I_RW2] + 64 * 1024, W_W2 + 1024 * 64 * 2, 64, 1024); break;
    case 17: plain(p.in[I_RA2], W_A2, 64, 1024); break;
    case 18: plain(p.in[I_RA2] + 64 * 1024, W_A2 + 1024 * 64 * 2, 64, 1024); break;
    case 19: plain(p.in[I_MSG], W_SGU, 1024, 256); J.dseg = 32; J.dstride = 64; J.doff = 0; break;
    case 20: plain(p.in[I_MSU], W_SGU, 1024, 256); J.dseg = 32; J.dstride = 64; J.doff = 32; break;
    case 21: plain(p.in[I_MSG] + 1024 * 256, W_SGU + 1048576, 1024, 256); J.dseg = 32; J.dstride = 64; J.doff = 0; break;
    case 22: plain(p.in[I_MSU] + 1024 * 256, W_SGU + 1048576, 1024, 256); J.dseg = 32; J.dstride = 64; J.doff = 32; break;
    case 23: plain(p.in[I_MSD], W_SD, 256, 1024); break;
    case 24: plain(p.in[I_MSD] + 256 * 1024, W_SD + 524288, 256, 1024); break;
    case 25: plain(p.in[I_MWG] + (size_t)layer * 64 * 1024 * 256, OFF_WGU, 1024, 256); J.dseg = 32; J.dstride = 64; J.doff = 0; J.nmat = 64; J.smat = 1024 * 256; J.dmat = 512 * 1024; break;
    case 26: plain(p.in[I_MWU] + (size_t)layer * 64 * 1024 * 256, OFF_WGU, 1024, 256); J.dseg = 32; J.dstride = 64; J.doff = 32; J.nmat = 64; J.smat = 1024 * 256; J.dmat = 512 * 1024; break;
    default: plain(p.in[I_MWD] + (size_t)layer * 64 * 256 * 1024, OFF_WD, 256, 1024); J.nmat = 64; J.smat = 256 * 1024; J.dmat = 1024 * 256; break;
    }
}
DEVI int job_tiles(const CJob& J) { return J.nmat * (J.nlog / 64) * ((J.K + 127) / 128); }
DEVI void conv_tile(const CJob& J, int t, char* lds) {
    const int ktiles = (J.K + 127) / 128, ntiles = J.nlog / 64;
    const int mat = t / (ktiles * ntiles); const int r = t - mat * ktiles * ntiles; const int nt = r / ktiles, ktile = r - nt * ktiles;
    const float* src = J.src + (size_t)mat * J.smat; u16* dst = J.dst + (size_t)mat * J.dmat;
    unsigned* sm = (unsigned*)lds;
    const int tid = tidx(), ng = tid & 15, kp = tid >> 4;
    const int n0 = nt * 64 + ng * 4;
    const int scol = (n0 / J.sseg) * J.sstride + J.soff + (n0 % J.sseg);
    const bool nval = n0 < J.nvalid;
#pragma unroll
    for (int pass = 0; pass < 2; ++pass) {
        const int k = ktile * 128 + pass * 64 + kp * 2;
        float4 v0 = make_float4(0.f, 0.f, 0.f, 0.f), v1 = v0;
        if (nval && k < J.K) {
            v0 = *(const float4*)(src + (size_t)k * J.ldsrc + scol); v1 = *(const float4*)(src + (size_t)(k + 1) * J.ldsrc + scol);
            if (J.gain) { const float g0 = J.gain[k], g1 = J.gain[k + 1]; v0.x *= g0; v0.y *= g0; v0.z *= g0; v0.w *= g0; v1.x *= g1; v1.y *= g1; v1.z *= g1; v1.w *= g1; }
        }
        const int kk = pass * 32 + kp;
        sm[(ng * 4 + 0) * 66 + kk] = pack2(v0.x, v1.x); sm[(ng * 4 + 1) * 66 + kk] = pack2(v0.y, v1.y);
        sm[(ng * 4 + 2) * 66 + kk] = pack2(v0.z, v1.z); sm[(ng * 4 + 3) * 66 + kk] = pack2(v0.w, v1.w);
    }
    __syncthreads();
#pragma unroll
    for (int i = 0; i < 2; ++i) {
        const int c = tid + 512 * i, row = c >> 4, ch = c & 15;
        const int n = nt * 64 + row; const int drow = (n / J.dseg) * J.dstride + J.doff + (n % J.dseg);
        const int k = ktile * 128 + ch * 8;
        if (k < J.K) { uint2 lo = *(const uint2*)(sm + row * 66 + ch * 4), hi = *(const uint2*)(sm + row * 66 + ch * 4 + 2); uint4 v = make_uint4(lo.x, lo.y, hi.x, hi.y); *(uint4*)(dst + (size_t)drow * J.K + k) = v; }
    }
    __syncthreads();
}
DEVI void conv_jobs(const Params& p, int jlo, int jhi, int layer, int unit_base, char* lds) {
    const int G = gridDim.x, bid = blockIdx.x;
    int acc = unit_base;
    for (int j = jlo; j < jhi; ++j) {
        CJob J; get_job(p, j, layer, J); const int n = job_tiles(J);
        const int t0 = (bid - (acc % G) + G) % G;
        for (int t = t0; t < n; t += G) conv_tile(J, t, lds);
        acc += n;
    }
}
DEVI void mods_unit(const Params& p, int u, char* lds) {
    const int l = u / 96, cg = u % 96;
    float* sil = (float*)lds;
    float* red = sil + 1024 * 12;
    const int tid = tidx(), lane = tid & 63, w = tid >> 6;
    for (int i = tid; i < 9 * 1024; i += 512) { const int bb = i >> 10, k = i & 1023; const float v = bb < 8 ? p.in[I_C][bb * 1024 + k] : p.in[I_CCTX][k]; sil[k * 12 + bb] = siluf_(v); }
    __syncthreads();
    float acc[9];
#pragma unroll
    for (int i = 0; i < 9; ++i) acc[i] = 0.f;
    const float* wp = p.in[I_ADAW] + (size_t)l * 1024 * 6144 + cg * 64 + lane;
#pragma unroll 4
    for (int kk = 0; kk < 128; ++kk) {
        const int k = w * 128 + kk; const float wv = wp[(size_t)k * 6144];
        const float4 s0 = *(const float4*)(sil + k * 12), s1 = *(const float4*)(sil + k * 12 + 4); const float s2 = sil[k * 12 + 8];
        acc[0] += s0.x * wv; acc[1] += s0.y * wv; acc[2] += s0.z * wv; acc[3] += s0.w * wv; acc[4] += s1.x * wv; acc[5] += s1.y * wv; acc[6] += s1.z * wv; acc[7] += s1.w * wv; acc[8] += s2 * wv;
    }
#pragma unroll
    for (int i = 0; i < 9; ++i) red[(w * 9 + i) * 64 + lane] = acc[i];
    __syncthreads();
    for (int i = tid; i < 9 * 64; i += 512) {
        const int bb = i >> 6, c = i & 63; float s = 0.f;
        for (int ww = 0; ww < 8; ++ww) s += red[(ww * 9 + bb) * 64 + c];
        const int col = cg * 64 + c;
        ((float*)(p.ws + OFF_MODS))[(size_t)(l * 9 + bb) * 6144 + col] = s + p.in[I_ADAB][l * 6144 + col];
    }
    __syncthreads();
}
DEVI void phase_prologue(const Params& p, char* lds) {
    const int bid = blockIdx.x, G = gridDim.x;
    if (bid == G - 1) {
        int* cnt = (int*)(p.ws + OFF_CNT);
        for (int i = tidx(); i < 2 * NCHUNK * 64; i += 512) cnt[i] = 0;
        float2* tab = (float2*)(p.ws + OFF_ROPE);
        for (int i = tidx(); i < 64 * 16; i += 512) { const int coord = i >> 4, f = i & 15; const float inv = exp2f(-(float)f * (13.287712379549449f / 16.f)); const float a = (float)coord * inv; tab[i] = make_float2(cosf(a), sinf(a)); }
    }
    {
        u16* wro = (u16*)(p.ws + OFF_WROUT);
        for (int i = bid * 512 + tidx(); i < 2 * 1024 * 64; i += G * 512) {
            const int l = i >> 16, k = (i >> 6) & 1023, e = i & 63;
            const float wv = p.in[I_MROUT][i]; const u16 hi = (u16)pack2(wv, 0.f); const u16 lo = (u16)pack2(wv - bf1(hi), 0.f);
            u16* row = wro + ((size_t)l * 64 + e) * 3072; row[k] = hi; row[1024 + k] = hi; row[2048 + k] = lo;
        }
    }
    for (int u = bid; u < 192; u += G) mods_unit(p, u, lds);
    conv_jobs(p, 0, 25, 0, 192, lds);
}

DEVI void norm_rows(const RowSrc& src, int mode, int nrows, const float* __restrict__ gain, const float* __restrict__ mods_l, int ishift, int iscale, u16* __restrict__ dst) {
    const int lane = tidx() & 63, w = tidx() >> 6;
    for (int r = blockIdx.x * 8 + w; r < nrows; r += gridDim.x * 8) {
        int bb; const float* xr = row_ptr(src, mode, r, bb);
        float4 v[4]; float ss = 0.f;
#pragma unroll
        for (int i = 0; i < 4; ++i) { v[i] = ((const float4*)xr)[lane + 64 * i]; ss += v[i].x * v[i].x + v[i].y * v[i].y + v[i].z * v[i].z + v[i].w * v[i].w; }
        ss = wave_sum(ss);
        const float rs = rsqrtf(ss * (1.f / 1024.f) + 1e-6f);
        const float* msh = mods_l + (size_t)bb * 6144 + ishift * 1024; const float* msc = mods_l + (size_t)bb * 6144 + iscale * 1024;
#pragma unroll
        for (int i = 0; i < 4; ++i) {
            const int c = (lane + 64 * i) * 4;
            const float4 g = *(const float4*)(gain + c), sh = *(const float4*)(msh + c), sc = *(const float4*)(msc + c);
            uint2 o; o.x = pack2(v[i].x * rs * g.x * (1.f + sc.x) + sh.x, v[i].y * rs * g.y * (1.f + sc.y) + sh.y);
            o.y = pack2(v[i].z * rs * g.z * (1.f + sc.z) + sh.z, v[i].w * rs * g.w * (1.f + sc.w) + sh.w);
            *(uint2*)(dst + (size_t)r * DM + c) = o;
        }
    }
}

DEVI void phase_gemm_win(const Params& p, char* lds) {
    const u16* A = (const u16*)(p.ws + A_N0); const u16* W = (const u16*)(p.ws + W_IN);
    u16* CQ = (u16*)(p.ws + A_CQ); u16* CKV = (u16*)(p.ws + A_CKV); u16* KA = (u16*)(p.ws + A_KA); u16* QS = (u16*)(p.ws + A_QS); u16* KS = (u16*)(p.ws + A_KS); u16* VS = (u16*)(p.ws + A_VS);
    const float2* tab = (const float2*)(p.ws + OFF_ROPE);
    const int NT = 12, MT = T0 / 256;
    GemmRegs<4, 2> R; bool primed = false;
    for (int uu = blockIdx.x; uu < ((NT * MT + 255) & ~255); uu += gridDim.x) {
        const int u = swz(uu); if (u >= NT * MT) continue;
        const int mt = u / NT, nt = u % NT; const int m0 = mt * 256, n0 = nt * 128;
        const int un = (uu + (int)gridDim.x < ((NT * MT + 255) & ~255)) ? swz(uu + gridDim.x) : NT * MT; const bool hasn = un < NT * MT;
        const int m0n = (un / NT) * 256, n0n = (un % NT) * 128;
        auto arow = [&](int r) { return A + (size_t)(m0 + r) * DM; };
        auto arow_n = [&](int r) { return A + (size_t)(m0n + r) * DM; };
        auto xf = [&](int r, int cw, f32x16 (&t)[2], int h) {
            const int row = m0 + r; const int b = row / LT, pp = row - b * LT;
#pragma unroll
            for (int ni = 0; ni < 2; ++ni) {
                const int c32 = n0 + cw + ni * 32;
                if (c32 >= 640 && c32 < 1344) {
                    const int cc = c32 - 640; rope_tile(t[ni], (cc >> 5) & 1, pp, h, tab);
                    if (c32 >= 704 && c32 < 1216) {
#pragma unroll
                        for (int i = 0; i < 16; ++i) t[ni][i] *= QS_SCALE;
                    }
                }
            }
        };
        auto st = [&](int r, int c8, u32x4 v) {
            const int row = m0 + r; const int b = row / LT, pp = row - b * LT; const int c = n0 + c8;
            if (c < 384) *(u32x4*)(CQ + (size_t)row * 384 + c) = v;
            else if (c < 640) *(u32x4*)(CKV + (size_t)row * 256 + (c - 384)) = v;
            else if (c < 704) { for (int hd = 0; hd < 4; ++hd) *(u32x4*)(KA + ((size_t)(b * 4 + hd) * LT + pp) * 192 + 128 + (c - 640)) = v; }
            else if (c < 1216) { const int cc = c - 704; *(u32x4*)(QS + ((size_t)(b * 8 + (cc >> 6)) * LT + pp) * 64 + (cc & 63)) = v; }
            else if (c < 1344) { const int cc = c - 1216; *(u32x4*)(KS + ((size_t)(b * 2 + (cc >> 6)) * LT + pp) * 64 + (cc & 63)) = v; }
            else if (c < 1472) { const int cc = c - 1344; *(u32x4*)(VS + ((size_t)(b * 2 + (cc >> 6)) * LT + pp) * 64 + (cc & 63)) = v; }
        };
        gemm_tile<256, 128, false>(R, primed, arow, W + (size_t)n0 * DM, arow_n, hasn ? W + (size_t)n0n * DM : nullptr, DM, DM, xf, st, lds); primed = hasn;
    }
}
DEVI void phase_gemm_qkv(const Params& p, char* lds) {
    const u16* CQ = (const u16*)(p.ws + A_CQ); const u16* CKV = (const u16*)(p.ws + A_CKV);
    u16* QA = (u16*)(p.ws + A_QA); u16* KA = (u16*)(p.ws + A_KA); u16* VA = (u16*)(p.ws + A_VA);
    const float2* tab = (const float2*)(p.ws + OFF_ROPE);
    const int MT = T0 / 256;
    for (int uu = blockIdx.x; uu < ((14 * MT + 255) & ~255); uu += gridDim.x) {
        const int u = swz(uu); if (u >= 14 * MT) continue;
        const int mt = u / 14, j = u % 14; const int m0 = mt * 256;
        if (j < 6) {
            const int n0 = j * 128;
            auto arow = [&](int r) { return CQ + (size_t)(m0 + r) * 384; };
            auto xf = [&](int r, int cw, f32x16 (&t)[2], int h) {
                const int row = m0 + r; const int pp = row % LT;
#pragma unroll
                for (int ni = 0; ni < 2; ++ni) {
                    const int c32 = n0 + cw + ni * 32; const int wi = c32 % 192;
                    if (wi >= 128) rope_tile(t[ni], (wi - 128) >> 5, pp, h, tab);
#pragma unroll
                    for (int i = 0; i < 16; ++i) t[ni][i] *= QA_SCALE;
                }
            };
            auto st = [&](int r, int c8, u32x4 v) {
                const int row = m0 + r; const int b = row / LT, pp = row - b * LT; const int c = n0 + c8; const int hd = c / 192, wi = c - hd * 192;
                *(u32x4*)(QA + ((size_t)(b * 4 + hd) * LT + pp) * 192 + wi) = v;
            };
            GemmRegs<4, 2> R; gemm_tile<256, 128, true>(R, false, arow, (const u16*)(p.ws + W_UQ) + (size_t)n0 * 384, arow, (const u16*)nullptr, 384, 384, xf, st, lds);
        } else {
            const bool isv = j >= 10; const int n0 = (isv ? j - 10 : j - 6) * 128;
            auto arow = [&](int r) { return CKV + (size_t)(m0 + r) * 256; };
            auto xf = [&](int, int, f32x16 (&)[2], int) {};
            auto st = [&](int r, int c8, u32x4 v) {
                const int row = m0 + r; const int b = row / LT, pp = row - b * LT; const int c = n0 + c8; const int hd = c >> 7, wi = c & 127;
                if (isv) *(u32x4*)(VA + ((size_t)(b * 4 + hd) * LT + pp) * 128 + wi) = v;
                else *(u32x4*)(KA + ((size_t)(b * 4 + hd) * LT + pp) * 192 + wi) = v;
            };
            GemmRegs<4, 2> R; gemm_tile<256, 128, true>(R, false, arow, (const u16*)(p.ws + (isv ? W_UV : W_UK)) + (size_t)n0 * 256, arow, (const u16*)nullptr, 256, 256, xf, st, lds);
        }
    }
}

template <int DQK, int DV, bool SWA>
DEVI void attn_unit(const u16* __restrict__ Q, const u16* __restrict__ Kp, const u16* __restrict__ Vp, int q0, int a0, int na, int b0, int nb2,
                    float m_init, u16* __restrict__ outp  , char* lds) {
    constexpr int KSTR = DQK + 8, VSTR = DV + 32, KCH = DQK / 8, VCH = DV / 8, NKC = 64 * KCH / 512, NVC = 64 * VCH / 512, NS = DQK / 16, NDT = DV / 32;
    const int tid = tidx(), lane = tid & 63, w = tid >> 6, l31 = lane & 31, h = lane >> 5;
    u16* sK = (u16*)lds; u16* sV = sK + 2 * 64 * KSTR;
    const int qpos = q0 + w * 32 + l31;
    bf16x8 qf[NS];
#pragma unroll
    for (int s = 0; s < NS; ++s) qf[s] = *(const bf16x8*)(Q + (size_t)qpos * DQK + s * 16 + h * 8);
    f32x16 o[NDT];
#pragma unroll
    for (int d = 0; d < NDT; ++d)
#pragma unroll
        for (int i = 0; i < 16; ++i) o[d][i] = 0.f;
    float m = m_init, lsum = 0.f;
    const int nt = na + nb2;
    u32x4 rk[NKC], rv[NVC];
    auto tile_pos = [&](int t) { return t < na ? a0 + 64 * t : b0 + 64 * (t - na); };
    auto gload = [&](int t) {
        const int kp0 = tile_pos(t);
        const u16* kb_ = Kp + (size_t)kp0 * DQK + tid * 8; const u16* vb_ = Vp + (size_t)kp0 * DV + tid * 8;
#pragma unroll
        for (int i = 0; i < NKC; ++i) rk[i] = *(const u32x4*)(kb_ + 4096 * i);
#pragma unroll
        for (int i = 0; i < NVC; ++i) rv[i] = *(const u32x4*)(vb_ + 4096 * i);
    };
    gload(0);
    const int tr_row = 4 * h + ((lane & 15) >> 2), tr_col = 16 * ((lane >> 4) & 1) + 4 * (lane & 3);
    for (int t = 0; t < nt; ++t) {
        u16* k_ = sK + (t & 1) * 64 * KSTR; u16* v_ = sV + (t & 1) * 64 * VSTR;
#pragma unroll
        for (int i = 0; i < NKC; ++i) { const int c = tid + 512 * i, row = c / KCH, ch = c % KCH; *(u32x4*)(k_ + row * KSTR + ch * 8) = rk[i]; }
#pragma unroll
        for (int i = 0; i < NVC; ++i) { const int c = tid + 512 * i, row = c / VCH, ch = c % VCH; *(u32x4*)(v_ + row * VSTR + ch * 8) = rv[i]; }
        __syncthreads();
        if (t + 1 < nt) gload(t + 1);
        f32x16 st[2];
#pragma unroll
        for (int k2 = 0; k2 < 2; ++k2) {
#pragma unroll
            for (int i = 0; i < 16; ++i) st[k2][i] = 0.f;
#pragma unroll
            for (int s = 0; s < NS; ++s) {
                const bf16x8 kf = *(const bf16x8*)(k_ + (k2 * 32 + l31) * KSTR + s * 16 + h * 8);
                st[k2] = __builtin_amdgcn_mfma_f32_32x32x16_bf16(kf, qf[s], st[k2], 0, 0, 0);
            }
        }
        __builtin_amdgcn_sched_barrier(0);
        if (SWA && t >= na) {
            const int kp0 = tile_pos(t);
#pragma unroll
            for (int k2 = 0; k2 < 2; ++k2)
#pragma unroll
                for (int i = 0; i < 16; ++i) {
                    const int key = kp0 + k2 * 32 + (i & 3) + 8 * (i >> 2) + 4 * h; const int d = qpos - key;
                    if (d > 128 || d < -128) st[k2][i] = -1e30f;
                }
        }
        float mx = st[0][0];
#pragma unroll
        for (int k2 = 0; k2 < 2; ++k2)
#pragma unroll
            for (int i = 0; i < 16; ++i) mx = fmaxf(mx, st[k2][i]);
        mx = fmaxf(mx, xhalf(mx));
        const float mn = fmaxf(m, mx); const float alpha = __builtin_amdgcn_exp2f(m - mn); m = mn;
        float ps = 0.f;
#pragma unroll
        for (int k2 = 0; k2 < 2; ++k2)
#pragma unroll
            for (int i = 0; i < 16; ++i) { const float pv = __builtin_amdgcn_exp2f(st[k2][i] - mn); st[k2][i] = pv; ps += pv; }
        lsum = lsum * alpha + ps;
#pragma unroll
        for (int d = 0; d < NDT; ++d)
#pragma unroll
            for (int i = 0; i < 16; ++i) o[d][i] *= alpha;
#pragma unroll
        for (int s16 = 0; s16 < 4; ++s16) {
            __builtin_amdgcn_sched_barrier(0);
            bf16x8 pf; unsigned* pu = (unsigned*)&pf;
#pragma unroll
            for (int jj = 0; jj < 4; ++jj) pu[jj] = pack2(st[s16 >> 1][8 * (s16 & 1) + 2 * jj], st[s16 >> 1][8 * (s16 & 1) + 2 * jj + 1]);
#pragma unroll
            for (int d = 0; d < NDT; ++d) {
                const u16* base = v_ + (16 * s16 + tr_row) * VSTR + d * 32 + tr_col;
                const s16x4 lo = __builtin_amdgcn_ds_read_tr16_b64_v4i16((LAS s16x4*)(base));
                const s16x4 hi = __builtin_amdgcn_ds_read_tr16_b64_v4i16((LAS s16x4*)(base + 8 * VSTR));
                bf16x8 vf; vf[0] = lo[0]; vf[1] = lo[1]; vf[2] = lo[2]; vf[3] = lo[3]; vf[4] = hi[0]; vf[5] = hi[1]; vf[6] = hi[2]; vf[7] = hi[3];
                o[d] = __builtin_amdgcn_mfma_f32_32x32x16_bf16(vf, pf, o[d], 0, 0, 0);
            }
        }
    }
    float lt = lsum + xhalf(lsum);
    if (SWA) lt += __builtin_amdgcn_exp2f(m_init - m);
    const float inv = 1.f / lt;
    u16* orow = outp + (size_t)qpos * DM;
#pragma unroll
    for (int d = 0; d < NDT; ++d)
#pragma unroll
        for (int g = 0; g < 4; ++g) { uint2 v; v.x = pack2(o[d][4 * g] * inv, o[d][4 * g + 1] * inv); v.y = pack2(o[d][4 * g + 2] * inv, o[d][4 * g + 3] * inv); *(uint2*)(orow + d * 32 + 8 * g + 4 * h) = v; }
    __syncthreads();
}
DEVI void phase_attention(const Params& p, char* lds) {
    const u16* QA = (const u16*)(p.ws + A_QA); const u16* KA = (const u16*)(p.ws + A_KA); const u16* VA = (const u16*)(p.ws + A_VA);
    const u16* QS = (const u16*)(p.ws + A_QS); const u16* KS = (const u16*)(p.ws + A_KS); const u16* VS = (const u16*)(p.ws + A_VS);
    u16* mix = (u16*)(p.ws + A_N0);
    for (int uu = blockIdx.x; uu < 1792; uu += gridDim.x) {
        const int u = swz(uu); if (u >= 1632) continue;
        if (u < 544) {
            int b, hd, q0, na;
            if (u < 512) { b = u >> 6; hd = (u >> 4) & 3; q0 = LC + (u & 15) * 256; na = 68; }
            else { const int v = u - 512; b = v >> 2; hd = v & 3; q0 = 0; na = 4; }
            const size_t bh = (size_t)(b * 4 + hd) * LT;
            attn_unit<192, 128, false>(QA + bh * 192, KA + bh * 192, VA + bh * 128, q0, 0, na, 0, 0, -1e30f, mix + (size_t)b * LT * DM + hd * 128, lds);
        } else {
            int b, hd, q0, b0 = 0, nb2 = 0;
            if (u < 1568) { const int v = u - 544; b = v >> 7; hd = (v >> 4) & 7; const int s0 = (v & 15) * 256; q0 = LC + s0;
                int lo = s0 - 128; if (lo < 0) lo = 0; int hi = s0 + 256 + 128; if (hi > SEQ) hi = SEQ; b0 = LC + lo; nb2 = (hi - lo) >> 6; }
            else { const int v = u - 1568; b = v >> 3; hd = v & 7; q0 = 0; }
            const int kvh = hd >> 2; const size_t qb = (size_t)(b * 8 + hd) * LT, kb = (size_t)(b * 2 + kvh) * LT;
            attn_unit<64, 64, true>(QS + qb * 64, KS + kb * 64, VS + kb * 64, q0, 0, 4, b0, nb2, p.in[I_ASINK][hd] * LOG2E, mix + (size_t)b * LT * DM + 512 + hd * 64, lds);
        }
    }
}
DEVI void phase_gemm_wo(const Params& p, const u16* A, const u16* W, const RowSrc& resid, int mode, int layer, char* lds) {
    float* XC = (float*)(p.ws + OFF_XC); float* XL = p.out;
    const float* mods_l = (const float*)(p.ws + OFF_MODS) + (size_t)layer * 9 * 6144;
    const int MT = (mode == 0 ? T0 : TL) / 256;
    GemmRegs<4, 2> R; bool primed = false;
    for (int uu = blockIdx.x; uu < ((8 * MT + 255) & ~255); uu += gridDim.x) {
        const int u = swz(uu); if (u >= 8 * MT) continue;
        const int mt = u >> 3, nt = u & 7; const int m0 = mt * 256, n0 = nt * 128;
        const int un = (uu + (int)gridDim.x < ((8 * MT + 255) & ~255)) ? swz(uu + gridDim.x) : 8 * MT; const bool hasn = un < 8 * MT;
        const int m0n = (un >> 3) * 256, n0n = (un & 7) * 128;
        auto arow = [&](int r) { return A + (size_t)(m0 + r) * DM; };
        auto arow_n = [&](int r) { return A + (size_t)(m0n + r) * DM; };
        auto xf = [&](int, int, f32x16 (&)[2], int) {};
        auto st = [&](int r, int c8, u32x4 v) {
            int bb; const float* rs = row_ptr(resid, mode, m0 + r, bb); int bb2; float* xo = row_ptr_w(XC, XL, mode, m0 + r, bb2);
            const float* mg = mods_l + (size_t)bb * 6144 + 2 * 1024; const int c = n0 + c8;
            const float4 r0 = *(const float4*)(rs + c), r1 = *(const float4*)(rs + c + 4), g0 = *(const float4*)(mg + c), g1 = *(const float4*)(mg + c + 4);
            float4 o0, o1;
            o0.x = r0.x + g0.x * bf_lo(v[0]); o0.y = r0.y + g0.y * bf_hi(v[0]); o0.z = r0.z + g0.z * bf_lo(v[1]); o0.w = r0.w + g0.w * bf_hi(v[1]);
            o1.x = r1.x + g1.x * bf_lo(v[2]); o1.y = r1.y + g1.y * bf_hi(v[2]); o1.z = r1.z + g1.z * bf_lo(v[3]); o1.w = r1.w + g1.w * bf_hi(v[3]);
            *(float4*)(xo + c) = o0; *(float4*)(xo + c + 4) = o1;
        };
        gemm_tile<256, 128, false>(R, primed, arow, W + (size_t)n0 * DM, arow_n, hasn ? W + (size_t)n0n * DM : nullptr, DM, DM, xf, st, lds); primed = hasn;
    }
}

DEVI void phase_moe_norm(const Params& p, int layer) {
    const int mode = layer == 0 ? 0 : 1; const int ntok = layer == 0 ? T0 : TL;
    RowSrc src; src.ctx = (const float*)(p.ws + OFF_XC); src.lat = p.out;
    const float* gain = p.in[I_NFFN] + layer * 1024; const float* mods_l = (const float*)(p.ws + OFF_MODS) + (size_t)layer * 9 * 6144;
    u16* n1 = (u16*)(p.ws + M_N1); u16* nlo = (u16*)(p.ws + M_ACT);
    const int lane = tidx() & 63, w = tidx() >> 6;
    for (int r = blockIdx.x * 8 + w; r < ntok; r += gridDim.x * 8) {
        int bb; const float* xr = row_ptr(src, mode, r, bb);
        float4 v[4]; float ss = 0.f;
#pragma unroll
        for (int i = 0; i < 4; ++i) { v[i] = ((const float4*)xr)[lane + 64 * i]; ss += v[i].x * v[i].x + v[i].y * v[i].y + v[i].z * v[i].z + v[i].w * v[i].w; }
        ss = wave_sum(ss);
        const float rs = rsqrtf(ss * (1.f / 1024.f) + 1e-6f);
        const float* msh = mods_l + (size_t)bb * 6144 + 3 * 1024; const float* msc = mods_l + (size_t)bb * 6144 + 4 * 1024;
#pragma unroll
        for (int i = 0; i < 4; ++i) {
            const int c = (lane + 64 * i) * 4;
            const float4 g = *(const float4*)(gain + c), sh = *(const float4*)(msh + c), sc = *(const float4*)(msc + c);
            const float y0 = v[i].x * rs * g.x * (1.f + sc.x) + sh.x, y1 = v[i].y * rs * g.y * (1.f + sc.y) + sh.y, y2 = v[i].z * rs * g.z * (1.f + sc.z) + sh.z, y3 = v[i].w * rs * g.w * (1.f + sc.w) + sh.w;
            uint2 o; o.x = pack2(y0, y1); o.y = pack2(y2, y3);
            *(uint2*)(n1 + (size_t)r * DM + c) = o;
            uint2 ol; ol.x = pack2(y0 - bf_lo(o.x), y1 - bf_hi(o.x)); ol.y = pack2(y2 - bf_lo(o.y), y3 - bf_hi(o.y));
            *(uint2*)(nlo + (size_t)r * DM + c) = ol;
        }
    }
}
DEVI void router_tile(const u16* __restrict__ H, const u16* __restrict__ L, const u16* __restrict__ Wt, int m0, char* lds) {
    constexpr int BM = 256, BN = 128, WN = 2, NA = 4, NBC = 2, STR = 72;
    const int tid = tidx(), lane = tid & 63, w = tid >> 6, wm = w / WN, wn = w % WN, l31 = lane & 31, h = lane >> 5;
    u16* sA = (u16*)lds; u16* sB = sA + 2 * BM * STR;
    const int crow = tid >> 3, kc = tid & 7;
    const u16* ph[NA]; const u16* pl[NA]; const u16* pb[NBC];
#pragma unroll
    for (int i = 0; i < NA; ++i) { ph[i] = H + (size_t)(m0 + crow + 64 * i) * DM + kc * 8; pl[i] = L + (size_t)(m0 + crow + 64 * i) * DM + kc * 8; }
#pragma unroll
    for (int i = 0; i < NBC; ++i) pb[i] = Wt + (size_t)((crow + 64 * i) & 63) * 3072 + kc * 8;
    u32x4 ra[NA], rb[NBC];
    auto gload = [&](int kt) {
        const int seg = kt >> 4, kk = (kt & 15) * 64;
#pragma unroll
        for (int i = 0; i < NA; ++i) ra[i] = *(const u32x4*)((seg == 1 ? pl[i] : ph[i]) + kk);
#pragma unroll
        for (int i = 0; i < NBC; ++i) rb[i] = *(const u32x4*)(pb[i] + kt * 64);
    };
    gload(0);
    f32x16 acc[2][2];
#pragma unroll
    for (int a = 0; a < 2; ++a)
#pragma unroll
        for (int b = 0; b < 2; ++b)
#pragma unroll
            for (int i = 0; i < 16; ++i) acc[a][b][i] = 0.f;
    for (int kt = 0; kt < 48; ++kt) {
        u16* a_ = sA + (kt & 1) * BM * STR; u16* b_ = sB + (kt & 1) * BN * STR;
#pragma unroll
        for (int i = 0; i < NA; ++i) *(u32x4*)(a_ + (crow + 64 * i) * STR + kc * 8) = ra[i];
#pragma unroll
        for (int i = 0; i < NBC; ++i) *(u32x4*)(b_ + (crow + 64 * i) * STR + kc * 8) = rb[i];
        lds_barrier();
        gload(kt + 1 < 48 ? kt + 1 : 47);
#pragma unroll
        for (int ks = 0; ks < 4; ++ks) {
            bf16x8 af[2], bfr[2];
#pragma unroll
            for (int mi = 0; mi < 2; ++mi) af[mi] = *(const bf16x8*)(a_ + (wm * 64 + mi * 32 + l31) * STR + ks * 16 + h * 8);
#pragma unroll
            for (int ni = 0; ni < 2; ++ni) bfr[ni] = *(const bf16x8*)(b_ + (wn * 64 + ni * 32 + l31) * STR + ks * 16 + h * 8);
#pragma unroll
            for (int mi = 0; mi < 2; ++mi)
#pragma unroll
                for (int ni = 0; ni < 2; ++ni) acc[mi][ni] = __builtin_amdgcn_mfma_f32_32x32x16_bf16(bfr[ni], af[mi], acc[mi][ni], 0, 0, 0);
        }
    }
    lds_barrier();
    float* LG = (float*)lds;
    if (wn == 0) {
#pragma unroll
        for (int mi = 0; mi < 2; ++mi)
#pragma unroll
            for (int ni = 0; ni < 2; ++ni)
#pragma unroll
                for (int g = 0; g < 4; ++g)
                    *(float4*)(LG + (wm * 64 + mi * 32 + l31) * 64 + ni * 32 + 8 * g + 4 * h) = make_float4(acc[mi][ni][4 * g], acc[mi][ni][4 * g + 1], acc[mi][ni][4 * g + 2], acc[mi][ni][4 * g + 3]);
    }
    lds_barrier();
}
DEVI void phase_moe_route(const Params& p, int layer, char* lds) {
    const int ntok = layer == 0 ? T0 : TL; const int tc = ntok / NCHUNK;
    const float ebias = p.in[I_MBIAS][layer * 64 + (tidx() & 63)];
    int* cnt = (int*)(p.ws + OFF_CNT) + layer * NCHUNK * 64;
    int* tok_e = (int*)(p.ws + OFF_TOKE); int* tok_r = (int*)(p.ws + OFF_TOKR); int* ltok = (int*)(p.ws + OFF_LTOK); float* lg = (float*)(p.ws + OFF_LG);
    const u16* H = (const u16*)(p.ws + M_N1); const u16* L = (const u16*)(p.ws + M_ACT); const u16* Wt = (const u16*)(p.ws + OFF_WROUT) + (size_t)layer * 64 * 3072;
    const int lane = tidx() & 63, w = tidx() >> 6;
    const float* LG = (const float*)lds;
    for (int u = blockIdx.x; u < ntok / 256; u += gridDim.x) {
        router_tile(H, L, Wt, u * 256, lds);
        for (int j = 0; j < 32; ++j) {
            const int rl = w * 32 + j; const int tok = u * 256 + rl;
            const float lgt = LG[rl * 64 + lane];
            const float score = 1.f / (1.f + expf(-lgt)); const float choice = score + ebias;
            const float m1 = red8_max(choice);
            const unsigned long long bm = __ballot(choice == m1);
            const unsigned gm = (unsigned)(bm >> (lane & 56)) & 0xffu; const int first = __ffs(gm) - 1;
            const float m2 = red8_max(((lane & 7) == first) ? -INFINITY : choice);
            const float gs = m1 + m2;
            int rank = 0;
#pragma unroll
            for (int g2 = 0; g2 < 8; ++g2) { const float og = __shfl(gs, g2 * 8); rank += (og > gs || (og == gs && g2 < (lane >> 3))) ? 1 : 0; }
            float cm = rank < 4 ? choice : -INFINITY;
            unsigned long long sel = 0ull; float ssum = 0.f;
#pragma unroll
            for (int it = 0; it < 6; ++it) {
                const float mxv = wave_max(cm);
                const unsigned long long bmm = __ballot(cm == mxv);
                const int win = __ffsll((long long)bmm) - 1;
                sel |= 1ull << win; ssum += __shfl(score, win);
                if (lane == win) cm = -INFINITY;
            }
            if ((sel >> lane) & 1ull) {
                const int jj = __popcll(sel & ((1ull << lane) - 1ull));
                const int ch = tok / tc; const int rk = atomicAdd(&cnt[ch * 64 + lane], 1);
                tok_e[tok * 6 + jj] = lane; tok_r[tok * 6 + jj] = rk;
                ltok[((size_t)ch * 64 + lane) * tc + rk] = tok; lg[((size_t)ch * 64 + lane) * tc + rk] = 2.5f * score / ssum;
            }
        }
        lds_barrier();
    }
}
struct SegTab { int* cnt; int* off; int* tpre; };
DEVI SegTab build_segtab(const Params& p, int layer, int tc, char* lds_tab) {
    SegTab T; T.cnt = (int*)lds_tab; T.off = T.cnt + 264; T.tpre = T.off + 264;
    const int* cnt = (const int*)(p.ws + OFF_CNT) + layer * NCHUNK * 64;
    const int tid = tidx();
    if (tid < 260) { const int ch = tid / 65, e = tid % 65; T.cnt[tid] = e < 64 ? cnt[ch * 64 + e] : tc; }
    __syncthreads();
    if (tid < 64) {
        int lc[5], lt_[5]; int sc = 0, st = 0;
#pragma unroll
        for (int j = 0; j < 5; ++j) { const int s = 5 * tid + j; const int v = s < 260 ? T.cnt[s] : 0; lc[j] = sc; lt_[j] = st; sc += v; st += (v + 127) >> 7; }
        int ic = sc, it = st;
        for (int o = 1; o < 64; o <<= 1) { const int a = __shfl_up(ic, o), b2 = __shfl_up(it, o); if (tid >= o) { ic += a; it += b2; } }
        const int bc = ic - sc, bt = it - st;
#pragma unroll
        for (int j = 0; j < 5; ++j) { const int s = 5 * tid + j; if (s <= 260) { T.tpre[s] = bt + lt_[j]; T.off[s] = bc + lc[j]; } }
    }
    __syncthreads();
    return T;
}
DEVI int find_seg(const SegTab& T, int lo_seg, int hi_seg, int mt) {
    int lo = lo_seg, hi = hi_seg;
    while (hi - lo > 1) { const int mid = (lo + hi) >> 1; if (T.tpre[mid] <= mt) lo = mid; else hi = mid; }
    return lo;
}
DEVI void phase_moe_gemm1(const Params& p, int layer, char* lds) {
    const int ntok = layer == 0 ? T0 : TL; const int tc = ntok / NCHUNK;
    char* tabmem = lds + 110592; SegTab T = build_segtab(p, layer, tc, tabmem);
    const u16* n1 = (const u16*)(p.ws + M_N1); u16* act = (u16*)(p.ws + M_ACT);
    const int* ltok = (const int*)(p.ws + OFF_LTOK); const float* lg = (const float*)(p.ws + OFF_LG);
    const int nunits = T.tpre[260] * 2;
    GemmRegs<2, 4> R; bool primed = false;
    for (int uu = blockIdx.x; uu < ((nunits + 255) & ~255); uu += gridDim.x) {
        const int u = swz(uu); if (u >= nunits) continue;
        const int mt = u >> 1, nt = u & 1; const int seg = find_seg(T, 0, 260, mt); const int ch = seg / 65, e = seg % 65;
        const int un = (uu + (int)gridDim.x < ((nunits + 255) & ~255)) ? swz(uu + gridDim.x) : nunits; const bool hasn = un < nunits;
        const int mtn = hasn ? un >> 1 : mt; const int segn = find_seg(T, 0, 260, mtn); const int chn = segn / 65, en = segn % 65;
        const int cntn = T.cnt[segn], row0n = (mtn - T.tpre[segn]) * 128; const int* ltn = ltok + ((size_t)chn * 64 + en) * tc;
        const u16* Wn = en < 64 ? (const u16*)(p.ws + OFF_WGU) + (size_t)en * 512 * 1024 : (const u16*)(p.ws + W_SGU) + (size_t)layer * 512 * 1024;
        auto arow_n = [&](int r) { int s2 = row0n + r; if (s2 >= cntn) s2 = cntn - 1; const int tok = en < 64 ? ltn[s2] : chn * tc + s2; return n1 + (size_t)tok * DM; };
        const int cntv = T.cnt[seg], row0 = (mt - T.tpre[seg]) * 128; const int n0 = nt * 256;
        const int* lt = ltok + ((size_t)ch * 64 + e) * tc; const float* lgp = lg + ((size_t)ch * 64 + e) * tc;
        const u16* W = e < 64 ? (const u16*)(p.ws + OFF_WGU) + (size_t)e * 512 * 1024 : (const u16*)(p.ws + W_SGU) + (size_t)layer * 512 * 1024;
        auto arow = [&](int r) { int s = row0 + r; if (s >= cntv) s = cntv - 1; const int tok = e < 64 ? lt[s] : ch * tc + s; return n1 + (size_t)tok * DM; };
        const size_t arow0 = (size_t)ch * 7 * tc + (T.off[seg] - T.off[ch * 65]) + row0;
        auto xf = [&](int r, int cw, f32x16 (&t)[2], int h) {
            int s2 = row0 + r; if (s2 >= cntv) s2 = cntv - 1;
            const float gw = e < 64 ? lgp[s2] : 1.f;
#pragma unroll
            for (int i = 0; i < 16; ++i) { const float gt = t[0][i], up = t[1][i]; t[0][i] = gt / (1.f + __expf(-gt)) * up * gw; }
        };
        auto st = [&](int r, int c8, u32x4 v) {
            if (row0 + r >= cntv || (c8 & 32)) return;
            *(u32x4*)(act + (arow0 + r) * 256 + ((n0 + (c8 & ~63)) >> 1) + (c8 & 31)) = v;
        };
        gemm_tile<128, 256, false>(R, primed, arow, W + (size_t)n0 * DM, arow_n, hasn ? Wn + (size_t)((un & 1) * 256) * DM : nullptr, DM, DM, xf, st, lds); primed = hasn;
    }
}
DEVI void phase_moe_g2c(const Params& p, int layer, int chg, int chc, char* lds) {
    const int mode = layer == 0 ? 0 : 1; const int ntok = layer == 0 ? T0 : TL; const int tc = ntok / NCHUNK;
    char* tabmem = lds + 110592; SegTab T = build_segtab(p, layer, tc, tabmem);
    const u16* act = (const u16*)(p.ws + M_ACT);
    const int* tok_e = (const int*)(p.ws + OFF_TOKE); const int* tok_r = (const int*)(p.ws + OFF_TOKR);
    float* XC = (float*)(p.ws + OFF_XC); float* XL = p.out;
    const float* mods_l = (const float*)(p.ws + OFF_MODS) + (size_t)layer * 9 * 6144;
    const int lane = tidx() & 63, w = tidx() >> 6;
    int nunits = 0, t_lo = 0;
    if (chg >= 0) { t_lo = T.tpre[chg * 65]; nunits = (T.tpre[chg * 65 + 65] - t_lo) * 4; }
    const int G = gridDim.x; const int nround = (nunits + 255) >> 8;
    int my_units = 0; for (int r = 0; r < nround; ++r) my_units += swz((int)blockIdx.x + r * G) < nunits ? 1 : 0;
    const int crounds = chc >= 0 ? (tc + G * 8 - 1) / (G * 8) : 0;
    int cdone = 0;
    auto combine_rounds = [&](int upto) {
        const u16* outr = (const u16*)(p.ws + M_OUTR + (size_t)(chc & 1) * SZ_OUTR);
        for (; cdone < upto; ++cdone) {
            const int tl = (cdone * G + (int)blockIdx.x) * 8 + w; if (tl >= tc) continue;
            const int tok = chc * tc + tl; int bb; float* xr = row_ptr_w(XC, XL, mode, tok, bb);
            const float* mg = mods_l + (size_t)bb * 6144 + 5 * 1024;
            int rows[7];
#pragma unroll
            for (int j = 0; j < 6; ++j) rows[j] = T.off[chc * 65 + tok_e[tok * 6 + j]] - T.off[chc * 65] + tok_r[tok * 6 + j];
            rows[6] = 6 * tc + tl;
#pragma unroll
            for (int i = 0; i < 2; ++i) {
                const int c = (lane + 64 * i) * 8;
                float acc[8];
#pragma unroll
                for (int q = 0; q < 8; ++q) acc[q] = 0.f;
#pragma unroll
                for (int j = 0; j < 7; ++j) {
                    const uint4 v = *(const uint4*)(outr + (size_t)rows[j] * DM + c);
                    acc[0] += bf_lo(v.x); acc[1] += bf_hi(v.x); acc[2] += bf_lo(v.y); acc[3] += bf_hi(v.y); acc[4] += bf_lo(v.z); acc[5] += bf_hi(v.z); acc[6] += bf_lo(v.w); acc[7] += bf_hi(v.w);
                }
                float4 x0 = *(float4*)(xr + c), x1 = *(float4*)(xr + c + 4); const float4 g0 = *(const float4*)(mg + c), g1 = *(const float4*)(mg + c + 4);
                x0.x += g0.x * acc[0]; x0.y += g0.y * acc[1]; x0.z += g0.z * acc[2]; x0.w += g0.w * acc[3]; x1.x += g1.x * acc[4]; x1.y += g1.y * acc[5]; x1.z += g1.z * acc[6]; x1.w += g1.w * acc[7];
                *(float4*)(xr + c) = x0; *(float4*)(xr + c + 4) = x1;
            }
        }
    };
    int ui = 0;
    GemmRegs<2, 4> R; bool primed = false;
    for (int uu = blockIdx.x; uu < nround * 256; uu += G) {
        const int u = swz(uu); if (u >= nunits) continue;
        u16* outw = (u16*)(p.ws + M_OUTR + (size_t)(chg & 1) * SZ_OUTR);
        const int mt = t_lo + (u >> 2), nt = u & 3; const int seg = find_seg(T, chg * 65, chg * 65 + 65, mt); const int e = seg % 65;
        const int un = (uu + G < nround * 256) ? swz(uu + G) : nunits; const bool hasn = un < nunits;
        const int mtn = hasn ? t_lo + (un >> 2) : mt; const int segn = find_seg(T, chg * 65, chg * 65 + 65, mtn); const int en = segn % 65;
        const int cntn = T.cnt[segn], row0n = (mtn - T.tpre[segn]) * 128;
        const u16* An = act + ((size_t)chg * 7 * tc + (size_t)(T.off[segn] - T.off[chg * 65]) + row0n) * 256;
        const u16* Wn = en < 64 ? (const u16*)(p.ws + OFF_WD) + (size_t)en * 1024 * 256 : (const u16*)(p.ws + W_SD) + (size_t)layer * 1024 * 256;
        auto arow_n = [&](int r) { int s2 = row0n + r; if (s2 >= cntn) s2 = cntn - 1; return An + (size_t)(s2 - row0n) * 256; };
        const int cntv = T.cnt[seg], row0 = (mt - T.tpre[seg]) * 128; const int n0 = nt * 256;
        const size_t lrow0 = (size_t)(T.off[seg] - T.off[chg * 65]) + row0;
        const u16* A = act + ((size_t)chg * 7 * tc + lrow0) * 256;
        const u16* W = e < 64 ? (const u16*)(p.ws + OFF_WD) + (size_t)e * 1024 * 256 : (const u16*)(p.ws + W_SD) + (size_t)layer * 1024 * 256;
        auto arow = [&](int r) { int s2 = row0 + r; if (s2 >= cntv) s2 = cntv - 1; return A + (size_t)(s2 - row0) * 256; };
        auto xf = [&](int, int, f32x16 (&)[2], int) {};
        auto st = [&](int r, int c8, u32x4 v) { if (row0 + r < cntv) *(u32x4*)(outw + (lrow0 + r) * DM + n0 + c8) = v; };
        gemm_tile<128, 256, false>(R, primed, arow, W + (size_t)n0 * 256, arow_n, hasn ? Wn + (size_t)((un & 3) * 256) * 256 : nullptr, 256, 256, xf, st, lds); primed = hasn;
        ++ui; combine_rounds((int)(((long)crounds * ui) / my_units));
    }
    combine_rounds(crounds);
}

DEVI void phase_rwkv_mix(const Params& p, int i0, int i1, int i2) {
    const u16* nn = (const u16*)(p.ws + R_NN); u16* xm = (u16*)(p.ws + R_XM0);
    const float* mu = p.in[I_RMU]; const int idx[3] = {i0, i1, i2};
    const int lane = tidx() & 63, w = tidx() >> 6;
    for (int r = blockIdx.x * 8 + w; r < T0; r += gridDim.x * 8) {
        const int b = r / LT, pp = r - b * LT;
        const bool hasprev = (pp != 0) && (pp != LC), hasnext = (pp != LC - 1) && (pp != LT - 1);
#pragma unroll
        for (int half = 0; half < 2; ++half) {
            const int c = half * 512 + lane * 8;
            const uint4 cur = *(const uint4*)(nn + (size_t)r * DM + c);
            uint4 sh = make_uint4(0, 0, 0, 0);
            if (half == 0) { if (hasprev) sh = *(const uint4*)(nn + (size_t)(r - 1) * DM + c); }
            else { if (hasnext) sh = *(const uint4*)(nn + (size_t)(r + 1) * DM + c); }
            float nv[8], xx[8];
            nv[0] = bf_lo(cur.x); nv[1] = bf_hi(cur.x); nv[2] = bf_lo(cur.y); nv[3] = bf_hi(cur.y); nv[4] = bf_lo(cur.z); nv[5] = bf_hi(cur.z); nv[6] = bf_lo(cur.w); nv[7] = bf_hi(cur.w);
            xx[0] = bf_lo(sh.x) - nv[0]; xx[1] = bf_hi(sh.x) - nv[1]; xx[2] = bf_lo(sh.y) - nv[2]; xx[3] = bf_hi(sh.y) - nv[3]; xx[4] = bf_lo(sh.z) - nv[4]; xx[5] = bf_hi(sh.z) - nv[5]; xx[6] = bf_lo(sh.w) - nv[6]; xx[7] = bf_hi(sh.w) - nv[7];
#pragma unroll
            for (int j = 0; j < 3; ++j) {
                const float4 m0 = *(const float4*)(mu + idx[j] * 1024 + c), m1 = *(const float4*)(mu + idx[j] * 1024 + c + 4);
                uint4 o; o.x = pack2(nv[0] + xx[0] * m0.x, nv[1] + xx[1] * m0.y); o.y = pack2(nv[2] + xx[2] * m0.z, nv[3] + xx[3] * m0.w);
                o.z = pack2(nv[4] + xx[4] * m1.x, nv[5] + xx[5] * m1.y); o.w = pack2(nv[6] + xx[6] * m1.z, nv[7] + xx[7] * m1.w);
                *(uint4*)(xm + (size_t)j * T0 * DM + (size_t)r * DM + c) = o;
            }
        }
    }
}
DEVI void phase_rwkv_gemm_rkv(const Params& p, char* lds) {
    const int MT = T0 / 256;
    GemmRegs<4, 2> R; bool primed = false;
    for (int uu = blockIdx.x; uu < ((3 * 8 * MT + 255) & ~255); uu += gridDim.x) {
        const int u = swz(uu); if (u >= 3 * 8 * MT) continue;
        const int j = u / (8 * MT), v = u % (8 * MT); const int mt = v >> 3, nt = v & 7; const int m0 = mt * 256, n0 = nt * 128;
        const u16* A = (const u16*)(p.ws + R_XM0) + (size_t)j * T0 * DM; const u16* W = (const u16*)(p.ws + W_RR) + (size_t)j * DM * DM; u16* O = (u16*)(p.ws + R_RR) + (size_t)j * T0 * DM;
        const int un = (uu + (int)gridDim.x < ((3 * 8 * MT + 255) & ~255)) ? swz(uu + gridDim.x) : 3 * 8 * MT; const bool hasn = un < 3 * 8 * MT;
        const int jn = hasn ? un / (8 * MT) : j, vn = hasn ? un % (8 * MT) : v;
        const u16* An = (const u16*)(p.ws + R_XM0) + (size_t)jn * T0 * DM + (size_t)((vn >> 3) * 256) * DM; const u16* Wn = (const u16*)(p.ws + W_RR) + (size_t)jn * DM * DM + (size_t)((vn & 7) * 128) * DM;
        auto arow = [&](int r) { return A + (size_t)(m0 + r) * DM; };
        auto arow_n = [&](int r) { return An + (size_t)r * DM; };
        auto xf = [&](int, int, f32x16 (&)[2], int) {};
        auto st = [&](int r, int c8, u32x4 v) { *(u32x4*)(O + (size_t)(m0 + r) * DM + n0 + c8) = v; };
        gemm_tile<256, 128, false>(R, primed, arow, W + (size_t)n0 * DM, arow_n, hasn ? Wn : nullptr, DM, DM, xf, st, lds); primed = hasn;
    }
}
DEVI void phase_rwkv_gemm_small(const Params& p, char* lds) {
    const int MT = T0 / 256;
    for (int u = blockIdx.x; u < 3 * MT; u += gridDim.x) {
        const int j = u / MT, mt = u % MT; const int m0 = mt * 256;
        const u16* A = (const u16*)(p.ws + R_XM0) + (size_t)j * T0 * DM;
        const u16* W = (const u16*)(p.ws + (j == 0 ? W_W1 : j == 1 ? W_A1 : W_G1)); u16* O = (u16*)(p.ws + (j == 0 ? R_HW : j == 1 ? R_HA : R_HG));
        auto arow = [&](int r) { return A + (size_t)(m0 + r) * DM; };
        auto xf = [&](int, int, f32x16 (&t)[2], int) {
#pragma unroll
            for (int ni = 0; ni < 2; ++ni)
#pragma unroll
                for (int i = 0; i < 16; ++i) { const float x = t[ni][i]; t[ni][i] = j == 0 ? tanhf_(x) : j == 1 ? x : sigmoidf_(x); }
        };
        auto st = [&](int r, int c8, u32x4 v) { *(u32x4*)(O + (size_t)(m0 + r) * 128 + c8) = v; };
        GemmRegs<4, 2> R; gemm_tile<256, 128, false>(R, false, arow, W, arow, (const u16*)nullptr, DM, DM, xf, st, lds);
    }
}
DEVI void phase_rwkv_gemm_g(const Params& p, char* lds) {
    const int MT = T0 / 256; const u16* A = (const u16*)(p.ws + R_HG); const u16* W = (const u16*)(p.ws + W_G2); u16* O = (u16*)(p.ws + R_GG);
    for (int uu = blockIdx.x; uu < ((8 * MT + 255) & ~255); uu += gridDim.x) {
        const int u = swz(uu); if (u >= 8 * MT) continue;
        const int mt = u >> 3, nt = u & 7; const int m0 = mt * 256, n0 = nt * 128;
        auto arow = [&](int r) { return A + (size_t)(m0 + r) * 128; };
        auto xf = [&](int, int, f32x16 (&)[2], int) {};
        auto st = [&](int r, int c8, u32x4 v) { *(u32x4*)(O + (size_t)(m0 + r) * DM + n0 + c8) = v; };
        GemmRegs<4, 2> R; gemm_tile<256, 128, false>(R, false, arow, W + (size_t)n0 * 128, arow, (const u16*)nullptr, 128, 128, xf, st, lds);
    }
}
DEVI float red16_sum(float x) { x += dppf(x, 0); x += dppf(x, 1); x += dppf(x, 2); int xi = __builtin_bit_cast(int, x); x += __builtin_bit_cast(float, __builtin_amdgcn_mov_dpp(xi, 0x140, 0xF, 0xF, true)); return x; }
DEVI bf16x8 frag_perm(const u16* rowp, int ks, int h) {
    const uint2 lo = *(const uint2*)(rowp + 16 * ks + 4 * h), hi = *(const uint2*)(rowp + 16 * ks + 8 + 4 * h);
    u32x4 v = {lo.x, lo.y, hi.x, hi.y}; return __builtin_bit_cast(bf16x8, v);
}
DEVI bf16x8 tr_frag(const u16* base, int stride, int lane) {
    const u16* q = base + (4 * (lane >> 5) + ((lane & 15) >> 2)) * stride + 16 * ((lane >> 4) & 1) + 4 * (lane & 3);
    const s16x4 lo = __builtin_amdgcn_ds_read_tr16_b64_v4i16((LAS s16x4*)q), hi = __builtin_amdgcn_ds_read_tr16_b64_v4i16((LAS s16x4*)(q + 8 * stride));
    bf16x8 v; v[0] = lo[0]; v[1] = lo[1]; v[2] = lo[2]; v[3] = lo[3]; v[4] = hi[0]; v[5] = hi[1]; v[6] = hi[2]; v[7] = hi[3]; return v;
}
DEVI bf16x8 frag_plain(const u16* rowp, int ks, int h) { return *(const bf16x8*)(rowp + 16 * ks + 8 * h); }
DEVI bf16x8 acc_to_b(const f32x16& t, int s) {
    u32x4 v = {pack2(t[8 * s], t[8 * s + 1]), pack2(t[8 * s + 2], t[8 * s + 3]), pack2(t[8 * s + 4], t[8 * s + 5]), pack2(t[8 * s + 6], t[8 * s + 7])};
    return __builtin_bit_cast(bf16x8, v);
}
#define MFMA(a, b, c) __builtin_amdgcn_mfma_f32_32x32x16_bf16(a, b, c, 0, 0, 0)
DEVI void phase_rwkv_scan(const Params& p, char* lds) {
    float* LW = (float*)lds; float* AA = LW + 2048; float* CP = AA + 2048;
    u16* At = (u16*)(lds + 24576); u16* Bt = At + 2304; u16* Kt = Bt + 2304; u16* Rt = Kt + 2304;
    u16* Vr = (u16*)(lds + 43008); u16* Khr = Vr + 3072; u16* Bhr = Khr + 3072;
    float* Lf = (float*)(lds + 61440);
    u16* Lo = (u16*)(lds + 66048); u16* Lak = Lo + 1280; u16* Mrb = Lak + 1280; u16* Mrk = Mrb + 1280; u16* Td = Mrk + 1280;
    float* PC = (float*)(lds + 78848); u16* YS = (u16*)(lds + 79104);
    const u16* r_g = (const u16*)(p.ws + R_RR); const u16* k_g = (const u16*)(p.ws + R_RK); const u16* v_g = (const u16*)(p.ws + R_RV);
    const u16* hw = (const u16*)(p.ws + R_HW); const u16* ha = (const u16*)(p.ws + R_HA);
    const int tid = tidx(), lane = tid & 63, w = tid >> 6, l31 = lane & 31, hh = lane >> 5;
    for (int u = blockIdx.x; u < 256; u += gridDim.x) {
        const int dir = u & 1, hd = (u >> 1) & 15, b = u >> 5;
        u16* y_g = (u16*)(p.ws + (dir ? R_YB : R_YF)); float* rkb = (float*)(p.ws + R_RKB) + (size_t)dir * T0 * 16;
        const int mat = (w >> 1) & 1, ctt = w & 1;
        u16* W2L = (u16*)(lds + 86016);
        float* KC = (float*)(lds + 86016 + 18432);
        for (int i = tid; i < 2 * 64 * 8; i += 512) { const int m = i >> 9, c = (i >> 3) & 63, ch = i & 7;
            *(u32x4*)(W2L + (m * 64 + c) * 72 + ch * 8) = *(const u32x4*)((const u16*)(p.ws + (m ? W_A2 : W_W2)) + (size_t)dir * 1024 * 64 + (size_t)(hd * 64 + c) * 64 + ch * 8); }
        if (tid < 64) { KC[tid] = p.in[I_RKK][hd * 64 + tid]; KC[64 + tid] = p.in[I_RKA][hd * 64 + tid]; KC[128 + tid] = p.in[I_RRK][hd * 64 + tid]; }
        const u16* w2l = W2L + (mat * 64 + ctt * 32 + l31) * 72;
        const float* bias0 = (mat ? p.in[I_RA0] : p.in[I_RW0]) + dir * 1024 + hd * 64 + ctt * 32;
        const u16* hsrc = mat ? ha : hw;
        const int t2 = tid >> 4, c4 = (tid & 15) * 4; const int cg = hd * 64 + c4;
        for (int i = tid; i < 1280; i += 512) Td[i] = 0;
        f32x16 Z[2];
#pragma unroll
        for (int a = 0; a < 2; ++a)
#pragma unroll
            for (int i = 0; i < 16; ++i) Z[a][i] = 0.f;
        __syncthreads();
        const size_t rowb = (size_t)b * LT;
        auto chunk_p0 = [&](int ci) { int pc; if (ci < 8) { pc = dir ? 7 - ci : ci; return 32 * pc; } pc = dir ? 135 - ci : ci - 8; return LC + 32 * pc; };
        bf16x8 hfr[4]; uint2 ru, ku, vu;
        {
            const int p0 = chunk_p0(0);
            const int pos = dir ? p0 + 31 - l31 : p0 + l31; const u16* hp = hsrc + (rowb + pos) * 128 + dir * 64;
#pragma unroll
            for (int ks = 0; ks < 4; ++ks) hfr[ks] = *(const bf16x8*)(hp + ks * 16 + hh * 8);
            const int pos2 = dir ? p0 + 31 - t2 : p0 + t2; const size_t go = (rowb + pos2) * DM + cg;
            ru = *(const uint2*)(r_g + go); ku = *(const uint2*)(k_g + go); vu = *(const uint2*)(v_g + go);
        }
        for (int ci = 0; ci < 136; ++ci) {
            const int p0 = chunk_p0(ci); const int p0n = chunk_p0(ci < 135 ? ci + 1 : ci);
            if (w < 4) {
                f32x16 acc;
#pragma unroll
                for (int i = 0; i < 16; ++i) acc[i] = 0.f;
#pragma unroll
                for (int ks = 0; ks < 4; ++ks) acc = MFMA(hfr[ks], frag_plain(w2l, ks, hh), acc);
                {
                    const int pos = dir ? p0n + 31 - l31 : p0n + l31; const u16* hp = hsrc + (rowb + pos) * 128 + dir * 64;
#pragma unroll
                    for (int ks = 0; ks < 4; ++ks) hfr[ks] = *(const bf16x8*)(hp + ks * 16 + hh * 8);
                }
                const float bv = bias0[l31];
                float* dstm = (mat ? AA : CP) + ctt * 32 + l31;
                if (mat) {
#pragma unroll
                    for (int i = 0; i < 16; ++i) dstm[((i & 3) + 8 * (i >> 2) + 4 * hh) * 64] = sigmoidf_(acc[i] + bv);
                } else {
                    f32x16 lo, cp;
#pragma unroll
                    for (int i = 0; i < 16; ++i) { const float lw = -0.6065306597126334f * sigmoidf_(acc[i] + bv); const float hi = bf1((u16)(pack2(lw, 0.f))); acc[i] = hi; lo[i] = lw - hi; cp[i] = 0.f; }
#pragma unroll
                    for (int ks = 0; ks < 2; ++ks) {
                        u32x4 tv;
#pragma unroll
                        for (int q = 0; q < 4; ++q) { const int ta = 16 * ks + 8 * (q >> 1) + 4 * hh + 2 * (q & 1); tv[q] = ((ta <= l31) ? 0x3F80u : 0u) | ((ta + 1 <= l31) ? 0x3F800000u : 0u); }
                        const bf16x8 tri = __builtin_bit_cast(bf16x8, tv);
                        cp = MFMA(tri, acc_to_b(acc, ks), cp); cp = MFMA(tri, acc_to_b(lo, ks), cp);
                    }
#pragma unroll
                    for (int i = 0; i < 16; ++i) dstm[((i & 3) + 8 * (i >> 2) + 4 * hh) * 64] = cp[i];
                }
            }
            const int pos2 = dir ? p0 + 31 - t2 : p0 + t2;
            lds_barrier();
            {
                const float rv[4] = {bf_lo(ru.x), bf_hi(ru.x), bf_lo(ru.y), bf_hi(ru.y)}, kv[4] = {bf_lo(ku.x), bf_hi(ku.x), bf_lo(ku.y), bf_hi(ku.y)};
                const float4 a4 = *(const float4*)(AA + t2 * 64 + c4), cp4 = *(const float4*)(CP + t2 * 64 + c4), ce4 = *(const float4*)(CP + 31 * 64 + c4);
                float4 cq4 = make_float4(0.f, 0.f, 0.f, 0.f); if (t2 > 0) cq4 = *(const float4*)(CP + (t2 - 1) * 64 + c4);
                const float av[4] = {a4.x, a4.y, a4.z, a4.w}, cpv[4] = {cp4.x, cp4.y, cp4.z, cp4.w}, cev[4] = {ce4.x, ce4.y, ce4.z, ce4.w}, cqv[4] = {cq4.x, cq4.y, cq4.z, cq4.w};
                const float4 kkc = *(const float4*)(KC + c4), kac = *(const float4*)(KC + 64 + c4), rkc = *(const float4*)(KC + 128 + c4);
                const float kkcv[4] = {kkc.x, kkc.y, kkc.z, kkc.w}, kacv[4] = {kac.x, kac.y, kac.z, kac.w}, rkcv[4] = {rkc.x, rkc.y, rkc.z, rkc.w};
                float kk[4], km[4], ssq = 0.f, rks = 0.f;
#pragma unroll
                for (int i = 0; i < 4; ++i) { kk[i] = kv[i] * kkcv[i]; ssq += kk[i] * kk[i]; km[i] = kv[i] * (1.f + (av[i] - 1.f) * kacv[i]); rks += rv[i] * km[i] * rkcv[i]; }
                ssq = red16_sum(ssq); rks = red16_sum(rks);
                const float inv = 1.f / fmaxf(sqrtf(ssq), 1e-12f);
                float at[4], bt[4], kt[4], rt[4], bh[4], kh[4];
#pragma unroll
                for (int i = 0; i < 4; ++i) {
                    const float kn = kk[i] * inv, bb = kn * av[i];
                    const float en = __expf(-cpv[i]), eh = __expf(cev[i] - cpv[i]);
                    at[i] = -kn * __expf(cqv[i]); bt[i] = bb * en; kt[i] = km[i] * en; rt[i] = rv[i] * __expf(cpv[i]); bh[i] = bb * eh; kh[i] = km[i] * eh;
                }
                uint2 o;
                o.x = pack2(at[0], at[1]); o.y = pack2(at[2], at[3]); *(uint2*)(At + t2 * 72 + c4) = o;
                o.x = pack2(bt[0], bt[1]); o.y = pack2(bt[2], bt[3]); *(uint2*)(Bt + t2 * 72 + c4) = o;
                o.x = pack2(kt[0], kt[1]); o.y = pack2(kt[2], kt[3]); *(uint2*)(Kt + t2 * 72 + c4) = o;
                o.x = pack2(rt[0], rt[1]); o.y = pack2(rt[2], rt[3]); *(uint2*)(Rt + t2 * 72 + c4) = o;
                o.x = pack2(kh[0], kh[1]); o.y = pack2(kh[2], kh[3]); *(uint2*)(Khr + t2 * 96 + c4) = o;
                o.x = pack2(bh[0], bh[1]); o.y = pack2(bh[2], bh[3]); *(uint2*)(Bhr + t2 * 96 + c4) = o;
                *(uint2*)(Vr + t2 * 96 + c4) = vu;
                if (t2 == 0) *(float4*)(PC + c4) = make_float4(__expf(cev[0]), __expf(cev[1]), __expf(cev[2]), __expf(cev[3]));
                if ((tid & 15) == 0) rkb[(rowb + pos2) * 16 + hd] = rks;
                const int pos2n = dir ? p0n + 31 - t2 : p0n + t2; const size_t gon = (rowb + pos2n) * DM + cg;
                ru = *(const uint2*)(r_g + gon); ku = *(const uint2*)(k_g + gon); vu = *(const uint2*)(v_g + gon);
            }
            lds_barrier();
            if (w < 4) {
                const u16* X1 = (w < 2) ? At : Rt; const u16* X2 = (w & 1) ? Kt : Bt;
                f32x16 acc;
#pragma unroll
                for (int i = 0; i < 16; ++i) acc[i] = 0.f;
#pragma unroll
                for (int ks = 0; ks < 4; ++ks) acc = MFMA(frag_plain(X2 + l31 * 72, ks, hh), frag_plain(X1 + l31 * 72, ks, hh), acc);
#pragma unroll
                for (int i = 0; i < 16; ++i) { const int s = (i & 3) + 8 * (i >> 2) + 4 * hh; const bool keep = (w < 2) ? (s < l31) : (s <= l31); if (!keep) acc[i] = 0.f; }
                if (w == 0) {
#pragma unroll
                    for (int g = 0; g < 4; ++g) {
                        *(float4*)(Lf + l31 * 36 + 8 * g + 4 * hh) = make_float4(acc[4 * g], acc[4 * g + 1], acc[4 * g + 2], acc[4 * g + 3]);
                        const bool lo = (l31 >= 16) && (8 * g + 4 * hh < 16);
                        uint2 o; o.x = lo ? pack2(acc[4 * g], acc[4 * g + 1]) : 0u; o.y = lo ? pack2(acc[4 * g + 2], acc[4 * g + 3]) : 0u; *(uint2*)(Lo + l31 * 40 + 8 * g + 4 * hh) = o;
                    }
                } else {
                    u16* dst = (w == 1) ? Lak : (w == 2) ? Mrb : Mrk;
#pragma unroll
                    for (int g = 0; g < 4; ++g) { uint2 o; o.x = pack2(acc[4 * g], acc[4 * g + 1]); o.y = pack2(acc[4 * g + 2], acc[4 * g + 3]); *(uint2*)(dst + l31 * 40 + 8 * g + 4 * hh) = o; }
                }
            }
            lds_barrier();
            f32x16 XZ, Ya; bf16x8 zf[4];
            if (w >= 6) {
                const int blk = w - 6, j = lane & 15; const float* Lb = Lf + (16 * blk) * 36 + 16 * blk;
                const float4 l4 = *(const float4*)(Lb + (lane >> 2) * 36 + 4 * (lane & 3));
                const int li[4] = {__builtin_bit_cast(int, l4.x), __builtin_bit_cast(int, l4.y), __builtin_bit_cast(int, l4.z), __builtin_bit_cast(int, l4.w)};
                float x[16];
#pragma unroll
                for (int t = 0; t < 16; ++t) {
                    float a0 = (j == t) ? 1.f : 0.f, a1 = 0.f;
#pragma unroll
                    for (int s2 = 0; s2 < t; ++s2) {
                        const float lv = __builtin_bit_cast(float, __builtin_amdgcn_readlane(li[s2 & 3], 4 * t + (s2 >> 2)));
                        if (s2 & 1) a1 += lv * x[s2]; else a0 += lv * x[s2];
                    }
                    x[t] = a0 + a1;
                }
                if (lane < 16) {
#pragma unroll
                    for (int t = 0; t < 16; ++t) Td[(16 * blk + t) * 40 + 16 * blk + j] = (u16)(pack2(x[t], 0.f));
                }
            } else if (w < 2) {
#pragma unroll
                for (int s = 0; s < 4; ++s) zf[s] = acc_to_b(Z[s >> 1], s & 1);
#pragma unroll
                for (int i = 0; i < 16; ++i) { XZ[i] = 0.f; Ya[i] = 0.f; }
#pragma unroll
                for (int s = 0; s < 4; ++s) { XZ = MFMA(frag_perm(At + l31 * 72, s, hh), zf[s], XZ); Ya = MFMA(frag_perm(Rt + l31 * 72, s, hh), zf[s], Ya); }
                bf16x8 vf[2];
#pragma unroll
                for (int ks = 0; ks < 2; ++ks) {
                    vf[ks] = tr_frag(Vr + (16 * ks) * 96 + 32 * w, 96, lane);
                    XZ = MFMA(frag_perm(Lak + l31 * 40, ks, hh), vf[ks], XZ); Ya = MFMA(frag_perm(Mrk + l31 * 40, ks, hh), vf[ks], Ya);
                }
#pragma unroll
                for (int kt = 0; kt < 2; ++kt) {
#pragma unroll
                    for (int g = 0; g < 4; ++g) { const float4 pc4 = *(const float4*)(PC + 32 * kt + 8 * g + 4 * hh);
                        Z[kt][4 * g] *= pc4.x; Z[kt][4 * g + 1] *= pc4.y; Z[kt][4 * g + 2] *= pc4.z; Z[kt][4 * g + 3] *= pc4.w; }
#pragma unroll
                    for (int ks = 0; ks < 2; ++ks) Z[kt] = MFMA(tr_frag(Khr + (16 * ks) * 96 + 32 * kt, 96, lane), vf[ks], Z[kt]);
                }
            }
            lds_barrier();
            if (w < 2) {
                f32x16 U1 = {}, W = {};
#pragma unroll
                for (int i = 0; i < 16; ++i) { U1[i] = 0.f; W[i] = 0.f; }
#pragma unroll
                for (int ks = 0; ks < 2; ++ks) U1 = MFMA(frag_perm(Td + l31 * 40, ks, hh), acc_to_b(XZ, ks), U1);
#pragma unroll
                for (int ks = 0; ks < 2; ++ks) W = MFMA(frag_perm(Lo + l31 * 40, ks, hh), acc_to_b(U1, ks), W);
#pragma unroll
                for (int ks = 0; ks < 2; ++ks) U1 = MFMA(frag_perm(Td + l31 * 40, ks, hh), acc_to_b(W, ks), U1);
                const bf16x8 uf0 = acc_to_b(U1, 0), uf1 = acc_to_b(U1, 1);
                Ya = MFMA(frag_perm(Mrb + l31 * 40, 0, hh), uf0, Ya); Ya = MFMA(frag_perm(Mrb + l31 * 40, 1, hh), uf1, Ya);
#pragma unroll
                for (int kt = 0; kt < 2; ++kt) { Z[kt] = MFMA(tr_frag(Bhr + 32 * kt, 96, lane), uf0, Z[kt]); Z[kt] = MFMA(tr_frag(Bhr + 16 * 96 + 32 * kt, 96, lane), uf1, Z[kt]); }
#pragma unroll
                for (int i = 0; i < 16; ++i) { const int t = (i & 3) + 8 * (i >> 2) + 4 * hh; YS[t * 72 + 32 * w + l31] = (u16)pack2(Ya[i], 0.f); }
            }
            lds_barrier();
            if (ci >= 8) { const uint2 yv = *(const uint2*)(YS + t2 * 72 + c4); *(uint2*)(y_g + (rowb + pos2) * DM + cg) = yv; }
        }
        __syncthreads();
    }
}
DEVI void phase_rwkv_readout(const Params& p) {
    const u16* yf = (const u16*)(p.ws + R_YF); const u16* yb = (const u16*)(p.ws + R_YB); const u16* vg = (const u16*)(p.ws + R_RV); const u16* gg = (const u16*)(p.ws + R_GG);
    const float* rkb = (const float*)(p.ws + R_RKB); u16* rd = (u16*)(p.ws + R_RD);
    const float* lnw = p.in[I_RLNW]; const float* lnb = p.in[I_RLNB];
    const int lane = tidx() & 63, w = tidx() >> 6;
    for (int t = blockIdx.x * 8 + w; t < TL; t += gridDim.x * 8) {
        const int b = t >> 12, s = t & 4095; const size_t row = (size_t)b * LT + LC + s; const int c = lane * 16; const int hd = lane >> 2;
        float y[16], vv[16], gv[16];
#pragma unroll
        for (int q = 0; q < 2; ++q) {
            const uint4 a = *(const uint4*)(yf + row * DM + c + 8 * q), bq = *(const uint4*)(yb + row * DM + c + 8 * q), v4 = *(const uint4*)(vg + row * DM + c + 8 * q), g4 = *(const uint4*)(gg + row * DM + c + 8 * q);
            y[8 * q + 0] = bf_lo(a.x) + bf_lo(bq.x); y[8 * q + 1] = bf_hi(a.x) + bf_hi(bq.x); y[8 * q + 2] = bf_lo(a.y) + bf_lo(bq.y); y[8 * q + 3] = bf_hi(a.y) + bf_hi(bq.y);
            y[8 * q + 4] = bf_lo(a.z) + bf_lo(bq.z); y[8 * q + 5] = bf_hi(a.z) + bf_hi(bq.z); y[8 * q + 6] = bf_lo(a.w) + bf_lo(bq.w); y[8 * q + 7] = bf_hi(a.w) + bf_hi(bq.w);
            vv[8 * q + 0] = bf_lo(v4.x); vv[8 * q + 1] = bf_hi(v4.x); vv[8 * q + 2] = bf_lo(v4.y); vv[8 * q + 3] = bf_hi(v4.y); vv[8 * q + 4] = bf_lo(v4.z); vv[8 * q + 5] = bf_hi(v4.z); vv[8 * q + 6] = bf_lo(v4.w); vv[8 * q + 7] = bf_hi(v4.w);
            gv[8 * q + 0] = bf_lo(g4.x); gv[8 * q + 1] = bf_hi(g4.x); gv[8 * q + 2] = bf_lo(g4.y); gv[8 * q + 3] = bf_hi(g4.y); gv[8 * q + 4] = bf_lo(g4.z); gv[8 * q + 5] = bf_hi(g4.z); gv[8 * q + 6] = bf_lo(g4.w); gv[8 * q + 7] = bf_hi(g4.w);
        }
        float sm = 0.f;
#pragma unroll
        for (int i = 0; i < 16; ++i) sm += y[i];
        sm = red4_sum(sm); const float mean = sm * (1.f / 64.f);
        float vs = 0.f;
#pragma unroll
        for (int i = 0; i < 16; ++i) { const float d = y[i] - mean; vs += d * d; }
        vs = red4_sum(vs); const float rstd = rsqrtf(vs * (1.f / 64.f) + 64e-5f);
        const float bon = rkb[row * 16 + hd] + rkb[(size_t)T0 * 16 + row * 16 + hd];
        unsigned ow[8];
#pragma unroll
        for (int i = 0; i < 8; ++i) {
            const int c0 = c + 2 * i;
            const float o0 = ((y[2 * i] - mean) * rstd * lnw[c0] + lnb[c0] + bon * vv[2 * i]) * gv[2 * i];
            const float o1 = ((y[2 * i + 1] - mean) * rstd * lnw[c0 + 1] + lnb[c0 + 1] + bon * vv[2 * i + 1]) * gv[2 * i + 1];
            ow[i] = pack2(o0, o1);
        }
        *(uint4*)(rd + (size_t)t * DM + c) = make_uint4(ow[0], ow[1], ow[2], ow[3]); *(uint4*)(rd + (size_t)t * DM + c + 8) = make_uint4(ow[4], ow[5], ow[6], ow[7]);
    }
}
DEVI void phase_final_norm(const Params& p) {
    const float* g = p.in[I_NFIN]; float* X = p.out;
    const int lane = tidx() & 63, w = tidx() >> 6;
    for (int r = blockIdx.x * 8 + w; r < TL; r += gridDim.x * 8) {
        float4* xr = (float4*)(X + (size_t)r * DM); float4 v[4]; float ss = 0.f;
#pragma unroll
        for (int i = 0; i < 4; ++i) { v[i] = xr[lane + 64 * i]; ss += v[i].x * v[i].x + v[i].y * v[i].y + v[i].z * v[i].z + v[i].w * v[i].w; }
        ss = wave_sum(ss); const float rs = rsqrtf(ss * (1.f / 1024.f) + 1e-6f);
#pragma unroll
        for (int i = 0; i < 4; ++i) { const float4 gg = ((const float4*)g)[lane + 64 * i]; float4 o; o.x = v[i].x * rs * gg.x; o.y = v[i].y * rs * gg.y; o.z = v[i].z * rs * gg.z; o.w = v[i].w * rs * gg.w; xr[lane + 64 * i] = o; }
    }
}

constexpr int N_PHASES = 32;
template <int PH> DEVI void run_phase(const Params& p, char* lds) {
    const float* mods = (const float*)(p.ws + OFF_MODS);
    RowSrc in_src; in_src.ctx = p.in[I_CTX]; in_src.lat = p.in[I_X];
    RowSrc x_src; x_src.ctx = (const float*)(p.ws + OFF_XC); x_src.lat = p.out;
    if constexpr (PH == 0) phase_prologue(p, lds);
    else if constexpr (PH == 1) norm_rows(in_src, 0, T0, p.in[I_NMIX], mods, 0, 1, (u16*)(p.ws + A_N0));
    else if constexpr (PH == 2) phase_gemm_win(p, lds);
    else if constexpr (PH == 3) phase_gemm_qkv(p, lds);
    else if constexpr (PH == 4) { phase_attention(p, lds); conv_jobs(p, 25, 28, 0, 0, lds); }
    else if constexpr (PH == 5) phase_gemm_wo(p, (const u16*)(p.ws + A_N0), (const u16*)(p.ws + W_OA), in_src, 0, 0, lds);
    else if constexpr (PH == 6) phase_moe_norm(p, 0);
    else if constexpr (PH == 7) phase_moe_route(p, 0, lds);
    else if constexpr (PH == 8) phase_moe_gemm1(p, 0, lds);
    else if constexpr (PH >= 9 && PH <= 13) phase_moe_g2c(p, 0, PH - 9 < NCHUNK ? PH - 9 : -1, PH - 10, lds);
    else if constexpr (PH == 14) norm_rows(x_src, 0, T0, p.in[I_NMIX] + 1024, mods + 9 * 6144, 0, 1, (u16*)(p.ws + R_NN));
    else if constexpr (PH == 15) phase_rwkv_mix(p, 0, 2, 3);
    else if constexpr (PH == 16) phase_rwkv_gemm_rkv(p, lds);
    else if constexpr (PH == 17) phase_rwkv_mix(p, 1, 4, 5);
    else if constexpr (PH == 18) phase_rwkv_gemm_small(p, lds);
    else if constexpr (PH == 19) phase_rwkv_gemm_g(p, lds);
    else if constexpr (PH == 20) phase_rwkv_scan(p, lds);
    else if constexpr (PH == 21) phase_rwkv_readout(p);
    else if constexpr (PH == 22) { phase_gemm_wo(p, (const u16*)(p.ws + R_RD), (const u16*)(p.ws + W_RO), x_src, 1, 1, lds); conv_jobs(p, 25, 28, 1, 0, lds); }
    else if constexpr (PH == 23) phase_moe_norm(p, 1);
    else if constexpr (PH == 24) phase_moe_route(p, 1, lds);
    else if constexpr (PH == 25) phase_moe_gemm1(p, 1, lds);
    else if constexpr (PH >= 26 && PH <= 30) phase_moe_g2c(p, 1, PH - 26 < NCHUNK ? PH - 26 : -1, PH - 27, lds);
    else if constexpr (PH == 31) phase_final_norm(p);
}

#if MEGA
template <int PH, int END> DEVI void run_range(const Params& p_, char* lds, const XcdBarrier& bar) {
    const Params& p = *(const Params*)__builtin_amdgcn_kernarg_segment_ptr();
    run_phase<PH>(p, lds);
    if constexpr (PH + 1 < END) { xcd_barrier(bar); run_range<PH + 1, END>(p_, lds, bar); }
}
template <int A, int B> __global__ void __launch_bounds__(512, 2) k_range(Params p, unsigned* barw) {
    extern __shared__ __attribute__((aligned(16))) char smem[];
    if (threadIdx.x == 0) *(uint4*)smem = make_uint4(0u, 0u, 0u, 0u);
    __syncthreads();
    const XcdBarrier bar = xcd_barrier_post(barw, (volatile LAS unsigned*)smem);
    run_range<A, B>(p, smem + 64, bar);
}
template <int A, int B> static void launch_range(const Params& p, unsigned* barw, hipStream_t s) {
    static int grid = 0;
    if (!grid) {
        int dev = 0, cus = 0, per_cu = 0;
        (void)hipGetDevice(&dev);
        (void)hipDeviceGetAttribute(&cus, hipDeviceAttributeMultiprocessorCount, dev);
        (void)hipFuncSetAttribute((const void*)k_range<A, B>, hipFuncAttributeMaxDynamicSharedMemorySize, LDS_BYTES);
        (void)hipOccupancyMaxActiveBlocksPerMultiprocessor(&per_cu, (const void*)k_range<A, B>, 512, LDS_BYTES);
        if (per_cu < 1) fprintf(stderr, "occupancy query says 0 blocks per CU\n");
        grid = cus;
    }
    k_range<A, B><<<grid, 512, LDS_BYTES, s>>>(p, barw);
}
extern "C" void kernel_launch(void* const* d_in, const int* in_sizes, int n_in, void* d_out, int out_size, void* d_ws, size_t ws_size, hipStream_t stream) {
    Params p{};
    for (int i = 0; i < N_IN; ++i) p.in[i] = (const float*)d_in[i];
    p.out = (float*)d_out; p.ws = (char*)d_ws;
    if (ws_size < WS_NEED) { fprintf(stderr, "workspace too small\n"); return; }
    (void)hipMemsetAsync(p.ws + OFF_BAR, 0, XCD_BAR_WORDS * sizeof(unsigned), stream);
    launch_range<0, N_PHASES>(p, (unsigned*)(p.ws + OFF_BAR), stream);
}
#else
template <int PH> __global__ void __launch_bounds__(512, 2) k_phase(Params p) {
    extern __shared__ __attribute__((aligned(16))) char smem[];
    run_phase<PH>(p, smem + 64);
}
template <int PH> static void launch_phase(const Params& p, hipStream_t s) {
    static bool attr = false;
    if (!attr) { hipFuncSetAttribute((const void*)k_phase<PH>, hipFuncAttributeMaxDynamicSharedMemorySize, LDS_BYTES); attr = true; }
    k_phase<PH><<<256, 512, LDS_BYTES, s>>>(p);
}
template <int PH> static void launch_all(const Params& p, hipStream_t s) {
    launch_phase<PH>(p, s);
    if constexpr (PH + 1 < N_PHASES) launch_all<PH + 1>(p, s);
}

extern "C" void kernel_launch(void* const* d_in, const int* in_sizes, int n_in, void* d_out, int out_size, void* d_ws, size_t ws_size, hipStream_t stream) {
    Params p{};
    for (int i = 0; i < N_IN; ++i) p.in[i] = (const float*)d_in[i];
    p.out = (float*)d_out; p.ws = (char*)d_ws;
    if (ws_size < WS_NEED) { fprintf(stderr, "workspace too small: %zu < %zu\n", ws_size, (size_t)WS_NEED); return; }
    launch_all<0>(p, stream);
}
#endif
```

```cpp
#include <hip/hip_runtime.h>
#include <stdint.h>
#include <stdio.h>
#include <type_traits>

#ifndef MEGA
#define MEGA 1
#endif

typedef unsigned short u16;
typedef short bf16x8 __attribute__((ext_vector_type(8)));
typedef short s16x4 __attribute__((ext_vector_type(4)));
typedef float f32x16 __attribute__((ext_vector_type(16)));
typedef float f32x4 __attribute__((ext_vector_type(4)));
typedef float f32x2 __attribute__((ext_vector_type(2)));
typedef unsigned u32x4 __attribute__((ext_vector_type(4)));
typedef __bf16 bf2 __attribute__((ext_vector_type(2)));
#define DEVI __device__ __forceinline__
#define LAS __attribute__((address_space(3)))
__device__ __forceinline__ int tidx() { int t = threadIdx.x; asm volatile("" : "+v"(t)); return t; }

constexpr int NB = 8, SEQ = 4096, LC = 256, LT = 4352, DM = 1024, T0 = NB * LT, TL = NB * SEQ;
constexpr int NCHUNK = 4;
constexpr float LOG2E = 1.4426950408889634f;
constexpr float QA_SCALE = 0.07216878364870322f * LOG2E;
constexpr float QS_SCALE = 0.125f * LOG2E;

enum { I_X = 0, I_C, I_CTX, I_CCTX, I_ADAW, I_ADAB, I_NMIX, I_NFFN, I_NFIN, I_AWIN, I_AQN, I_AKVN, I_AWUQ, I_AWUKV, I_ASINK, I_AWO,
       I_RMU, I_RWR, I_RWK, I_RWV, I_RWO, I_RG1, I_RG2, I_RW0, I_RW1, I_RW2, I_RA0, I_RA1, I_RA2, I_RKK, I_RKA, I_RRK, I_RLNW, I_RLNB,
       I_MROUT, I_MBIAS, I_MWG, I_MWU, I_MWD, I_MSG, I_MSU, I_MSD, N_IN };

struct Params { const float* in[N_IN]; float* out; char* ws; };

constexpr size_t OFF_BAR = 0, OFF_CNT = 16384, OFF_ROPE = 20480, OFF_MODS = 32768, OFF_WSTAT = 524288;
constexpr size_t W_IN = OFF_WSTAT, W_UQ = W_IN + 3145728, W_UK = W_UQ + 589824, W_UV = W_UK + 262144, W_OA = W_UV + 262144,
                 W_RR = W_OA + 2097152, W_RK = W_RR + 2097152, W_RV = W_RK + 2097152, W_RO = W_RV + 2097152,
                 W_G1 = W_RO + 2097152, W_W1 = W_G1 + 262144, W_A1 = W_W1 + 262144, W_G2 = W_A1 + 262144, W_W2 = W_G2 + 262144, W_A2 = W_W2 + 262144,
                 W_SGU = W_A2 + 262144, W_SD = W_SGU + 2 * 1048576, W_END = W_SD + 2 * 524288;
constexpr size_t OFF_XC = OFF_WSTAT + 20971520;
constexpr size_t OFF_TOKE = OFF_XC + 8388608, OFF_TOKR = OFF_TOKE + 835584, OFF_LTOK = OFF_TOKR + 835584, OFF_LG = OFF_LTOK + 8912896;
constexpr size_t OFF_WROUT = OFF_LG + 8912896;
constexpr size_t OFF_D = OFF_XC + 8388608 + 20971520;
static_assert(OFF_WROUT + 2 * 64 * 3072 * 2 <= OFF_D, "router weights overflow");
constexpr size_t WGU_BYTES = 64ull * 512 * 1024 * 2, WD_BYTES = 64ull * 1024 * 256 * 2;
constexpr size_t OFF_WGU = OFF_D, OFF_WD = OFF_D + WGU_BYTES;
constexpr size_t OFF_G = OFF_D + WGU_BYTES + WD_BYTES;
constexpr size_t SZ_T0D = (size_t)T0 * 1024 * 2;
constexpr size_t A_N0 = OFF_G, A_CQ = A_N0 + SZ_T0D, A_CKV = A_CQ + (size_t)T0 * 384 * 2, A_QA = A_CKV + (size_t)T0 * 256 * 2, A_KA = A_QA + (size_t)T0 * 768 * 2,
                 A_VA = A_KA + (size_t)T0 * 768 * 2, A_QS = A_VA + (size_t)T0 * 512 * 2, A_KS = A_QS + (size_t)T0 * 512 * 2, A_VS = A_KS + (size_t)T0 * 128 * 2, A_END = A_VS + (size_t)T0 * 128 * 2;
constexpr size_t M_N1 = OFF_G, M_ACT = M_N1 + SZ_T0D, M_OUTR = M_ACT + (size_t)7 * T0 * 256 * 2, SZ_OUTR = (size_t)7 * 8704 * 1024 * 2, M_END = M_OUTR + 2 * SZ_OUTR;
constexpr size_t R_XM0 = OFF_D, R_XM1 = R_XM0 + SZ_T0D, R_XM2 = R_XM1 + SZ_T0D, R_RR = R_XM2 + SZ_T0D, R_RK = R_RR + SZ_T0D, R_RV = R_RK + SZ_T0D, R_NN = R_RV + SZ_T0D,
                 R_HG = R_NN + SZ_T0D, R_HW = R_HG + (size_t)T0 * 128 * 2, R_HA = R_HW + (size_t)T0 * 128 * 2, R_RKB = R_HA + (size_t)T0 * 128 * 2, R_END = R_RKB + (size_t)2 * T0 * 16 * 4;
constexpr size_t R_GG = R_XM0, R_YF = R_XM1, R_YB = R_XM2, R_RD = R_NN;
constexpr size_t WS_NEED = R_END > M_END ? R_END : M_END;

constexpr int LDS_BYTES = 64 + 131072;

DEVI unsigned pack2(float a, float b) { f32x2 v = {a, b}; bf2 r = __builtin_convertvector(v, bf2); return __builtin_bit_cast(unsigned, r); }
DEVI float bf_lo(unsigned u) { return __builtin_bit_cast(float, u << 16); }
DEVI float bf_hi(unsigned u) { return __builtin_bit_cast(float, u & 0xffff0000u); }
DEVI float bf1(u16 u) { return __builtin_bit_cast(float, ((unsigned)u) << 16); }
DEVI float dppf(float x, const int ctrl_sel) {
    int xi = __builtin_bit_cast(int, x), y;
    if (ctrl_sel == 0) y = __builtin_amdgcn_mov_dpp(xi, 0xB1, 0xF, 0xF, true);
    else if (ctrl_sel == 1) y = __builtin_amdgcn_mov_dpp(xi, 0x4E, 0xF, 0xF, true);
    else y = __builtin_amdgcn_mov_dpp(xi, 0x141, 0xF, 0xF, true);
    return __builtin_bit_cast(float, y);
}
DEVI float red8_sum(float x) { x += dppf(x, 0); x += dppf(x, 1); x += dppf(x, 2); return x; }
DEVI float red8_max(float x) { x = fmaxf(x, dppf(x, 0)); x = fmaxf(x, dppf(x, 1)); x = fmaxf(x, dppf(x, 2)); return x; }
DEVI float red4_sum(float x) { x += dppf(x, 0); x += dppf(x, 1); return x; }
DEVI float wave_sum(float x) { for (int o = 32; o > 0; o >>= 1) x += __shfl_xor(x, o); return x; }
DEVI float wave_max(float x) { for (int o = 32; o > 0; o >>= 1) x = fmaxf(x, __shfl_xor(x, o)); return x; }
DEVI float xhalf(float x) {
    int l = (int)__builtin_amdgcn_mbcnt_hi(~0u, __builtin_amdgcn_mbcnt_lo(~0u, 0u)); asm volatile("" : "+v"(l));
    return __builtin_bit_cast(float, __builtin_amdgcn_ds_bpermute((l ^ 32) << 2, __builtin_bit_cast(int, x)));
}
DEVI void lds_barrier() { asm volatile("s_waitcnt lgkmcnt(0)\n\ts_barrier" ::: "memory"); }
DEVI float sigmoidf_(float x) { return 1.f / (1.f + __expf(-x)); }
DEVI float siluf_(float x) { return x / (1.f + __expf(-x)); }
DEVI float tanhf_(float x) { float e = __expf(2.f * x); return 1.f - 2.f / (e + 1.f); }

#define XB_TMO      128
#define XB_XCNT(j)  (256  + 64 * (j))
#define XB_XSUB(j)  (1280 + 64 * (j))
#define XB_XGEN(j)  (2304 + 64 * (j))
#define XB_TOP      3328
#define XB_TOPGEN   3392
#define XCD_BAR_WORDS 3456
#define XB_SPIN_CAP (1u << 20)
DEVI unsigned xb_ld(unsigned* p)              { return __hip_atomic_load(p, __ATOMIC_RELAXED, __HIP_MEMORY_SCOPE_AGENT); }
DEVI unsigned xb_add(unsigned* p, unsigned v) { return __hip_atomic_fetch_add(p, v, __ATOMIC_RELAXED, __HIP_MEMORY_SCOPE_AGENT); }
DEVI unsigned xb_xcc_id() { return (unsigned)__builtin_amdgcn_s_getreg((3 << 11) | 20) & 0xFu; }
#define XB_SPIN(cond, bar) do { unsigned _sp = 0; while (cond) { __builtin_amdgcn_s_sleep(1); \
    if ((++_sp & 255u) == 0u) { if (xb_ld(&(bar)[XB_TMO])) break; if (_sp > XB_SPIN_CAP) { atomicAdd(&(bar)[XB_TMO], 1u); break; } } } } while (0)
struct XcdBarrier { unsigned* bar; unsigned x; volatile LAS unsigned* st; };
DEVI XcdBarrier xcd_barrier_post(unsigned* bar, volatile LAS unsigned* st) {
    XcdBarrier b; b.bar = bar; b.x = xb_xcc_id(); b.st = st;
    if (threadIdx.x == 0) (void)xb_add(&bar[XB_XCNT(b.x)], 1u);
    return b;
}
DEVI void xcd_barrier_complete(unsigned* bar, unsigned x, unsigned& nloc, unsigned& nx) {
    const unsigned G = gridDim.x * gridDim.y * gridDim.z;
    unsigned sum, cnt, mine, sp = 0u;
    for (;;) {
        sum = 0u; cnt = 0u; mine = 0u;
#pragma unroll
        for (unsigned j = 0; j < 16; ++j) { const unsigned c = xb_ld(&bar[XB_XCNT(j)]); sum += c; cnt += (c > 0u) ? 1u : 0u; mine = (j == x) ? c : mine; }
        if (sum == G) break;
        __builtin_amdgcn_s_sleep(1);
        if ((++sp & 255u) == 0u) { if (xb_ld(&bar[XB_TMO])) break; if (sp > XB_SPIN_CAP) { atomicAdd(&bar[XB_TMO], 1u); break; } }
    }
    nloc = mine > 0u ? mine : 1u; nx = cnt > 0u ? cnt : 1u;
}
DEVI void xcd_barrier(const XcdBarrier& b) {
    asm volatile("s_waitcnt vmcnt(0)" ::: "memory");
    __syncthreads();
    if (threadIdx.x == 0) {
        unsigned* bar = b.bar;
        __builtin_amdgcn_s_waitcnt(0);
        unsigned nloc = b.st[0], nx = b.st[1];
        if (nloc == 0u) { xcd_barrier_complete(bar, b.x, nloc, nx); b.st[0] = nloc; b.st[1] = nx; }
        const unsigned old = xb_add(&bar[XB_XSUB(b.x)], 1u);
        const unsigned gen = old / nloc;
        if (old + 1u == (gen + 1u) * nloc) {
            __builtin_amdgcn_fence(__ATOMIC_RELEASE, "agent");
            asm volatile("s_waitcnt vmcnt(0)" ::: "memory");
            const unsigned og = xb_add(&bar[XB_TOP], 1u);
            const unsigned tg = og / nx;
            if (og + 1u == (tg + 1u) * nx) xb_add(&bar[XB_TOPGEN], 1u);
            else XB_SPIN(xb_ld(&bar[XB_TOPGEN]) == tg, bar);
            __builtin_amdgcn_fence(__ATOMIC_ACQUIRE, "agent");
            xb_add(&bar[XB_XGEN(b.x)], 1u);
            asm volatile("s_waitcnt vmcnt(0)" ::: "memory");
        } else {
            XB_SPIN(xb_ld(&bar[XB_XGEN(b.x)]) == gen, bar);
            __builtin_amdgcn_fence(__ATOMIC_ACQUIRE, "agent");
            asm volatile("s_waitcnt vmcnt(0)" ::: "memory");
        }
    }
    __syncthreads();
}

DEVI int swz(int u) { return (u & ~255) | ((u & 7) << 5) | ((u >> 3) & 31); }
struct RowSrc { const float* ctx; const float* lat; };
DEVI const float* row_ptr(const RowSrc& s, int mode, int r, int& bb) {
    if (mode == 0) { int b = r / LT, pp = r - b * LT; if (pp < LC) { bb = 8; return s.ctx + (size_t)(b * LC + pp) * DM; } bb = b; return s.lat + (size_t)(b * SEQ + pp - LC) * DM; }
    bb = r >> 12; return s.lat + (size_t)r * DM;
}
DEVI float* row_ptr_w(float* ctx, float* lat, int mode, int r, int& bb) {
    if (mode == 0) { int b = r / LT, pp = r - b * LT; if (pp < LC) { bb = 8; return ctx + (size_t)(b * LC + pp) * DM; } bb = b; return lat + (size_t)(b * SEQ + pp - LC) * DM; }
    bb = r >> 12; return lat + (size_t)r * DM;
}

DEVI float sumsq8(const bf16x8& v) {
    float s = 0.f;
    const unsigned* u = (const unsigned*)&v;
#pragma unroll
    for (int i = 0; i < 4; ++i) { bf2 b = __builtin_bit_cast(bf2, u[i]); s = __builtin_amdgcn_fdot2_f32_bf16(b, b, s, false); }
    return s;
}
template <int NA, int NBC> struct GemmRegs { u32x4 ra[2][NA], rb[2][NBC]; };
template <int BM, int BN, bool ROWNORM, class ARow, class ARowN, class XF, class ST>
DEVI void gemm_tile(GemmRegs<BM / 64, BN / 64>& R, bool primed, ARow arow, const u16* __restrict__ Bt, ARowN arow_n, const u16* __restrict__ Bt_n, int ldb, int K, XF xf, ST st, char* lds, size_t ksA = 64, size_t ksB = 64) {
    constexpr int WN = BN / 64, NA = BM / 64, NBC = BN / 64, STR = 72;
    const int tid = tidx(), lane = tid & 63, w = tid >> 6, wm = w / WN, wn = w % WN, l31 = lane & 31, h = lane >> 5;
    u16* sA = (u16*)lds; u16* sB = sA + 2 * BM * STR;
    const int crow = tid >> 3, kc = tid & 7;
    const u16* pa[NA]; const u16* pb[NBC]; const u16* pan[NA]; const u16* pbn[NBC];
#pragma unroll
    for (int i = 0; i < NA; ++i) { pa[i] = arow(crow + 64 * i) + kc * 8; pan[i] = pa[i]; }
#pragma unroll
    for (int i = 0; i < NBC; ++i) { pb[i] = Bt + (size_t)(crow + 64 * i) * ldb + kc * 8; pbn[i] = pb[i]; }
    const bool chain = Bt_n != nullptr;
    if (chain) {
#pragma unroll
        for (int i = 0; i < NA; ++i) pan[i] = arow_n(crow + 64 * i) + kc * 8;
#pragma unroll
        for (int i = 0; i < NBC; ++i) pbn[i] = Bt_n + (size_t)(crow + 64 * i) * ldb + kc * 8;
    }
    const int nk = K >> 6;
    auto load_tile = [&](int g, auto setc) {
        constexpr int set = decltype(setc)::value;
        if (g < nk) {
#pragma unroll
            for (int i = 0; i < NA; ++i) R.ra[set][i] = *(const u32x4*)(pa[i] + g * ksA);
#pragma unroll
            for (int i = 0; i < NBC; ++i) R.rb[set][i] = *(const u32x4*)(pb[i] + g * ksB);
        } else if (chain && g < nk + 2) {
#pragma unroll
            for (int i = 0; i < NA; ++i) R.ra[set][i] = *(const u32x4*)(pan[i] + (g - nk) * ksA);
#pragma unroll
            for (int i = 0; i < NBC; ++i) R.rb[set][i] = *(const u32x4*)(pbn[i] + (g - nk) * ksB);
        }
    };
    using I0 = std::integral_constant<int, 0>; using I1 = std::integral_constant<int, 1>;
    if (!primed) { load_tile(0, I0{}); load_tile(1, I1{}); }
    f32x16 acc[2][2];
#pragma unroll
    for (int a = 0; a < 2; ++a)
#pragma unroll
        for (int b = 0; b < 2; ++b)
#pragma unroll
            for (int i = 0; i < 16; ++i) acc[a][b][i] = 0.f;
    float ss[2] = {0.f, 0.f};
#pragma unroll
    for (int i = 0; i < NA; ++i) *(u32x4*)(sA + (crow + 64 * i) * STR + kc * 8) = R.ra[0][i];
#pragma unroll
    for (int i = 0; i < NBC; ++i) *(u32x4*)(sB + (crow + 64 * i) * STR + kc * 8) = R.rb[0][i];
    lds_barrier();
    load_tile(2, I0{});
    auto ktile = [&](int kt, auto curc) {
        constexpr int cur = decltype(curc)::value, nxt = cur ^ 1;
        const u16* a_ = sA + cur * BM * STR; const u16* b_ = sB + cur * BN * STR;
        u16* an = sA + nxt * BM * STR; u16* bn = sB + nxt * BN * STR;
#pragma unroll
        for (int ks = 0; ks < 4; ++ks) {
            bf16x8 af[2], bfr[2];
#pragma unroll
            for (int mi = 0; mi < 2; ++mi) af[mi] = *(const bf16x8*)(a_ + (wm * 64 + mi * 32 + l31) * STR + ks * 16 + h * 8);
#pragma unroll
            for (int ni = 0; ni < 2; ++ni) bfr[ni] = *(const bf16x8*)(b_ + (wn * 64 + ni * 32 + l31) * STR + ks * 16 + h * 8);
            if (ROWNORM) { ss[0] += sumsq8(af[0]); ss[1] += sumsq8(af[1]); }
#pragma unroll
            for (int mi = 0; mi < 2; ++mi)
#pragma unroll
                for (int ni = 0; ni < 2; ++ni) acc[mi][ni] = __builtin_amdgcn_mfma_f32_32x32x16_bf16(bfr[ni], af[mi], acc[mi][ni], 0, 0, 0);
            if (ks == 1 && kt + 1 < nk) {
#pragma unroll
                for (int i = 0; i < NA; ++i) *(u32x4*)(an + (crow + 64 * i) * STR + kc * 8) = R.ra[nxt][i];
#pragma unroll
                for (int i = 0; i < NBC; ++i) *(u32x4*)(bn + (crow + 64 * i) * STR + kc * 8) = R.rb[nxt][i];
            }
        }
        lds_barrier();
        load_tile(kt + 3, std::integral_constant<int, nxt>{});
    };
    for (int kt = 0; kt < nk; kt += 2) { ktile(kt, I0{}); ktile(kt + 1, I1{}); }
    if (ROWNORM) {
#pragma unroll
        for (int mi = 0; mi < 2; ++mi) {
            float s = ss[mi] + __shfl_xor(ss[mi], 32);
            float r = rsqrtf(s / (float)K + 1e-6f);
#pragma unroll
            for (int ni = 0; ni < 2; ++ni)
#pragma unroll
                for (int i = 0; i < 16; ++i) acc[mi][ni][i] *= r;
        }
    }
    constexpr int TS = BN + 4;
    u16* sT = (u16*)lds;
    lds_barrier();
#pragma unroll
    for (int mi = 0; mi < 2; ++mi) {
        const int r = wm * 64 + mi * 32 + l31;
        xf(r, wn * 64, acc[mi], h);
#pragma unroll
        for (int ni = 0; ni < 2; ++ni)
#pragma unroll
            for (int g = 0; g < 4; ++g) { uint2 v; v.x = pack2(acc[mi][ni][4 * g], acc[mi][ni][4 * g + 1]); v.y = pack2(acc[mi][ni][4 * g + 2], acc[mi][ni][4 * g + 3]);
                *(uint2*)(sT + r * TS + wn * 64 + ni * 32 + 8 * g + 4 * h) = v; }
    }
    lds_barrier();
#pragma unroll 2
    for (int q = tid; q < BM * BN / 8; q += 512) {
        const int r = q / (BN / 8), c8 = (q % (BN / 8)) * 8;
        const uint2 lo = *(const uint2*)(sT + r * TS + c8), hi = *(const uint2*)(sT + r * TS + c8 + 4);
        u32x4 v = {lo.x, lo.y, hi.x, hi.y};
        st(r, c8, v);
    }
    lds_barrier();
}
DEVI void store_tile_bf16(u16* dst, const f32x16& t, int h) {
#pragma unroll
    for (int g = 0; g < 4; ++g) { uint2 v; v.x = pack2(t[4 * g], t[4 * g + 1]); v.y = pack2(t[4 * g + 2], t[4 * g + 3]); *(uint2*)(dst + 8 * g + 4 * h) = v; }
}
DEVI void rope_tile(f32x16& t, int axis, int pp, int h, const float2* __restrict__ tab) {
    if (pp < LC) return;
    const int s = pp - LC; const int coord = axis ? (s & 63) : (s >> 6);
#pragma unroll
    for (int g = 0; g < 2; ++g)
#pragma unroll
        for (int i = 0; i < 4; ++i) {
            const float2 cs = tab[coord * 16 + 8 * g + 4 * h + i];
            const float x1 = t[4 * g + i], x2 = t[4 * (g + 2) + i];
            t[4 * g + i] = x1 * cs.x - x2 * cs.y; t[4 * (g + 2) + i] = x2 * cs.x + x1 * cs.y;
        }
}

struct CJob { const float* src; u16* dst; const float* gain; int K, ldsrc, nlog, nvalid, sseg, sstride, soff, dseg, dstride, doff; int nmat; size_t smat, dmat; int ktiled; };
DEVI void get_job(const Params& p, int j, int layer, CJob& J) {
    char* ws = p.ws;
    J.gain = nullptr; J.ktiled = 0; J.nmat = 1; J.smat = 0; J.dmat = 0; J.sseg = 1 << 30; J.sstride = 0; J.soff = 0; J.dseg = 1 << 30; J.dstride = 0; J.doff = 0;
    auto plain = [&](const float* src, size_t dstoff, int K, int N) { J.src = src; J.dst = (u16*)(ws + dstoff); J.K = K; J.ldsrc = N; J.nlog = N; J.nvalid = N; };
    switch (j) {
    case 0: plain(p.in[I_AWIN], W_IN, 1024, 1472); J.nlog = 1536; break;
    case 1: plain(p.in[I_AWUQ], W_UQ, 384, 768); J.gain = p.in[I_AQN]; break;
    case 2: plain(p.in[I_AWUKV], W_UK, 256, 1024); J.nlog = 512; J.nvalid = 512; J.sseg = 128; J.sstride = 256; J.soff = 0; J.gain = p.in[I_AKVN]; break;
    case 3: plain(p.in[I_AWUKV], W_UV, 256, 1024); J.nlog = 512; J.nvalid = 512; J.sseg = 128; J.sstride = 256; J.soff = 128; J.gain = p.in[I_AKVN]; break;
    case 4: plain(p.in[I_AWO], W_OA, 1024, 1024); break;
    case 5: plain(p.in[I_RWR], W_RR, 1024, 1024); break;
    case 6: plain(p.in[I_RWK], W_RK, 1024, 1024); break;
    case 7: plain(p.in[I_RWV], W_RV, 1024, 1024); break;
    case 8: plain(p.in[I_RWO], W_RO, 1024, 1024); break;
    case 9: plain(p.in[I_RG1], W_G1, 1024, 128); break;
    case 10: plain(p.in[I_RW1], W_W1, 1024, 64); break;
    case 11: plain(p.in[I_RW1] + 1024 * 64, W_W1 + 64 * 1024 * 2, 1024, 64); break;
    case 12: plain(p.in[I_RA1], W_A1, 1024, 64); break;
    case 13: plain(p.in[I_RA1] + 1024 * 64, W_A1 + 64 * 1024 * 2, 1024, 64); break;
    case 14: plain(p.in[I_RG2], W_G2, 128, 1024); break;
    case 15: plain(p.in[I_RW2], W_W2, 64, 1024); break;
    case 16: plain(p.in[I_RW2] + 64 * 1024, W_W2 + 1024 * 64 * 2, 64, 1024); break;
    case 17: plain(p.in[I_RA2], W_A2, 64, 1024); break;
    case 18: plain(p.in[I_RA2] + 64 * 1024, W_A2 + 1024 * 64 * 2, 64, 1024); break;
    case 19: plain(p.in[I_MSG], W_SGU, 1024, 256); J.dseg = 32; J.dstride = 64; J.doff = 0; break;
    case 20: plain(p.in[I_MSU], W_SGU, 1024, 256); J.dseg = 32; J.dstride = 64; J.doff = 32; break;
    case 21: plain(p.in[I_MSG] + 1024 * 256, W_SGU + 1048576, 1024, 256); J.dseg = 32; J.dstride = 64; J.doff = 0; break;
    case 22: plain(p.in[I_MSU] + 1024 * 256, W_SGU + 1048576, 1024, 256); J.dseg = 32; J.dstride = 64; J.doff = 32; break;
    case 23: plain(p.in[I_MSD], W_SD, 256, 1024); J.ktiled = 1; break;
    case 24: plain(p.in[I_MSD] + 256 * 1024, W_SD + 524288, 256, 1024); J.ktiled = 1; break;
    case 25: plain(p.in[I_MWG] + (size_t)layer * 64 * 1024 * 256, OFF_WGU, 1024, 256); J.dseg = 32; J.dstride = 64; J.doff = 0; J.nmat = 64; J.smat = 1024 * 256; J.dmat = 512 * 1024; break;
    case 26: plain(p.in[I_MWU] + (size_t)layer * 64 * 1024 * 256, OFF_WGU, 1024, 256); J.dseg = 32; J.dstride = 64; J.doff = 32; J.nmat = 64; J.smat = 1024 * 256; J.dmat = 512 * 1024; break;
    default: plain(p.in[I_MWD] + (size_t)layer * 64 * 256 * 1024, OFF_WD, 256, 1024); J.nmat = 64; J.smat = 256 * 1024; J.dmat = 1024 * 256; J.ktiled = 1; break;
    }
}
DEVI int job_tiles(const CJob& J) { return J.nmat * (J.nlog / 64) * ((J.K + 127) / 128); }
DEVI void conv_tile(const CJob& J, int t, char* lds) {
    const int ktiles = (J.K + 127) / 128, ntiles = J.nlog / 64;
    const int mat = t / (ktiles * ntiles); const int r = t - mat * ktiles * ntiles; const int nt = r / ktiles, ktile = r - nt * ktiles;
    const float* src = J.src + (size_t)mat * J.smat; u16* dst = J.dst + (size_t)mat * J.dmat;
    unsigned* sm = (unsigned*)lds;
    const int tid = tidx(), ng = tid & 15, kp = tid >> 4;
    const int n0 = nt * 64 + ng * 4;
    const int scol = (n0 / J.sseg) * J.sstride + J.soff + (n0 % J.sseg);
    const bool nval = n0 < J.nvalid;
#pragma unroll
    for (int pass = 0; pass < 2; ++pass) {
        const int k = ktile * 128 + pass * 64 + kp * 2;
        float4 v0 = make_float4(0.f, 0.f, 0.f, 0.f), v1 = v0;
        if (nval && k < J.K) {
            v0 = *(const float4*)(src + (size_t)k * J.ldsrc + scol); v1 = *(const float4*)(src + (size_t)(k + 1) * J.ldsrc + scol);
            if (J.gain) { const float g0 = J.gain[k], g1 = J.gain[k + 1]; v0.x *= g0; v0.y *= g0; v0.z *= g0; v0.w *= g0; v1.x *= g1; v1.y *= g1; v1.z *= g1; v1.w *= g1; }
        }
        const int kk = pass * 32 + kp;
        sm[(ng * 4 + 0) * 66 + kk] = pack2(v0.x, v1.x); sm[(ng * 4 + 1) * 66 + kk] = pack2(v0.y, v1.y);
        sm[(ng * 4 + 2) * 66 + kk] = pack2(v0.z, v1.z); sm[(ng * 4 + 3) * 66 + kk] = pack2(v0.w, v1.w);
    }
    __syncthreads();
#pragma unroll
    for (int i = 0; i < 2; ++i) {
        const int c = tid + 512 * i, row = c >> 4, ch = c & 15;
        const int n = nt * 64 + row; const int drow = (n / J.dseg) * J.dstride + J.doff + (n % J.dseg);
        const int k = ktile * 128 + ch * 8;
        if (k < J.K) { uint2 lo = *(const uint2*)(sm + row * 66 + ch * 4), hi = *(const uint2*)(sm + row * 66 + ch * 4 + 2); uint4 v = make_uint4(lo.x, lo.y, hi.x, hi.y);
            u16* dp = J.ktiled ? dst + ((size_t)(k >> 6) * J.nlog + drow) * 64 + (k & 63) : dst + (size_t)drow * J.K + k; *(uint4*)dp = v; }
    }
    __syncthreads();
}
DEVI void conv_jobs(const Params& p, int jlo, int jhi, int layer, int unit_base, char* lds) {
    const int G = gridDim.x, bid = blockIdx.x;
    int acc = unit_base;
    for (int j = jlo; j < jhi; ++j) {
        CJob J; get_job(p, j, layer, J); const int n = job_tiles(J);
        const int t0 = (bid - (acc % G) + G) % G;
        for (int t = t0; t < n; t += G) conv_tile(J, t, lds);
        acc += n;
    }
}
DEVI void mods_unit(const Params& p, int u, char* lds) {
    const int l = u / 96, cg = u % 96;
    float* sil = (float*)lds;
    float* red = sil + 1024 * 12;
    const int tid = tidx(), lane = tid & 63, w = tid >> 6;
    for (int i = tid; i < 9 * 1024; i += 512) { const int bb = i >> 10, k = i & 1023; const float v = bb < 8 ? p.in[I_C][bb * 1024 + k] : p.in[I_CCTX][k]; sil[k * 12 + bb] = siluf_(v); }
    __syncthreads();
    float acc[9];
#pragma unroll
    for (int i = 0; i < 9; ++i) acc[i] = 0.f;
    const float* wp = p.in[I_ADAW] + (size_t)l * 1024 * 6144 + cg * 64 + lane;
#pragma unroll 4
    for (int kk = 0; kk < 128; ++kk) {
        const int k = w * 128 + kk; const float wv = wp[(size_t)k * 6144];
        const float4 s0 = *(const float4*)(sil + k * 12), s1 = *(const float4*)(sil + k * 12 + 4); const float s2 = sil[k * 12 + 8];
        acc[0] += s0.x * wv; acc[1] += s0.y * wv; acc[2] += s0.z * wv; acc[3] += s0.w * wv; acc[4] += s1.x * wv; acc[5] += s1.y * wv; acc[6] += s1.z * wv; acc[7] += s1.w * wv; acc[8] += s2 * wv;
    }
#pragma unroll
    for (int i = 0; i < 9; ++i) red[(w * 9 + i) * 64 + lane] = acc[i];
    __syncthreads();
    for (int i = tid; i < 9 * 64; i += 512) {
        const int bb = i >> 6, c = i & 63; float s = 0.f;
        for (int ww = 0; ww < 8; ++ww) s += red[(ww * 9 + bb) * 64 + c];
        const int col = cg * 64 + c;
        ((float*)(p.ws + OFF_MODS))[(size_t)(l * 9 + bb) * 6144 + col] = s + p.in[I_ADAB][l * 6144 + col];
    }
    __syncthreads();
}
DEVI void phase_prologue(const Params& p, char* lds) {
    const int bid = blockIdx.x, G = gridDim.x;
    if (bid == G - 1) {
        int* cnt = (int*)(p.ws + OFF_CNT);
        for (int i = tidx(); i < 2 * NCHUNK * 64; i += 512) cnt[i] = 0;
        float2* tab = (float2*)(p.ws + OFF_ROPE);
        for (int i = tidx(); i < 64 * 16; i += 512) { const int coord = i >> 4, f = i & 15; const float inv = exp2f(-(float)f * (13.287712379549449f / 16.f)); const float a = (float)coord * inv; tab[i] = make_float2(cosf(a), sinf(a)); }
    }
    {
        u16* wro = (u16*)(p.ws + OFF_WROUT);
        for (int i = bid * 512 + tidx(); i < 2 * 1024 * 64; i += G * 512) {
            const int l = i >> 16, k = (i >> 6) & 1023, e = i & 63;
            const float wv = p.in[I_MROUT][i]; const u16 hi = (u16)pack2(wv, 0.f); const u16 lo = (u16)pack2(wv - bf1(hi), 0.f);
            u16* row = wro + ((size_t)l * 64 + e) * 3072; row[k] = hi; row[1024 + k] = hi; row[2048 + k] = lo;
        }
    }
    for (int u = bid; u < 192; u += G) mods_unit(p, u, lds);
    conv_jobs(p, 0, 25, 0, 192, lds);
}

DEVI void norm_rows(const RowSrc& src, int mode, int nrows, const float* __restrict__ gain, const float* __restrict__ mods_l, int ishift, int iscale, u16* __restrict__ dst) {
    const int lane = tidx() & 63, w = tidx() >> 6;
    for (int r = blockIdx.x * 8 + w; r < nrows; r += gridDim.x * 8) {
        int bb; const float* xr = row_ptr(src, mode, r, bb);
        float4 v[4]; float ss = 0.f;
#pragma unroll
        for (int i = 0; i < 4; ++i) { v[i] = ((const float4*)xr)[lane + 64 * i]; ss += v[i].x * v[i].x + v[i].y * v[i].y + v[i].z * v[i].z + v[i].w * v[i].w; }
        ss = wave_sum(ss);
        const float rs = rsqrtf(ss * (1.f / 1024.f) + 1e-6f);
        const float* msh = mods_l + (size_t)bb * 6144 + ishift * 1024; const float* msc = mods_l + (size_t)bb * 6144 + iscale * 1024;
#pragma unroll
        for (int i = 0; i < 4; ++i) {
            const int c = (lane + 64 * i) * 4;
            const float4 g = *(const float4*)(gain + c), sh = *(const float4*)(msh + c), sc = *(const float4*)(msc + c);
            uint2 o; o.x = pack2(v[i].x * rs * g.x * (1.f + sc.x) + sh.x, v[i].y * rs * g.y * (1.f + sc.y) + sh.y);
            o.y = pack2(v[i].z * rs * g.z * (1.f + sc.z) + sh.z, v[i].w * rs * g.w * (1.f + sc.w) + sh.w);
            *(uint2*)(dst + (size_t)r * DM + c) = o;
        }
    }
}

DEVI void phase_gemm_win(const Params& p, char* lds) {
    const u16* A = (const u16*)(p.ws + A_N0); const u16* W = (const u16*)(p.ws + W_IN);
    u16* CQ = (u16*)(p.ws + A_CQ); u16* CKV = (u16*)(p.ws + A_CKV); u16* KA = (u16*)(p.ws + A_KA); u16* QS = (u16*)(p.ws + A_QS); u16* KS = (u16*)(p.ws + A_KS); u16* VS = (u16*)(p.ws + A_VS);
    const float2* tab = (const float2*)(p.ws + OFF_ROPE);
    const int NT = 12, MT = T0 / 256;
    GemmRegs<4, 2> R; bool primed = false;
    for (int uu = blockIdx.x; uu < ((NT * MT + 255) & ~255); uu += gridDim.x) {
        const int u = swz(uu); if (u >= NT * MT) continue;
        const int mt = u / NT, nt = u % NT; const int m0 = mt * 256, n0 = nt * 128;
        const int un = (uu + (int)gridDim.x < ((NT * MT + 255) & ~255)) ? swz(uu + gridDim.x) : NT * MT; const bool hasn = un < NT * MT;
        const int m0n = (un / NT) * 256, n0n = (un % NT) * 128;
        auto arow = [&](int r) { return A + (size_t)(m0 + r) * DM; };
        auto arow_n = [&](int r) { return A + (size_t)(m0n + r) * DM; };
        auto xf = [&](int r, int cw, f32x16 (&t)[2], int h) {
            const int row = m0 + r; const int b = row / LT, pp = row - b * LT;
#pragma unroll
            for (int ni = 0; ni < 2; ++ni) {
                const int c32 = n0 + cw + ni * 32;
                if (c32 >= 640 && c32 < 1344) {
                    const int cc = c32 - 640; rope_tile(t[ni], (cc >> 5) & 1, pp, h, tab);
                    if (c32 >= 704 && c32 < 1216) {
#pragma unroll
                        for (int i = 0; i < 16; ++i) t[ni][i] *= QS_SCALE;
                    }
                }
            }
        };
        auto st = [&](int r, int c8, u32x4 v) {
            const int row = m0 + r; const int b = row / LT, pp = row - b * LT; const int c = n0 + c8;
            if (c < 384) *(u32x4*)(CQ + (size_t)row * 384 + c) = v;
            else if (c < 640) *(u32x4*)(CKV + (size_t)row * 256 + (c - 384)) = v;
            else if (c < 704) { for (int hd = 0; hd < 4; ++hd) *(u32x4*)(KA + ((size_t)(b * 4 + hd) * LT + pp) * 192 + 128 + (c - 640)) = v; }
            else if (c < 1216) { const int cc = c - 704; *(u32x4*)(QS + ((size_t)(b * 8 + (cc >> 6)) * LT + pp) * 64 + (cc & 63)) = v; }
            else if (c < 1344) { const int cc = c - 1216; *(u32x4*)(KS + ((size_t)(b * 2 + (cc >> 6)) * LT + pp) * 64 + (cc & 63)) = v; }
            else if (c < 1472) { const int cc = c - 1344; *(u32x4*)(VS + ((size_t)(b * 2 + (cc >> 6)) * LT + pp) * 64 + (cc & 63)) = v; }
        };
        gemm_tile<256, 128, false>(R, primed, arow, W + (size_t)n0 * DM, arow_n, hasn ? W + (size_t)n0n * DM : nullptr, DM, DM, xf, st, lds); primed = hasn;
    }
}
DEVI void phase_gemm_qkv(const Params& p, char* lds) {
    const u16* CQ = (const u16*)(p.ws + A_CQ); const u16* CKV = (const u16*)(p.ws + A_CKV);
    u16* QA = (u16*)(p.ws + A_QA); u16* KA = (u16*)(p.ws + A_KA); u16* VA = (u16*)(p.ws + A_VA);
    const float2* tab = (const float2*)(p.ws + OFF_ROPE);
    const int MT = T0 / 256;
    for (int uu = blockIdx.x; uu < ((14 * MT + 255) & ~255); uu += gridDim.x) {
        const int u = swz(uu); if (u >= 14 * MT) continue;
        const int mt = u / 14, j = u % 14; const int m0 = mt * 256;
        if (j < 6) {
            const int n0 = j * 128;
            auto arow = [&](int r) { return CQ + (size_t)(m0 + r) * 384; };
            auto xf = [&](int r, int cw, f32x16 (&t)[2], int h) {
                const int row = m0 + r; const int pp = row % LT;
#pragma unroll
                for (int ni = 0; ni < 2; ++ni) {
                    const int c32 = n0 + cw + ni * 32; const int wi = c32 % 192;
                    if (wi >= 128) rope_tile(t[ni], (wi - 128) >> 5, pp, h, tab);
#pragma unroll
                    for (int i = 0; i < 16; ++i) t[ni][i] *= QA_SCALE;
                }
            };
            auto st = [&](int r, int c8, u32x4 v) {
                const int row = m0 + r; const int b = row / LT, pp = row - b * LT; const int c = n0 + c8; const int hd = c / 192, wi = c - hd * 192;
                *(u32x4*)(QA + ((size_t)(b * 4 + hd) * LT + pp) * 192 + wi) = v;
            };
            GemmRegs<4, 2> R; gemm_tile<256, 128, true>(R, false, arow, (const u16*)(p.ws + W_UQ) + (size_t)n0 * 384, arow, (const u16*)nullptr, 384, 384, xf, st, lds);
        } else {
            const bool isv = j >= 10; const int n0 = (isv ? j - 10 : j - 6) * 128;
            auto arow = [&](int r) { return CKV + (size_t)(m0 + r) * 256; };
            auto xf = [&](int, int, f32x16 (&)[2], int) {};
            auto st = [&](int r, int c8, u32x4 v) {
                const int row = m0 + r; const int b = row / LT, pp = row - b * LT; const int c = n0 + c8; const int hd = c >> 7, wi = c & 127;
                if (isv) *(u32x4*)(VA + ((size_t)(b * 4 + hd) * LT + pp) * 128 + wi) = v;
                else *(u32x4*)(KA + ((size_t)(b * 4 + hd) * LT + pp) * 192 + wi) = v;
            };
            GemmRegs<4, 2> R; gemm_tile<256, 128, true>(R, false, arow, (const u16*)(p.ws + (isv ? W_UV : W_UK)) + (size_t)n0 * 256, arow, (const u16*)nullptr, 256, 256, xf, st, lds);
        }
    }
}

template <int DQK, int DV, bool SWA>
DEVI void attn_unit(const u16* __restrict__ Q, const u16* __restrict__ Kp, const u16* __restrict__ Vp, int q0, int a0, int na, int b0, int nb2,
                    float m_init, u16* __restrict__ outp  , char* lds) {
    constexpr int KSTR = DQK + 8, VSTR = DV + 32, KCH = DQK / 8, VCH = DV / 8, NKC = 64 * KCH / 512, NVC = 64 * VCH / 512, NS = DQK / 16, NDT = DV / 32;
    const int tid = tidx(), lane = tid & 63, w = tid >> 6, l31 = lane & 31, h = lane >> 5;
    u16* sK = (u16*)lds; u16* sV = sK + 2 * 64 * KSTR;
    const int qpos = q0 + w * 32 + l31;
    bf16x8 qf[NS];
#pragma unroll
    for (int s = 0; s < NS; ++s) qf[s] = *(const bf16x8*)(Q + (size_t)qpos * DQK + s * 16 + h * 8);
    f32x16 o[NDT];
#pragma unroll
    for (int d = 0; d < NDT; ++d)
#pragma unroll
        for (int i = 0; i < 16; ++i) o[d][i] = 0.f;
    float m = m_init, lsum = 0.f;
    const int nt = na + nb2;
    u32x4 rk[NKC], rv[NVC];
    auto tile_pos = [&](int t) { return t < na ? a0 + 64 * t : b0 + 64 * (t - na); };
    auto gload = [&](int t) {
        const int kp0 = tile_pos(t);
        const u16* kb_ = Kp + (size_t)kp0 * DQK + tid * 8; const u16* vb_ = Vp + (size_t)kp0 * DV + tid * 8;
#pragma unroll
        for (int i = 0; i < NKC; ++i) rk[i] = *(const u32x4*)(kb_ + 4096 * i);
#pragma unroll
        for (int i = 0; i < NVC; ++i) rv[i] = *(const u32x4*)(vb_ + 4096 * i);
    };
    gload(0);
    const int tr_row = 4 * h + ((lane & 15) >> 2), tr_col = 16 * ((lane >> 4) & 1) + 4 * (lane & 3);
    for (int t = 0; t < nt; ++t) {
        u16* k_ = sK + (t & 1) * 64 * KSTR; u16* v_ = sV + (t & 1) * 64 * VSTR;
#pragma unroll
        for (int i = 0; i < NKC; ++i) { const int c = tid + 512 * i, row = c / KCH, ch = c % KCH; *(u32x4*)(k_ + row * KSTR + ch * 8) = rk[i]; }
#pragma unroll
        for (int i = 0; i < NVC; ++i) { const int c = tid + 512 * i, row = c / VCH, ch = c % VCH; *(u32x4*)(v_ + row * VSTR + ch * 8) = rv[i]; }
        __syncthreads();
        if (t + 1 < nt) gload(t + 1);
        f32x16 st[2];
#pragma unroll
        for (int k2 = 0; k2 < 2; ++k2) {
#pragma unroll
            for (int i = 0; i < 16; ++i) st[k2][i] = 0.f;
#pragma unroll
            for (int s = 0; s < NS; ++s) {
                const bf16x8 kf = *(const bf16x8*)(k_ + (k2 * 32 + l31) * KSTR + s * 16 + h * 8);
                st[k2] = __builtin_amdgcn_mfma_f32_32x32x16_bf16(kf, qf[s], st[k2], 0, 0, 0);
            }
        }
        __builtin_amdgcn_sched_barrier(0);
        if (SWA && t >= na) {
            const int kp0 = tile_pos(t);
#pragma unroll
            for (int k2 = 0; k2 < 2; ++k2)
#pragma unroll
                for (int i = 0; i < 16; ++i) {
                    const int key = kp0 + k2 * 32 + (i & 3) + 8 * (i >> 2) + 4 * h; const int d = qpos - key;
                    if (d > 128 || d < -128) st[k2][i] = -1e30f;
                }
        }
        float mx = st[0][0];
#pragma unroll
        for (int k2 = 0; k2 < 2; ++k2)
#pragma unroll
            for (int i = 0; i < 16; ++i) mx = fmaxf(mx, st[k2][i]);
        mx = fmaxf(mx, xhalf(mx));
        const float mn = fmaxf(m, mx); const float alpha = __builtin_amdgcn_exp2f(m - mn); m = mn;
        float ps = 0.f;
#pragma unroll
        for (int k2 = 0; k2 < 2; ++k2)
#pragma unroll
            for (int i = 0; i < 16; ++i) { const float pv = __builtin_amdgcn_exp2f(st[k2][i] - mn); st[k2][i] = pv; ps += pv; }
        lsum = lsum * alpha + ps;
#pragma unroll
        for (int d = 0; d < NDT; ++d)
#pragma unroll
            for (int i = 0; i < 16; ++i) o[d][i] *= alpha;
#pragma unroll
        for (int s16 = 0; s16 < 4; ++s16) {
            __builtin_amdgcn_sched_barrier(0);
            bf16x8 pf; unsigned* pu = (unsigned*)&pf;
#pragma unroll
            for (int jj = 0; jj < 4; ++jj) pu[jj] = pack2(st[s16 >> 1][8 * (s16 & 1) + 2 * jj], st[s16 >> 1][8 * (s16 & 1) + 2 * jj + 1]);
#pragma unroll
            for (int d = 0; d < NDT; ++d) {
                const u16* base = v_ + (16 * s16 + tr_row) * VSTR + d * 32 + tr_col;
                const s16x4 lo = __builtin_amdgcn_ds_read_tr16_b64_v4i16((LAS s16x4*)(base));
                const s16x4 hi = __builtin_amdgcn_ds_read_tr16_b64_v4i16((LAS s16x4*)(base + 8 * VSTR));
                bf16x8 vf; vf[0] = lo[0]; vf[1] = lo[1]; vf[2] = lo[2]; vf[3] = lo[3]; vf[4] = hi[0]; vf[5] = hi[1]; vf[6] = hi[2]; vf[7] = hi[3];
                o[d] = __builtin_amdgcn_mfma_f32_32x32x16_bf16(vf, pf, o[d], 0, 0, 0);
            }
        }
    }
    float lt = lsum + xhalf(lsum);
    if (SWA) lt += __builtin_amdgcn_exp2f(m_init - m);
    const float inv = 1.f / lt;
    u16* orow = outp + (size_t)qpos * DM;
#pragma unroll
    for (int d = 0; d < NDT; ++d)
#pragma unroll
        for (int g = 0; g < 4; ++g) { uint2 v; v.x = pack2(o[d][4 * g] * inv, o[d][4 * g + 1] * inv); v.y = pack2(o[d][4 * g + 2] * inv, o[d][4 * g + 3] * inv); *(uint2*)(orow + d * 32 + 8 * g + 4 * h) = v; }
    __syncthreads();
}
DEVI void phase_attention(const Params& p, char* lds) {
    const u16* QA = (const u16*)(p.ws + A_QA); const u16* KA = (const u16*)(p.ws + A_KA); const u16* VA = (const u16*)(p.ws + A_VA);
    const u16* QS = (const u16*)(p.ws + A_QS); const u16* KS = (const u16*)(p.ws + A_KS); const u16* VS = (const u16*)(p.ws + A_VS);
    u16* mix = (u16*)(p.ws + A_N0);
    for (int uu = blockIdx.x; uu < 1792; uu += gridDim.x) {
        const int u = swz(uu); if (u >= 1632) continue;
        if (u < 544) {
            int b, hd, q0, na;
            if (u < 512) { b = u >> 6; hd = (u >> 4) & 3; q0 = LC + (u & 15) * 256; na = 68; }
            else { const int v = u - 512; b = v >> 2; hd = v & 3; q0 = 0; na = 4; }
            const size_t bh = (size_t)(b * 4 + hd) * LT;
            attn_unit<192, 128, false>(QA + bh * 192, KA + bh * 192, VA + bh * 128, q0, 0, na, 0, 0, -1e30f, mix + (size_t)b * LT * DM + hd * 128, lds);
        } else {
            int b, hd, q0, b0 = 0, nb2 = 0;
            if (u < 1568) { const int v = u - 544; b = v >> 7; hd = (v >> 4) & 7; const int s0 = (v & 15) * 256; q0 = LC + s0;
                int lo = s0 - 128; if (lo < 0) lo = 0; int hi = s0 + 256 + 128; if (hi > SEQ) hi = SEQ; b0 = LC + lo; nb2 = (hi - lo) >> 6; }
            else { const int v = u - 1568; b = v >> 3; hd = v & 7; q0 = 0; }
            const int kvh = hd >> 2; const size_t qb = (size_t)(b * 8 + hd) * LT, kb = (size_t)(b * 2 + kvh) * LT;
            attn_unit<64, 64, true>(QS + qb * 64, KS + kb * 64, VS + kb * 64, q0, 0, 4, b0, nb2, p.in[I_ASINK][hd] * LOG2E, mix + (size_t)b * LT * DM + 512 + hd * 64, lds);
        }
    }
}
DEVI void phase_gemm_wo(const Params& p, const u16* A, const u16* W, const RowSrc& resid, int mode, int layer, char* lds) {
    float* XC = (float*)(p.ws + OFF_XC); float* XL = p.out;
    const float* mods_l = (const float*)(p.ws + OFF_MODS) + (size_t)layer * 9 * 6144;
    const int MT = (mode == 0 ? T0 : TL) / 256;
    GemmRegs<4, 2> R; bool primed = false;
    for (int uu = blockIdx.x; uu < ((8 * MT + 255) & ~255); uu += gridDim.x) {
        const int u = swz(uu); if (u >= 8 * MT) continue;
        const int mt = u >> 3, nt = u & 7; const int m0 = mt * 256, n0 = nt * 128;
        const int un = (uu + (int)gridDim.x < ((8 * MT + 255) & ~255)) ? swz(uu + gridDim.x) : 8 * MT; const bool hasn = un < 8 * MT;
        const int m0n = (un >> 3) * 256, n0n = (un & 7) * 128;
        auto arow = [&](int r) { return A + (size_t)(m0 + r) * DM; };
        auto arow_n = [&](int r) { return A + (size_t)(m0n + r) * DM; };
        auto xf = [&](int, int, f32x16 (&)[2], int) {};
        auto st = [&](int r, int c8, u32x4 v) {
            int bb; const float* rs = row_ptr(resid, mode, m0 + r, bb); int bb2; float* xo = row_ptr_w(XC, XL, mode, m0 + r, bb2);
            const float* mg = mods_l + (size_t)bb * 6144 + 2 * 1024; const int c = n0 + c8;
            const float4 r0 = *(const float4*)(rs + c), r1 = *(const float4*)(rs + c + 4), g0 = *(const float4*)(mg + c), g1 = *(const float4*)(mg + c + 4);
            float4 o0, o1;
            o0.x = r0.x + g0.x * bf_lo(v[0]); o0.y = r0.y + g0.y * bf_hi(v[0]); o0.z = r0.z + g0.z * bf_lo(v[1]); o0.w = r0.w + g0.w * bf_hi(v[1]);
            o1.x = r1.x + g1.x * bf_lo(v[2]); o1.y = r1.y + g1.y * bf_hi(v[2]); o1.z = r1.z + g1.z * bf_lo(v[3]); o1.w = r1.w + g1.w * bf_hi(v[3]);
            *(float4*)(xo + c) = o0; *(float4*)(xo + c + 4) = o1;
        };
        gemm_tile<256, 128, false>(R, primed, arow, W + (size_t)n0 * DM, arow_n, hasn ? W + (size_t)n0n * DM : nullptr, DM, DM, xf, st, lds); primed = hasn;
    }
}

DEVI void phase_moe_norm(const Params& p, int layer) {
    const int mode = layer == 0 ? 0 : 1; const int ntok = layer == 0 ? T0 : TL;
    RowSrc src; src.ctx = (const float*)(p.ws + OFF_XC); src.lat = p.out;
    const float* gain = p.in[I_NFFN] + layer * 1024; const float* mods_l = (const float*)(p.ws + OFF_MODS) + (size_t)layer * 9 * 6144;
    u16* n1 = (u16*)(p.ws + M_N1); u16* nlo = (u16*)(p.ws + M_ACT);
    const int lane = tidx() & 63, w = tidx() >> 6;
    for (int r = blockIdx.x * 8 + w; r < ntok; r += gridDim.x * 8) {
        int bb; const float* xr = row_ptr(src, mode, r, bb);
        float4 v[4]; float ss = 0.f;
#pragma unroll
        for (int i = 0; i < 4; ++i) { v[i] = ((const float4*)xr)[lane + 64 * i]; ss += v[i].x * v[i].x + v[i].y * v[i].y + v[i].z * v[i].z + v[i].w * v[i].w; }
        ss = wave_sum(ss);
        const float rs = rsqrtf(ss * (1.f / 1024.f) + 1e-6f);
        const float* msh = mods_l + (size_t)bb * 6144 + 3 * 1024; const float* msc = mods_l + (size_t)bb * 6144 + 4 * 1024;
#pragma unroll
        for (int i = 0; i < 4; ++i) {
            const int c = (lane + 64 * i) * 4;
            const float4 g = *(const float4*)(gain + c), sh = *(const float4*)(msh + c), sc = *(const float4*)(msc + c);
            const float y0 = v[i].x * rs * g.x * (1.f + sc.x) + sh.x, y1 = v[i].y * rs * g.y * (1.f + sc.y) + sh.y, y2 = v[i].z * rs * g.z * (1.f + sc.z) + sh.z, y3 = v[i].w * rs * g.w * (1.f + sc.w) + sh.w;
            uint2 o; o.x = pack2(y0, y1); o.y = pack2(y2, y3);
            *(uint2*)(n1 + (size_t)r * DM + c) = o;
            uint2 ol; ol.x = pack2(y0 - bf_lo(o.x), y1 - bf_hi(o.x)); ol.y = pack2(y2 - bf_lo(o.y), y3 - bf_hi(o.y));
            *(uint2*)(nlo + (size_t)r * DM + c) = ol;
        }
    }
}
DEVI void router_tile(const u16* __restrict__ H, const u16* __restrict__ L, const u16* __restrict__ Wt, int m0, char* lds) {
    constexpr int BM = 256, BN = 128, WN = 2, NA = 4, NBC = 2, STR = 72;
    const int tid = tidx(), lane = tid & 63, w = tid >> 6, wm = w / WN, wn = w % WN, l31 = lane & 31, h = lane >> 5;
    u16* sA = (u16*)lds; u16* sB = sA + 2 * BM * STR;
    const int crow = tid >> 3, kc = tid & 7;
    const u16* ph[NA]; const u16* pl[NA]; const u16* pb[NBC];
#pragma unroll
    for (int i = 0; i < NA; ++i) { ph[i] = H + (size_t)(m0 + crow + 64 * i) * DM + kc * 8; pl[i] = L + (size_t)(m0 + crow + 64 * i) * DM + kc * 8; }
#pragma unroll
    for (int i = 0; i < NBC; ++i) pb[i] = Wt + (size_t)((crow + 64 * i) & 63) * 3072 + kc * 8;
    u32x4 ra[NA], rb[NBC];
    auto gload = [&](int kt) {
        const int seg = kt >> 4, kk = (kt & 15) * 64;
#pragma unroll
        for (int i = 0; i < NA; ++i) ra[i] = *(const u32x4*)((seg == 1 ? pl[i] : ph[i]) + kk);
#pragma unroll
        for (int i = 0; i < NBC; ++i) rb[i] = *(const u32x4*)(pb[i] + kt * 64);
    };
    gload(0);
    f32x16 acc[2][2];
#pragma unroll
    for (int a = 0; a < 2; ++a)
#pragma unroll
        for (int b = 0; b < 2; ++b)
#pragma unroll
            for (int i = 0; i < 16; ++i) acc[a][b][i] = 0.f;
    for (int kt = 0; kt < 48; ++kt) {
        u16* a_ = sA + (kt & 1) * BM * STR; u16* b_ = sB + (kt & 1) * BN * STR;
#pragma unroll
        for (int i = 0; i < NA; ++i) *(u32x4*)(a_ + (crow + 64 * i) * STR + kc * 8) = ra[i];
#pragma unroll
        for (int i = 0; i < NBC; ++i) *(u32x4*)(b_ + (crow + 64 * i) * STR + kc * 8) = rb[i];
        lds_barrier();
        gload(kt + 1 < 48 ? kt + 1 : 47);
#pragma unroll
        for (int ks = 0; ks < 4; ++ks) {
            bf16x8 af[2], bfr[2];
#pragma unroll
            for (int mi = 0; mi < 2; ++mi) af[mi] = *(const bf16x8*)(a_ + (wm * 64 + mi * 32 + l31) * STR + ks * 16 + h * 8);
#pragma unroll
            for (int ni = 0; ni < 2; ++ni) bfr[ni] = *(const bf16x8*)(b_ + (wn * 64 + ni * 32 + l31) * STR + ks * 16 + h * 8);
#pragma unroll
            for (int mi = 0; mi < 2; ++mi)
#pragma unroll
                for (int ni = 0; ni < 2; ++ni) acc[mi][ni] = __builtin_amdgcn_mfma_f32_32x32x16_bf16(bfr[ni], af[mi], acc[mi][ni], 0, 0, 0);
        }
    }
    lds_barrier();
    float* LG = (float*)lds;
    if (wn == 0) {
#pragma unroll
        for (int mi = 0; mi < 2; ++mi)
#pragma unroll
            for (int ni = 0; ni < 2; ++ni)
#pragma unroll
                for (int g = 0; g < 4; ++g)
                    *(float4*)(LG + (wm * 64 + mi * 32 + l31) * 64 + ni * 32 + 8 * g + 4 * h) = make_float4(acc[mi][ni][4 * g], acc[mi][ni][4 * g + 1], acc[mi][ni][4 * g + 2], acc[mi][ni][4 * g + 3]);
    }
    lds_barrier();
}
DEVI void phase_moe_route(const Params& p, int layer, char* lds) {
    const int ntok = layer == 0 ? T0 : TL; const int tc = ntok / NCHUNK;
    const float ebias = p.in[I_MBIAS][layer * 64 + (tidx() & 63)];
    int* cnt = (int*)(p.ws + OFF_CNT) + layer * NCHUNK * 64;
    int* tok_e = (int*)(p.ws + OFF_TOKE); int* tok_r = (int*)(p.ws + OFF_TOKR); int* ltok = (int*)(p.ws + OFF_LTOK); float* lg = (float*)(p.ws + OFF_LG);
    const u16* H = (const u16*)(p.ws + M_N1); const u16* L = (const u16*)(p.ws + M_ACT); const u16* Wt = (const u16*)(p.ws + OFF_WROUT) + (size_t)layer * 64 * 3072;
    const int lane = tidx() & 63, w = tidx() >> 6;
    const float* LG = (const float*)lds;
    for (int u = blockIdx.x; u < ntok / 256; u += gridDim.x) {
        router_tile(H, L, Wt, u * 256, lds);
        for (int j = 0; j < 32; ++j) {
            const int rl = w * 32 + j; const int tok = u * 256 + rl;
            const float lgt = LG[rl * 64 + lane];
            const float score = 1.f / (1.f + expf(-lgt)); const float choice = score + ebias;
            const float m1 = red8_max(choice);
            const unsigned long long bm = __ballot(choice == m1);
            const unsigned gm = (unsigned)(bm >> (lane & 56)) & 0xffu; const int first = __ffs(gm) - 1;
            const float m2 = red8_max(((lane & 7) == first) ? -INFINITY : choice);
            const float gs = m1 + m2;
            int rank = 0;
#pragma unroll
            for (int g2 = 0; g2 < 8; ++g2) { const float og = __shfl(gs, g2 * 8); rank += (og > gs || (og == gs && g2 < (lane >> 3))) ? 1 : 0; }
            float cm = rank < 4 ? choice : -INFINITY;
            unsigned long long sel = 0ull; float ssum = 0.f;
#pragma unroll
            for (int it = 0; it < 6; ++it) {
                const float mxv = wave_max(cm);
                const unsigned long long bmm = __ballot(cm == mxv);
                const int win = __ffsll((long long)bmm) - 1;
                sel |= 1ull << win; ssum += __shfl(score, win);
                if (lane == win) cm = -INFINITY;
            }
            if ((sel >> lane) & 1ull) {
                const int jj = __popcll(sel & ((1ull << lane) - 1ull));
                const int ch = tok / tc; const int rk = atomicAdd(&cnt[ch * 64 + lane], 1);
                tok_e[tok * 6 + jj] = lane; tok_r[tok * 6 + jj] = rk;
                ltok[((size_t)ch * 64 + lane) * tc + rk] = tok; lg[((size_t)ch * 64 + lane) * tc + rk] = 2.5f * score / ssum;
            }
        }
        lds_barrier();
    }
}
struct SegTab { int* cnt; int* off; int* tpre; };
DEVI SegTab build_segtab(const Params& p, int layer, int tc, char* lds_tab) {
    SegTab T; T.cnt = (int*)lds_tab; T.off = T.cnt + 264; T.tpre = T.off + 264;
    const int* cnt = (const int*)(p.ws + OFF_CNT) + layer * NCHUNK * 64;
    const int tid = tidx();
    if (tid < 260) { const int ch = tid / 65, e = tid % 65; T.cnt[tid] = e < 64 ? cnt[ch * 64 + e] : tc; }
    __syncthreads();
    if (tid < 64) {
        int lc[5], lt_[5]; int sc = 0, st = 0;
#pragma unroll
        for (int j = 0; j < 5; ++j) { const int s = 5 * tid + j; const int v = s < 260 ? T.cnt[s] : 0; lc[j] = sc; lt_[j] = st; sc += v; st += (v + 127) >> 7; }
        int ic = sc, it = st;
        for (int o = 1; o < 64; o <<= 1) { const int a = __shfl_up(ic, o), b2 = __shfl_up(it, o); if (tid >= o) { ic += a; it += b2; } }
        const int bc = ic - sc, bt = it - st;
#pragma unroll
        for (int j = 0; j < 5; ++j) { const int s = 5 * tid + j; if (s <= 260) { T.tpre[s] = bt + lt_[j]; T.off[s] = bc + lc[j]; } }
    }
    __syncthreads();
    return T;
}
DEVI int find_seg(const SegTab& T, int lo_seg, int hi_seg, int mt) {
    int lo = lo_seg, hi = hi_seg;
    while (hi - lo > 1) { const int mid = (lo + hi) >> 1; if (T.tpre[mid] <= mt) lo = mid; else hi = mid; }
    return lo;
}
DEVI void phase_moe_gemm1(const Params& p, int layer, char* lds) {
    const int ntok = layer == 0 ? T0 : TL; const int tc = ntok / NCHUNK;
    char* tabmem = lds + 110592; SegTab T = build_segtab(p, layer, tc, tabmem);
    const u16* n1 = (const u16*)(p.ws + M_N1); u16* act = (u16*)(p.ws + M_ACT);
    const int* ltok = (const int*)(p.ws + OFF_LTOK); const float* lg = (const float*)(p.ws + OFF_LG);
    const int nunits = T.tpre[260] * 2;
    GemmRegs<2, 4> R; bool primed = false;
    for (int uu = blockIdx.x; uu < ((nunits + 255) & ~255); uu += gridDim.x) {
        const int u = swz(uu); if (u >= nunits) continue;
        const int mt = u >> 1, nt = u & 1; const int seg = find_seg(T, 0, 260, mt); const int ch = seg / 65, e = seg % 65;
        const int un = (uu + (int)gridDim.x < ((nunits + 255) & ~255)) ? swz(uu + gridDim.x) : nunits; const bool hasn = un < nunits;
        const int mtn = hasn ? un >> 1 : mt; const int segn = find_seg(T, 0, 260, mtn); const int chn = segn / 65, en = segn % 65;
        const int cntn = T.cnt[segn], row0n = (mtn - T.tpre[segn]) * 128; const int* ltn = ltok + ((size_t)chn * 64 + en) * tc;
        const u16* Wn = en < 64 ? (const u16*)(p.ws + OFF_WGU) + (size_t)en * 512 * 1024 : (const u16*)(p.ws + W_SGU) + (size_t)layer * 512 * 1024;
        auto arow_n = [&](int r) { int s2 = row0n + r; if (s2 >= cntn) s2 = cntn - 1; const int tok = en < 64 ? ltn[s2] : chn * tc + s2; return n1 + (size_t)tok * DM; };
        const int cntv = T.cnt[seg], row0 = (mt - T.tpre[seg]) * 128; const int n0 = nt * 256;
        const int* lt = ltok + ((size_t)ch * 64 + e) * tc; const float* lgp = lg + ((size_t)ch * 64 + e) * tc;
        const u16* W = e < 64 ? (const u16*)(p.ws + OFF_WGU) + (size_t)e * 512 * 1024 : (const u16*)(p.ws + W_SGU) + (size_t)layer * 512 * 1024;
        auto arow = [&](int r) { int s = row0 + r; if (s >= cntv) s = cntv - 1; const int tok = e < 64 ? lt[s] : ch * tc + s; return n1 + (size_t)tok * DM; };
        const size_t arow0 = (size_t)ch * 7 * tc + (T.off[seg] - T.off[ch * 65]) + row0;
        auto xf = [&](int r, int cw, f32x16 (&t)[2], int h) {
            int s2 = row0 + r; if (s2 >= cntv) s2 = cntv - 1;
            const float gw = e < 64 ? lgp[s2] : 1.f;
#pragma unroll
            for (int i = 0; i < 16; ++i) { const float gt = t[0][i], up = t[1][i]; t[0][i] = gt / (1.f + __expf(-gt)) * up * gw; }
        };
        auto st = [&](int r, int c8, u32x4 v) {
            if (row0 + r >= cntv || (c8 & 32)) return;
            const int ac = ((n0 + (c8 & ~63)) >> 1) + (c8 & 31);
            *(u32x4*)(act + ((size_t)(ac >> 6) * (7 * (size_t)ntok) + arow0 + r) * 64 + (ac & 63)) = v;
        };
        gemm_tile<128, 256, false>(R, primed, arow, W + (size_t)n0 * DM, arow_n, hasn ? Wn + (size_t)((un & 1) * 256) * DM : nullptr, DM, DM, xf, st, lds); primed = hasn;
    }
}
DEVI void phase_moe_g2c(const Params& p, int layer, int chg, int chc, char* lds) {
    const int mode = layer == 0 ? 0 : 1; const int ntok = layer == 0 ? T0 : TL; const int tc = ntok / NCHUNK;
    char* tabmem = lds + 110592; SegTab T = build_segtab(p, layer, tc, tabmem);
    const u16* act = (const u16*)(p.ws + M_ACT);
    const int* tok_e = (const int*)(p.ws + OFF_TOKE); const int* tok_r = (const int*)(p.ws + OFF_TOKR);
    float* XC = (float*)(p.ws + OFF_XC); float* XL = p.out;
    const float* mods_l = (const float*)(p.ws + OFF_MODS) + (size_t)layer * 9 * 6144;
    const int lane = tidx() & 63, w = tidx() >> 6;
    int nunits = 0, t_lo = 0;
    if (chg >= 0) { t_lo = T.tpre[chg * 65]; nunits = (T.tpre[chg * 65 + 65] - t_lo) * 4; }
    const int G = gridDim.x; const int nround = (nunits + G - 1) / G;
    const int rho = ((int)blockIdx.x & 7) * (G >> 3) + ((int)blockIdx.x >> 3); const int ubeg = rho * nround;
    int my_units = nunits - ubeg; if (my_units > nround) my_units = nround; if (my_units < 0) my_units = 0;
    const int crounds = chc >= 0 ? (tc + G * 8 - 1) / (G * 8) : 0;
    int cdone = 0;
    auto combine_rounds = [&](int upto) {
        const u16* outr = (const u16*)(p.ws + M_OUTR + (size_t)(chc & 1) * SZ_OUTR);
        for (; cdone < upto; ++cdone) {
            const int tl = (cdone * G + (int)blockIdx.x) * 8 + w; if (tl >= tc) continue;
            const int tok = chc * tc + tl; int bb; float* xr = row_ptr_w(XC, XL, mode, tok, bb);
            const float* mg = mods_l + (size_t)bb * 6144 + 5 * 1024;
            int rows[7];
#pragma unroll
            for (int j = 0; j < 6; ++j) rows[j] = T.off[chc * 65 + tok_e[tok * 6 + j]] - T.off[chc * 65] + tok_r[tok * 6 + j];
            rows[6] = 6 * tc + tl;
            float4 xs[2][2]; float fss = 0.f;
#pragma unroll
            for (int i = 0; i < 2; ++i) {
                const int c = (lane + 64 * i) * 8;
                float acc[8];
#pragma unroll
                for (int q = 0; q < 8; ++q) acc[q] = 0.f;
#pragma unroll
                for (int j = 0; j < 7; ++j) {
                    const uint4 v = *(const uint4*)(outr + (size_t)rows[j] * DM + c);
                    acc[0] += bf_lo(v.x); acc[1] += bf_hi(v.x); acc[2] += bf_lo(v.y); acc[3] += bf_hi(v.y); acc[4] += bf_lo(v.z); acc[5] += bf_hi(v.z); acc[6] += bf_lo(v.w); acc[7] += bf_hi(v.w);
                }
                float4 x0 = *(float4*)(xr + c), x1 = *(float4*)(xr + c + 4); const float4 g0 = *(const float4*)(mg + c), g1 = *(const float4*)(mg + c + 4);
                x0.x += g0.x * acc[0]; x0.y += g0.y * acc[1]; x0.z += g0.z * acc[2]; x0.w += g0.w * acc[3]; x1.x += g1.x * acc[4]; x1.y += g1.y * acc[5]; x1.z += g1.z * acc[6]; x1.w += g1.w * acc[7];
                xs[i][0] = x0; xs[i][1] = x1;
                fss += x0.x * x0.x + x0.y * x0.y + x0.z * x0.z + x0.w * x0.w + x1.x * x1.x + x1.y * x1.y + x1.z * x1.z + x1.w * x1.w;
            }
            if (layer == 1) {
                fss = wave_sum(fss); const float rs = rsqrtf(fss * (1.f / 1024.f) + 1e-6f); const float* gf = p.in[I_NFIN];
#pragma unroll
                for (int i = 0; i < 2; ++i) { const int c = (lane + 64 * i) * 8; const float4 f0 = *(const float4*)(gf + c), f1 = *(const float4*)(gf + c + 4);
                    xs[i][0].x *= rs * f0.x; xs[i][0].y *= rs * f0.y; xs[i][0].z *= rs * f0.z; xs[i][0].w *= rs * f0.w; xs[i][1].x *= rs * f1.x; xs[i][1].y *= rs * f1.y; xs[i][1].z *= rs * f1.z; xs[i][1].w *= rs * f1.w; }
            }
#pragma unroll
            for (int i = 0; i < 2; ++i) { const int c = (lane + 64 * i) * 8; *(float4*)(xr + c) = xs[i][0]; *(float4*)(xr + c + 4) = xs[i][1]; }
        }
    };
    int ui = 0;
    GemmRegs<2, 4> R; bool primed = false;
    for (int u = ubeg; u < ubeg + my_units; ++u) {
        u16* outw = (u16*)(p.ws + M_OUTR + (size_t)(chg & 1) * SZ_OUTR);
        const int mt = t_lo + (u >> 2), nt = u & 3; const int seg = find_seg(T, chg * 65, chg * 65 + 65, mt); const int e = seg % 65;
        const int un = u + 1; const bool hasn = un < ubeg + my_units;
        const int mtn = hasn ? t_lo + (un >> 2) : mt; const int segn = find_seg(T, chg * 65, chg * 65 + 65, mtn); const int en = segn % 65;
        const int cntn = T.cnt[segn], row0n = (mtn - T.tpre[segn]) * 128;
        const u16* An = act + ((size_t)chg * 7 * tc + (size_t)(T.off[segn] - T.off[chg * 65]) + row0n) * 64;
        const u16* Wn = en < 64 ? (const u16*)(p.ws + OFF_WD) + (size_t)en * 1024 * 256 : (const u16*)(p.ws + W_SD) + (size_t)layer * 1024 * 256;
        auto arow_n = [&](int r) { int s2 = row0n + r; if (s2 >= cntn) s2 = cntn - 1; return An + (size_t)(s2 - row0n) * 64; };
        const int cntv = T.cnt[seg], row0 = (mt - T.tpre[seg]) * 128; const int n0 = nt * 256;
        const size_t lrow0 = (size_t)(T.off[seg] - T.off[chg * 65]) + row0;
        const u16* A = act + ((size_t)chg * 7 * tc + lrow0) * 64;
        const u16* W = e < 64 ? (const u16*)(p.ws + OFF_WD) + (size_t)e * 1024 * 256 : (const u16*)(p.ws + W_SD) + (size_t)layer * 1024 * 256;
        auto arow = [&](int r) { int s2 = row0 + r; if (s2 >= cntv) s2 = cntv - 1; return A + (size_t)(s2 - row0) * 64; };
        auto xf = [&](int, int, f32x16 (&)[2], int) {};
        auto st = [&](int r, int c8, u32x4 v) { if (row0 + r < cntv) __builtin_nontemporal_store(v, (u32x4*)(outw + (lrow0 + r) * DM + n0 + c8)); };
        gemm_tile<128, 256, false>(R, primed, arow, W + (size_t)n0 * 64, arow_n, hasn ? Wn + (size_t)((un & 3) * 256) * 64 : nullptr, 64, 256, xf, st, lds, (size_t)7 * ntok * 64, (size_t)1024 * 64); primed = hasn;
        ++ui; combine_rounds((int)(((long)crounds * ui) / my_units));
    }
    combine_rounds(crounds);
}

DEVI void phase_rwkv_mix(const Params& p, int i0, int i1, int i2) {
    const u16* nn = (const u16*)(p.ws + R_NN); u16* xm = (u16*)(p.ws + R_XM0);
    const float* mu = p.in[I_RMU]; const int idx[3] = {i0, i1, i2};
    const int lane = tidx() & 63, w = tidx() >> 6;
    for (int r = blockIdx.x * 8 + w; r < T0; r += gridDim.x * 8) {
        const int b = r / LT, pp = r - b * LT;
        const bool hasprev = (pp != 0) && (pp != LC), hasnext = (pp != LC - 1) && (pp != LT - 1);
#pragma unroll
        for (int half = 0; half < 2; ++half) {
            const int c = half * 512 + lane * 8;
            const uint4 cur = *(const uint4*)(nn + (size_t)r * DM + c);
            uint4 sh = make_uint4(0, 0, 0, 0);
            if (half == 0) { if (hasprev) sh = *(const uint4*)(nn + (size_t)(r - 1) * DM + c); }
            else { if (hasnext) sh = *(const uint4*)(nn + (size_t)(r + 1) * DM + c); }
            float nv[8], xx[8];
            nv[0] = bf_lo(cur.x); nv[1] = bf_hi(cur.x); nv[2] = bf_lo(cur.y); nv[3] = bf_hi(cur.y); nv[4] = bf_lo(cur.z); nv[5] = bf_hi(cur.z); nv[6] = bf_lo(cur.w); nv[7] = bf_hi(cur.w);
            xx[0] = bf_lo(sh.x) - nv[0]; xx[1] = bf_hi(sh.x) - nv[1]; xx[2] = bf_lo(sh.y) - nv[2]; xx[3] = bf_hi(sh.y) - nv[3]; xx[4] = bf_lo(sh.z) - nv[4]; xx[5] = bf_hi(sh.z) - nv[5]; xx[6] = bf_lo(sh.w) - nv[6]; xx[7] = bf_hi(sh.w) - nv[7];
#pragma unroll
            for (int j = 0; j < 3; ++j) {
                const float4 m0 = *(const float4*)(mu + idx[j] * 1024 + c), m1 = *(const float4*)(mu + idx[j] * 1024 + c + 4);
                uint4 o; o.x = pack2(nv[0] + xx[0] * m0.x, nv[1] + xx[1] * m0.y); o.y = pack2(nv[2] + xx[2] * m0.z, nv[3] + xx[3] * m0.w);
                o.z = pack2(nv[4] + xx[4] * m1.x, nv[5] + xx[5] * m1.y); o.w = pack2(nv[6] + xx[6] * m1.z, nv[7] + xx[7] * m1.w);
                *(uint4*)(xm + (size_t)j * T0 * DM + (size_t)r * DM + c) = o;
            }
        }
    }
}
DEVI void phase_rwkv_gemm_rkv(const Params& p, char* lds) {
    const int MT = T0 / 256;
    GemmRegs<4, 2> R; bool primed = false;
    for (int uu = blockIdx.x; uu < ((3 * 8 * MT + 255) & ~255); uu += gridDim.x) {
        const int u = swz(uu); if (u >= 3 * 8 * MT) continue;
        const int j = u / (8 * MT), v = u % (8 * MT); const int mt = v >> 3, nt = v & 7; const int m0 = mt * 256, n0 = nt * 128;
        const u16* A = (const u16*)(p.ws + R_XM0) + (size_t)j * T0 * DM; const u16* W = (const u16*)(p.ws + W_RR) + (size_t)j * DM * DM; u16* O = (u16*)(p.ws + R_RR) + (size_t)j * T0 * DM;
        const int un = (uu + (int)gridDim.x < ((3 * 8 * MT + 255) & ~255)) ? swz(uu + gridDim.x) : 3 * 8 * MT; const bool hasn = un < 3 * 8 * MT;
        const int jn = hasn ? un / (8 * MT) : j, vn = hasn ? un % (8 * MT) : v;
        const u16* An = (const u16*)(p.ws + R_XM0) + (size_t)jn * T0 * DM + (size_t)((vn >> 3) * 256) * DM; const u16* Wn = (const u16*)(p.ws + W_RR) + (size_t)jn * DM * DM + (size_t)((vn & 7) * 128) * DM;
        auto arow = [&](int r) { return A + (size_t)(m0 + r) * DM; };
        auto arow_n = [&](int r) { return An + (size_t)r * DM; };
        auto xf = [&](int, int, f32x16 (&)[2], int) {};
        auto st = [&](int r, int c8, u32x4 v) { *(u32x4*)(O + (size_t)(m0 + r) * DM + n0 + c8) = v; };
        gemm_tile<256, 128, false>(R, primed, arow, W + (size_t)n0 * DM, arow_n, hasn ? Wn : nullptr, DM, DM, xf, st, lds); primed = hasn;
    }
}
DEVI void phase_rwkv_gemm_small(const Params& p, char* lds) {
    const int MT = T0 / 256;
    for (int u = blockIdx.x; u < 3 * MT; u += gridDim.x) {
        const int j = u / MT, mt = u % MT; const int m0 = mt * 256;
        const u16* A = (const u16*)(p.ws + R_XM0) + (size_t)j * T0 * DM;
        const u16* W = (const u16*)(p.ws + (j == 0 ? W_W1 : j == 1 ? W_A1 : W_G1)); u16* O = (u16*)(p.ws + (j == 0 ? R_HW : j == 1 ? R_HA : R_HG));
        auto arow = [&](int r) { return A + (size_t)(m0 + r) * DM; };
        auto xf = [&](int, int, f32x16 (&t)[2], int) {
#pragma unroll
            for (int ni = 0; ni < 2; ++ni)
#pragma unroll
                for (int i = 0; i < 16; ++i) { const float x = t[ni][i]; t[ni][i] = j == 0 ? tanhf_(x) : j == 1 ? x : sigmoidf_(x); }
        };
        auto st = [&](int r, int c8, u32x4 v) { *(u32x4*)(O + (size_t)(m0 + r) * 128 + c8) = v; };
        GemmRegs<4, 2> R; gemm_tile<256, 128, false>(R, false, arow, W, arow, (const u16*)nullptr, DM, DM, xf, st, lds);
    }
}
DEVI void phase_rwkv_gemm_g(const Params& p, char* lds) {
    const int MT = T0 / 256; const u16* A = (const u16*)(p.ws + R_HG); const u16* W = (const u16*)(p.ws + W_G2); u16* O = (u16*)(p.ws + R_GG);
    for (int uu = blockIdx.x; uu < ((8 * MT + 255) & ~255); uu += gridDim.x) {
        const int u = swz(uu); if (u >= 8 * MT) continue;
        const int mt = u >> 3, nt = u & 7; const int m0 = mt * 256, n0 = nt * 128;
        auto arow = [&](int r) { return A + (size_t)(m0 + r) * 128; };
        auto xf = [&](int, int, f32x16 (&)[2], int) {};
        auto st = [&](int r, int c8, u32x4 v) { *(u32x4*)(O + (size_t)(m0 + r) * DM + n0 + c8) = v; };
        GemmRegs<4, 2> R; gemm_tile<256, 128, false>(R, false, arow, W + (size_t)n0 * 128, arow, (const u16*)nullptr, 128, 128, xf, st, lds);
    }
}
DEVI float red16_sum(float x) { x += dppf(x, 0); x += dppf(x, 1); x += dppf(x, 2); int xi = __builtin_bit_cast(int, x); x += __builtin_bit_cast(float, __builtin_amdgcn_mov_dpp(xi, 0x140, 0xF, 0xF, true)); return x; }
DEVI bf16x8 frag_perm(const u16* rowp, int ks, int h) {
    const uint2 lo = *(const uint2*)(rowp + 16 * ks + 4 * h), hi = *(const uint2*)(rowp + 16 * ks + 8 + 4 * h);
    u32x4 v = {lo.x, lo.y, hi.x, hi.y}; return __builtin_bit_cast(bf16x8, v);
}
DEVI bf16x8 tr_frag(const u16* base, int stride, int lane) {
    const u16* q = base + (4 * (lane >> 5) + ((lane & 15) >> 2)) * stride + 16 * ((lane >> 4) & 1) + 4 * (lane & 3);
    const s16x4 lo = __builtin_amdgcn_ds_read_tr16_b64_v4i16((LAS s16x4*)q), hi = __builtin_amdgcn_ds_read_tr16_b64_v4i16((LAS s16x4*)(q + 8 * stride));
    bf16x8 v; v[0] = lo[0]; v[1] = lo[1]; v[2] = lo[2]; v[3] = lo[3]; v[4] = hi[0]; v[5] = hi[1]; v[6] = hi[2]; v[7] = hi[3]; return v;
}
DEVI bf16x8 frag_plain(const u16* rowp, int ks, int h) { return *(const bf16x8*)(rowp + 16 * ks + 8 * h); }
DEVI bf16x8 acc_to_b(const f32x16& t, int s) {
    u32x4 v = {pack2(t[8 * s], t[8 * s + 1]), pack2(t[8 * s + 2], t[8 * s + 3]), pack2(t[8 * s + 4], t[8 * s + 5]), pack2(t[8 * s + 6], t[8 * s + 7])};
    return __builtin_bit_cast(bf16x8, v);
}
#define MFMA(a, b, c) __builtin_amdgcn_mfma_f32_32x32x16_bf16(a, b, c, 0, 0, 0)
DEVI void phase_rwkv_scan(const Params& p, char* lds) {
    float* AAb = (float*)lds;
    float* CPb0 = (float*)(lds + 16384); float* CPb1 = (float*)(lds + 106496);
    u16* At = (u16*)(lds + 24576); u16* Bt = At + 2304; u16* Kt = Bt + 2304; u16* Rt = Kt + 2304;
    u16* Vr = (u16*)(lds + 43008); u16* Khr = Vr + 3072; u16* Bhr = Khr + 3072;
    float* Lf = (float*)(lds + 61440);
    u16* Lo = (u16*)(lds + 66048); u16* Lak = Lo + 1280; u16* Mrb = Lak + 1280; u16* Mrk = Mrb + 1280; u16* Td = Mrk + 1280;
    float* PC = (float*)(lds + 78848); u16* YS = (u16*)(lds + 79104);
    const u16* r_g = (const u16*)(p.ws + R_RR); const u16* k_g = (const u16*)(p.ws + R_RK); const u16* v_g = (const u16*)(p.ws + R_RV);
    const u16* hw = (const u16*)(p.ws + R_HW); const u16* ha = (const u16*)(p.ws + R_HA);
    const int tid = tidx(), lane = tid & 63, w = tid >> 6, l31 = lane & 31, hh = lane >> 5;
    for (int u = blockIdx.x; u < 256; u += gridDim.x) {
        const int dir = u & 1, hd = (u >> 1) & 15, b = u >> 5;
        u16* y_g = (u16*)(p.ws + (dir ? R_YB : R_YF)); float* rkb = (float*)(p.ws + R_RKB) + (size_t)dir * T0 * 16;
        const int wq = (w - 2) & 3; const int mat = (wq >> 1) & 1, ctt = wq & 1;
        u16* W2L = (u16*)(lds + 86016);
        float* KC = (float*)(lds + 86016 + 18432);
        for (int i = tid; i < 2 * 64 * 8; i += 512) { const int m = i >> 9, c = (i >> 3) & 63, ch = i & 7;
            *(u32x4*)(W2L + (m * 64 + c) * 72 + ch * 8) = *(const u32x4*)((const u16*)(p.ws + (m ? W_A2 : W_W2)) + (size_t)dir * 1024 * 64 + (size_t)(hd * 64 + c) * 64 + ch * 8); }
        if (tid < 64) { KC[tid] = p.in[I_RKK][hd * 64 + tid]; KC[64 + tid] = p.in[I_RKA][hd * 64 + tid]; KC[128 + tid] = p.in[I_RRK][hd * 64 + tid]; }
        const u16* w2l = W2L + (mat * 64 + ctt * 32 + l31) * 72;
        const float* bias0 = (mat ? p.in[I_RA0] : p.in[I_RW0]) + dir * 1024 + hd * 64 + ctt * 32;
        const u16* hsrc = mat ? ha : hw;
        const int t2 = tid >> 4, c4 = (tid & 15) * 4; const int cg = hd * 64 + c4;
        for (int i = tid; i < 1280; i += 512) Td[i] = 0;
        f32x16 Z[2];
#pragma unroll
        for (int a = 0; a < 2; ++a)
#pragma unroll
            for (int i = 0; i < 16; ++i) Z[a][i] = 0.f;
        __syncthreads();
        const size_t rowb = (size_t)b * LT;
        auto chunk_p0 = [&](int ci) { int pc; if (ci < 8) { pc = dir ? 7 - ci : ci; return 32 * pc; } pc = dir ? 135 - ci : ci - 8; return LC + 32 * pc; };
        bf16x8 hfr[4]; uint2 ru, ku, vu;
        {
            const int p0 = chunk_p0(0);
            const int pos = dir ? p0 + 31 - l31 : p0 + l31; const u16* hp = hsrc + (rowb + pos) * 128 + dir * 64;
#pragma unroll
            for (int ks = 0; ks < 4; ++ks) hfr[ks] = *(const bf16x8*)(hp + ks * 16 + hh * 8);
            const int pos2 = dir ? p0 + 31 - t2 : p0 + t2; const size_t go = (rowb + pos2) * DM + cg;
            ru = *(const uint2*)(r_g + go); ku = *(const uint2*)(k_g + go); vu = *(const uint2*)(v_g + go);
        }
        auto stage0 = [&](int pnn, int buf) {
            {
                f32x16 acc;
#pragma unroll
                for (int i = 0; i < 16; ++i) acc[i] = 0.f;
#pragma unroll
                for (int ks = 0; ks < 4; ++ks) acc = MFMA(hfr[ks], frag_plain(w2l, ks, hh), acc);
                {
                    const int pos = dir ? pnn + 31 - l31 : pnn + l31; const u16* hp = hsrc + (rowb + pos) * 128 + dir * 64;
#pragma unroll
                    for (int ks = 0; ks < 4; ++ks) hfr[ks] = *(const bf16x8*)(hp + ks * 16 + hh * 8);
                }
                const float bv = bias0[l31];
                float* dstm = (mat ? AAb + buf * 2048 : (buf ? CPb1 : CPb0)) + ctt * 32 + l31;
                if (mat) {
#pragma unroll
                    for (int i = 0; i < 16; ++i) dstm[((i & 3) + 8 * (i >> 2) + 4 * hh) * 64] = sigmoidf_(acc[i] + bv);
                } else {
                    f32x16 lo, cp;
#pragma unroll
                    for (int i = 0; i < 16; ++i) { const float lw = -0.6065306597126334f * sigmoidf_(acc[i] + bv); const float hi = bf1((u16)(pack2(lw, 0.f))); acc[i] = hi; lo[i] = lw - hi; cp[i] = 0.f; }
#pragma unroll
                    for (int ks = 0; ks < 2; ++ks) {
                        u32x4 tv;
#pragma unroll
                        for (int q = 0; q < 4; ++q) { const int ta = 16 * ks + 8 * (q >> 1) + 4 * hh + 2 * (q & 1); tv[q] = ((ta <= l31) ? 0x3F80u : 0u) | ((ta + 1 <= l31) ? 0x3F800000u : 0u); }
                        const bf16x8 tri = __builtin_bit_cast(bf16x8, tv);
                        cp = MFMA(tri, acc_to_b(acc, ks), cp); cp = MFMA(tri, acc_to_b(lo, ks), cp);
                    }
#pragma unroll
                    for (int i = 0; i < 16; ++i) dstm[((i & 3) + 8 * (i >> 2) + 4 * hh) * 64] = cp[i];
                }
            }
        };
        if (w >= 2 && w < 6) stage0(chunk_p0(1), 0);
        lds_barrier();
        for (int ci = 0; ci < 136; ++ci) {
            const int p0 = chunk_p0(ci); const int p0n = chunk_p0(ci < 135 ? ci + 1 : ci);
            const float* AA = AAb + (ci & 1) * 2048; const float* CP = (ci & 1) ? CPb1 : CPb0;
            const int pos2 = dir ? p0 + 31 - t2 : p0 + t2;
            {
                const float rv[4] = {bf_lo(ru.x), bf_hi(ru.x), bf_lo(ru.y), bf_hi(ru.y)}, kv[4] = {bf_lo(ku.x), bf_hi(ku.x), bf_lo(ku.y), bf_hi(ku.y)};
                const float4 a4 = *(const float4*)(AA + t2 * 64 + c4), cp4 = *(const float4*)(CP + t2 * 64 + c4), ce4 = *(const float4*)(CP + 31 * 64 + c4);
                float4 cq4 = make_float4(0.f, 0.f, 0.f, 0.f); if (t2 > 0) cq4 = *(const float4*)(CP + (t2 - 1) * 64 + c4);
                const float av[4] = {a4.x, a4.y, a4.z, a4.w}, cpv[4] = {cp4.x, cp4.y, cp4.z, cp4.w}, cev[4] = {ce4.x, ce4.y, ce4.z, ce4.w}, cqv[4] = {cq4.x, cq4.y, cq4.z, cq4.w};
                const float4 kkc = *(const float4*)(KC + c4), kac = *(const float4*)(KC + 64 + c4), rkc = *(const float4*)(KC + 128 + c4);
                const float kkcv[4] = {kkc.x, kkc.y, kkc.z, kkc.w}, kacv[4] = {kac.x, kac.y, kac.z, kac.w}, rkcv[4] = {rkc.x, rkc.y, rkc.z, rkc.w};
                float kk[4], km[4], ssq = 0.f, rks = 0.f;
#pragma unroll
                for (int i = 0; i < 4; ++i) { kk[i] = kv[i] * kkcv[i]; ssq += kk[i] * kk[i]; km[i] = kv[i] * (1.f + (av[i] - 1.f) * kacv[i]); rks += rv[i] * km[i] * rkcv[i]; }
                ssq = red16_sum(ssq); rks = red16_sum(rks);
                const float inv = 1.f / fmaxf(sqrtf(ssq), 1e-12f);
                float at[4], bt[4], kt[4], rt[4], bh[4], kh[4];
#pragma unroll
                for (int i = 0; i < 4; ++i) {
                    const float kn = kk[i] * inv, bb = kn * av[i];
                    const float en = __expf(-cpv[i]), eh = __expf(cev[i] - cpv[i]);
                    at[i] = -kn * __expf(cqv[i]); bt[i] = bb * en; kt[i] = km[i] * en; rt[i] = rv[i] * __expf(cpv[i]); bh[i] = bb * eh; kh[i] = km[i] * eh;
                }
                uint2 o;
                o.x = pack2(at[0], at[1]); o.y = pack2(at[2], at[3]); *(uint2*)(At + t2 * 72 + c4) = o;
                o.x = pack2(bt[0], bt[1]); o.y = pack2(bt[2], bt[3]); *(uint2*)(Bt + t2 * 72 + c4) = o;
                o.x = pack2(kt[0], kt[1]); o.y = pack2(kt[2], kt[3]); *(uint2*)(Kt + t2 * 72 + c4) = o;
                o.x = pack2(rt[0], rt[1]); o.y = pack2(rt[2], rt[3]); *(uint2*)(Rt + t2 * 72 + c4) = o;
                o.x = pack2(kh[0], kh[1]); o.y = pack2(kh[2], kh[3]); *(uint2*)(Khr + t2 * 96 + c4) = o;
                o.x = pack2(bh[0], bh[1]); o.y = pack2(bh[2], bh[3]); *(uint2*)(Bhr + t2 * 96 + c4) = o;
                *(uint2*)(Vr + t2 * 96 + c4) = vu;
                if (t2 == 0) *(float4*)(PC + c4) = make_float4(__expf(cev[0]), __expf(cev[1]), __expf(cev[2]), __expf(cev[3]));
                if ((tid & 15) == 0) rkb[(rowb + pos2) * 16 + hd] = rks;
                const int pos2n = dir ? p0n + 31 - t2 : p0n + t2; const size_t gon = (rowb + pos2n) * DM + cg;
                ru = *(const uint2*)(r_g + gon); ku = *(const uint2*)(k_g + gon); vu = *(const uint2*)(v_g + gon);
            }
            lds_barrier();
            if (w < 4) {
                const u16* X1 = (w < 2) ? At : Rt; const u16* X2 = (w & 1) ? Kt : Bt;
                f32x16 acc;
#pragma unroll
                for (int i = 0; i < 16; ++i) acc[i] = 0.f;
#pragma unroll
                for (int ks = 0; ks < 4; ++ks) acc = MFMA(frag_plain(X2 + l31 * 72, ks, hh), frag_plain(X1 + l31 * 72, ks, hh), acc);
#pragma unroll
                for (int i = 0; i < 16; ++i) { const int s = (i & 3) + 8 * (i >> 2) + 4 * hh; const bool keep = (w < 2) ? (s < l31) : (s <= l31); if (!keep) acc[i] = 0.f; }
                if (w == 0) {
#pragma unroll
                    for (int g = 0; g < 4; ++g) {
                        *(float4*)(Lf + l31 * 36 + 8 * g + 4 * hh) = make_float4(acc[4 * g], acc[4 * g + 1], acc[4 * g + 2], acc[4 * g + 3]);
                        const bool lo = (l31 >= 16) && (8 * g + 4 * hh < 16);
                        uint2 o; o.x = lo ? pack2(acc[4 * g], acc[4 * g + 1]) : 0u; o.y = lo ? pack2(acc[4 * g + 2], acc[4 * g + 3]) : 0u; *(uint2*)(Lo + l31 * 40 + 8 * g + 4 * hh) = o;
                    }
                } else {
                    u16* dst = (w == 1) ? Lak : (w == 2) ? Mrb : Mrk;
#pragma unroll
                    for (int g = 0; g < 4; ++g) { uint2 o; o.x = pack2(acc[4 * g], acc[4 * g + 1]); o.y = pack2(acc[4 * g + 2], acc[4 * g + 3]); *(uint2*)(dst + l31 * 40 + 8 * g + 4 * hh) = o; }
                }
            }
            lds_barrier();
            f32x16 XZ, Ya; bf16x8 zf[4];
            if (w >= 6) {
                const int blk = w - 6, j = lane & 15; const float* Lb = Lf + (16 * blk) * 36 + 16 * blk;
                const float4 l4 = *(const float4*)(Lb + (lane >> 2) * 36 + 4 * (lane & 3));
                const int li[4] = {__builtin_bit_cast(int, l4.x), __builtin_bit_cast(int, l4.y), __builtin_bit_cast(int, l4.z), __builtin_bit_cast(int, l4.w)};
                float x[16];
#pragma unroll
                for (int t = 0; t < 16; ++t) {
                    float a0 = (j == t) ? 1.f : 0.f, a1 = 0.f;
#pragma unroll
                    for (int s2 = 0; s2 < t; ++s2) {
                        const float lv = __builtin_bit_cast(float, __builtin_amdgcn_readlane(li[s2 & 3], 4 * t + (s2 >> 2)));
                        if (s2 & 1) a1 += lv * x[s2]; else a0 += lv * x[s2];
                    }
                    x[t] = a0 + a1;
                }
                if (lane < 16) {
#pragma unroll
                    for (int t = 0; t < 16; ++t) Td[(16 * blk + t) * 40 + 16 * blk + j] = (u16)(pack2(x[t], 0.f));
                }
            } else if (w >= 2) {
                if (ci + 1 < 136) stage0(chunk_p0(ci + 2 < 136 ? ci + 2 : 135), (ci + 1) & 1);
            } else {
#pragma unroll
                for (int s = 0; s < 4; ++s) zf[s] = acc_to_b(Z[s >> 1], s & 1);
#pragma unroll
                for (int i = 0; i < 16; ++i) { XZ[i] = 0.f; Ya[i] = 0.f; }
#pragma unroll
                for (int s = 0; s < 4; ++s) { XZ = MFMA(frag_perm(At + l31 * 72, s, hh), zf[s], XZ); Ya = MFMA(frag_perm(Rt + l31 * 72, s, hh), zf[s], Ya); }
                bf16x8 vf[2];
#pragma unroll
                for (int ks = 0; ks < 2; ++ks) {
                    vf[ks] = tr_frag(Vr + (16 * ks) * 96 + 32 * w, 96, lane);
                    XZ = MFMA(frag_perm(Lak + l31 * 40, ks, hh), vf[ks], XZ); Ya = MFMA(frag_perm(Mrk + l31 * 40, ks, hh), vf[ks], Ya);
                }
#pragma unroll
                for (int kt = 0; kt < 2; ++kt) {
#pragma unroll
                    for (int g = 0; g < 4; ++g) { const float4 pc4 = *(const float4*)(PC + 32 * kt + 8 * g + 4 * hh);
                        Z[kt][4 * g] *= pc4.x; Z[kt][4 * g + 1] *= pc4.y; Z[kt][4 * g + 2] *= pc4.z; Z[kt][4 * g + 3] *= pc4.w; }
#pragma unroll
                    for (int ks = 0; ks < 2; ++ks) Z[kt] = MFMA(tr_frag(Khr + (16 * ks) * 96 + 32 * kt, 96, lane), vf[ks], Z[kt]);
                }
            }
            lds_barrier();
            if (w < 2) {
                f32x16 U1 = {}, W = {};
#pragma unroll
                for (int i = 0; i < 16; ++i) { U1[i] = 0.f; W[i] = 0.f; }
#pragma unroll
                for (int ks = 0; ks < 2; ++ks) U1 = MFMA(frag_perm(Td + l31 * 40, ks, hh), acc_to_b(XZ, ks), U1);
#pragma unroll
                for (int ks = 0; ks < 2; ++ks) W = MFMA(frag_perm(Lo + l31 * 40, ks, hh), acc_to_b(U1, ks), W);
#pragma unroll
                for (int ks = 0; ks < 2; ++ks) U1 = MFMA(frag_perm(Td + l31 * 40, ks, hh), acc_to_b(W, ks), U1);
                const bf16x8 uf0 = acc_to_b(U1, 0), uf1 = acc_to_b(U1, 1);
                Ya = MFMA(frag_perm(Mrb + l31 * 40, 0, hh), uf0, Ya); Ya = MFMA(frag_perm(Mrb + l31 * 40, 1, hh), uf1, Ya);
#pragma unroll
                for (int kt = 0; kt < 2; ++kt) { Z[kt] = MFMA(tr_frag(Bhr + 32 * kt, 96, lane), uf0, Z[kt]); Z[kt] = MFMA(tr_frag(Bhr + 16 * 96 + 32 * kt, 96, lane), uf1, Z[kt]); }
#pragma unroll
                for (int i = 0; i < 16; ++i) { const int t = (i & 3) + 8 * (i >> 2) + 4 * hh; YS[t * 72 + 32 * w + l31] = (u16)pack2(Ya[i], 0.f); }
            }
            lds_barrier();
            if (ci >= 8) { const uint2 yv = *(const uint2*)(YS + t2 * 72 + c4); *(uint2*)(y_g + (rowb + pos2) * DM + cg) = yv; }
        }
        __syncthreads();
    }
}
DEVI void phase_rwkv_readout(const Params& p) {
    const u16* yf = (const u16*)(p.ws + R_YF); const u16* yb = (const u16*)(p.ws + R_YB); const u16* vg = (const u16*)(p.ws + R_RV); const u16* gg = (const u16*)(p.ws + R_GG);
    const float* rkb = (const float*)(p.ws + R_RKB); u16* rd = (u16*)(p.ws + R_RD);
    const float* lnw = p.in[I_RLNW]; const float* lnb = p.in[I_RLNB];
    const int lane = tidx() & 63, w = tidx() >> 6;
    for (int t = blockIdx.x * 8 + w; t < TL; t += gridDim.x * 8) {
        const int b = t >> 12, s = t & 4095; const size_t row = (size_t)b * LT + LC + s; const int c = lane * 16; const int hd = lane >> 2;
        float y[16], vv[16], gv[16];
#pragma unroll
        for (int q = 0; q < 2; ++q) {
            const uint4 a = *(const uint4*)(yf + row * DM + c + 8 * q), bq = *(const uint4*)(yb + row * DM + c + 8 * q), v4 = *(const uint4*)(vg + row * DM + c + 8 * q), g4 = *(const uint4*)(gg + row * DM + c + 8 * q);
            y[8 * q + 0] = bf_lo(a.x) + bf_lo(bq.x); y[8 * q + 1] = bf_hi(a.x) + bf_hi(bq.x); y[8 * q + 2] = bf_lo(a.y) + bf_lo(bq.y); y[8 * q + 3] = bf_hi(a.y) + bf_hi(bq.y);
            y[8 * q + 4] = bf_lo(a.z) + bf_lo(bq.z); y[8 * q + 5] = bf_hi(a.z) + bf_hi(bq.z); y[8 * q + 6] = bf_lo(a.w) + bf_lo(bq.w); y[8 * q + 7] = bf_hi(a.w) + bf_hi(bq.w);
            vv[8 * q + 0] = bf_lo(v4.x); vv[8 * q + 1] = bf_hi(v4.x); vv[8 * q + 2] = bf_lo(v4.y); vv[8 * q + 3] = bf_hi(v4.y); vv[8 * q + 4] = bf_lo(v4.z); vv[8 * q + 5] = bf_hi(v4.z); vv[8 * q + 6] = bf_lo(v4.w); vv[8 * q + 7] = bf_hi(v4.w);
            gv[8 * q + 0] = bf_lo(g4.x); gv[8 * q + 1] = bf_hi(g4.x); gv[8 * q + 2] = bf_lo(g4.y); gv[8 * q + 3] = bf_hi(g4.y); gv[8 * q + 4] = bf_lo(g4.z); gv[8 * q + 5] = bf_hi(g4.z); gv[8 * q + 6] = bf_lo(g4.w); gv[8 * q + 7] = bf_hi(g4.w);
        }
        float sm = 0.f;
#pragma unroll
        for (int i = 0; i < 16; ++i) sm += y[i];
        sm = red4_sum(sm); const float mean = sm * (1.f / 64.f);
        float vs = 0.f;
#pragma unroll
        for (int i = 0; i < 16; ++i) { const float d = y[i] - mean; vs += d * d; }
        vs = red4_sum(vs); const float rstd = rsqrtf(vs * (1.f / 64.f) + 64e-5f);
        const float bon = rkb[row * 16 + hd] + rkb[(size_t)T0 * 16 + row * 16 + hd];
        unsigned ow[8];
#pragma unroll
        for (int i = 0; i < 8; ++i) {
            const int c0 = c + 2 * i;
            const float o0 = ((y[2 * i] - mean) * rstd * lnw[c0] + lnb[c0] + bon * vv[2 * i]) * gv[2 * i];
            const float o1 = ((y[2 * i + 1] - mean) * rstd * lnw[c0 + 1] + lnb[c0 + 1] + bon * vv[2 * i + 1]) * gv[2 * i + 1];
            ow[i] = pack2(o0, o1);
        }
        *(uint4*)(rd + (size_t)t * DM + c) = make_uint4(ow[0], ow[1], ow[2], ow[3]); *(uint4*)(rd + (size_t)t * DM + c + 8) = make_uint4(ow[4], ow[5], ow[6], ow[7]);
    }
}
DEVI void phase_final_norm(const Params& p) {
    const float* g = p.in[I_NFIN]; float* X = p.out;
    const int lane = tidx() & 63, w = tidx() >> 6;
    for (int r = blockIdx.x * 8 + w; r < TL; r += gridDim.x * 8) {
        float4* xr = (float4*)(X + (size_t)r * DM); float4 v[4]; float ss = 0.f;
#pragma unroll
        for (int i = 0; i < 4; ++i) { v[i] = xr[lane + 64 * i]; ss += v[i].x * v[i].x + v[i].y * v[i].y + v[i].z * v[i].z + v[i].w * v[i].w; }
        ss = wave_sum(ss); const float rs = rsqrtf(ss * (1.f / 1024.f) + 1e-6f);
#pragma unroll
        for (int i = 0; i < 4; ++i) { const float4 gg = ((const float4*)g)[lane + 64 * i]; float4 o; o.x = v[i].x * rs * gg.x; o.y = v[i].y * rs * gg.y; o.z = v[i].z * rs * gg.z; o.w = v[i].w * rs * gg.w; xr[lane + 64 * i] = o; }
    }
}

constexpr int N_PHASES = 30;
template <int PH> DEVI void run_phase(const Params& p, char* lds) {
    const float* mods = (const float*)(p.ws + OFF_MODS);
    RowSrc in_src; in_src.ctx = p.in[I_CTX]; in_src.lat = p.in[I_X];
    RowSrc x_src; x_src.ctx = (const float*)(p.ws + OFF_XC); x_src.lat = p.out;
    if constexpr (PH == 0) phase_prologue(p, lds);
    else if constexpr (PH == 1) norm_rows(in_src, 0, T0, p.in[I_NMIX], mods, 0, 1, (u16*)(p.ws + A_N0));
    else if constexpr (PH == 2) phase_gemm_win(p, lds);
    else if constexpr (PH == 3) phase_gemm_qkv(p, lds);
    else if constexpr (PH == 4) { phase_attention(p, lds); conv_jobs(p, 25, 28, 0, 0, lds); }
    else if constexpr (PH == 5) phase_gemm_wo(p, (const u16*)(p.ws + A_N0), (const u16*)(p.ws + W_OA), in_src, 0, 0, lds);
    else if constexpr (PH == 6) phase_moe_norm(p, 0);
    else if constexpr (PH == 7) phase_moe_route(p, 0, lds);
    else if constexpr (PH == 8) phase_moe_gemm1(p, 0, lds);
    else if constexpr (PH >= 9 && PH <= 13) phase_moe_g2c(p, 0, PH - 9 < NCHUNK ? PH - 9 : -1, PH - 10, lds);
    else if constexpr (PH == 14) norm_rows(x_src, 0, T0, p.in[I_NMIX] + 1024, mods + 9 * 6144, 0, 1, (u16*)(p.ws + R_NN));
    else if constexpr (PH == 15) phase_rwkv_mix(p, 0, 2, 3);
    else if constexpr (PH == 16) phase_rwkv_gemm_rkv(p, lds);
    else if constexpr (PH == 17) phase_rwkv_mix(p, 1, 4, 5);
    else if constexpr (PH == 18) phase_rwkv_gemm_small(p, lds);
    else if constexpr (PH == 19) { phase_rwkv_gemm_g(p, lds); phase_rwkv_scan(p, lds); }
    else if constexpr (PH == 20) phase_rwkv_readout(p);
    else if constexpr (PH == 21) { phase_gemm_wo(p, (const u16*)(p.ws + R_RD), (const u16*)(p.ws + W_RO), x_src, 1, 1, lds); conv_jobs(p, 25, 28, 1, 0, lds); }
    else if constexpr (PH == 22) phase_moe_norm(p, 1);
    else if constexpr (PH == 23) phase_moe_route(p, 1, lds);
    else if constexpr (PH == 24) phase_moe_gemm1(p, 1, lds);
    else if constexpr (PH >= 25 && PH <= 29) phase_moe_g2c(p, 1, PH - 25 < NCHUNK ? PH - 25 : -1, PH - 26, lds);
}

#if MEGA
template <int PH, int END> DEVI void run_range(const Params& p_, char* lds, const XcdBarrier& bar) {
    const Params& p = *(const Params*)__builtin_amdgcn_kernarg_segment_ptr();
    run_phase<PH>(p, lds);
    if constexpr (PH + 1 < END) { xcd_barrier(bar); run_range<PH + 1, END>(p_, lds, bar); }
}
template <int A, int B> __global__ void __launch_bounds__(512, 2) k_range(Params p, unsigned* barw) {
    extern __shared__ __attribute__((aligned(16))) char smem[];
    if (threadIdx.x == 0) *(uint4*)smem = make_uint4(0u, 0u, 0u, 0u);
    __syncthreads();
    const XcdBarrier bar = xcd_barrier_post(barw, (volatile LAS unsigned*)smem);
    run_range<A, B>(p, smem + 64, bar);
}
template <int A, int B> static void launch_range(const Params& p, unsigned* barw, hipStream_t s) {
    static int grid = 0;
    if (!grid) {
        int dev = 0, cus = 0, per_cu = 0;
        (void)hipGetDevice(&dev);
        (void)hipDeviceGetAttribute(&cus, hipDeviceAttributeMultiprocessorCount, dev);
        (void)hipFuncSetAttribute((const void*)k_range<A, B>, hipFuncAttributeMaxDynamicSharedMemorySize, LDS_BYTES);
        (void)hipOccupancyMaxActiveBlocksPerMultiprocessor(&per_cu, (const void*)k_range<A, B>, 512, LDS_BYTES);
        if (per_cu < 1) fprintf(stderr, "occupancy query says 0 blocks per CU\n");
        grid = cus;
    }
    k_range<A, B><<<grid, 512, LDS_BYTES, s>>>(p, barw);
}
extern "C" void kernel_launch(void* const* d_in, const int* in_sizes, int n_in, void* d_out, int out_size, void* d_ws, size_t ws_size, hipStream_t stream) {
    Params p{};
    for (int i = 0; i < N_IN; ++i) p.in[i] = (const float*)d_in[i];
    p.out = (float*)d_out; p.ws = (char*)d_ws;
    if (ws_size < WS_NEED) { fprintf(stderr, "workspace too small\n"); return; }
    (void)hipMemsetAsync(p.ws + OFF_BAR, 0, XCD_BAR_WORDS * sizeof(unsigned), stream);
    launch_range<0, N_PHASES>(p, (unsigned*)(p.ws + OFF_BAR), stream);
}
#else
template <int PH> __global__ void __launch_bounds__(512, 2) k_phase(Params p) {
    extern __shared__ __attribute__((aligned(16))) char smem[];
    run_phase<PH>(p, smem + 64);
}
template <int PH> static void launch_phase(const Params& p, hipStream_t s) {
    static bool attr = false;
    if (!attr) { hipFuncSetAttribute((const void*)k_phase<PH>, hipFuncAttributeMaxDynamicSharedMemorySize, LDS_BYTES); attr = true; }
    k_phase<PH><<<256, 512, LDS_BYTES, s>>>(p);
}
template <int PH> static void launch_all(const Params& p, hipStream_t s) {
    launch_phase<PH>(p, s);
    if constexpr (PH + 1 < N_PHASES) launch_all<PH + 1>(p, s);
}

extern "C" void kernel_launch(void* const* d_in, const int* in_sizes, int n_in, void* d_out, int out_size, void* d_ws, size_t ws_size, hipStream_t stream) {
    Params p{};
    for (int i = 0; i < N_IN; ++i) p.in[i] = (const float*)d_in[i];
    p.out = (float*)d_out; p.ws = (char*)d_ws;
    if (ws_size < WS_NEED) { fprintf(stderr, "workspace too small: %zu < %zu\n", ws_size, (size_t)WS_NEED); return; }
    launch_all<0>(p, stream);
}
#endif
```

```cpp
#include <hip/hip_runtime.h>
#include <stdint.h>
#include <stdio.h>
#include <type_traits>

#ifndef MEGA
#define MEGA 1
#endif

typedef unsigned short u16;
typedef short bf16x8 __attribute__((ext_vector_type(8)));
typedef short s16x4 __attribute__((ext_vector_type(4)));
typedef float f32x16 __attribute__((ext_vector_type(16)));
typedef float f32x4 __attribute__((ext_vector_type(4)));
typedef float f32x2 __attribute__((ext_vector_type(2)));
typedef unsigned u32x4 __attribute__((ext_vector_type(4)));
typedef __bf16 bf2 __attribute__((ext_vector_type(2)));
#define DEVI __device__ __forceinline__
#define LAS __attribute__((address_space(3)))
__device__ __forceinline__ int tidx() { int t = threadIdx.x; asm volatile("" : "+v"(t)); return t; }

constexpr int NB = 8, SEQ = 4096, LC = 256, LT = 4352, DM = 1024, T0 = NB * LT, TL = NB * SEQ;
constexpr int NCHUNK = 4;
constexpr float LOG2E = 1.4426950408889634f;
constexpr float QA_SCALE = 0.07216878364870322f * LOG2E;
constexpr float QS_SCALE = 0.125f * LOG2E;

enum { I_X = 0, I_C, I_CTX, I_CCTX, I_ADAW, I_ADAB, I_NMIX, I_NFFN, I_NFIN, I_AWIN, I_AQN, I_AKVN, I_AWUQ, I_AWUKV, I_ASINK, I_AWO,
       I_RMU, I_RWR, I_RWK, I_RWV, I_RWO, I_RG1, I_RG2, I_RW0, I_RW1, I_RW2, I_RA0, I_RA1, I_RA2, I_RKK, I_RKA, I_RRK, I_RLNW, I_RLNB,
       I_MROUT, I_MBIAS, I_MWG, I_MWU, I_MWD, I_MSG, I_MSU, I_MSD, N_IN };

struct Params { const float* in[N_IN]; float* out; char* ws; };

constexpr size_t OFF_BAR = 0, OFF_CNT = 16384, OFF_ROPE = 20480, OFF_MODS = 32768, OFF_WSTAT = 524288;
constexpr size_t W_IN = OFF_WSTAT, W_UQ = W_IN + 3145728, W_UK = W_UQ + 589824, W_UV = W_UK + 262144, W_OA = W_UV + 262144,
                 W_RR = W_OA + 2097152, W_RK = W_RR + 2097152, W_RV = W_RK + 2097152, W_RO = W_RV + 2097152,
                 W_G1 = W_RO + 2097152, W_W1 = W_G1 + 262144, W_A1 = W_W1 + 262144, W_G2 = W_A1 + 262144, W_W2 = W_G2 + 262144, W_A2 = W_W2 + 262144,
                 W_SGU = W_A2 + 262144, W_SD = W_SGU + 2 * 1048576, W_END = W_SD + 2 * 524288;
constexpr size_t OFF_XC = OFF_WSTAT + 20971520;
constexpr size_t OFF_TOKE = OFF_XC + 8388608, OFF_TOKR = OFF_TOKE + 835584, OFF_LTOK = OFF_TOKR + 835584, OFF_LG = OFF_LTOK + 8912896;
constexpr size_t OFF_WROUT = OFF_LG + 8912896;
constexpr size_t OFF_D = OFF_XC + 8388608 + 20971520;
static_assert(OFF_WROUT + 2 * 64 * 3072 * 2 <= OFF_D, "router weights overflow");
constexpr size_t WGU_BYTES = 64ull * 512 * 1024 * 2, WD_BYTES = 64ull * 1024 * 256 * 2;
constexpr size_t OFF_WGU = OFF_D, OFF_WD = OFF_D + WGU_BYTES;
constexpr size_t OFF_G = OFF_D + WGU_BYTES + WD_BYTES;
constexpr size_t SZ_T0D = (size_t)T0 * 1024 * 2;
constexpr size_t A_N0 = OFF_G, A_CQ = A_N0 + SZ_T0D, A_CKV = A_CQ + (size_t)T0 * 384 * 2, A_QA = A_CKV + (size_t)T0 * 256 * 2, A_KA = A_QA + (size_t)T0 * 768 * 2,
                 A_VA = A_KA + (size_t)T0 * 768 * 2, A_QS = A_VA + (size_t)T0 * 512 * 2, A_KS = A_QS + (size_t)T0 * 512 * 2, A_VS = A_KS + (size_t)T0 * 128 * 2, A_END = A_VS + (size_t)T0 * 128 * 2;
constexpr size_t M_N1 = OFF_G, M_ACT = M_N1 + SZ_T0D, M_OUTR = M_ACT + (size_t)7 * T0 * 256 * 2, SZ_OUTR = (size_t)7 * 8704 * 1024 * 2, M_END = M_OUTR + 2 * SZ_OUTR;
constexpr size_t R_XM0 = OFF_D, R_XM1 = R_XM0 + SZ_T0D, R_XM2 = R_XM1 + SZ_T0D, R_RR = R_XM2 + SZ_T0D, R_RK = R_RR + SZ_T0D, R_RV = R_RK + SZ_T0D, R_NN = R_RV + SZ_T0D,
                 R_HG = R_NN + SZ_T0D, R_HW = R_HG + (size_t)T0 * 128 * 2, R_HA = R_HW + (size_t)T0 * 128 * 2, R_RKB = R_HA + (size_t)T0 * 128 * 2, R_END = R_RKB + (size_t)2 * T0 * 16 * 4;
constexpr size_t R_GG = R_XM0, R_YF = R_XM1, R_YB = R_XM2, R_RD = R_NN;
constexpr size_t WS_NEED = R_END > M_END ? R_END : M_END;

constexpr int LDS_BYTES = 64 + 131072;

DEVI unsigned pack2(float a, float b) { f32x2 v = {a, b}; bf2 r = __builtin_convertvector(v, bf2); return __builtin_bit_cast(unsigned, r); }
DEVI float bf_lo(unsigned u) { return __builtin_bit_cast(float, u << 16); }
DEVI float bf_hi(unsigned u) { return __builtin_bit_cast(float, u & 0xffff0000u); }
DEVI float bf1(u16 u) { return __builtin_bit_cast(float, ((unsigned)u) << 16); }
DEVI float dppf(float x, const int ctrl_sel) {
    int xi = __builtin_bit_cast(int, x), y;
    if (ctrl_sel == 0) y = __builtin_amdgcn_mov_dpp(xi, 0xB1, 0xF, 0xF, true);
    else if (ctrl_sel == 1) y = __builtin_amdgcn_mov_dpp(xi, 0x4E, 0xF, 0xF, true);
    else y = __builtin_amdgcn_mov_dpp(xi, 0x141, 0xF, 0xF, true);
    return __builtin_bit_cast(float, y);
}
DEVI float red8_sum(float x) { x += dppf(x, 0); x += dppf(x, 1); x += dppf(x, 2); return x; }
DEVI float red8_max(float x) { x = fmaxf(x, dppf(x, 0)); x = fmaxf(x, dppf(x, 1)); x = fmaxf(x, dppf(x, 2)); return x; }
DEVI float red4_sum(float x) { x += dppf(x, 0); x += dppf(x, 1); return x; }
DEVI float wave_sum(float x) { for (int o = 32; o > 0; o >>= 1) x += __shfl_xor(x, o); return x; }
DEVI float wave_max(float x) { for (int o = 32; o > 0; o >>= 1) x = fmaxf(x, __shfl_xor(x, o)); return x; }
DEVI float xhalf(float x) {
    int l = (int)__builtin_amdgcn_mbcnt_hi(~0u, __builtin_amdgcn_mbcnt_lo(~0u, 0u)); asm volatile("" : "+v"(l));
    return __builtin_bit_cast(float, __builtin_amdgcn_ds_bpermute((l ^ 32) << 2, __builtin_bit_cast(int, x)));
}
DEVI void lds_barrier() { asm volatile("s_waitcnt lgkmcnt(0)\n\ts_barrier" ::: "memory"); }
DEVI float sigmoidf_(float x) { return 1.f / (1.f + __expf(-x)); }
DEVI float siluf_(float x) { return x / (1.f + __expf(-x)); }
DEVI float tanhf_(float x) { float e = __expf(2.f * x); return 1.f - 2.f / (e + 1.f); }

#define XB_TMO      128
#define XB_XCNT(j)  (256  + 64 * (j))
#define XB_XSUB(j)  (1280 + 64 * (j))
#define XB_XGEN(j)  (2304 + 64 * (j))
#define XB_TOP      3328
#define XB_TOPGEN   3392
#define XCD_BAR_WORDS 3456
#define XB_SPIN_CAP (1u << 20)
DEVI unsigned xb_ld(unsigned* p)              { return __hip_atomic_load(p, __ATOMIC_RELAXED, __HIP_MEMORY_SCOPE_AGENT); }
DEVI unsigned xb_add(unsigned* p, unsigned v) { return __hip_atomic_fetch_add(p, v, __ATOMIC_RELAXED, __HIP_MEMORY_SCOPE_AGENT); }
DEVI unsigned xb_xcc_id() { return (unsigned)__builtin_amdgcn_s_getreg((3 << 11) | 20) & 0xFu; }
#define XB_SPIN(cond, bar) do { unsigned _sp = 0; while (cond) { __builtin_amdgcn_s_sleep(1); \
    if ((++_sp & 255u) == 0u) { if (xb_ld(&(bar)[XB_TMO])) break; if (_sp > XB_SPIN_CAP) { atomicAdd(&(bar)[XB_TMO], 1u); break; } } } } while (0)
struct XcdBarrier { unsigned* bar; unsigned x; volatile LAS unsigned* st; };
DEVI XcdBarrier xcd_barrier_post(unsigned* bar, volatile LAS unsigned* st) {
    XcdBarrier b; b.bar = bar; b.x = xb_xcc_id(); b.st = st;
    if (threadIdx.x == 0) (void)xb_add(&bar[XB_XCNT(b.x)], 1u);
    return b;
}
DEVI void xcd_barrier_complete(unsigned* bar, unsigned x, unsigned& nloc, unsigned& nx) {
    const unsigned G = gridDim.x * gridDim.y * gridDim.z;
    unsigned sum, cnt, mine, sp = 0u;
    for (;;) {
        sum = 0u; cnt = 0u; mine = 0u;
#pragma unroll
        for (unsigned j = 0; j < 16; ++j) { const unsigned c = xb_ld(&bar[XB_XCNT(j)]); sum += c; cnt += (c > 0u) ? 1u : 0u; mine = (j == x) ? c : mine; }
        if (sum == G) break;
        __builtin_amdgcn_s_sleep(1);
        if ((++sp & 255u) == 0u) { if (xb_ld(&bar[XB_TMO])) break; if (sp > XB_SPIN_CAP) { atomicAdd(&bar[XB_TMO], 1u); break; } }
    }
    nloc = mine > 0u ? mine : 1u; nx = cnt > 0u ? cnt : 1u;
}
DEVI void xcd_barrier(const XcdBarrier& b) {
    asm volatile("s_waitcnt vmcnt(0)" ::: "memory");
    __syncthreads();
    if (threadIdx.x == 0) {
        unsigned* bar = b.bar;
        __builtin_amdgcn_s_waitcnt(0);
        unsigned nloc = b.st[0], nx = b.st[1];
        if (nloc == 0u) { xcd_barrier_complete(bar, b.x, nloc, nx); b.st[0] = nloc; b.st[1] = nx; }
        const unsigned old = xb_add(&bar[XB_XSUB(b.x)], 1u);
        const unsigned gen = old / nloc;
        if (old + 1u == (gen + 1u) * nloc) {
            __builtin_amdgcn_fence(__ATOMIC_RELEASE, "agent");
            asm volatile("s_waitcnt vmcnt(0)" ::: "memory");
            const unsigned og = xb_add(&bar[XB_TOP], 1u);
            const unsigned tg = og / nx;
            if (og + 1u == (tg + 1u) * nx) xb_add(&bar[XB_TOPGEN], 1u);
            else XB_SPIN(xb_ld(&bar[XB_TOPGEN]) == tg, bar);
            __builtin_amdgcn_fence(__ATOMIC_ACQUIRE, "agent");
            xb_add(&bar[XB_XGEN(b.x)], 1u);
            asm volatile("s_waitcnt vmcnt(0)" ::: "memory");
        } else {
            XB_SPIN(xb_ld(&bar[XB_XGEN(b.x)]) == gen, bar);
            __builtin_amdgcn_fence(__ATOMIC_ACQUIRE, "agent");
            asm volatile("s_waitcnt vmcnt(0)" ::: "memory");
        }
    }
    __syncthreads();
}

DEVI int swz(int u) { return gridDim.x == 256 ? ((u & ~255) | ((u & 7) << 5) | ((u >> 3) & 31)) : u; }
struct RowSrc { const float* ctx; const float* lat; };
DEVI const float* row_ptr(const RowSrc& s, int mode, int r, int& bb) {
    if (mode == 0) { int b = r / LT, pp = r - b * LT; if (pp < LC) { bb = 8; return s.ctx + (size_t)(b * LC + pp) * DM; } bb = b; return s.lat + (size_t)(b * SEQ + pp - LC) * DM; }
    bb = r >> 12; return s.lat + (size_t)r * DM;
}
DEVI float* row_ptr_w(float* ctx, float* lat, int mode, int r, int& bb) {
    if (mode == 0) { int b = r / LT, pp = r - b * LT; if (pp < LC) { bb = 8; return ctx + (size_t)(b * LC + pp) * DM; } bb = b; return lat + (size_t)(b * SEQ + pp - LC) * DM; }
    bb = r >> 12; return lat + (size_t)r * DM;
}

DEVI float sumsq8(const bf16x8& v) {
    float s = 0.f;
    const unsigned* u = (const unsigned*)&v;
#pragma unroll
    for (int i = 0; i < 4; ++i) { bf2 b = __builtin_bit_cast(bf2, u[i]); s = __builtin_amdgcn_fdot2_f32_bf16(b, b, s, false); }
    return s;
}
template <int NA, int NBC> struct GemmRegs { u32x4 ra[2][NA], rb[2][NBC]; };
template <int BM, int BN, bool ROWNORM, class ARow, class ARowN, class XF, class ST>
DEVI void gemm_tile(GemmRegs<BM / 64, BN / 64>& R, bool primed, ARow arow, const u16* __restrict__ Bt, ARowN arow_n, const u16* __restrict__ Bt_n, int ldb, int K, XF xf, ST st, char* lds, size_t ksA = 64, size_t ksB = 64) {
    constexpr int WN = BN / 64, NA = BM / 64, NBC = BN / 64, STR = 72;
    const int tid = tidx(), lane = tid & 63, w = tid >> 6, wm = w / WN, wn = w % WN, l31 = lane & 31, h = lane >> 5;
    u16* sA = (u16*)lds; u16* sB = sA + 2 * BM * STR;
    const int crow = tid >> 3, kc = tid & 7;
    const u16* pa[NA]; const u16* pb[NBC]; const u16* pan[NA]; const u16* pbn[NBC];
#pragma unroll
    for (int i = 0; i < NA; ++i) { pa[i] = arow(crow + 64 * i) + kc * 8; pan[i] = pa[i]; }
#pragma unroll
    for (int i = 0; i < NBC; ++i) { pb[i] = Bt + (size_t)(crow + 64 * i) * ldb + kc * 8; pbn[i] = pb[i]; }
    const bool chain = Bt_n != nullptr;
    if (chain) {
#pragma unroll
        for (int i = 0; i < NA; ++i) pan[i] = arow_n(crow + 64 * i) + kc * 8;
#pragma unroll
        for (int i = 0; i < NBC; ++i) pbn[i] = Bt_n + (size_t)(crow + 64 * i) * ldb + kc * 8;
    }
    const int nk = K >> 6;
    auto load_tile = [&](int g, auto setc) {
        constexpr int set = decltype(setc)::value;
        if (g < nk) {
#pragma unroll
            for (int i = 0; i < NA; ++i) R.ra[set][i] = *(const u32x4*)(pa[i] + g * ksA);
#pragma unroll
            for (int i = 0; i < NBC; ++i) R.rb[set][i] = *(const u32x4*)(pb[i] + g * ksB);
        } else if (chain && g < nk + 2) {
#pragma unroll
            for (int i = 0; i < NA; ++i) R.ra[set][i] = *(const u32x4*)(pan[i] + (g - nk) * ksA);
#pragma unroll
            for (int i = 0; i < NBC; ++i) R.rb[set][i] = *(const u32x4*)(pbn[i] + (g - nk) * ksB);
        }
    };
    using I0 = std::integral_constant<int, 0>; using I1 = std::integral_constant<int, 1>;
    if (!primed) { load_tile(0, I0{}); load_tile(1, I1{}); }
    f32x16 acc[2][2];
#pragma unroll
    for (int a = 0; a < 2; ++a)
#pragma unroll
        for (int b = 0; b < 2; ++b)
#pragma unroll
            for (int i = 0; i < 16; ++i) acc[a][b][i] = 0.f;
    float ss[2] = {0.f, 0.f};
#pragma unroll
    for (int i = 0; i < NA; ++i) *(u32x4*)(sA + (crow + 64 * i) * STR + kc * 8) = R.ra[0][i];
#pragma unroll
    for (int i = 0; i < NBC; ++i) *(u32x4*)(sB + (crow + 64 * i) * STR + kc * 8) = R.rb[0][i];
    lds_barrier();
    load_tile(2, I0{});
    auto ktile = [&](int kt, auto curc) {
        constexpr int cur = decltype(curc)::value, nxt = cur ^ 1;
        const u16* a_ = sA + cur * BM * STR; const u16* b_ = sB + cur * BN * STR;
        u16* an = sA + nxt * BM * STR; u16* bn = sB + nxt * BN * STR;
#pragma unroll
        for (int ks = 0; ks < 4; ++ks) {
            bf16x8 af[2], bfr[2];
#pragma unroll
            for (int mi = 0; mi < 2; ++mi) af[mi] = *(const bf16x8*)(a_ + (wm * 64 + mi * 32 + l31) * STR + ks * 16 + h * 8);
#pragma unroll
            for (int ni = 0; ni < 2; ++ni) bfr[ni] = *(const bf16x8*)(b_ + (wn * 64 + ni * 32 + l31) * STR + ks * 16 + h * 8);
            if (ROWNORM) { ss[0] += sumsq8(af[0]); ss[1] += sumsq8(af[1]); }
#pragma unroll
            for (int mi = 0; mi < 2; ++mi)
#pragma unroll
                for (int ni = 0; ni < 2; ++ni) acc[mi][ni] = __builtin_amdgcn_mfma_f32_32x32x16_bf16(bfr[ni], af[mi], acc[mi][ni], 0, 0, 0);
            if (ks == 1 && kt + 1 < nk) {
#pragma unroll
                for (int i = 0; i < NA; ++i) *(u32x4*)(an + (crow + 64 * i) * STR + kc * 8) = R.ra[nxt][i];
#pragma unroll
                for (int i = 0; i < NBC; ++i) *(u32x4*)(bn + (crow + 64 * i) * STR + kc * 8) = R.rb[nxt][i];
            }
        }
        lds_barrier();
        load_tile(kt + 3, std::integral_constant<int, nxt>{});
    };
    for (int kt = 0; kt < nk; kt += 2) { ktile(kt, I0{}); ktile(kt + 1, I1{}); }
    if (ROWNORM) {
#pragma unroll
        for (int mi = 0; mi < 2; ++mi) {
            float s = ss[mi] + __shfl_xor(ss[mi], 32);
            float r = rsqrtf(s / (float)K + 1e-6f);
#pragma unroll
            for (int ni = 0; ni < 2; ++ni)
#pragma unroll
                for (int i = 0; i < 16; ++i) acc[mi][ni][i] *= r;
        }
    }
    constexpr int PS = 72;
    u16* sP = (u16*)lds + w * (64 * PS);
    lds_barrier();
#pragma unroll
    for (int mi = 0; mi < 2; ++mi) {
        xf(wm * 64 + mi * 32 + l31, wn * 64, acc[mi], h);
#pragma unroll
        for (int ni = 0; ni < 2; ++ni)
#pragma unroll
            for (int g = 0; g < 4; ++g) { uint2 v; v.x = pack2(acc[mi][ni][4 * g], acc[mi][ni][4 * g + 1]); v.y = pack2(acc[mi][ni][4 * g + 2], acc[mi][ni][4 * g + 3]);
                *(uint2*)(sP + (mi * 32 + l31) * PS + ni * 32 + 8 * g + 4 * h) = v; }
    }
    asm volatile("s_waitcnt lgkmcnt(0)" ::: "memory");
    __builtin_amdgcn_wave_barrier();
#pragma unroll
    for (int i = 0; i < 8; ++i) {
        const int rr = 8 * i + (lane >> 3), cc = (lane & 7) * 8;
        const u32x4 v = *(const u32x4*)(sP + rr * PS + cc);
        st(wm * 64 + rr, wn * 64 + cc, v);
    }
    lds_barrier();
}
DEVI void store_tile_bf16(u16* dst, const f32x16& t, int h) {
#pragma unroll
    for (int g = 0; g < 4; ++g) { uint2 v; v.x = pack2(t[4 * g], t[4 * g + 1]); v.y = pack2(t[4 * g + 2], t[4 * g + 3]); *(uint2*)(dst + 8 * g + 4 * h) = v; }
}
DEVI void rope_tile(f32x16& t, int axis, int pp, int h, const float2* __restrict__ tab) {
    if (pp < LC) return;
    const int s = pp - LC; const int coord = axis ? (s & 63) : (s >> 6);
#pragma unroll
    for (int g = 0; g < 2; ++g)
#pragma unroll
        for (int i = 0; i < 4; ++i) {
            const float2 cs = tab[coord * 16 + 8 * g + 4 * h + i];
            const float x1 = t[4 * g + i], x2 = t[4 * (g + 2) + i];
            t[4 * g + i] = x1 * cs.x - x2 * cs.y; t[4 * (g + 2) + i] = x2 * cs.x + x1 * cs.y;
        }
}

struct CJob { const float* src; u16* dst; const float* gain; int K, ldsrc, nlog, nvalid, sseg, sstride, soff, dseg, dstride, doff; int nmat; size_t smat, dmat; int ktiled; };
DEVI void get_job(const Params& p, int j, int layer, CJob& J) {
    char* ws = p.ws;
    J.gain = nullptr; J.ktiled = 0; J.nmat = 1; J.smat = 0; J.dmat = 0; J.sseg = 1 << 30; J.sstride = 0; J.soff = 0; J.dseg = 1 << 30; J.dstride = 0; J.doff = 0;
    auto plain = [&](const float* src, size_t dstoff, int K, int N) { J.src = src; J.dst = (u16*)(ws + dstoff); J.K = K; J.ldsrc = N; J.nlog = N; J.nvalid = N; };
    switch (j) {
    case 0: plain(p.in[I_AWIN], W_IN, 1024, 1472); J.nlog = 1536; break;
    case 1: plain(p.in[I_AWUQ], W_UQ, 384, 768); J.gain = p.in[I_AQN]; break;
    case 2: plain(p.in[I_AWUKV], W_UK, 256, 1024); J.nlog = 512; J.nvalid = 512; J.sseg = 128; J.sstride = 256; J.soff = 0; J.gain = p.in[I_AKVN]; break;
    case 3: plain(p.in[I_AWUKV], W_UV, 256, 1024); J.nlog = 512; J.nvalid = 512; J.sseg = 128; J.sstride = 256; J.soff = 128; J.gain = p.in[I_AKVN]; break;
    case 4: plain(p.in[I_AWO], W_OA, 1024, 1024); break;
    case 5: plain(p.in[I_RWR], W_RR, 1024, 1024); break;
    case 6: plain(p.in[I_RWK], W_RK, 1024, 1024); break;
    case 7: plain(p.in[I_RWV], W_RV, 1024, 1024); break;
    case 8: plain(p.in[I_RWO], W_RO, 1024, 1024); break;
    case 9: plain(p.in[I_RG1], W_G1, 1024, 128); break;
    case 10: plain(p.in[I_RW1], W_W1, 1024, 64); break;
    case 11: plain(p.in[I_RW1] + 1024 * 64, W_W1 + 64 * 1024 * 2, 1024, 64); break;
    case 12: plain(p.in[I_RA1], W_A1, 1024, 64); break;
    case 13: plain(p.in[I_RA1] + 1024 * 64, W_A1 + 64 * 1024 * 2, 1024, 64); break;
    case 14: plain(p.in[I_RG2], W_G2, 128, 1024); break;
    case 15: plain(p.in[I_RW2], W_W2, 64, 1024); break;
    case 16: plain(p.in[I_RW2] + 64 * 1024, W_W2 + 1024 * 64 * 2, 64, 1024); break;
    case 17: plain(p.in[I_RA2], W_A2, 64, 1024); break;
    case 18: plain(p.in[I_RA2] + 64 * 1024, W_A2 + 1024 * 64 * 2, 64, 1024); break;
    case 19: plain(p.in[I_MSG], W_SGU, 1024, 256); J.dseg = 32; J.dstride = 64; J.doff = 0; break;
    case 20: plain(p.in[I_MSU], W_SGU, 1024, 256); J.dseg = 32; J.dstride = 64; J.doff = 32; break;
    case 21: plain(p.in[I_MSG] + 1024 * 256, W_SGU + 1048576, 1024, 256); J.dseg = 32; J.dstride = 64; J.doff = 0; break;
    case 22: plain(p.in[I_MSU] + 1024 * 256, W_SGU + 1048576, 1024, 256); J.dseg = 32; J.dstride = 64; J.doff = 32; break;
    case 23: plain(p.in[I_MSD], W_SD, 256, 1024); J.ktiled = 1; break;
    case 24: plain(p.in[I_MSD] + 256 * 1024, W_SD + 524288, 256, 1024); J.ktiled = 1; break;
    case 25: plain(p.in[I_MWG] + (size_t)layer * 64 * 1024 * 256, OFF_WGU, 1024, 256); J.dseg = 32; J.dstride = 64; J.doff = 0; J.nmat = 64; J.smat = 1024 * 256; J.dmat = 512 * 1024; break;
    case 26: plain(p.in[I_MWU] + (size_t)layer * 64 * 1024 * 256, OFF_WGU, 1024, 256); J.dseg = 32; J.dstride = 64; J.doff = 32; J.nmat = 64; J.smat = 1024 * 256; J.dmat = 512 * 1024; break;
    default: plain(p.in[I_MWD] + (size_t)layer * 64 * 256 * 1024, OFF_WD, 256, 1024); J.nmat = 64; J.smat = 256 * 1024; J.dmat = 1024 * 256; J.ktiled = 1; break;
    }
}
DEVI int job_tiles(const CJob& J) { return J.nmat * (J.nlog / 64) * ((J.K + 127) / 128); }
DEVI void conv_tile(const CJob& J, int t, char* lds) {
    const int ktiles = (J.K + 127) / 128, ntiles = J.nlog / 64;
    const int mat = t / (ktiles * ntiles); const int r = t - mat * ktiles * ntiles; const int nt = r / ktiles, ktile = r - nt * ktiles;
    const float* src = J.src + (size_t)mat * J.smat; u16* dst = J.dst + (size_t)mat * J.dmat;
    unsigned* sm = (unsigned*)lds;
    const int tid = tidx(), ng = tid & 15, kp = tid >> 4;
    const int n0 = nt * 64 + ng * 4;
    const int scol = (n0 / J.sseg) * J.sstride + J.soff + (n0 % J.sseg);
    const bool nval = n0 < J.nvalid;
#pragma unroll
    for (int pass = 0; pass < 2; ++pass) {
        const int k = ktile * 128 + pass * 64 + kp * 2;
        float4 v0 = make_float4(0.f, 0.f, 0.f, 0.f), v1 = v0;
        if (nval && k < J.K) {
            v0 = *(const float4*)(src + (size_t)k * J.ldsrc + scol); v1 = *(const float4*)(src + (size_t)(k + 1) * J.ldsrc + scol);
            if (J.gain) { const float g0 = J.gain[k], g1 = J.gain[k + 1]; v0.x *= g0; v0.y *= g0; v0.z *= g0; v0.w *= g0; v1.x *= g1; v1.y *= g1; v1.z *= g1; v1.w *= g1; }
        }
        const int kk = pass * 32 + kp;
        sm[(ng * 4 + 0) * 66 + kk] = pack2(v0.x, v1.x); sm[(ng * 4 + 1) * 66 + kk] = pack2(v0.y, v1.y);
        sm[(ng * 4 + 2) * 66 + kk] = pack2(v0.z, v1.z); sm[(ng * 4 + 3) * 66 + kk] = pack2(v0.w, v1.w);
    }
    __syncthreads();
#pragma unroll
    for (int i = 0; i < 2; ++i) {
        const int c = tid + 512 * i, row = c >> 4, ch = c & 15;
        const int n = nt * 64 + row; const int drow = (n / J.dseg) * J.dstride + J.doff + (n % J.dseg);
        const int k = ktile * 128 + ch * 8;
        if (k < J.K) { uint2 lo = *(const uint2*)(sm + row * 66 + ch * 4), hi = *(const uint2*)(sm + row * 66 + ch * 4 + 2); uint4 v = make_uint4(lo.x, lo.y, hi.x, hi.y);
            u16* dp = J.ktiled ? dst + ((size_t)(k >> 6) * J.nlog + drow) * 64 + (k & 63) : dst + (size_t)drow * J.K + k; *(uint4*)dp = v; }
    }
    __syncthreads();
}
DEVI void conv_jobs(const Params& p, int jlo, int jhi, int layer, int unit_base, char* lds) {
    const int G = gridDim.x, bid = blockIdx.x;
    int acc = unit_base;
    for (int j = jlo; j < jhi; ++j) {
        CJob J; get_job(p, j, layer, J); const int n = job_tiles(J);
        const int t0 = (bid - (acc % G) + G) % G;
        for (int t = t0; t < n; t += G) conv_tile(J, t, lds);
        acc += n;
    }
}
DEVI void mods_unit(const Params& p, int u, char* lds) {
    const int l = u / 96, cg = u % 96;
    float* sil = (float*)lds;
    float* red = sil + 1024 * 12;
    const int tid = tidx(), lane = tid & 63, w = tid >> 6;
    for (int i = tid; i < 9 * 1024; i += 512) { const int bb = i >> 10, k = i & 1023; const float v = bb < 8 ? p.in[I_C][bb * 1024 + k] : p.in[I_CCTX][k]; sil[k * 12 + bb] = siluf_(v); }
    __syncthreads();
    float acc[9];
#pragma unroll
    for (int i = 0; i < 9; ++i) acc[i] = 0.f;
    const float* wp = p.in[I_ADAW] + (size_t)l * 1024 * 6144 + cg * 64 + lane;
#pragma unroll 4
    for (int kk = 0; kk < 128; ++kk) {
        const int k = w * 128 + kk; const float wv = wp[(size_t)k * 6144];
        const float4 s0 = *(const float4*)(sil + k * 12), s1 = *(const float4*)(sil + k * 12 + 4); const float s2 = sil[k * 12 + 8];
        acc[0] += s0.x * wv; acc[1] += s0.y * wv; acc[2] += s0.z * wv; acc[3] += s0.w * wv; acc[4] += s1.x * wv; acc[5] += s1.y * wv; acc[6] += s1.z * wv; acc[7] += s1.w * wv; acc[8] += s2 * wv;
    }
#pragma unroll
    for (int i = 0; i < 9; ++i) red[(w * 9 + i) * 64 + lane] = acc[i];
    __syncthreads();
    for (int i = tid; i < 9 * 64; i += 512) {
        const int bb = i >> 6, c = i & 63; float s = 0.f;
        for (int ww = 0; ww < 8; ++ww) s += red[(ww * 9 + bb) * 64 + c];
        const int col = cg * 64 + c;
        ((float*)(p.ws + OFF_MODS))[(size_t)(l * 9 + bb) * 6144 + col] = s + p.in[I_ADAB][l * 6144 + col];
    }
    __syncthreads();
}
DEVI void phase_prologue(const Params& p, char* lds) {
    const int bid = blockIdx.x, G = gridDim.x;
    if (bid == G - 1) {
        int* cnt = (int*)(p.ws + OFF_CNT);
        for (int i = tidx(); i < 2 * NCHUNK * 64; i += 512) cnt[i] = 0;
        float2* tab = (float2*)(p.ws + OFF_ROPE);
        for (int i = tidx(); i < 64 * 16; i += 512) { const int coord = i >> 4, f = i & 15; const float inv = exp2f(-(float)f * (13.287712379549449f / 16.f)); const float a = (float)coord * inv; tab[i] = make_float2(cosf(a), sinf(a)); }
    }
    {
        u16* wro = (u16*)(p.ws + OFF_WROUT);
        for (int i = bid * 512 + tidx(); i < 2 * 1024 * 64; i += G * 512) {
            const int l = i >> 16, k = (i >> 6) & 1023, e = i & 63;
            const float wv = p.in[I_MROUT][i]; const u16 hi = (u16)pack2(wv, 0.f); const u16 lo = (u16)pack2(wv - bf1(hi), 0.f);
            u16* row = wro + ((size_t)l * 64 + e) * 3072; row[k] = hi; row[1024 + k] = hi; row[2048 + k] = lo;
        }
    }
    for (int u = bid; u < 192; u += G) mods_unit(p, u, lds);
    conv_jobs(p, 0, 25, 0, 192, lds);
}

DEVI void norm_rows(const RowSrc& src, int mode, int nrows, const float* __restrict__ gain, const float* __restrict__ mods_l, int ishift, int iscale, u16* __restrict__ dst) {
    const int lane = tidx() & 63, w = tidx() >> 6;
    for (int r = blockIdx.x * 8 + w; r < nrows; r += gridDim.x * 8) {
        int bb; const float* xr = row_ptr(src, mode, r, bb);
        float4 v[4]; float ss = 0.f;
#pragma unroll
        for (int i = 0; i < 4; ++i) { v[i] = ((const float4*)xr)[lane + 64 * i]; ss += v[i].x * v[i].x + v[i].y * v[i].y + v[i].z * v[i].z + v[i].w * v[i].w; }
        ss = wave_sum(ss);
        const float rs = rsqrtf(ss * (1.f / 1024.f) + 1e-6f);
        const float* msh = mods_l + (size_t)bb * 6144 + ishift * 1024; const float* msc = mods_l + (size_t)bb * 6144 + iscale * 1024;
#pragma unroll
        for (int i = 0; i < 4; ++i) {
            const int c = (lane + 64 * i) * 4;
            const float4 g = *(const float4*)(gain + c), sh = *(const float4*)(msh + c), sc = *(const float4*)(msc + c);
            uint2 o; o.x = pack2(v[i].x * rs * g.x * (1.f + sc.x) + sh.x, v[i].y * rs * g.y * (1.f + sc.y) + sh.y);
            o.y = pack2(v[i].z * rs * g.z * (1.f + sc.z) + sh.z, v[i].w * rs * g.w * (1.f + sc.w) + sh.w);
            *(uint2*)(dst + (size_t)r * DM + c) = o;
        }
    }
}

DEVI void phase_gemm_win(const Params& p, char* lds) {
    const u16* A = (const u16*)(p.ws + A_N0); const u16* W = (const u16*)(p.ws + W_IN);
    u16* CQ = (u16*)(p.ws + A_CQ); u16* CKV = (u16*)(p.ws + A_CKV); u16* KA = (u16*)(p.ws + A_KA); u16* QS = (u16*)(p.ws + A_QS); u16* KS = (u16*)(p.ws + A_KS); u16* VS = (u16*)(p.ws + A_VS);
    const float2* tab = (const float2*)(p.ws + OFF_ROPE);
    const int NT = 12, MT = T0 / 256;
    GemmRegs<4, 2> R; bool primed = false;
    for (int uu = blockIdx.x; uu < ((NT * MT + 255) & ~255); uu += gridDim.x) {
        const int u = swz(uu); if (u >= NT * MT) continue;
        const int mt = u / NT, nt = u % NT; const int m0 = mt * 256, n0 = nt * 128;
        const int un = (uu + (int)gridDim.x < ((NT * MT + 255) & ~255)) ? swz(uu + gridDim.x) : NT * MT; const bool hasn = un < NT * MT;
        const int m0n = (un / NT) * 256, n0n = (un % NT) * 128;
        auto arow = [&](int r) { return A + (size_t)(m0 + r) * DM; };
        auto arow_n = [&](int r) { return A + (size_t)(m0n + r) * DM; };
        auto xf = [&](int r, int cw, f32x16 (&t)[2], int h) {
            const int row = m0 + r; const int b = row / LT, pp = row - b * LT;
#pragma unroll
            for (int ni = 0; ni < 2; ++ni) {
                const int c32 = n0 + cw + ni * 32;
                if (c32 >= 640 && c32 < 1344) {
                    const int cc = c32 - 640; rope_tile(t[ni], (cc >> 5) & 1, pp, h, tab);
                    if (c32 >= 704 && c32 < 1216) {
#pragma unroll
                        for (int i = 0; i < 16; ++i) t[ni][i] *= QS_SCALE;
                    }
                }
            }
        };
        auto st = [&](int r, int c8, u32x4 v) {
            const int row = m0 + r; const int b = row / LT, pp = row - b * LT; const int c = n0 + c8;
            if (c < 384) *(u32x4*)(CQ + (size_t)row * 384 + c) = v;
            else if (c < 640) *(u32x4*)(CKV + (size_t)row * 256 + (c - 384)) = v;
            else if (c < 704) { for (int hd = 0; hd < 4; ++hd) *(u32x4*)(KA + ((size_t)(b * 4 + hd) * LT + pp) * 192 + 128 + (c - 640)) = v; }
            else if (c < 1216) { const int cc = c - 704; *(u32x4*)(QS + ((size_t)(b * 8 + (cc >> 6)) * LT + pp) * 64 + (cc & 63)) = v; }
            else if (c < 1344) { const int cc = c - 1216; *(u32x4*)(KS + ((size_t)(b * 2 + (cc >> 6)) * LT + pp) * 64 + (cc & 63)) = v; }
            else if (c < 1472) { const int cc = c - 1344; *(u32x4*)(VS + ((size_t)(b * 2 + (cc >> 6)) * LT + pp) * 64 + (cc & 63)) = v; }
        };
        gemm_tile<256, 128, false>(R, primed, arow, W + (size_t)n0 * DM, arow_n, hasn ? W + (size_t)n0n * DM : nullptr, DM, DM, xf, st, lds); primed = hasn;
    }
}
DEVI void phase_gemm_qkv(const Params& p, char* lds) {
    const u16* CQ = (const u16*)(p.ws + A_CQ); const u16* CKV = (const u16*)(p.ws + A_CKV);
    u16* QA = (u16*)(p.ws + A_QA); u16* KA = (u16*)(p.ws + A_KA); u16* VA = (u16*)(p.ws + A_VA);
    const float2* tab = (const float2*)(p.ws + OFF_ROPE);
    const int MT = T0 / 256;
    for (int uu = blockIdx.x; uu < ((14 * MT + 255) & ~255); uu += gridDim.x) {
        const int u = swz(uu); if (u >= 14 * MT) continue;
        const int mt = u / 14, j = u % 14; const int m0 = mt * 256;
        if (j < 6) {
            const int n0 = j * 128;
            auto arow = [&](int r) { return CQ + (size_t)(m0 + r) * 384; };
            auto xf = [&](int r, int cw, f32x16 (&t)[2], int h) {
                const int row = m0 + r; const int pp = row % LT;
#pragma unroll
                for (int ni = 0; ni < 2; ++ni) {
                    const int c32 = n0 + cw + ni * 32; const int wi = c32 % 192;
                    if (wi >= 128) rope_tile(t[ni], (wi - 128) >> 5, pp, h, tab);
#pragma unroll
                    for (int i = 0; i < 16; ++i) t[ni][i] *= QA_SCALE;
                }
            };
            auto st = [&](int r, int c8, u32x4 v) {
                const int row = m0 + r; const int b = row / LT, pp = row - b * LT; const int c = n0 + c8; const int hd = c / 192, wi = c - hd * 192;
                *(u32x4*)(QA + ((size_t)(b * 4 + hd) * LT + pp) * 192 + wi) = v;
            };
            GemmRegs<4, 2> R; gemm_tile<256, 128, true>(R, false, arow, (const u16*)(p.ws + W_UQ) + (size_t)n0 * 384, arow, (const u16*)nullptr, 384, 384, xf, st, lds);
        } else {
            const bool isv = j >= 10; const int n0 = (isv ? j - 10 : j - 6) * 128;
            auto arow = [&](int r) { return CKV + (size_t)(m0 + r) * 256; };
            auto xf = [&](int, int, f32x16 (&)[2], int) {};
            auto st = [&](int r, int c8, u32x4 v) {
                const int row = m0 + r; const int b = row / LT, pp = row - b * LT; const int c = n0 + c8; const int hd = c >> 7, wi = c & 127;
                if (isv) *(u32x4*)(VA + ((size_t)(b * 4 + hd) * LT + pp) * 128 + wi) = v;
                else *(u32x4*)(KA + ((size_t)(b * 4 + hd) * LT + pp) * 192 + wi) = v;
            };
            GemmRegs<4, 2> R; gemm_tile<256, 128, true>(R, false, arow, (const u16*)(p.ws + (isv ? W_UV : W_UK)) + (size_t)n0 * 256, arow, (const u16*)nullptr, 256, 256, xf, st, lds);
        }
    }
}

template <int DQK, int DV, bool SWA>
DEVI void attn_unit(const u16* __restrict__ Q, const u16* __restrict__ Kp, const u16* __restrict__ Vp, int q0, int a0, int na, int b0, int nb2,
                    float m_init, u16* __restrict__ outp  , char* lds) {
    constexpr int KSTR = DQK + 8, VSTR = DV + 32, KCH = DQK / 8, VCH = DV / 8, NKC = 64 * KCH / 512, NVC = 64 * VCH / 512, NS = DQK / 16, NDT = DV / 32;
    const int tid = tidx(), lane = tid & 63, w = tid >> 6, l31 = lane & 31, h = lane >> 5;
    u16* sK = (u16*)lds; u16* sV = sK + 2 * 64 * KSTR;
    const int qpos = q0 + w * 32 + l31;
    bf16x8 qf[NS];
#pragma unroll
    for (int s = 0; s < NS; ++s) qf[s] = *(const bf16x8*)(Q + (size_t)qpos * DQK + s * 16 + h * 8);
    f32x16 o[NDT];
#pragma unroll
    for (int d = 0; d < NDT; ++d)
#pragma unroll
        for (int i = 0; i < 16; ++i) o[d][i] = 0.f;
    float m = m_init, lsum = 0.f;
    const int nt = na + nb2;
    u32x4 rk[NKC], rv[NVC];
    auto tile_pos = [&](int t) { return t < na ? a0 + 64 * t : b0 + 64 * (t - na); };
    auto gload = [&](int t) {
        const int kp0 = tile_pos(t);
        const u16* kb_ = Kp + (size_t)kp0 * DQK + tid * 8; const u16* vb_ = Vp + (size_t)kp0 * DV + tid * 8;
#pragma unroll
        for (int i = 0; i < NKC; ++i) rk[i] = *(const u32x4*)(kb_ + 4096 * i);
#pragma unroll
        for (int i = 0; i < NVC; ++i) rv[i] = *(const u32x4*)(vb_ + 4096 * i);
    };
    gload(0);
    const int tr_row = 4 * h + ((lane & 15) >> 2), tr_col = 16 * ((lane >> 4) & 1) + 4 * (lane & 3);
    for (int t = 0; t < nt; ++t) {
        u16* k_ = sK + (t & 1) * 64 * KSTR; u16* v_ = sV + (t & 1) * 64 * VSTR;
#pragma unroll
        for (int i = 0; i < NKC; ++i) { const int c = tid + 512 * i, row = c / KCH, ch = c % KCH; *(u32x4*)(k_ + row * KSTR + ch * 8) = rk[i]; }
#pragma unroll
        for (int i = 0; i < NVC; ++i) { const int c = tid + 512 * i, row = c / VCH, ch = c % VCH; *(u32x4*)(v_ + row * VSTR + ch * 8) = rv[i]; }
        __syncthreads();
        if (t + 1 < nt) gload(t + 1);
        f32x16 st[2];
#pragma unroll
        for (int k2 = 0; k2 < 2; ++k2) {
#pragma unroll
            for (int i = 0; i < 16; ++i) st[k2][i] = 0.f;
#pragma unroll
            for (int s = 0; s < NS; ++s) {
                const bf16x8 kf = *(const bf16x8*)(k_ + (k2 * 32 + l31) * KSTR + s * 16 + h * 8);
                st[k2] = __builtin_amdgcn_mfma_f32_32x32x16_bf16(kf, qf[s], st[k2], 0, 0, 0);
            }
        }
        __builtin_amdgcn_sched_barrier(0);
        if (SWA && t >= na) {
            const int kp0 = tile_pos(t);
#pragma unroll
            for (int k2 = 0; k2 < 2; ++k2)
#pragma unroll
                for (int i = 0; i < 16; ++i) {
                    const int key = kp0 + k2 * 32 + (i & 3) + 8 * (i >> 2) + 4 * h; const int d = qpos - key;
                    if (d > 128 || d < -128) st[k2][i] = -1e30f;
                }
        }
        float mx = st[0][0];
#pragma unroll
        for (int k2 = 0; k2 < 2; ++k2)
#pragma unroll
            for (int i = 0; i < 16; ++i) mx = fmaxf(mx, st[k2][i]);
        mx = fmaxf(mx, xhalf(mx));
        const float mn = fmaxf(m, mx); const float alpha = __builtin_amdgcn_exp2f(m - mn); m = mn;
        float ps = 0.f;
#pragma unroll
        for (int k2 = 0; k2 < 2; ++k2)
#pragma unroll
            for (int i = 0; i < 16; ++i) { const float pv = __builtin_amdgcn_exp2f(st[k2][i] - mn); st[k2][i] = pv; ps += pv; }
        lsum = lsum * alpha + ps;
#pragma unroll
        for (int d = 0; d < NDT; ++d)
#pragma unroll
            for (int i = 0; i < 16; ++i) o[d][i] *= alpha;
#pragma unroll
        for (int s16 = 0; s16 < 4; ++s16) {
            __builtin_amdgcn_sched_barrier(0);
            bf16x8 pf; unsigned* pu = (unsigned*)&pf;
#pragma unroll
            for (int jj = 0; jj < 4; ++jj) pu[jj] = pack2(st[s16 >> 1][8 * (s16 & 1) + 2 * jj], st[s16 >> 1][8 * (s16 & 1) + 2 * jj + 1]);
#pragma unroll
            for (int d = 0; d < NDT; ++d) {
                const u16* base = v_ + (16 * s16 + tr_row) * VSTR + d * 32 + tr_col;
                const s16x4 lo = __builtin_amdgcn_ds_read_tr16_b64_v4i16((LAS s16x4*)(base));
                const s16x4 hi = __builtin_amdgcn_ds_read_tr16_b64_v4i16((LAS s16x4*)(base + 8 * VSTR));
                bf16x8 vf; vf[0] = lo[0]; vf[1] = lo[1]; vf[2] = lo[2]; vf[3] = lo[3]; vf[4] = hi[0]; vf[5] = hi[1]; vf[6] = hi[2]; vf[7] = hi[3];
                o[d] = __builtin_amdgcn_mfma_f32_32x32x16_bf16(vf, pf, o[d], 0, 0, 0);
            }
        }
    }
    float lt = lsum + xhalf(lsum);
    if (SWA) lt += __builtin_amdgcn_exp2f(m_init - m);
    const float inv = 1.f / lt;
    u16* orow = outp + (size_t)qpos * DM;
#pragma unroll
    for (int d = 0; d < NDT; ++d)
#pragma unroll
        for (int g = 0; g < 4; ++g) { uint2 v; v.x = pack2(o[d][4 * g] * inv, o[d][4 * g + 1] * inv); v.y = pack2(o[d][4 * g + 2] * inv, o[d][4 * g + 3] * inv); *(uint2*)(orow + d * 32 + 8 * g + 4 * h) = v; }
    __syncthreads();
}
DEVI void phase_attention(const Params& p, char* lds) {
    const u16* QA = (const u16*)(p.ws + A_QA); const u16* KA = (const u16*)(p.ws + A_KA); const u16* VA = (const u16*)(p.ws + A_VA);
    const u16* QS = (const u16*)(p.ws + A_QS); const u16* KS = (const u16*)(p.ws + A_KS); const u16* VS = (const u16*)(p.ws + A_VS);
    u16* mix = (u16*)(p.ws + A_N0);
    for (int uu = blockIdx.x; uu < 1792; uu += gridDim.x) {
        const int u = swz(uu); if (u >= 1632) continue;
        if (u < 544) {
            int b, hd, q0, na;
            if (u < 512) { b = u >> 6; hd = (u >> 4) & 3; q0 = LC + (u & 15) * 256; na = 68; }
            else { const int v = u - 512; b = v >> 2; hd = v & 3; q0 = 0; na = 4; }
            const size_t bh = (size_t)(b * 4 + hd) * LT;
            attn_unit<192, 128, false>(QA + bh * 192, KA + bh * 192, VA + bh * 128, q0, 0, na, 0, 0, -1e30f, mix + (size_t)b * LT * DM + hd * 128, lds);
        } else {
            int b, hd, q0, b0 = 0, nb2 = 0;
            if (u < 1568) { const int v = u - 544; b = v >> 7; hd = (v >> 4) & 7; const int s0 = (v & 15) * 256; q0 = LC + s0;
                int lo = s0 - 128; if (lo < 0) lo = 0; int hi = s0 + 256 + 128; if (hi > SEQ) hi = SEQ; b0 = LC + lo; nb2 = (hi - lo) >> 6; }
            else { const int v = u - 1568; b = v >> 3; hd = v & 7; q0 = 0; }
            const int kvh = hd >> 2; const size_t qb = (size_t)(b * 8 + hd) * LT, kb = (size_t)(b * 2 + kvh) * LT;
            attn_unit<64, 64, true>(QS + qb * 64, KS + kb * 64, VS + kb * 64, q0, 0, 4, b0, nb2, p.in[I_ASINK][hd] * LOG2E, mix + (size_t)b * LT * DM + 512 + hd * 64, lds);
        }
    }
}
DEVI void phase_gemm_wo(const Params& p, const u16* A, const u16* W, const RowSrc& resid, int mode, int layer, char* lds) {
    float* XC = (float*)(p.ws + OFF_XC); float* XL = p.out;
    const float* mods_l = (const float*)(p.ws + OFF_MODS) + (size_t)layer * 9 * 6144;
    const int MT = (mode == 0 ? T0 : TL) / 256;
    GemmRegs<4, 2> R; bool primed = false;
    for (int uu = blockIdx.x; uu < ((8 * MT + 255) & ~255); uu += gridDim.x) {
        const int u = swz(uu); if (u >= 8 * MT) continue;
        const int mt = u >> 3, nt = u & 7; const int m0 = mt * 256, n0 = nt * 128;
        const int un = (uu + (int)gridDim.x < ((8 * MT + 255) & ~255)) ? swz(uu + gridDim.x) : 8 * MT; const bool hasn = un < 8 * MT;
        const int m0n = (un >> 3) * 256, n0n = (un & 7) * 128;
        auto arow = [&](int r) { return A + (size_t)(m0 + r) * DM; };
        auto arow_n = [&](int r) { return A + (size_t)(m0n + r) * DM; };
        auto xf = [&](int, int, f32x16 (&)[2], int) {};
        auto st = [&](int r, int c8, u32x4 v) {
            int bb; const float* rs = row_ptr(resid, mode, m0 + r, bb); int bb2; float* xo = row_ptr_w(XC, XL, mode, m0 + r, bb2);
            const float* mg = mods_l + (size_t)bb * 6144 + 2 * 1024; const int c = n0 + c8;
            const float4 r0 = *(const float4*)(rs + c), r1 = *(const float4*)(rs + c + 4), g0 = *(const float4*)(mg + c), g1 = *(const float4*)(mg + c + 4);
            float4 o0, o1;
            o0.x = r0.x + g0.x * bf_lo(v[0]); o0.y = r0.y + g0.y * bf_hi(v[0]); o0.z = r0.z + g0.z * bf_lo(v[1]); o0.w = r0.w + g0.w * bf_hi(v[1]);
            o1.x = r1.x + g1.x * bf_lo(v[2]); o1.y = r1.y + g1.y * bf_hi(v[2]); o1.z = r1.z + g1.z * bf_lo(v[3]); o1.w = r1.w + g1.w * bf_hi(v[3]);
            *(float4*)(xo + c) = o0; *(float4*)(xo + c + 4) = o1;
        };
        gemm_tile<256, 128, false>(R, primed, arow, W + (size_t)n0 * DM, arow_n, hasn ? W + (size_t)n0n * DM : nullptr, DM, DM, xf, st, lds); primed = hasn;
    }
}

DEVI void phase_moe_norm(const Params& p, int layer) {
    const int mode = layer == 0 ? 0 : 1; const int ntok = layer == 0 ? T0 : TL;
    RowSrc src; src.ctx = (const float*)(p.ws + OFF_XC); src.lat = p.out;
    const float* gain = p.in[I_NFFN] + layer * 1024; const float* mods_l = (const float*)(p.ws + OFF_MODS) + (size_t)layer * 9 * 6144;
    u16* n1 = (u16*)(p.ws + M_N1); u16* nlo = (u16*)(p.ws + M_ACT);
    const int lane = tidx() & 63, w = tidx() >> 6;
    for (int r = blockIdx.x * 8 + w; r < ntok; r += gridDim.x * 8) {
        int bb; const float* xr = row_ptr(src, mode, r, bb);
        float4 v[4]; float ss = 0.f;
#pragma unroll
        for (int i = 0; i < 4; ++i) { v[i] = ((const float4*)xr)[lane + 64 * i]; ss += v[i].x * v[i].x + v[i].y * v[i].y + v[i].z * v[i].z + v[i].w * v[i].w; }
        ss = wave_sum(ss);
        const float rs = rsqrtf(ss * (1.f / 1024.f) + 1e-6f);
        const float* msh = mods_l + (size_t)bb * 6144 + 3 * 1024; const float* msc = mods_l + (size_t)bb * 6144 + 4 * 1024;
#pragma unroll
        for (int i = 0; i < 4; ++i) {
            const int c = (lane + 64 * i) * 4;
            const float4 g = *(const float4*)(gain + c), sh = *(const float4*)(msh + c), sc = *(const float4*)(msc + c);
            const float y0 = v[i].x * rs * g.x * (1.f + sc.x) + sh.x, y1 = v[i].y * rs * g.y * (1.f + sc.y) + sh.y, y2 = v[i].z * rs * g.z * (1.f + sc.z) + sh.z, y3 = v[i].w * rs * g.w * (1.f + sc.w) + sh.w;
            uint2 o; o.x = pack2(y0, y1); o.y = pack2(y2, y3);
            *(uint2*)(n1 + (size_t)r * DM + c) = o;
            uint2 ol; ol.x = pack2(y0 - bf_lo(o.x), y1 - bf_hi(o.x)); ol.y = pack2(y2 - bf_lo(o.y), y3 - bf_hi(o.y));
            *(uint2*)(nlo + (size_t)r * DM + c) = ol;
        }
    }
}
DEVI void router_tile(const u16* __restrict__ H, const u16* __restrict__ L, const u16* __restrict__ Wt, int m0, char* lds) {
    constexpr int BM = 256, BN = 128, WN = 2, NA = 4, NBC = 2, STR = 72;
    const int tid = tidx(), lane = tid & 63, w = tid >> 6, wm = w / WN, wn = w % WN, l31 = lane & 31, h = lane >> 5;
    u16* sA = (u16*)lds; u16* sB = sA + 2 * BM * STR;
    const int crow = tid >> 3, kc = tid & 7;
    const u16* ph[NA]; const u16* pl[NA]; const u16* pb[NBC];
#pragma unroll
    for (int i = 0; i < NA; ++i) { ph[i] = H + (size_t)(m0 + crow + 64 * i) * DM + kc * 8; pl[i] = L + (size_t)(m0 + crow + 64 * i) * DM + kc * 8; }
#pragma unroll
    for (int i = 0; i < NBC; ++i) pb[i] = Wt + (size_t)((crow + 64 * i) & 63) * 3072 + kc * 8;
    u32x4 ra[NA], rb[NBC];
    auto gload = [&](int kt) {
        const int seg = kt >> 4, kk = (kt & 15) * 64;
#pragma unroll
        for (int i = 0; i < NA; ++i) ra[i] = *(const u32x4*)((seg == 1 ? pl[i] : ph[i]) + kk);
#pragma unroll
        for (int i = 0; i < NBC; ++i) rb[i] = *(const u32x4*)(pb[i] + kt * 64);
    };
    gload(0);
    f32x16 acc[2][2];
#pragma unroll
    for (int a = 0; a < 2; ++a)
#pragma unroll
        for (int b = 0; b < 2; ++b)
#pragma unroll
            for (int i = 0; i < 16; ++i) acc[a][b][i] = 0.f;
    for (int kt = 0; kt < 48; ++kt) {
        u16* a_ = sA + (kt & 1) * BM * STR; u16* b_ = sB + (kt & 1) * BN * STR;
#pragma unroll
        for (int i = 0; i < NA; ++i) *(u32x4*)(a_ + (crow + 64 * i) * STR + kc * 8) = ra[i];
#pragma unroll
        for (int i = 0; i < NBC; ++i) *(u32x4*)(b_ + (crow + 64 * i) * STR + kc * 8) = rb[i];
        lds_barrier();
        gload(kt + 1 < 48 ? kt + 1 : 47);
#pragma unroll
        for (int ks = 0; ks < 4; ++ks) {
            bf16x8 af[2], bfr[2];
#pragma unroll
            for (int mi = 0; mi < 2; ++mi) af[mi] = *(const bf16x8*)(a_ + (wm * 64 + mi * 32 + l31) * STR + ks * 16 + h * 8);
#pragma unroll
            for (int ni = 0; ni < 2; ++ni) bfr[ni] = *(const bf16x8*)(b_ + (wn * 64 + ni * 32 + l31) * STR + ks * 16 + h * 8);
#pragma unroll
            for (int mi = 0; mi < 2; ++mi)
#pragma unroll
                for (int ni = 0; ni < 2; ++ni) acc[mi][ni] = __builtin_amdgcn_mfma_f32_32x32x16_bf16(bfr[ni], af[mi], acc[mi][ni], 0, 0, 0);
        }
    }
    lds_barrier();
    float* LG = (float*)lds;
    if (wn == 0) {
#pragma unroll
        for (int mi = 0; mi < 2; ++mi)
#pragma unroll
            for (int ni = 0; ni < 2; ++ni)
#pragma unroll
                for (int g = 0; g < 4; ++g)
                    *(float4*)(LG + (wm * 64 + mi * 32 + l31) * 64 + ni * 32 + 8 * g + 4 * h) = make_float4(acc[mi][ni][4 * g], acc[mi][ni][4 * g + 1], acc[mi][ni][4 * g + 2], acc[mi][ni][4 * g + 3]);
    }
    lds_barrier();
}
DEVI void phase_moe_route(const Params& p, int layer, char* lds) {
    const int ntok = layer == 0 ? T0 : TL; const int tc = ntok / NCHUNK;
    const float ebias = p.in[I_MBIAS][layer * 64 + (tidx() & 63)];
    int* cnt = (int*)(p.ws + OFF_CNT) + layer * NCHUNK * 64;
    int* tok_e = (int*)(p.ws + OFF_TOKE); int* tok_r = (int*)(p.ws + OFF_TOKR); int* ltok = (int*)(p.ws + OFF_LTOK); float* lg = (float*)(p.ws + OFF_LG);
    const u16* H = (const u16*)(p.ws + M_N1); const u16* L = (const u16*)(p.ws + M_ACT); const u16* Wt = (const u16*)(p.ws + OFF_WROUT) + (size_t)layer * 64 * 3072;
    const int lane = tidx() & 63, w = tidx() >> 6;
    const float* LG = (const float*)lds;
    for (int u = blockIdx.x; u < ntok / 256; u += gridDim.x) {
        router_tile(H, L, Wt, u * 256, lds);
        for (int j = 0; j < 32; ++j) {
            const int rl = w * 32 + j; const int tok = u * 256 + rl;
            const float lgt = LG[rl * 64 + lane];
            const float score = 1.f / (1.f + expf(-lgt)); const float choice = score + ebias;
            const float m1 = red8_max(choice);
            const unsigned long long bm = __ballot(choice == m1);
            const unsigned gm = (unsigned)(bm >> (lane & 56)) & 0xffu; const int first = __ffs(gm) - 1;
            const float m2 = red8_max(((lane & 7) == first) ? -INFINITY : choice);
            const float gs = m1 + m2;
            int rank = 0;
#pragma unroll
            for (int g2 = 0; g2 < 8; ++g2) { const float og = __shfl(gs, g2 * 8); rank += (og > gs || (og == gs && g2 < (lane >> 3))) ? 1 : 0; }
            float cm = rank < 4 ? choice : -INFINITY;
            unsigned long long sel = 0ull; float ssum = 0.f;
#pragma unroll
            for (int it = 0; it < 6; ++it) {
                const float mxv = wave_max(cm);
                const unsigned long long bmm = __ballot(cm == mxv);
                const int win = __ffsll((long long)bmm) - 1;
                sel |= 1ull << win; ssum += __shfl(score, win);
                if (lane == win) cm = -INFINITY;
            }
            if ((sel >> lane) & 1ull) {
                const int jj = __popcll(sel & ((1ull << lane) - 1ull));
                const int ch = tok / tc; const int rk = atomicAdd(&cnt[ch * 64 + lane], 1);
                tok_e[tok * 6 + jj] = lane; tok_r[tok * 6 + jj] = rk;
                ltok[((size_t)ch * 64 + lane) * tc + rk] = tok; lg[((size_t)ch * 64 + lane) * tc + rk] = 2.5f * score / ssum;
            }
        }
        lds_barrier();
    }
}
struct SegTab { int* cnt; int* off; int* tpre; };
DEVI SegTab build_segtab(const Params& p, int layer, int tc, char* lds_tab) {
    SegTab T; T.cnt = (int*)lds_tab; T.off = T.cnt + 264; T.tpre = T.off + 264;
    const int* cnt = (const int*)(p.ws + OFF_CNT) + layer * NCHUNK * 64;
    const int tid = tidx();
    if (tid < 260) { const int ch = tid / 65, e = tid % 65; T.cnt[tid] = e < 64 ? cnt[ch * 64 + e] : tc; }
    __syncthreads();
    if (tid < 64) {
        int lc[5], lt_[5]; int sc = 0, st = 0;
#pragma unroll
        for (int j = 0; j < 5; ++j) { const int s = 5 * tid + j; const int v = s < 260 ? T.cnt[s] : 0; lc[j] = sc; lt_[j] = st; sc += v; st += (v + 127) >> 7; }
        int ic = sc, it = st;
        for (int o = 1; o < 64; o <<= 1) { const int a = __shfl_up(ic, o), b2 = __shfl_up(it, o); if (tid >= o) { ic += a; it += b2; } }
        const int bc = ic - sc, bt = it - st;
#pragma unroll
        for (int j = 0; j < 5; ++j) { const int s = 5 * tid + j; if (s <= 260) { T.tpre[s] = bt + lt_[j]; T.off[s] = bc + lc[j]; } }
    }
    __syncthreads();
    return T;
}
DEVI int find_seg(const SegTab& T, int lo_seg, int hi_seg, int mt) {
    int lo = lo_seg, hi = hi_seg;
    while (hi - lo > 1) { const int mid = (lo + hi) >> 1; if (T.tpre[mid] <= mt) lo = mid; else hi = mid; }
    return lo;
}
DEVI void phase_moe_gemm1(const Params& p, int layer, char* lds) {
    const int ntok = layer == 0 ? T0 : TL; const int tc = ntok / NCHUNK;
    char* tabmem = lds + 110592; SegTab T = build_segtab(p, layer, tc, tabmem);
    const u16* n1 = (const u16*)(p.ws + M_N1); u16* act = (u16*)(p.ws + M_ACT);
    const int* ltok = (const int*)(p.ws + OFF_LTOK); const float* lg = (const float*)(p.ws + OFF_LG);
    const int nunits = T.tpre[260] * 2;
    GemmRegs<2, 4> R; bool primed = false;
    for (int uu = blockIdx.x; uu < ((nunits + 255) & ~255); uu += gridDim.x) {
        const int u = swz(uu); if (u >= nunits) continue;
        const int mt = u >> 1, nt = u & 1; const int seg = find_seg(T, 0, 260, mt); const int ch = seg / 65, e = seg % 65;
        const int un = (uu + (int)gridDim.x < ((nunits + 255) & ~255)) ? swz(uu + gridDim.x) : nunits; const bool hasn = un < nunits;
        const int mtn = hasn ? un >> 1 : mt; const int segn = find_seg(T, 0, 260, mtn); const int chn = segn / 65, en = segn % 65;
        const int cntn = T.cnt[segn], row0n = (mtn - T.tpre[segn]) * 128; const int* ltn = ltok + ((size_t)chn * 64 + en) * tc;
        const u16* Wn = en < 64 ? (const u16*)(p.ws + OFF_WGU) + (size_t)en * 512 * 1024 : (const u16*)(p.ws + W_SGU) + (size_t)layer * 512 * 1024;
        auto arow_n = [&](int r) { int s2 = row0n + r; if (s2 >= cntn) s2 = cntn - 1; const int tok = en < 64 ? ltn[s2] : chn * tc + s2; return n1 + (size_t)tok * DM; };
        const int cntv = T.cnt[seg], row0 = (mt - T.tpre[seg]) * 128; const int n0 = nt * 256;
        const int* lt = ltok + ((size_t)ch * 64 + e) * tc; const float* lgp = lg + ((size_t)ch * 64 + e) * tc;
        const u16* W = e < 64 ? (const u16*)(p.ws + OFF_WGU) + (size_t)e * 512 * 1024 : (const u16*)(p.ws + W_SGU) + (size_t)layer * 512 * 1024;
        auto arow = [&](int r) { int s = row0 + r; if (s >= cntv) s = cntv - 1; const int tok = e < 64 ? lt[s] : ch * tc + s; return n1 + (size_t)tok * DM; };
        const size_t arow0 = (size_t)ch * 7 * tc + (T.off[seg] - T.off[ch * 65]) + row0;
        auto xf = [&](int r, int cw, f32x16 (&t)[2], int h) {
            int s2 = row0 + r; if (s2 >= cntv) s2 = cntv - 1;
            const float gw = e < 64 ? lgp[s2] : 1.f;
#pragma unroll
            for (int i = 0; i < 16; ++i) { const float gt = t[0][i], up = t[1][i]; t[0][i] = gt / (1.f + __expf(-gt)) * up * gw; }
        };
        auto st = [&](int r, int c8, u32x4 v) {
            if (row0 + r >= cntv || (c8 & 32)) return;
            const int ac = ((n0 + (c8 & ~63)) >> 1) + (c8 & 31);
            *(u32x4*)(act + ((size_t)(ac >> 6) * (7 * (size_t)ntok) + arow0 + r) * 64 + (ac & 63)) = v;
        };
        gemm_tile<128, 256, false>(R, primed, arow, W + (size_t)n0 * DM, arow_n, hasn ? Wn + (size_t)((un & 1) * 256) * DM : nullptr, DM, DM, xf, st, lds); primed = hasn;
    }
}
DEVI void phase_moe_g2c(const Params& p, int layer, int chg, int chc, char* lds) {
    const int mode = layer == 0 ? 0 : 1; const int ntok = layer == 0 ? T0 : TL; const int tc = ntok / NCHUNK;
    char* tabmem = lds + 110592; SegTab T = build_segtab(p, layer, tc, tabmem);
    const u16* act = (const u16*)(p.ws + M_ACT);
    const int* tok_e = (const int*)(p.ws + OFF_TOKE); const int* tok_r = (const int*)(p.ws + OFF_TOKR);
    float* XC = (float*)(p.ws + OFF_XC); float* XL = p.out;
    const float* mods_l = (const float*)(p.ws + OFF_MODS) + (size_t)layer * 9 * 6144;
    const int lane = tidx() & 63, w = tidx() >> 6;
    int nunits = 0, t_lo = 0;
    if (chg >= 0) { t_lo = T.tpre[chg * 65]; nunits = (T.tpre[chg * 65 + 65] - t_lo) * 4; }
    const int G = gridDim.x; const int nround = (nunits + G - 1) / G;
    const int rho = ((int)blockIdx.x & 7) * (G >> 3) + ((int)blockIdx.x >> 3); const int ubeg = rho * nround;
    int my_units = nunits - ubeg; if (my_units > nround) my_units = nround; if (my_units < 0) my_units = 0;
    const int crounds = chc >= 0 ? (tc + G * 8 - 1) / (G * 8) : 0;
    int cdone = 0;
    auto combine_rounds = [&](int upto) {
        const u16* outr = (const u16*)(p.ws + M_OUTR + (size_t)(chc & 1) * SZ_OUTR);
        for (; cdone < upto; ++cdone) {
            const int tl = (cdone * G + (int)blockIdx.x) * 8 + w; if (tl >= tc) continue;
            const int tok = chc * tc + tl; int bb; float* xr = row_ptr_w(XC, XL, mode, tok, bb);
            const float* mg = mods_l + (size_t)bb * 6144 + 5 * 1024;
            int rows[7];
#pragma unroll
            for (int j = 0; j < 6; ++j) rows[j] = T.off[chc * 65 + tok_e[tok * 6 + j]] - T.off[chc * 65] + tok_r[tok * 6 + j];
            rows[6] = 6 * tc + tl;
            float4 xs[2][2]; float fss = 0.f;
#pragma unroll
            for (int i = 0; i < 2; ++i) {
                const int c = (lane + 64 * i) * 8;
                float acc[8];
#pragma unroll
                for (int q = 0; q < 8; ++q) acc[q] = 0.f;
#pragma unroll
                for (int j = 0; j < 7; ++j) {
                    const uint4 v = *(const uint4*)(outr + (size_t)rows[j] * DM + c);
                    acc[0] += bf_lo(v.x); acc[1] += bf_hi(v.x); acc[2] += bf_lo(v.y); acc[3] += bf_hi(v.y); acc[4] += bf_lo(v.z); acc[5] += bf_hi(v.z); acc[6] += bf_lo(v.w); acc[7] += bf_hi(v.w);
                }
                float4 x0 = *(float4*)(xr + c), x1 = *(float4*)(xr + c + 4); const float4 g0 = *(const float4*)(mg + c), g1 = *(const float4*)(mg + c + 4);
                x0.x += g0.x * acc[0]; x0.y += g0.y * acc[1]; x0.z += g0.z * acc[2]; x0.w += g0.w * acc[3]; x1.x += g1.x * acc[4]; x1.y += g1.y * acc[5]; x1.z += g1.z * acc[6]; x1.w += g1.w * acc[7];
                xs[i][0] = x0; xs[i][1] = x1;
                fss += x0.x * x0.x + x0.y * x0.y + x0.z * x0.z + x0.w * x0.w + x1.x * x1.x + x1.y * x1.y + x1.z * x1.z + x1.w * x1.w;
            }
            if (layer == 1) {
                fss = wave_sum(fss); const float rs = rsqrtf(fss * (1.f / 1024.f) + 1e-6f); const float* gf = p.in[I_NFIN];
#pragma unroll
                for (int i = 0; i < 2; ++i) { const int c = (lane + 64 * i) * 8; const float4 f0 = *(const float4*)(gf + c), f1 = *(const float4*)(gf + c + 4);
                    xs[i][0].x *= rs * f0.x; xs[i][0].y *= rs * f0.y; xs[i][0].z *= rs * f0.z; xs[i][0].w *= rs * f0.w; xs[i][1].x *= rs * f1.x; xs[i][1].y *= rs * f1.y; xs[i][1].z *= rs * f1.z; xs[i][1].w *= rs * f1.w; }
            }
#pragma unroll
            for (int i = 0; i < 2; ++i) { const int c = (lane + 64 * i) * 8; *(float4*)(xr + c) = xs[i][0]; *(float4*)(xr + c + 4) = xs[i][1]; }
        }
    };
    int ui = 0;
    GemmRegs<2, 4> R; bool primed = false;
    for (int u = ubeg; u < ubeg + my_units; ++u) {
        u16* outw = (u16*)(p.ws + M_OUTR + (size_t)(chg & 1) * SZ_OUTR);
        const int mt = t_lo + (u >> 2), nt = u & 3; const int seg = find_seg(T, chg * 65, chg * 65 + 65, mt); const int e = seg % 65;
        const int un = u + 1; const bool hasn = un < ubeg + my_units;
        const int mtn = hasn ? t_lo + (un >> 2) : mt; const int segn = find_seg(T, chg * 65, chg * 65 + 65, mtn); const int en = segn % 65;
        const int cntn = T.cnt[segn], row0n = (mtn - T.tpre[segn]) * 128;
        const u16* An = act + ((size_t)chg * 7 * tc + (size_t)(T.off[segn] - T.off[chg * 65]) + row0n) * 64;
        const u16* Wn = en < 64 ? (const u16*)(p.ws + OFF_WD) + (size_t)en * 1024 * 256 : (const u16*)(p.ws + W_SD) + (size_t)layer * 1024 * 256;
        auto arow_n = [&](int r) { int s2 = row0n + r; if (s2 >= cntn) s2 = cntn - 1; return An + (size_t)(s2 - row0n) * 64; };
        const int cntv = T.cnt[seg], row0 = (mt - T.tpre[seg]) * 128; const int n0 = nt * 256;
        const size_t lrow0 = (size_t)(T.off[seg] - T.off[chg * 65]) + row0;
        const u16* A = act + ((size_t)chg * 7 * tc + lrow0) * 64;
        const u16* W = e < 64 ? (const u16*)(p.ws + OFF_WD) + (size_t)e * 1024 * 256 : (const u16*)(p.ws + W_SD) + (size_t)layer * 1024 * 256;
        auto arow = [&](int r) { int s2 = row0 + r; if (s2 >= cntv) s2 = cntv - 1; return A + (size_t)(s2 - row0) * 64; };
        auto xf = [&](int, int, f32x16 (&)[2], int) {};
        auto st = [&](int r, int c8, u32x4 v) { if (row0 + r < cntv) __builtin_nontemporal_store(v, (u32x4*)(outw + (lrow0 + r) * DM + n0 + c8)); };
        gemm_tile<128, 256, false>(R, primed, arow, W + (size_t)n0 * 64, arow_n, hasn ? Wn + (size_t)((un & 3) * 256) * 64 : nullptr, 64, 256, xf, st, lds, (size_t)7 * ntok * 64, (size_t)1024 * 64); primed = hasn;
        ++ui; combine_rounds((int)(((long)crounds * ui) / my_units));
    }
    combine_rounds(crounds);
}

DEVI void phase_rwkv_mix(const Params& p, int i0, int i1, int i2) {
    const u16* nn = (const u16*)(p.ws + R_NN); u16* xm = (u16*)(p.ws + R_XM0);
    const float* mu = p.in[I_RMU]; const int idx[3] = {i0, i1, i2};
    const int lane = tidx() & 63, w = tidx() >> 6;
    for (int r = blockIdx.x * 8 + w; r < T0; r += gridDim.x * 8) {
        const int b = r / LT, pp = r - b * LT;
        const bool hasprev = (pp != 0) && (pp != LC), hasnext = (pp != LC - 1) && (pp != LT - 1);
#pragma unroll
        for (int half = 0; half < 2; ++half) {
            const int c = half * 512 + lane * 8;
            const uint4 cur = *(const uint4*)(nn + (size_t)r * DM + c);
            uint4 sh = make_uint4(0, 0, 0, 0);
            if (half == 0) { if (hasprev) sh = *(const uint4*)(nn + (size_t)(r - 1) * DM + c); }
            else { if (hasnext) sh = *(const uint4*)(nn + (size_t)(r + 1) * DM + c); }
            float nv[8], xx[8];
            nv[0] = bf_lo(cur.x); nv[1] = bf_hi(cur.x); nv[2] = bf_lo(cur.y); nv[3] = bf_hi(cur.y); nv[4] = bf_lo(cur.z); nv[5] = bf_hi(cur.z); nv[6] = bf_lo(cur.w); nv[7] = bf_hi(cur.w);
            xx[0] = bf_lo(sh.x) - nv[0]; xx[1] = bf_hi(sh.x) - nv[1]; xx[2] = bf_lo(sh.y) - nv[2]; xx[3] = bf_hi(sh.y) - nv[3]; xx[4] = bf_lo(sh.z) - nv[4]; xx[5] = bf_hi(sh.z) - nv[5]; xx[6] = bf_lo(sh.w) - nv[6]; xx[7] = bf_hi(sh.w) - nv[7];
#pragma unroll
            for (int j = 0; j < 3; ++j) {
                const float4 m0 = *(const float4*)(mu + idx[j] * 1024 + c), m1 = *(const float4*)(mu + idx[j] * 1024 + c + 4);
                uint4 o; o.x = pack2(nv[0] + xx[0] * m0.x, nv[1] + xx[1] * m0.y); o.y = pack2(nv[2] + xx[2] * m0.z, nv[3] + xx[3] * m0.w);
                o.z = pack2(nv[4] + xx[4] * m1.x, nv[5] + xx[5] * m1.y); o.w = pack2(nv[6] + xx[6] * m1.z, nv[7] + xx[7] * m1.w);
                *(uint4*)(xm + (size_t)j * T0 * DM + (size_t)r * DM + c) = o;
            }
        }
    }
}
DEVI void phase_rwkv_gemm_rkv(const Params& p, char* lds) {
    const int MT = T0 / 256;
    GemmRegs<4, 2> R; bool primed = false;
    for (int uu = blockIdx.x; uu < ((3 * 8 * MT + 255) & ~255); uu += gridDim.x) {
        const int u = swz(uu); if (u >= 3 * 8 * MT) continue;
        const int j = u / (8 * MT), v = u % (8 * MT); const int mt = v >> 3, nt = v & 7; const int m0 = mt * 256, n0 = nt * 128;
        const u16* A = (const u16*)(p.ws + R_XM0) + (size_t)j * T0 * DM; const u16* W = (const u16*)(p.ws + W_RR) + (size_t)j * DM * DM; u16* O = (u16*)(p.ws + R_RR) + (size_t)j * T0 * DM;
        const int un = (uu + (int)gridDim.x < ((3 * 8 * MT + 255) & ~255)) ? swz(uu + gridDim.x) : 3 * 8 * MT; const bool hasn = un < 3 * 8 * MT;
        const int jn = hasn ? un / (8 * MT) : j, vn = hasn ? un % (8 * MT) : v;
        const u16* An = (const u16*)(p.ws + R_XM0) + (size_t)jn * T0 * DM + (size_t)((vn >> 3) * 256) * DM; const u16* Wn = (const u16*)(p.ws + W_RR) + (size_t)jn * DM * DM + (size_t)((vn & 7) * 128) * DM;
        auto arow = [&](int r) { return A + (size_t)(m0 + r) * DM; };
        auto arow_n = [&](int r) { return An + (size_t)r * DM; };
        auto xf = [&](int, int, f32x16 (&)[2], int) {};
        auto st = [&](int r, int c8, u32x4 v) { *(u32x4*)(O + (size_t)(m0 + r) * DM + n0 + c8) = v; };
        gemm_tile<256, 128, false>(R, primed, arow, W + (size_t)n0 * DM, arow_n, hasn ? Wn : nullptr, DM, DM, xf, st, lds); primed = hasn;
    }
}
DEVI void phase_rwkv_gemm_small(const Params& p, char* lds) {
    const int MT = T0 / 256;
    for (int u = blockIdx.x; u < 3 * MT; u += gridDim.x) {
        const int j = u / MT, mt = u % MT; const int m0 = mt * 256;
        const u16* A = (const u16*)(p.ws + R_XM0) + (size_t)j * T0 * DM;
        const u16* W = (const u16*)(p.ws + (j == 0 ? W_W1 : j == 1 ? W_A1 : W_G1)); u16* O = (u16*)(p.ws + (j == 0 ? R_HW : j == 1 ? R_HA : R_HG));
        auto arow = [&](int r) { return A + (size_t)(m0 + r) * DM; };
        auto xf = [&](int, int, f32x16 (&t)[2], int) {
#pragma unroll
            for (int ni = 0; ni < 2; ++ni)
#pragma unroll
                for (int i = 0; i < 16; ++i) { const float x = t[ni][i]; t[ni][i] = j == 0 ? tanhf_(x) : j == 1 ? x : sigmoidf_(x); }
        };
        auto st = [&](int r, int c8, u32x4 v) { *(u32x4*)(O + (size_t)(m0 + r) * 128 + c8) = v; };
        GemmRegs<4, 2> R; gemm_tile<256, 128, false>(R, false, arow, W, arow, (const u16*)nullptr, DM, DM, xf, st, lds);
    }
}
DEVI void phase_rwkv_gemm_g(const Params& p, char* lds) {
    const int MT = T0 / 256; const u16* A = (const u16*)(p.ws + R_HG); const u16* W = (const u16*)(p.ws + W_G2); u16* O = (u16*)(p.ws + R_GG);
    for (int uu = blockIdx.x; uu < ((8 * MT + 255) & ~255); uu += gridDim.x) {
        const int u = swz(uu); if (u >= 8 * MT) continue;
        const int mt = u >> 3, nt = u & 7; const int m0 = mt * 256, n0 = nt * 128;
        auto arow = [&](int r) { return A + (size_t)(m0 + r) * 128; };
        auto xf = [&](int, int, f32x16 (&)[2], int) {};
        auto st = [&](int r, int c8, u32x4 v) { *(u32x4*)(O + (size_t)(m0 + r) * DM + n0 + c8) = v; };
        GemmRegs<4, 2> R; gemm_tile<256, 128, false>(R, false, arow, W + (size_t)n0 * 128, arow, (const u16*)nullptr, 128, 128, xf, st, lds);
    }
}
DEVI float red16_sum(float x) { x += dppf(x, 0); x += dppf(x, 1); x += dppf(x, 2); int xi = __builtin_bit_cast(int, x); x += __builtin_bit_cast(float, __builtin_amdgcn_mov_dpp(xi, 0x140, 0xF, 0xF, true)); return x; }
DEVI bf16x8 frag_perm(const u16* rowp, int ks, int h) {
    const uint2 lo = *(const uint2*)(rowp + 16 * ks + 4 * h), hi = *(const uint2*)(rowp + 16 * ks + 8 + 4 * h);
    u32x4 v = {lo.x, lo.y, hi.x, hi.y}; return __builtin_bit_cast(bf16x8, v);
}
DEVI bf16x8 tr_frag(const u16* base, int stride, int lane) {
    const u16* q = base + (4 * (lane >> 5) + ((lane & 15) >> 2)) * stride + 16 * ((lane >> 4) & 1) + 4 * (lane & 3);
    const s16x4 lo = __builtin_amdgcn_ds_read_tr16_b64_v4i16((LAS s16x4*)q), hi = __builtin_amdgcn_ds_read_tr16_b64_v4i16((LAS s16x4*)(q + 8 * stride));
    bf16x8 v; v[0] = lo[0]; v[1] = lo[1]; v[2] = lo[2]; v[3] = lo[3]; v[4] = hi[0]; v[5] = hi[1]; v[6] = hi[2]; v[7] = hi[3]; return v;
}
DEVI bf16x8 frag_plain(const u16* rowp, int ks, int h) { return *(const bf16x8*)(rowp + 16 * ks + 8 * h); }
DEVI bf16x8 acc_to_b(const f32x16& t, int s) {
    u32x4 v = {pack2(t[8 * s], t[8 * s + 1]), pack2(t[8 * s + 2], t[8 * s + 3]), pack2(t[8 * s + 4], t[8 * s + 5]), pack2(t[8 * s + 6], t[8 * s + 7])};
    return __builtin_bit_cast(bf16x8, v);
}
#define MFMA(a, b, c) __builtin_amdgcn_mfma_f32_32x32x16_bf16(a, b, c, 0, 0, 0)
DEVI void phase_rwkv_scan(const Params& p, char* lds) {
    float* AAb = (float*)lds;
    float* CPb0 = (float*)(lds + 16384); float* CPb1 = (float*)(lds + 106496);
    u16* At = (u16*)(lds + 24576); u16* Bt = At + 2304; u16* Kt = Bt + 2304; u16* Rt = Kt + 2304;
    u16* Vr = (u16*)(lds + 43008); u16* Khr = Vr + 3072; u16* Bhr = Khr + 3072;
    float* Lf = (float*)(lds + 61440);
    u16* Lo = (u16*)(lds + 66048); u16* Lak = Lo + 1280; u16* Mrb = Lak + 1280; u16* Mrk = Mrb + 1280; u16* Td = Mrk + 1280;
    float* PC = (float*)(lds + 78848); u16* YS = (u16*)(lds + 79104);
    const u16* r_g = (const u16*)(p.ws + R_RR); const u16* k_g = (const u16*)(p.ws + R_RK); const u16* v_g = (const u16*)(p.ws + R_RV);
    const u16* hw = (const u16*)(p.ws + R_HW); const u16* ha = (const u16*)(p.ws + R_HA);
    const int tid = tidx(), lane = tid & 63, w = tid >> 6, l31 = lane & 31, hh = lane >> 5;
    for (int u = blockIdx.x; u < 256; u += gridDim.x) {
        const int dir = u & 1, hd = (u >> 1) & 15, b = u >> 5;
        u16* y_g = (u16*)(p.ws + (dir ? R_YB : R_YF)); float* rkb = (float*)(p.ws + R_RKB) + (size_t)dir * T0 * 16;
        const int wq = (w - 2) & 3; const int mat = (wq >> 1) & 1, ctt = wq & 1;
        u16* W2L = (u16*)(lds + 86016);
        float* KC = (float*)(lds + 86016 + 18432);
        for (int i = tid; i < 2 * 64 * 8; i += 512) { const int m = i >> 9, c = (i >> 3) & 63, ch = i & 7;
            *(u32x4*)(W2L + (m * 64 + c) * 72 + ch * 8) = *(const u32x4*)((const u16*)(p.ws + (m ? W_A2 : W_W2)) + (size_t)dir * 1024 * 64 + (size_t)(hd * 64 + c) * 64 + ch * 8); }
        if (tid < 64) { KC[tid] = p.in[I_RKK][hd * 64 + tid]; KC[64 + tid] = p.in[I_RKA][hd * 64 + tid]; KC[128 + tid] = p.in[I_RRK][hd * 64 + tid]; }
        const u16* w2l = W2L + (mat * 64 + ctt * 32 + l31) * 72;
        const float* bias0 = (mat ? p.in[I_RA0] : p.in[I_RW0]) + dir * 1024 + hd * 64 + ctt * 32;
        const u16* hsrc = mat ? ha : hw;
        const int t2 = tid >> 4, c4 = (tid & 15) * 4; const int cg = hd * 64 + c4;
        for (int i = tid; i < 1280; i += 512) Td[i] = 0;
        f32x16 Z[2];
#pragma unroll
        for (int a = 0; a < 2; ++a)
#pragma unroll
            for (int i = 0; i < 16; ++i) Z[a][i] = 0.f;
        __syncthreads();
        const size_t rowb = (size_t)b * LT;
        auto chunk_p0 = [&](int ci) { int pc; if (ci < 8) { pc = dir ? 7 - ci : ci; return 32 * pc; } pc = dir ? 135 - ci : ci - 8; return LC + 32 * pc; };
        bf16x8 hfr[4]; uint2 ru, ku, vu;
        {
            const int p0 = chunk_p0(0);
            const int pos = dir ? p0 + 31 - l31 : p0 + l31; const u16* hp = hsrc + (rowb + pos) * 128 + dir * 64;
#pragma unroll
            for (int ks = 0; ks < 4; ++ks) hfr[ks] = *(const bf16x8*)(hp + ks * 16 + hh * 8);
            const int pos2 = dir ? p0 + 31 - t2 : p0 + t2; const size_t go = (rowb + pos2) * DM + cg;
            ru = *(const uint2*)(r_g + go); ku = *(const uint2*)(k_g + go); vu = *(const uint2*)(v_g + go);
        }
        auto stage0 = [&](int pnn, int buf) {
            {
                f32x16 acc;
#pragma unroll
                for (int i = 0; i < 16; ++i) acc[i] = 0.f;
#pragma unroll
                for (int ks = 0; ks < 4; ++ks) acc = MFMA(hfr[ks], frag_plain(w2l, ks, hh), acc);
                {
                    const int pos = dir ? pnn + 31 - l31 : pnn + l31; const u16* hp = hsrc + (rowb + pos) * 128 + dir * 64;
#pragma unroll
                    for (int ks = 0; ks < 4; ++ks) hfr[ks] = *(const bf16x8*)(hp + ks * 16 + hh * 8);
                }
                const float bv = bias0[l31];
                float* dstm = (mat ? AAb + buf * 2048 : (buf ? CPb1 : CPb0)) + ctt * 32 + l31;
                if (mat) {
#pragma unroll
                    for (int i = 0; i < 16; ++i) dstm[((i & 3) + 8 * (i >> 2) + 4 * hh) * 64] = sigmoidf_(acc[i] + bv);
                } else {
                    f32x16 lo, cp;
#pragma unroll
                    for (int i = 0; i < 16; ++i) { const float lw = -0.6065306597126334f * sigmoidf_(acc[i] + bv); const float hi = bf1((u16)(pack2(lw, 0.f))); acc[i] = hi; lo[i] = lw - hi; cp[i] = 0.f; }
#pragma unroll
                    for (int ks = 0; ks < 2; ++ks) {
                        u32x4 tv;
#pragma unroll
                        for (int q = 0; q < 4; ++q) { const int ta = 16 * ks + 8 * (q >> 1) + 4 * hh + 2 * (q & 1); tv[q] = ((ta <= l31) ? 0x3F80u : 0u) | ((ta + 1 <= l31) ? 0x3F800000u : 0u); }
                        const bf16x8 tri = __builtin_bit_cast(bf16x8, tv);
                        cp = MFMA(tri, acc_to_b(acc, ks), cp); cp = MFMA(tri, acc_to_b(lo, ks), cp);
                    }
#pragma unroll
                    for (int i = 0; i < 16; ++i) dstm[((i & 3) + 8 * (i >> 2) + 4 * hh) * 64] = cp[i];
                }
            }
        };
        if (w >= 2 && w < 6) stage0(chunk_p0(1), 0);
        lds_barrier();
        for (int ci = 0; ci < 136; ++ci) {
            const int p0 = chunk_p0(ci); const int p0n = chunk_p0(ci < 135 ? ci + 1 : ci);
            const float* AA = AAb + (ci & 1) * 2048; const float* CP = (ci & 1) ? CPb1 : CPb0;
            const int pos2 = dir ? p0 + 31 - t2 : p0 + t2;
            {
                const float rv[4] = {bf_lo(ru.x), bf_hi(ru.x), bf_lo(ru.y), bf_hi(ru.y)}, kv[4] = {bf_lo(ku.x), bf_hi(ku.x), bf_lo(ku.y), bf_hi(ku.y)};
                const float4 a4 = *(const float4*)(AA + t2 * 64 + c4), cp4 = *(const float4*)(CP + t2 * 64 + c4), ce4 = *(const float4*)(CP + 31 * 64 + c4);
                float4 cq4 = make_float4(0.f, 0.f, 0.f, 0.f); if (t2 > 0) cq4 = *(const float4*)(CP + (t2 - 1) * 64 + c4);
                const float av[4] = {a4.x, a4.y, a4.z, a4.w}, cpv[4] = {cp4.x, cp4.y, cp4.z, cp4.w}, cev[4] = {ce4.x, ce4.y, ce4.z, ce4.w}, cqv[4] = {cq4.x, cq4.y, cq4.z, cq4.w};
                const float4 kkc = *(const float4*)(KC + c4), kac = *(const float4*)(KC + 64 + c4), rkc = *(const float4*)(KC + 128 + c4);
                const float kkcv[4] = {kkc.x, kkc.y, kkc.z, kkc.w}, kacv[4] = {kac.x, kac.y, kac.z, kac.w}, rkcv[4] = {rkc.x, rkc.y, rkc.z, rkc.w};
                float kk[4], km[4], ssq = 0.f, rks = 0.f;
#pragma unroll
                for (int i = 0; i < 4; ++i) { kk[i] = kv[i] * kkcv[i]; ssq += kk[i] * kk[i]; km[i] = kv[i] * (1.f + (av[i] - 1.f) * kacv[i]); rks += rv[i] * km[i] * rkcv[i]; }
                ssq = red16_sum(ssq); rks = red16_sum(rks);
                const float inv = 1.f / fmaxf(sqrtf(ssq), 1e-12f);
                float at[4], bt[4], kt[4], rt[4], bh[4], kh[4];
#pragma unroll
                for (int i = 0; i < 4; ++i) {
                    const float kn = kk[i] * inv, bb = kn * av[i];
                    const float en = __expf(-cpv[i]), eh = __expf(cev[i] - cpv[i]);
                    at[i] = -kn * __expf(cqv[i]); bt[i] = bb * en; kt[i] = km[i] * en; rt[i] = rv[i] * __expf(cpv[i]); bh[i] = bb * eh; kh[i] = km[i] * eh;
                }
                uint2 o;
                o.x = pack2(at[0], at[1]); o.y = pack2(at[2], at[3]); *(uint2*)(At + t2 * 72 + c4) = o;
                o.x = pack2(bt[0], bt[1]); o.y = pack2(bt[2], bt[3]); *(uint2*)(Bt + t2 * 72 + c4) = o;
                o.x = pack2(kt[0], kt[1]); o.y = pack2(kt[2], kt[3]); *(uint2*)(Kt + t2 * 72 + c4) = o;
                o.x = pack2(rt[0], rt[1]); o.y = pack2(rt[2], rt[3]); *(uint2*)(Rt + t2 * 72 + c4) = o;
                o.x = pack2(kh[0], kh[1]); o.y = pack2(kh[2], kh[3]); *(uint2*)(Khr + t2 * 96 + c4) = o;
                o.x = pack2(bh[0], bh[1]); o.y = pack2(bh[2], bh[3]); *(uint2*)(Bhr + t2 * 96 + c4) = o;
                *(uint2*)(Vr + t2 * 96 + c4) = vu;
                if (t2 == 0) *(float4*)(PC + c4) = make_float4(__expf(cev[0]), __expf(cev[1]), __expf(cev[2]), __expf(cev[3]));
                if ((tid & 15) == 0) rkb[(rowb + pos2) * 16 + hd] = rks;
                const int pos2n = dir ? p0n + 31 - t2 : p0n + t2; const size_t gon = (rowb + pos2n) * DM + cg;
                ru = *(const uint2*)(r_g + gon); ku = *(const uint2*)(k_g + gon); vu = *(const uint2*)(v_g + gon);
            }
            lds_barrier();
            if (w < 4) {
                const u16* X1 = (w < 2) ? At : Rt; const u16* X2 = (w & 1) ? Kt : Bt;
                f32x16 acc;
#pragma unroll
                for (int i = 0; i < 16; ++i) acc[i] = 0.f;
#pragma unroll
                for (int ks = 0; ks < 4; ++ks) acc = MFMA(frag_plain(X2 + l31 * 72, ks, hh), frag_plain(X1 + l31 * 72, ks, hh), acc);
#pragma unroll
                for (int i = 0; i < 16; ++i) { const int s = (i & 3) + 8 * (i >> 2) + 4 * hh; const bool keep = (w < 2) ? (s < l31) : (s <= l31); if (!keep) acc[i] = 0.f; }
                if (w == 0) {
#pragma unroll
                    for (int g = 0; g < 4; ++g) {
                        *(float4*)(Lf + l31 * 36 + 8 * g + 4 * hh) = make_float4(acc[4 * g], acc[4 * g + 1], acc[4 * g + 2], acc[4 * g + 3]);
                        const bool lo = (l31 >= 16) && (8 * g + 4 * hh < 16);
                        uint2 o; o.x = lo ? pack2(acc[4 * g], acc[4 * g + 1]) : 0u; o.y = lo ? pack2(acc[4 * g + 2], acc[4 * g + 3]) : 0u; *(uint2*)(Lo + l31 * 40 + 8 * g + 4 * hh) = o;
                    }
                } else {
                    u16* dst = (w == 1) ? Lak : (w == 2) ? Mrb : Mrk;
#pragma unroll
                    for (int g = 0; g < 4; ++g) { uint2 o; o.x = pack2(acc[4 * g], acc[4 * g + 1]); o.y = pack2(acc[4 * g + 2], acc[4 * g + 3]); *(uint2*)(dst + l31 * 40 + 8 * g + 4 * hh) = o; }
                }
            }
            lds_barrier();
            f32x16 XZ, Ya; bf16x8 zf[4];
            if (w >= 6) {
                const int blk = w - 6, j = lane & 15; const float* Lb = Lf + (16 * blk) * 36 + 16 * blk;
                const float4 l4 = *(const float4*)(Lb + (lane >> 2) * 36 + 4 * (lane & 3));
                const int li[4] = {__builtin_bit_cast(int, l4.x), __builtin_bit_cast(int, l4.y), __builtin_bit_cast(int, l4.z), __builtin_bit_cast(int, l4.w)};
                float x[16];
#pragma unroll
                for (int t = 0; t < 16; ++t) {
                    float a0 = (j == t) ? 1.f : 0.f, a1 = 0.f;
#pragma unroll
                    for (int s2 = 0; s2 < t; ++s2) {
                        const float lv = __builtin_bit_cast(float, __builtin_amdgcn_readlane(li[s2 & 3], 4 * t + (s2 >> 2)));
                        if (s2 & 1) a1 += lv * x[s2]; else a0 += lv * x[s2];
                    }
                    x[t] = a0 + a1;
                }
                if (lane < 16) {
#pragma unroll
                    for (int t = 0; t < 16; ++t) Td[(16 * blk + t) * 40 + 16 * blk + j] = (u16)(pack2(x[t], 0.f));
                }
            } else if (w >= 2) {
                if (ci + 1 < 136) stage0(chunk_p0(ci + 2 < 136 ? ci + 2 : 135), (ci + 1) & 1);
            } else {
#pragma unroll
                for (int s = 0; s < 4; ++s) zf[s] = acc_to_b(Z[s >> 1], s & 1);
#pragma unroll
                for (int i = 0; i < 16; ++i) { XZ[i] = 0.f; Ya[i] = 0.f; }
#pragma unroll
                for (int s = 0; s < 4; ++s) { XZ = MFMA(frag_perm(At + l31 * 72, s, hh), zf[s], XZ); Ya = MFMA(frag_perm(Rt + l31 * 72, s, hh), zf[s], Ya); }
                bf16x8 vf[2];
#pragma unroll
                for (int ks = 0; ks < 2; ++ks) {
                    vf[ks] = tr_frag(Vr + (16 * ks) * 96 + 32 * w, 96, lane);
                    XZ = MFMA(frag_perm(Lak + l31 * 40, ks, hh), vf[ks], XZ); Ya = MFMA(frag_perm(Mrk + l31 * 40, ks, hh), vf[ks], Ya);
                }
#pragma unroll
                for (int kt = 0; kt < 2; ++kt) {
#pragma unroll
                    for (int g = 0; g < 4; ++g) { const float4 pc4 = *(const float4*)(PC + 32 * kt + 8 * g + 4 * hh);
                        Z[kt][4 * g] *= pc4.x; Z[kt][4 * g + 1] *= pc4.y; Z[kt][4 * g + 2] *= pc4.z; Z[kt][4 * g + 3] *= pc4.w; }
#pragma unroll
                    for (int ks = 0; ks < 2; ++ks) Z[kt] = MFMA(tr_frag(Khr + (16 * ks) * 96 + 32 * kt, 96, lane), vf[ks], Z[kt]);
                }
            }
            lds_barrier();
            if (w < 2) {
                f32x16 U1 = {}, W = {};
#pragma unroll
                for (int i = 0; i < 16; ++i) { U1[i] = 0.f; W[i] = 0.f; }
#pragma unroll
                for (int ks = 0; ks < 2; ++ks) U1 = MFMA(frag_perm(Td + l31 * 40, ks, hh), acc_to_b(XZ, ks), U1);
#pragma unroll
                for (int ks = 0; ks < 2; ++ks) W = MFMA(frag_perm(Lo + l31 * 40, ks, hh), acc_to_b(U1, ks), W);
#pragma unroll
                for (int ks = 0; ks < 2; ++ks) U1 = MFMA(frag_perm(Td + l31 * 40, ks, hh), acc_to_b(W, ks), U1);
                const bf16x8 uf0 = acc_to_b(U1, 0), uf1 = acc_to_b(U1, 1);
                Ya = MFMA(frag_perm(Mrb + l31 * 40, 0, hh), uf0, Ya); Ya = MFMA(frag_perm(Mrb + l31 * 40, 1, hh), uf1, Ya);
#pragma unroll
                for (int kt = 0; kt < 2; ++kt) { Z[kt] = MFMA(tr_frag(Bhr + 32 * kt, 96, lane), uf0, Z[kt]); Z[kt] = MFMA(tr_frag(Bhr + 16 * 96 + 32 * kt, 96, lane), uf1, Z[kt]); }
#pragma unroll
                for (int i = 0; i < 16; ++i) { const int t = (i & 3) + 8 * (i >> 2) + 4 * hh; YS[t * 72 + 32 * w + l31] = (u16)pack2(Ya[i], 0.f); }
            }
            lds_barrier();
            if (ci >= 8) { const uint2 yv = *(const uint2*)(YS + t2 * 72 + c4); *(uint2*)(y_g + (rowb + pos2) * DM + cg) = yv; }
        }
        __syncthreads();
    }
}
DEVI void phase_rwkv_readout(const Params& p) {
    const u16* yf = (const u16*)(p.ws + R_YF); const u16* yb = (const u16*)(p.ws + R_YB); const u16* vg = (const u16*)(p.ws + R_RV); const u16* gg = (const u16*)(p.ws + R_GG);
    const float* rkb = (const float*)(p.ws + R_RKB); u16* rd = (u16*)(p.ws + R_RD);
    const float* lnw = p.in[I_RLNW]; const float* lnb = p.in[I_RLNB];
    const int lane = tidx() & 63, w = tidx() >> 6;
    for (int t = blockIdx.x * 8 + w; t < TL; t += gridDim.x * 8) {
        const int b = t >> 12, s = t & 4095; const size_t row = (size_t)b * LT + LC + s; const int c = lane * 16; const int hd = lane >> 2;
        float y[16], vv[16], gv[16];
#pragma unroll
        for (int q = 0; q < 2; ++q) {
            const uint4 a = *(const uint4*)(yf + row * DM + c + 8 * q), bq = *(const uint4*)(yb + row * DM + c + 8 * q), v4 = *(const uint4*)(vg + row * DM + c + 8 * q), g4 = *(const uint4*)(gg + row * DM + c + 8 * q);
            y[8 * q + 0] = bf_lo(a.x) + bf_lo(bq.x); y[8 * q + 1] = bf_hi(a.x) + bf_hi(bq.x); y[8 * q + 2] = bf_lo(a.y) + bf_lo(bq.y); y[8 * q + 3] = bf_hi(a.y) + bf_hi(bq.y);
            y[8 * q + 4] = bf_lo(a.z) + bf_lo(bq.z); y[8 * q + 5] = bf_hi(a.z) + bf_hi(bq.z); y[8 * q + 6] = bf_lo(a.w) + bf_lo(bq.w); y[8 * q + 7] = bf_hi(a.w) + bf_hi(bq.w);
            vv[8 * q + 0] = bf_lo(v4.x); vv[8 * q + 1] = bf_hi(v4.x); vv[8 * q + 2] = bf_lo(v4.y); vv[8 * q + 3] = bf_hi(v4.y); vv[8 * q + 4] = bf_lo(v4.z); vv[8 * q + 5] = bf_hi(v4.z); vv[8 * q + 6] = bf_lo(v4.w); vv[8 * q + 7] = bf_hi(v4.w);
            gv[8 * q + 0] = bf_lo(g4.x); gv[8 * q + 1] = bf_hi(g4.x); gv[8 * q + 2] = bf_lo(g4.y); gv[8 * q + 3] = bf_hi(g4.y); gv[8 * q + 4] = bf_lo(g4.z); gv[8 * q + 5] = bf_hi(g4.z); gv[8 * q + 6] = bf_lo(g4.w); gv[8 * q + 7] = bf_hi(g4.w);
        }
        float sm = 0.f;
#pragma unroll
        for (int i = 0; i < 16; ++i) sm += y[i];
        sm = red4_sum(sm); const float mean = sm * (1.f / 64.f);
        float vs = 0.f;
#pragma unroll
        for (int i = 0; i < 16; ++i) { const float d = y[i] - mean; vs += d * d; }
        vs = red4_sum(vs); const float rstd = rsqrtf(vs * (1.f / 64.f) + 64e-5f);
        const float bon = rkb[row * 16 + hd] + rkb[(size_t)T0 * 16 + row * 16 + hd];
        unsigned ow[8];
#pragma unroll
        for (int i = 0; i < 8; ++i) {
            const int c0 = c + 2 * i;
            const float o0 = ((y[2 * i] - mean) * rstd * lnw[c0] + lnb[c0] + bon * vv[2 * i]) * gv[2 * i];
            const float o1 = ((y[2 * i + 1] - mean) * rstd * lnw[c0 + 1] + lnb[c0 + 1] + bon * vv[2 * i + 1]) * gv[2 * i + 1];
            ow[i] = pack2(o0, o1);
        }
        *(uint4*)(rd + (size_t)t * DM + c) = make_uint4(ow[0], ow[1], ow[2], ow[3]); *(uint4*)(rd + (size_t)t * DM + c + 8) = make_uint4(ow[4], ow[5], ow[6], ow[7]);
    }
}
DEVI void phase_final_norm(const Params& p) {
    const float* g = p.in[I_NFIN]; float* X = p.out;
    const int lane = tidx() & 63, w = tidx() >> 6;
    for (int r = blockIdx.x * 8 + w; r < TL; r += gridDim.x * 8) {
        float4* xr = (float4*)(X + (size_t)r * DM); float4 v[4]; float ss = 0.f;
#pragma unroll
        for (int i = 0; i < 4; ++i) { v[i] = xr[lane + 64 * i]; ss += v[i].x * v[i].x + v[i].y * v[i].y + v[i].z * v[i].z + v[i].w * v[i].w; }
        ss = wave_sum(ss); const float rs = rsqrtf(ss * (1.f / 1024.f) + 1e-6f);
#pragma unroll
        for (int i = 0; i < 4; ++i) { const float4 gg = ((const float4*)g)[lane + 64 * i]; float4 o; o.x = v[i].x * rs * gg.x; o.y = v[i].y * rs * gg.y; o.z = v[i].z * rs * gg.z; o.w = v[i].w * rs * gg.w; xr[lane + 64 * i] = o; }
    }
}

constexpr int N_PHASES = 30;
template <int PH> DEVI void run_phase(const Params& p, char* lds) {
    const float* mods = (const float*)(p.ws + OFF_MODS);
    RowSrc in_src; in_src.ctx = p.in[I_CTX]; in_src.lat = p.in[I_X];
    RowSrc x_src; x_src.ctx = (const float*)(p.ws + OFF_XC); x_src.lat = p.out;
    if constexpr (PH == 0) phase_prologue(p, lds);
    else if constexpr (PH == 1) norm_rows(in_src, 0, T0, p.in[I_NMIX], mods, 0, 1, (u16*)(p.ws + A_N0));
    else if constexpr (PH == 2) phase_gemm_win(p, lds);
    else if constexpr (PH == 3) phase_gemm_qkv(p, lds);
    else if constexpr (PH == 4) { phase_attention(p, lds); conv_jobs(p, 25, 28, 0, 0, lds); }
    else if constexpr (PH == 5) phase_gemm_wo(p, (const u16*)(p.ws + A_N0), (const u16*)(p.ws + W_OA), in_src, 0, 0, lds);
    else if constexpr (PH == 6) phase_moe_norm(p, 0);
    else if constexpr (PH == 7) phase_moe_route(p, 0, lds);
    else if constexpr (PH == 8) phase_moe_gemm1(p, 0, lds);
    else if constexpr (PH >= 9 && PH <= 13) phase_moe_g2c(p, 0, PH - 9 < NCHUNK ? PH - 9 : -1, PH - 10, lds);
    else if constexpr (PH == 14) norm_rows(x_src, 0, T0, p.in[I_NMIX] + 1024, mods + 9 * 6144, 0, 1, (u16*)(p.ws + R_NN));
    else if constexpr (PH == 15) phase_rwkv_mix(p, 0, 2, 3);
    else if constexpr (PH == 16) phase_rwkv_gemm_rkv(p, lds);
    else if constexpr (PH == 17) phase_rwkv_mix(p, 1, 4, 5);
    else if constexpr (PH == 18) phase_rwkv_gemm_small(p, lds);
    else if constexpr (PH == 19) { phase_rwkv_gemm_g(p, lds); phase_rwkv_scan(p, lds); }
    else if constexpr (PH == 20) phase_rwkv_readout(p);
    else if constexpr (PH == 21) { phase_gemm_wo(p, (const u16*)(p.ws + R_RD), (const u16*)(p.ws + W_RO), x_src, 1, 1, lds); conv_jobs(p, 25, 28, 1, 0, lds); }
    else if constexpr (PH == 22) phase_moe_norm(p, 1);
    else if constexpr (PH == 23) phase_moe_route(p, 1, lds);
    else if constexpr (PH == 24) phase_moe_gemm1(p, 1, lds);
    else if constexpr (PH >= 25 && PH <= 29) phase_moe_g2c(p, 1, PH - 25 < NCHUNK ? PH - 25 : -1, PH - 26, lds);
}

#if MEGA
template <int PH, int END> DEVI void run_range(const Params& p_, char* lds, const XcdBarrier& bar) {
    const Params& p = *(const Params*)__builtin_amdgcn_kernarg_segment_ptr();
    run_phase<PH>(p, lds);
    if constexpr (PH + 1 < END) { xcd_barrier(bar); run_range<PH + 1, END>(p_, lds, bar); }
}
template <int A, int B> __global__ void __launch_bounds__(512, 2) k_range(Params p, unsigned* barw) {
    extern __shared__ __attribute__((aligned(16))) char smem[];
    if (threadIdx.x == 0) *(uint4*)smem = make_uint4(0u, 0u, 0u, 0u);
    __syncthreads();
    const XcdBarrier bar = xcd_barrier_post(barw, (volatile LAS unsigned*)smem);
    run_range<A, B>(p, smem + 64, bar);
}
template <int A, int B> static void launch_range(const Params& p, unsigned* barw, hipStream_t s) {
    static int grid = 0;
    if (!grid) {
        int dev = 0, cus = 0, per_cu = 0;
        (void)hipGetDevice(&dev);
        (void)hipDeviceGetAttribute(&cus, hipDeviceAttributeMultiprocessorCount, dev);
        (void)hipFuncSetAttribute((const void*)k_range<A, B>, hipFuncAttributeMaxDynamicSharedMemorySize, LDS_BYTES);
        (void)hipOccupancyMaxActiveBlocksPerMultiprocessor(&per_cu, (const void*)k_range<A, B>, 512, LDS_BYTES);
        if (per_cu < 1) fprintf(stderr, "occupancy query says 0 blocks per CU\n");
        grid = cus;
    }
    k_range<A, B><<<grid, 512, LDS_BYTES, s>>>(p, barw);
}
extern "C" void kernel_launch(void* const* d_in, const int* in_sizes, int n_in, void* d_out, int out_size, void* d_ws, size_t ws_size, hipStream_t stream) {
    Params p{};
    for (int i = 0; i < N_IN; ++i) p.in[i] = (const float*)d_in[i];
    p.out = (float*)d_out; p.ws = (char*)d_ws;
    if (ws_size < WS_NEED) { fprintf(stderr, "workspace too small\n"); return; }
    (void)hipMemsetAsync(p.ws + OFF_BAR, 0, XCD_BAR_WORDS * sizeof(unsigned), stream);
    launch_range<0, N_PHASES>(p, (unsigned*)(p.ws + OFF_BAR), stream);
}
#else
template <int PH> __global__ void __launch_bounds__(512, 2) k_phase(Params p) {
    extern __shared__ __attribute__((aligned(16))) char smem[];
    run_phase<PH>(p, smem + 64);
}
template <int PH> static void launch_phase(const Params& p, hipStream_t s) {
    static bool attr = false;
    if (!attr) { hipFuncSetAttribute((const void*)k_phase<PH>, hipFuncAttributeMaxDynamicSharedMemorySize, LDS_BYTES); attr = true; }
    k_phase<PH><<<256, 512, LDS_BYTES, s>>>(p);
}
template <int PH> static void launch_all(const Params& p, hipStream_t s) {
    launch_phase<PH>(p, s);
    if constexpr (PH + 1 < N_PHASES) launch_all<PH + 1>(p, s);
}

extern "C" void kernel_launch(void* const* d_in, const int* in_sizes, int n_in, void* d_out, int out_size, void* d_ws, size_t ws_size, hipStream_t stream) {
    Params p{};
    for (int i = 0; i < N_IN; ++i) p.in[i] = (const float*)d_in[i];
    p.out = (float*)d_out; p.ws = (char*)d_ws;
    if (ws_size < WS_NEED) { fprintf(stderr, "workspace too small: %zu < %zu\n", ws_size, (size_t)WS_NEED); return; }
    launch_all<0>(p, stream);
}
#endif
```

```cpp
#include <hip/hip_runtime.h>
#include <stdint.h>
#include <stdio.h>
#include <type_traits>

#ifndef MEGA
#define MEGA 1
#endif

typedef unsigned short u16;
typedef short bf16x8 __attribute__((ext_vector_type(8)));
typedef short s16x4 __attribute__((ext_vector_type(4)));
typedef float f32x16 __attribute__((ext_vector_type(16)));
typedef float f32x4 __attribute__((ext_vector_type(4)));
typedef float f32x2 __attribute__((ext_vector_type(2)));
typedef unsigned u32x4 __attribute__((ext_vector_type(4)));
typedef __bf16 bf2 __attribute__((ext_vector_type(2)));
#define DEVI __device__ __forceinline__
#define LAS __attribute__((address_space(3)))
__device__ __forceinline__ int tidx() { int t = threadIdx.x; asm volatile("" : "+v"(t)); return t; }

constexpr int NB = 8, SEQ = 4096, LC = 256, LT = 4352, DM = 1024, T0 = NB * LT, TL = NB * SEQ;
constexpr int NCHUNK = 4;
constexpr float LOG2E = 1.4426950408889634f;
constexpr float QA_SCALE = 0.07216878364870322f * LOG2E;
constexpr float QS_SCALE = 0.125f * LOG2E;

enum { I_X = 0, I_C, I_CTX, I_CCTX, I_ADAW, I_ADAB, I_NMIX, I_NFFN, I_NFIN, I_AWIN, I_AQN, I_AKVN, I_AWUQ, I_AWUKV, I_ASINK, I_AWO,
       I_RMU, I_RWR, I_RWK, I_RWV, I_RWO, I_RG1, I_RG2, I_RW0, I_RW1, I_RW2, I_RA0, I_RA1, I_RA2, I_RKK, I_RKA, I_RRK, I_RLNW, I_RLNB,
       I_MROUT, I_MBIAS, I_MWG, I_MWU, I_MWD, I_MSG, I_MSU, I_MSD, N_IN };

struct Params { const float* in[N_IN]; float* out; char* ws; };

constexpr size_t OFF_BAR = 0, OFF_CNT = 16384, OFF_ROPE = 20480, OFF_MODS = 32768, OFF_WSTAT = 524288;
constexpr size_t W_IN = OFF_WSTAT, W_UQ = W_IN + 3145728, W_UK = W_UQ + 589824, W_UV = W_UK + 262144, W_OA = W_UV + 262144,
                 W_RR = W_OA + 2097152, W_RK = W_RR + 2097152, W_RV = W_RK + 2097152, W_RO = W_RV + 2097152,
                 W_G1 = W_RO + 2097152, W_W1 = W_G1 + 262144, W_A1 = W_W1 + 262144, W_G2 = W_A1 + 262144, W_W2 = W_G2 + 262144, W_A2 = W_W2 + 262144,
                 W_SGU = W_A2 + 262144, W_SD = W_SGU + 2 * 1048576, W_END = W_SD + 2 * 524288;
constexpr size_t OFF_XC = OFF_WSTAT + 20971520;
constexpr size_t OFF_TOKE = OFF_XC + 8388608, OFF_TOKR = OFF_TOKE + 835584, OFF_LTOK = OFF_TOKR + 835584, OFF_LG = OFF_LTOK + 8912896;
constexpr size_t OFF_WROUT = OFF_LG + 8912896;
constexpr size_t OFF_D = OFF_XC + 8388608 + 20971520;
static_assert(OFF_WROUT + 2 * 64 * 3072 * 2 <= OFF_D, "router weights overflow");
constexpr size_t WGU_BYTES = 64ull * 512 * 1024 * 2, WD_BYTES = 64ull * 1024 * 256 * 2;
constexpr size_t OFF_WGU = OFF_D, OFF_WD = OFF_D + WGU_BYTES;
constexpr size_t OFF_G = OFF_D + WGU_BYTES + WD_BYTES;
constexpr size_t SZ_T0D = (size_t)T0 * 1024 * 2;
constexpr size_t A_N0 = OFF_G, A_CQ = A_N0 + SZ_T0D, A_CKV = A_CQ + (size_t)T0 * 384 * 2, A_QA = A_CKV + (size_t)T0 * 256 * 2, A_KA = A_QA + (size_t)T0 * 768 * 2,
                 A_VA = A_KA + (size_t)T0 * 768 * 2, A_QS = A_VA + (size_t)T0 * 512 * 2, A_KS = A_QS + (size_t)T0 * 512 * 2, A_VS = A_KS + (size_t)T0 * 128 * 2, A_END = A_VS + (size_t)T0 * 128 * 2;
constexpr size_t M_N1 = OFF_G, M_ACT = M_N1 + SZ_T0D, M_OUTR = M_ACT + (size_t)7 * T0 * 256 * 2, SZ_OUTR = (size_t)7 * 8704 * 1024 * 2, M_END = M_OUTR + 2 * SZ_OUTR;
constexpr size_t R_XM0 = OFF_D, R_XM1 = R_XM0 + SZ_T0D, R_XM2 = R_XM1 + SZ_T0D, R_RR = R_XM2 + SZ_T0D, R_RK = R_RR + SZ_T0D, R_RV = R_RK + SZ_T0D, R_NN = R_RV + SZ_T0D,
                 R_HG = R_NN + SZ_T0D, R_HW = R_HG + (size_t)T0 * 128 * 2, R_HA = R_HW + (size_t)T0 * 128 * 2, R_RKB = R_HA + (size_t)T0 * 128 * 2, R_END = R_RKB + (size_t)2 * T0 * 16 * 4;
constexpr size_t R_GG = R_XM0, R_YF = R_XM1, R_YB = R_XM2, R_RD = R_NN;
constexpr size_t WS_NEED = R_END > M_END ? R_END : M_END;

constexpr int LDS_BYTES = 64 + 131072;

DEVI unsigned pack2(float a, float b) { f32x2 v = {a, b}; bf2 r = __builtin_convertvector(v, bf2); return __builtin_bit_cast(unsigned, r); }
DEVI float bf_lo(unsigned u) { return __builtin_bit_cast(float, u << 16); }
DEVI float bf_hi(unsigned u) { return __builtin_bit_cast(float, u & 0xffff0000u); }
DEVI float bf1(u16 u) { return __builtin_bit_cast(float, ((unsigned)u) << 16); }
DEVI float dppf(float x, const int ctrl_sel) {
    int xi = __builtin_bit_cast(int, x), y;
    if (ctrl_sel == 0) y = __builtin_amdgcn_mov_dpp(xi, 0xB1, 0xF, 0xF, true);
    else if (ctrl_sel == 1) y = __builtin_amdgcn_mov_dpp(xi, 0x4E, 0xF, 0xF, true);
    else y = __builtin_amdgcn_mov_dpp(xi, 0x141, 0xF, 0xF, true);
    return __builtin_bit_cast(float, y);
}
DEVI float red8_sum(float x) { x += dppf(x, 0); x += dppf(x, 1); x += dppf(x, 2); return x; }
DEVI float red8_max(float x) { x = fmaxf(x, dppf(x, 0)); x = fmaxf(x, dppf(x, 1)); x = fmaxf(x, dppf(x, 2)); return x; }
DEVI float red4_sum(float x) { x += dppf(x, 0); x += dppf(x, 1); return x; }
DEVI float wave_sum(float x) { for (int o = 32; o > 0; o >>= 1) x += __shfl_xor(x, o); return x; }
DEVI float wave_max(float x) { for (int o = 32; o > 0; o >>= 1) x = fmaxf(x, __shfl_xor(x, o)); return x; }
DEVI float xhalf(float x) {
    int l = (int)__builtin_amdgcn_mbcnt_hi(~0u, __builtin_amdgcn_mbcnt_lo(~0u, 0u)); asm volatile("" : "+v"(l));
    return __builtin_bit_cast(float, __builtin_amdgcn_ds_bpermute((l ^ 32) << 2, __builtin_bit_cast(int, x)));
}
DEVI void lds_barrier() { asm volatile("s_waitcnt lgkmcnt(0)\n\ts_barrier" ::: "memory"); }
DEVI float sigmoidf_(float x) { return 1.f / (1.f + __expf(-x)); }
DEVI float siluf_(float x) { return x / (1.f + __expf(-x)); }
DEVI float tanhf_(float x) { float e = __expf(2.f * x); return 1.f - 2.f / (e + 1.f); }

#define XB_TMO      128
#define XB_XCNT(j)  (256  + 64 * (j))
#define XB_XSUB(j)  (1280 + 64 * (j))
#define XB_XGEN(j)  (2304 + 64 * (j))
#define XB_TOP      3328
#define XB_TOPGEN   3392
#define XCD_BAR_WORDS 3456
#define XB_SPIN_CAP (1u << 20)
DEVI unsigned xb_ld(unsigned* p)              { return __hip_atomic_load(p, __ATOMIC_RELAXED, __HIP_MEMORY_SCOPE_AGENT); }
DEVI unsigned xb_add(unsigned* p, unsigned v) { return __hip_atomic_fetch_add(p, v, __ATOMIC_RELAXED, __HIP_MEMORY_SCOPE_AGENT); }
DEVI unsigned xb_xcc_id() { return (unsigned)__builtin_amdgcn_s_getreg((3 << 11) | 20) & 0xFu; }
#define XB_SPIN(cond, bar) do { unsigned _sp = 0; while (cond) { __builtin_amdgcn_s_sleep(1); \
    if ((++_sp & 255u) == 0u) { if (xb_ld(&(bar)[XB_TMO])) break; if (_sp > XB_SPIN_CAP) { atomicAdd(&(bar)[XB_TMO], 1u); break; } } } } while (0)
struct XcdBarrier { unsigned* bar; unsigned x; volatile LAS unsigned* st; };
DEVI XcdBarrier xcd_barrier_post(unsigned* bar, volatile LAS unsigned* st) {
    XcdBarrier b; b.bar = bar; b.x = xb_xcc_id(); b.st = st;
    if (threadIdx.x == 0) (void)xb_add(&bar[XB_XCNT(b.x)], 1u);
    return b;
}
DEVI void xcd_barrier_complete(unsigned* bar, unsigned x, unsigned& nloc, unsigned& nx) {
    const unsigned G = gridDim.x * gridDim.y * gridDim.z;
    unsigned sum, cnt, mine, sp = 0u;
    for (;;) {
        sum = 0u; cnt = 0u; mine = 0u;
#pragma unroll
        for (unsigned j = 0; j < 16; ++j) { const unsigned c = xb_ld(&bar[XB_XCNT(j)]); sum += c; cnt += (c > 0u) ? 1u : 0u; mine = (j == x) ? c : mine; }
        if (sum == G) break;
        __builtin_amdgcn_s_sleep(1);
        if ((++sp & 255u) == 0u) { if (xb_ld(&bar[XB_TMO])) break; if (sp > XB_SPIN_CAP) { atomicAdd(&bar[XB_TMO], 1u); break; } }
    }
    nloc = mine > 0u ? mine : 1u; nx = cnt > 0u ? cnt : 1u;
}
DEVI void xcd_barrier(const XcdBarrier& b) {
    asm volatile("s_waitcnt vmcnt(0)" ::: "memory");
    __syncthreads();
    if (threadIdx.x == 0) {
        unsigned* bar = b.bar;
        __builtin_amdgcn_s_waitcnt(0);
        unsigned nloc = b.st[0], nx = b.st[1];
        if (nloc == 0u) { xcd_barrier_complete(bar, b.x, nloc, nx); b.st[0] = nloc; b.st[1] = nx; }
        const unsigned old = xb_add(&bar[XB_XSUB(b.x)], 1u);
        const unsigned gen = old / nloc;
        if (old + 1u == (gen + 1u) * nloc) {
            __builtin_amdgcn_fence(__ATOMIC_RELEASE, "agent");
            asm volatile("s_waitcnt vmcnt(0)" ::: "memory");
            const unsigned og = xb_add(&bar[XB_TOP], 1u);
            const unsigned tg = og / nx;
            if (og + 1u == (tg + 1u) * nx) xb_add(&bar[XB_TOPGEN], 1u);
            else XB_SPIN(xb_ld(&bar[XB_TOPGEN]) == tg, bar);
            __builtin_amdgcn_fence(__ATOMIC_ACQUIRE, "agent");
            xb_add(&bar[XB_XGEN(b.x)], 1u);
            asm volatile("s_waitcnt vmcnt(0)" ::: "memory");
        } else {
            XB_SPIN(xb_ld(&bar[XB_XGEN(b.x)]) == gen, bar);
            __builtin_amdgcn_fence(__ATOMIC_ACQUIRE, "agent");
            asm volatile("s_waitcnt vmcnt(0)" ::: "memory");
        }
    }
    __syncthreads();
}

DEVI int swz(int u) { return gridDim.x == 256 ? ((u & ~255) | ((u & 7) << 5) | ((u >> 3) & 31)) : u; }
struct RowSrc { const float* ctx; const float* lat; };
DEVI const float* row_ptr(const RowSrc& s, int mode, int r, int& bb) {
    if (mode == 0) { int b = r / LT, pp = r - b * LT; if (pp < LC) { bb = 8; return s.ctx + (size_t)(b * LC + pp) * DM; } bb = b; return s.lat + (size_t)(b * SEQ + pp - LC) * DM; }
    bb = r >> 12; return s.lat + (size_t)r * DM;
}
DEVI float* row_ptr_w(float* ctx, float* lat, int mode, int r, int& bb) {
    if (mode == 0) { int b = r / LT, pp = r - b * LT; if (pp < LC) { bb = 8; return ctx + (size_t)(b * LC + pp) * DM; } bb = b; return lat + (size_t)(b * SEQ + pp - LC) * DM; }
    bb = r >> 12; return lat + (size_t)r * DM;
}

DEVI float sumsq8(const bf16x8& v) {
    float s = 0.f;
    const unsigned* u = (const unsigned*)&v;
#pragma unroll
    for (int i = 0; i < 4; ++i) { bf2 b = __builtin_bit_cast(bf2, u[i]); s = __builtin_amdgcn_fdot2_f32_bf16(b, b, s, false); }
    return s;
}
template <int NA, int NBC> struct GemmRegs { u32x4 ra[2][NA], rb[2][NBC]; };
template <int BM, int BN, bool ROWNORM, class ARow, class ARowN, class XF, class ST>
DEVI void gemm_tile(GemmRegs<BM / 64, BN / 64>& R, bool primed, ARow arow, const u16* __restrict__ Bt, ARowN arow_n, const u16* __restrict__ Bt_n, int ldb, int K, XF xf, ST st, char* lds, size_t ksA = 64, size_t ksB = 64) {
    constexpr int WN = BN / 64, NA = BM / 64, NBC = BN / 64, STR = 72;
    const int tid = tidx(), lane = tid & 63, w = tid >> 6, wm = w / WN, wn = w % WN, l31 = lane & 31, h = lane >> 5;
    u16* sA = (u16*)lds; u16* sB = sA + 2 * BM * STR;
    const int crow = tid >> 3, kc = tid & 7;
    const u16* pa[NA]; const u16* pb[NBC]; const u16* pan[NA]; const u16* pbn[NBC];
#pragma unroll
    for (int i = 0; i < NA; ++i) { pa[i] = arow(crow + 64 * i) + kc * 8; pan[i] = pa[i]; }
#pragma unroll
    for (int i = 0; i < NBC; ++i) { pb[i] = Bt + (size_t)(crow + 64 * i) * ldb + kc * 8; pbn[i] = pb[i]; }
    const bool chain = Bt_n != nullptr;
    if (chain) {
#pragma unroll
        for (int i = 0; i < NA; ++i) pan[i] = arow_n(crow + 64 * i) + kc * 8;
#pragma unroll
        for (int i = 0; i < NBC; ++i) pbn[i] = Bt_n + (size_t)(crow + 64 * i) * ldb + kc * 8;
    }
    const int nk = K >> 6;
    auto load_tile = [&](int g, auto setc) {
        constexpr int set = decltype(setc)::value;
        if (g < nk) {
#pragma unroll
            for (int i = 0; i < NA; ++i) R.ra[set][i] = *(const u32x4*)(pa[i] + g * ksA);
#pragma unroll
            for (int i = 0; i < NBC; ++i) R.rb[set][i] = *(const u32x4*)(pb[i] + g * ksB);
        } else if (chain && g < nk + 2) {
#pragma unroll
            for (int i = 0; i < NA; ++i) R.ra[set][i] = *(const u32x4*)(pan[i] + (g - nk) * ksA);
#pragma unroll
            for (int i = 0; i < NBC; ++i) R.rb[set][i] = *(const u32x4*)(pbn[i] + (g - nk) * ksB);
        }
    };
    using I0 = std::integral_constant<int, 0>; using I1 = std::integral_constant<int, 1>;
    if (!primed) { load_tile(0, I0{}); load_tile(1, I1{}); }
    f32x16 acc[2][2];
#pragma unroll
    for (int a = 0; a < 2; ++a)
#pragma unroll
        for (int b = 0; b < 2; ++b)
#pragma unroll
            for (int i = 0; i < 16; ++i) acc[a][b][i] = 0.f;
    float ss[2] = {0.f, 0.f};
#pragma unroll
    for (int i = 0; i < NA; ++i) *(u32x4*)(sA + (crow + 64 * i) * STR + kc * 8) = R.ra[0][i];
#pragma unroll
    for (int i = 0; i < NBC; ++i) *(u32x4*)(sB + (crow + 64 * i) * STR + kc * 8) = R.rb[0][i];
    lds_barrier();
    load_tile(2, I0{});
    auto ktile = [&](int kt, auto curc) {
        constexpr int cur = decltype(curc)::value, nxt = cur ^ 1;
        const u16* a_ = sA + cur * BM * STR; const u16* b_ = sB + cur * BN * STR;
        u16* an = sA + nxt * BM * STR; u16* bn = sB + nxt * BN * STR;
#pragma unroll
        for (int ks = 0; ks < 4; ++ks) {
            bf16x8 af[2], bfr[2];
#pragma unroll
            for (int mi = 0; mi < 2; ++mi) af[mi] = *(const bf16x8*)(a_ + (wm * 64 + mi * 32 + l31) * STR + ks * 16 + h * 8);
#pragma unroll
            for (int ni = 0; ni < 2; ++ni) bfr[ni] = *(const bf16x8*)(b_ + (wn * 64 + ni * 32 + l31) * STR + ks * 16 + h * 8);
            if (ROWNORM) { ss[0] += sumsq8(af[0]); ss[1] += sumsq8(af[1]); }
#pragma unroll
            for (int mi = 0; mi < 2; ++mi)
#pragma unroll
                for (int ni = 0; ni < 2; ++ni) acc[mi][ni] = __builtin_amdgcn_mfma_f32_32x32x16_bf16(bfr[ni], af[mi], acc[mi][ni], 0, 0, 0);
            if (ks == 1 && kt + 1 < nk) {
#pragma unroll
                for (int i = 0; i < NA; ++i) *(u32x4*)(an + (crow + 64 * i) * STR + kc * 8) = R.ra[nxt][i];
#pragma unroll
                for (int i = 0; i < NBC; ++i) *(u32x4*)(bn + (crow + 64 * i) * STR + kc * 8) = R.rb[nxt][i];
            }
        }
        lds_barrier();
        load_tile(kt + 3, std::integral_constant<int, nxt>{});
    };
    for (int kt = 0; kt < nk; kt += 2) { ktile(kt, I0{}); ktile(kt + 1, I1{}); }
    if (ROWNORM) {
#pragma unroll
        for (int mi = 0; mi < 2; ++mi) {
            float s = ss[mi] + __shfl_xor(ss[mi], 32);
            float r = rsqrtf(s / (float)K + 1e-6f);
#pragma unroll
            for (int ni = 0; ni < 2; ++ni)
#pragma unroll
                for (int i = 0; i < 16; ++i) acc[mi][ni][i] *= r;
        }
    }
    constexpr int PS = 72;
    static_assert(8 * 32 * PS <= (BM >= BN ? BM : BN) * STR, "patches must fit in buffer 0 of the larger operand");
    u16* sP = (BM >= BN ? sA : sB) + w * (32 * PS);
#pragma unroll
    for (int mi = 0; mi < 2; ++mi) {
        xf(wm * 64 + mi * 32 + l31, wn * 64, acc[mi], h);
#pragma unroll
        for (int ni = 0; ni < 2; ++ni)
#pragma unroll
            for (int g = 0; g < 4; ++g) { uint2 v; v.x = pack2(acc[mi][ni][4 * g], acc[mi][ni][4 * g + 1]); v.y = pack2(acc[mi][ni][4 * g + 2], acc[mi][ni][4 * g + 3]);
                *(uint2*)(sP + l31 * PS + ni * 32 + 8 * g + 4 * h) = v; }
        asm volatile("s_waitcnt lgkmcnt(0)" ::: "memory");
        __builtin_amdgcn_wave_barrier();
#pragma unroll
        for (int i = 0; i < 4; ++i) {
            const int rr = 8 * i + (lane >> 3), cc = (lane & 7) * 8;
            const u32x4 v = *(const u32x4*)(sP + rr * PS + cc);
            st(wm * 64 + mi * 32 + rr, wn * 64 + cc, v);
        }
        asm volatile("s_waitcnt lgkmcnt(0)" ::: "memory");
        __builtin_amdgcn_wave_barrier();
    }
    lds_barrier();
}
DEVI void store_tile_bf16(u16* dst, const f32x16& t, int h) {
#pragma unroll
    for (int g = 0; g < 4; ++g) { uint2 v; v.x = pack2(t[4 * g], t[4 * g + 1]); v.y = pack2(t[4 * g + 2], t[4 * g + 3]); *(uint2*)(dst + 8 * g + 4 * h) = v; }
}
DEVI void rope_tile(f32x16& t, int axis, int pp, int h, const float2* __restrict__ tab) {
    if (pp < LC) return;
    const int s = pp - LC; const int coord = axis ? (s & 63) : (s >> 6);
#pragma unroll
    for (int g = 0; g < 2; ++g)
#pragma unroll
        for (int i = 0; i < 4; ++i) {
            const float2 cs = tab[coord * 16 + 8 * g + 4 * h + i];
            const float x1 = t[4 * g + i], x2 = t[4 * (g + 2) + i];
            t[4 * g + i] = x1 * cs.x - x2 * cs.y; t[4 * (g + 2) + i] = x2 * cs.x + x1 * cs.y;
        }
}

struct CJob { const float* src; u16* dst; const float* gain; int K, ldsrc, nlog, nvalid, sseg, sstride, soff, dseg, dstride, doff; int nmat; size_t smat, dmat; int ktiled; };
DEVI void get_job(const Params& p, int j, int layer, CJob& J) {
    char* ws = p.ws;
    J.gain = nullptr; J.ktiled = 0; J.nmat = 1; J.smat = 0; J.dmat = 0; J.sseg = 1 << 30; J.sstride = 0; J.soff = 0; J.dseg = 1 << 30; J.dstride = 0; J.doff = 0;
    auto plain = [&](const float* src, size_t dstoff, int K, int N) { J.src = src; J.dst = (u16*)(ws + dstoff); J.K = K; J.ldsrc = N; J.nlog = N; J.nvalid = N; };
    switch (j) {
    case 0: plain(p.in[I_AWIN], W_IN, 1024, 1472); J.nlog = 1536; break;
    case 1: plain(p.in[I_AWUQ], W_UQ, 384, 768); J.gain = p.in[I_AQN]; break;
    case 2: plain(p.in[I_AWUKV], W_UK, 256, 1024); J.nlog = 512; J.nvalid = 512; J.sseg = 128; J.sstride = 256; J.soff = 0; J.gain = p.in[I_AKVN]; break;
    case 3: plain(p.in[I_AWUKV], W_UV, 256, 1024); J.nlog = 512; J.nvalid = 512; J.sseg = 128; J.sstride = 256; J.soff = 128; J.gain = p.in[I_AKVN]; break;
    case 4: plain(p.in[I_AWO], W_OA, 1024, 1024); break;
    case 5: plain(p.in[I_RWR], W_RR, 1024, 1024); break;
    case 6: plain(p.in[I_RWK], W_RK, 1024, 1024); break;
    case 7: plain(p.in[I_RWV], W_RV, 1024, 1024); break;
    case 8: plain(p.in[I_RWO], W_RO, 1024, 1024); break;
    case 9: plain(p.in[I_RG1], W_G1, 1024, 128); break;
    case 10: plain(p.in[I_RW1], W_W1, 1024, 64); break;
    case 11: plain(p.in[I_RW1] + 1024 * 64, W_W1 + 64 * 1024 * 2, 1024, 64); break;
    case 12: plain(p.in[I_RA1], W_A1, 1024, 64); break;
    case 13: plain(p.in[I_RA1] + 1024 * 64, W_A1 + 64 * 1024 * 2, 1024, 64); break;
    case 14: plain(p.in[I_RG2], W_G2, 128, 1024); break;
    case 15: plain(p.in[I_RW2], W_W2, 64, 1024); break;
    case 16: plain(p.in[I_RW2] + 64 * 1024, W_W2 + 1024 * 64 * 2, 64, 1024); break;
    case 17: plain(p.in[I_RA2], W_A2, 64, 1024); break;
    case 18: plain(p.in[I_RA2] + 64 * 1024, W_A2 + 1024 * 64 * 2, 64, 1024); break;
    case 19: plain(p.in[I_MSG], W_SGU, 1024, 256); J.dseg = 32; J.dstride = 64; J.doff = 0; break;
    case 20: plain(p.in[I_MSU], W_SGU, 1024, 256); J.dseg = 32; J.dstride = 64; J.doff = 32; break;
    case 21: plain(p.in[I_MSG] + 1024 * 256, W_SGU + 1048576, 1024, 256); J.dseg = 32; J.dstride = 64; J.doff = 0; break;
    case 22: plain(p.in[I_MSU] + 1024 * 256, W_SGU + 1048576, 1024, 256); J.dseg = 32; J.dstride = 64; J.doff = 32; break;
    case 23: plain(p.in[I_MSD], W_SD, 256, 1024); J.ktiled = 1; break;
    case 24: plain(p.in[I_MSD] + 256 * 1024, W_SD + 524288, 256, 1024); J.ktiled = 1; break;
    case 25: plain(p.in[I_MWG] + (size_t)layer * 64 * 1024 * 256, OFF_WGU, 1024, 256); J.dseg = 32; J.dstride = 64; J.doff = 0; J.nmat = 64; J.smat = 1024 * 256; J.dmat = 512 * 1024; break;
    case 26: plain(p.in[I_MWU] + (size_t)layer * 64 * 1024 * 256, OFF_WGU, 1024, 256); J.dseg = 32; J.dstride = 64; J.doff = 32; J.nmat = 64; J.smat = 1024 * 256; J.dmat = 512 * 1024; break;
    default: plain(p.in[I_MWD] + (size_t)layer * 64 * 256 * 1024, OFF_WD, 256, 1024); J.nmat = 64; J.smat = 256 * 1024; J.dmat = 1024 * 256; J.ktiled = 1; break;
    }
}
DEVI int job_tiles(const CJob& J) { return J.nmat * (J.nlog / 64) * ((J.K + 127) / 128); }
DEVI void conv_tile(const CJob& J, int t, char* lds) {
    const int ktiles = (J.K + 127) / 128, ntiles = J.nlog / 64;
    const int mat = t / (ktiles * ntiles); const int r = t - mat * ktiles * ntiles; const int nt = r / ktiles, ktile = r - nt * ktiles;
    const float* src = J.src + (size_t)mat * J.smat; u16* dst = J.dst + (size_t)mat * J.dmat;
    unsigned* sm = (unsigned*)lds;
    const int tid = tidx(), ng = tid & 15, kp = tid >> 4;
    const int n0 = nt * 64 + ng * 4;
    const int scol = (n0 / J.sseg) * J.sstride + J.soff + (n0 % J.sseg);
    const bool nval = n0 < J.nvalid;
#pragma unroll
    for (int pass = 0; pass < 2; ++pass) {
        const int k = ktile * 128 + pass * 64 + kp * 2;
        float4 v0 = make_float4(0.f, 0.f, 0.f, 0.f), v1 = v0;
        if (nval && k < J.K) {
            v0 = *(const float4*)(src + (size_t)k * J.ldsrc + scol); v1 = *(const float4*)(src + (size_t)(k + 1) * J.ldsrc + scol);
            if (J.gain) { const float g0 = J.gain[k], g1 = J.gain[k + 1]; v0.x *= g0; v0.y *= g0; v0.z *= g0; v0.w *= g0; v1.x *= g1; v1.y *= g1; v1.z *= g1; v1.w *= g1; }
        }
        const int kk = pass * 32 + kp;
        sm[(ng * 4 + 0) * 66 + kk] = pack2(v0.x, v1.x); sm[(ng * 4 + 1) * 66 + kk] = pack2(v0.y, v1.y);
        sm[(ng * 4 + 2) * 66 + kk] = pack2(v0.z, v1.z); sm[(ng * 4 + 3) * 66 + kk] = pack2(v0.w, v1.w);
    }
    __syncthreads();
#pragma unroll
    for (int i = 0; i < 2; ++i) {
        const int c = tid + 512 * i, row = c >> 4, ch = c & 15;
        const int n = nt * 64 + row; const int drow = (n / J.dseg) * J.dstride + J.doff + (n % J.dseg);
        const int k = ktile * 128 + ch * 8;
        if (k < J.K) { uint2 lo = *(const uint2*)(sm + row * 66 + ch * 4), hi = *(const uint2*)(sm + row * 66 + ch * 4 + 2); uint4 v = make_uint4(lo.x, lo.y, hi.x, hi.y);
            u16* dp = J.ktiled ? dst + ((size_t)(k >> 6) * J.nlog + drow) * 64 + (k & 63) : dst + (size_t)drow * J.K + k; *(uint4*)dp = v; }
    }
    __syncthreads();
}
DEVI void conv_jobs(const Params& p, int jlo, int jhi, int layer, int unit_base, char* lds) {
    const int G = gridDim.x, bid = blockIdx.x;
    int acc = unit_base;
    for (int j = jlo; j < jhi; ++j) {
        CJob J; get_job(p, j, layer, J); const int n = job_tiles(J);
        const int t0 = (bid - (acc % G) + G) % G;
        for (int t = t0; t < n; t += G) conv_tile(J, t, lds);
        acc += n;
    }
}
DEVI void mods_unit(const Params& p, int u, char* lds) {
    const int l = u / 96, cg = u % 96;
    float* sil = (float*)lds;
    float* red = sil + 1024 * 12;
    const int tid = tidx(), lane = tid & 63, w = tid >> 6;
    for (int i = tid; i < 9 * 1024; i += 512) { const int bb = i >> 10, k = i & 1023; const float v = bb < 8 ? p.in[I_C][bb * 1024 + k] : p.in[I_CCTX][k]; sil[k * 12 + bb] = siluf_(v); }
    __syncthreads();
    float acc[9];
#pragma unroll
    for (int i = 0; i < 9; ++i) acc[i] = 0.f;
    const float* wp = p.in[I_ADAW] + (size_t)l * 1024 * 6144 + cg * 64 + lane;
#pragma unroll 4
    for (int kk = 0; kk < 128; ++kk) {
        const int k = w * 128 + kk; const float wv = wp[(size_t)k * 6144];
        const float4 s0 = *(const float4*)(sil + k * 12), s1 = *(const float4*)(sil + k * 12 + 4); const float s2 = sil[k * 12 + 8];
        acc[0] += s0.x * wv; acc[1] += s0.y * wv; acc[2] += s0.z * wv; acc[3] += s0.w * wv; acc[4] += s1.x * wv; acc[5] += s1.y * wv; acc[6] += s1.z * wv; acc[7] += s1.w * wv; acc[8] += s2 * wv;
    }
#pragma unroll
    for (int i = 0; i < 9; ++i) red[(w * 9 + i) * 64 + lane] = acc[i];
    __syncthreads();
    for (int i = tid; i < 9 * 64; i += 512) {
        const int bb = i >> 6, c = i & 63; float s = 0.f;
        for (int ww = 0; ww < 8; ++ww) s += red[(ww * 9 + bb) * 64 + c];
        const int col = cg * 64 + c;
        ((float*)(p.ws + OFF_MODS))[(size_t)(l * 9 + bb) * 6144 + col] = s + p.in[I_ADAB][l * 6144 + col];
    }
    __syncthreads();
}
DEVI void phase_prologue(const Params& p, char* lds) {
    const int bid = blockIdx.x, G = gridDim.x;
    if (bid == G - 1) {
        int* cnt = (int*)(p.ws + OFF_CNT);
        for (int i = tidx(); i < 2 * NCHUNK * 64; i += 512) cnt[i] = 0;
        float2* tab = (float2*)(p.ws + OFF_ROPE);
        for (int i = tidx(); i < 64 * 16; i += 512) { const int coord = i >> 4, f = i & 15; const float inv = exp2f(-(float)f * (13.287712379549449f / 16.f)); const float a = (float)coord * inv; tab[i] = make_float2(cosf(a), sinf(a)); }
    }
    {
        u16* wro = (u16*)(p.ws + OFF_WROUT);
        for (int i = bid * 512 + tidx(); i < 2 * 1024 * 64; i += G * 512) {
            const int l = i >> 16, k = (i >> 6) & 1023, e = i & 63;
            const float wv = p.in[I_MROUT][i]; const u16 hi = (u16)pack2(wv, 0.f); const u16 lo = (u16)pack2(wv - bf1(hi), 0.f);
            u16* row = wro + ((size_t)l * 64 + e) * 3072; row[k] = hi; row[1024 + k] = hi; row[2048 + k] = lo;
        }
    }
    for (int u = bid; u < 192; u += G) mods_unit(p, u, lds);
    conv_jobs(p, 0, 25, 0, 192, lds);
}

DEVI void norm_rows(const RowSrc& src, int mode, int nrows, const float* __restrict__ gain, const float* __restrict__ mods_l, int ishift, int iscale, u16* __restrict__ dst) {
    const int lane = tidx() & 63, w = tidx() >> 6;
    for (int r = blockIdx.x * 8 + w; r < nrows; r += gridDim.x * 8) {
        int bb; const float* xr = row_ptr(src, mode, r, bb);
        float4 v[4]; float ss = 0.f;
#pragma unroll
        for (int i = 0; i < 4; ++i) { v[i] = ((const float4*)xr)[lane + 64 * i]; ss += v[i].x * v[i].x + v[i].y * v[i].y + v[i].z * v[i].z + v[i].w * v[i].w; }
        ss = wave_sum(ss);
        const float rs = rsqrtf(ss * (1.f / 1024.f) + 1e-6f);
        const float* msh = mods_l + (size_t)bb * 6144 + ishift * 1024; const float* msc = mods_l + (size_t)bb * 6144 + iscale * 1024;
#pragma unroll
        for (int i = 0; i < 4; ++i) {
            const int c = (lane + 64 * i) * 4;
            const float4 g = *(const float4*)(gain + c), sh = *(const float4*)(msh + c), sc = *(const float4*)(msc + c);
            uint2 o; o.x = pack2(v[i].x * rs * g.x * (1.f + sc.x) + sh.x, v[i].y * rs * g.y * (1.f + sc.y) + sh.y);
            o.y = pack2(v[i].z * rs * g.z * (1.f + sc.z) + sh.z, v[i].w * rs * g.w * (1.f + sc.w) + sh.w);
            *(uint2*)(dst + (size_t)r * DM + c) = o;
        }
    }
}

DEVI void phase_gemm_win(const Params& p, char* lds) {
    const u16* A = (const u16*)(p.ws + A_N0); const u16* W = (const u16*)(p.ws + W_IN);
    u16* CQ = (u16*)(p.ws + A_CQ); u16* CKV = (u16*)(p.ws + A_CKV); u16* KA = (u16*)(p.ws + A_KA); u16* QS = (u16*)(p.ws + A_QS); u16* KS = (u16*)(p.ws + A_KS); u16* VS = (u16*)(p.ws + A_VS);
    const float2* tab = (const float2*)(p.ws + OFF_ROPE);
    const int NT = 12, MT = T0 / 256;
    GemmRegs<4, 2> R; bool primed = false;
    for (int uu = blockIdx.x; uu < ((NT * MT + 255) & ~255); uu += gridDim.x) {
        const int u = swz(uu); if (u >= NT * MT) continue;
        const int mt = u / NT, nt = u % NT; const int m0 = mt * 256, n0 = nt * 128;
        const int un = (uu + (int)gridDim.x < ((NT * MT + 255) & ~255)) ? swz(uu + gridDim.x) : NT * MT; const bool hasn = un < NT * MT;
        const int m0n = (un / NT) * 256, n0n = (un % NT) * 128;
        auto arow = [&](int r) { return A + (size_t)(m0 + r) * DM; };
        auto arow_n = [&](int r) { return A + (size_t)(m0n + r) * DM; };
        auto xf = [&](int r, int cw, f32x16 (&t)[2], int h) {
            const int row = m0 + r; const int b = row / LT, pp = row - b * LT;
#pragma unroll
            for (int ni = 0; ni < 2; ++ni) {
                const int c32 = n0 + cw + ni * 32;
                if (c32 >= 640 && c32 < 1344) {
                    const int cc = c32 - 640; rope_tile(t[ni], (cc >> 5) & 1, pp, h, tab);
                    if (c32 >= 704 && c32 < 1216) {
#pragma unroll
                        for (int i = 0; i < 16; ++i) t[ni][i] *= QS_SCALE;
                    }
                }
            }
        };
        auto st = [&](int r, int c8, u32x4 v) {
            const int row = m0 + r; const int b = row / LT, pp = row - b * LT; const int c = n0 + c8;
            if (c < 384) *(u32x4*)(CQ + (size_t)row * 384 + c) = v;
            else if (c < 640) *(u32x4*)(CKV + (size_t)row * 256 + (c - 384)) = v;
            else if (c < 704) { for (int hd = 0; hd < 4; ++hd) *(u32x4*)(KA + ((size_t)(b * 4 + hd) * LT + pp) * 192 + 128 + (c - 640)) = v; }
            else if (c < 1216) { const int cc = c - 704; *(u32x4*)(QS + ((size_t)(b * 8 + (cc >> 6)) * LT + pp) * 64 + (cc & 63)) = v; }
            else if (c < 1344) { const int cc = c - 1216; *(u32x4*)(KS + ((size_t)(b * 2 + (cc >> 6)) * LT + pp) * 64 + (cc & 63)) = v; }
            else if (c < 1472) { const int cc = c - 1344; *(u32x4*)(VS + ((size_t)(b * 2 + (cc >> 6)) * LT + pp) * 64 + (cc & 63)) = v; }
        };
        gemm_tile<256, 128, false>(R, primed, arow, W + (size_t)n0 * DM, arow_n, hasn ? W + (size_t)n0n * DM : nullptr, DM, DM, xf, st, lds); primed = hasn;
    }
}
DEVI void phase_gemm_qkv(const Params& p, char* lds) {
    const u16* CQ = (const u16*)(p.ws + A_CQ); const u16* CKV = (const u16*)(p.ws + A_CKV);
    u16* QA = (u16*)(p.ws + A_QA); u16* KA = (u16*)(p.ws + A_KA); u16* VA = (u16*)(p.ws + A_VA);
    const float2* tab = (const float2*)(p.ws + OFF_ROPE);
    const int MT = T0 / 256;
    for (int uu = blockIdx.x; uu < ((14 * MT + 255) & ~255); uu += gridDim.x) {
        const int u = swz(uu); if (u >= 14 * MT) continue;
        const int mt = u / 14, j = u % 14; const int m0 = mt * 256;
        if (j < 6) {
            const int n0 = j * 128;
            auto arow = [&](int r) { return CQ + (size_t)(m0 + r) * 384; };
            auto xf = [&](int r, int cw, f32x16 (&t)[2], int h) {
                const int row = m0 + r; const int pp = row % LT;
#pragma unroll
                for (int ni = 0; ni < 2; ++ni) {
                    const int c32 = n0 + cw + ni * 32; const int wi = c32 % 192;
                    if (wi >= 128) rope_tile(t[ni], (wi - 128) >> 5, pp, h, tab);
#pragma unroll
                    for (int i = 0; i < 16; ++i) t[ni][i] *= QA_SCALE;
                }
            };
            auto st = [&](int r, int c8, u32x4 v) {
                const int row = m0 + r; const int b = row / LT, pp = row - b * LT; const int c = n0 + c8; const int hd = c / 192, wi = c - hd * 192;
                *(u32x4*)(QA + ((size_t)(b * 4 + hd) * LT + pp) * 192 + wi) = v;
            };
            GemmRegs<4, 2> R; gemm_tile<256, 128, true>(R, false, arow, (const u16*)(p.ws + W_UQ) + (size_t)n0 * 384, arow, (const u16*)nullptr, 384, 384, xf, st, lds);
        } else {
            const bool isv = j >= 10; const int n0 = (isv ? j - 10 : j - 6) * 128;
            auto arow = [&](int r) { return CKV + (size_t)(m0 + r) * 256; };
            auto xf = [&](int, int, f32x16 (&)[2], int) {};
            auto st = [&](int r, int c8, u32x4 v) {
                const int row = m0 + r; const int b = row / LT, pp = row - b * LT; const int c = n0 + c8; const int hd = c >> 7, wi = c & 127;
                if (isv) *(u32x4*)(VA + ((size_t)(b * 4 + hd) * LT + pp) * 128 + wi) = v;
                else *(u32x4*)(KA + ((size_t)(b * 4 + hd) * LT + pp) * 192 + wi) = v;
            };
            GemmRegs<4, 2> R; gemm_tile<256, 128, true>(R, false, arow, (const u16*)(p.ws + (isv ? W_UV : W_UK)) + (size_t)n0 * 256, arow, (const u16*)nullptr, 256, 256, xf, st, lds);
        }
    }
}

template <int DQK, int DV, bool SWA>
DEVI void attn_unit(const u16* __restrict__ Q, const u16* __restrict__ Kp, const u16* __restrict__ Vp, int q0, int a0, int na, int b0, int nb2,
                    float m_init, u16* __restrict__ outp  , char* lds) {
    constexpr int KSTR = DQK + 8, VSTR = DV + 32, KCH = DQK / 8, VCH = DV / 8, NKC = 64 * KCH / 512, NVC = 64 * VCH / 512, NS = DQK / 16, NDT = DV / 32;
    const int tid = tidx(), lane = tid & 63, w = tid >> 6, l31 = lane & 31, h = lane >> 5;
    u16* sK = (u16*)lds; u16* sV = sK + 2 * 64 * KSTR;
    const int qpos = q0 + w * 32 + l31;
    bf16x8 qf[NS];
#pragma unroll
    for (int s = 0; s < NS; ++s) qf[s] = *(const bf16x8*)(Q + (size_t)qpos * DQK + s * 16 + h * 8);
    f32x16 o[NDT];
#pragma unroll
    for (int d = 0; d < NDT; ++d)
#pragma unroll
        for (int i = 0; i < 16; ++i) o[d][i] = 0.f;
    float m = m_init, lsum = 0.f;
    const int nt = na + nb2;
    u32x4 rk[NKC], rv[NVC];
    auto tile_pos = [&](int t) { return t < na ? a0 + 64 * t : b0 + 64 * (t - na); };
    auto gload = [&](int t) {
        const int kp0 = tile_pos(t);
        const u16* kb_ = Kp + (size_t)kp0 * DQK + tid * 8; const u16* vb_ = Vp + (size_t)kp0 * DV + tid * 8;
#pragma unroll
        for (int i = 0; i < NKC; ++i) rk[i] = *(const u32x4*)(kb_ + 4096 * i);
#pragma unroll
        for (int i = 0; i < NVC; ++i) rv[i] = *(const u32x4*)(vb_ + 4096 * i);
    };
    gload(0);
    const int tr_row = 4 * h + ((lane & 15) >> 2), tr_col = 16 * ((lane >> 4) & 1) + 4 * (lane & 3);
    for (int t = 0; t < nt; ++t) {
        u16* k_ = sK + (t & 1) * 64 * KSTR; u16* v_ = sV + (t & 1) * 64 * VSTR;
#pragma unroll
        for (int i = 0; i < NKC; ++i) { const int c = tid + 512 * i, row = c / KCH, ch = c % KCH; *(u32x4*)(k_ + row * KSTR + ch * 8) = rk[i]; }
#pragma unroll
        for (int i = 0; i < NVC; ++i) { const int c = tid + 512 * i, row = c / VCH, ch = c % VCH; *(u32x4*)(v_ + row * VSTR + ch * 8) = rv[i]; }
        __syncthreads();
        if (t + 1 < nt) gload(t + 1);
        f32x16 st[2];
#pragma unroll
        for (int k2 = 0; k2 < 2; ++k2) {
#pragma unroll
            for (int i = 0; i < 16; ++i) st[k2][i] = 0.f;
#pragma unroll
            for (int s = 0; s < NS; ++s) {
                const bf16x8 kf = *(const bf16x8*)(k_ + (k2 * 32 + l31) * KSTR + s * 16 + h * 8);
                st[k2] = __builtin_amdgcn_mfma_f32_32x32x16_bf16(kf, qf[s], st[k2], 0, 0, 0);
            }
        }
        __builtin_amdgcn_sched_barrier(0);
        if (SWA && t >= na) {
            const int kp0 = tile_pos(t);
#pragma unroll
            for (int k2 = 0; k2 < 2; ++k2)
#pragma unroll
                for (int i = 0; i < 16; ++i) {
                    const int key = kp0 + k2 * 32 + (i & 3) + 8 * (i >> 2) + 4 * h; const int d = qpos - key;
                    if (d > 128 || d < -128) st[k2][i] = -1e30f;
                }
        }
        float mx = st[0][0];
#pragma unroll
        for (int k2 = 0; k2 < 2; ++k2)
#pragma unroll
            for (int i = 0; i < 16; ++i) mx = fmaxf(mx, st[k2][i]);
        mx = fmaxf(mx, xhalf(mx));
        const float mn = fmaxf(m, mx); const float alpha = __builtin_amdgcn_exp2f(m - mn); m = mn;
        float ps = 0.f;
#pragma unroll
        for (int k2 = 0; k2 < 2; ++k2)
#pragma unroll
            for (int i = 0; i < 16; ++i) { const float pv = __builtin_amdgcn_exp2f(st[k2][i] - mn); st[k2][i] = pv; ps += pv; }
        lsum = lsum * alpha + ps;
#pragma unroll
        for (int d = 0; d < NDT; ++d)
#pragma unroll
            for (int i = 0; i < 16; ++i) o[d][i] *= alpha;
#pragma unroll
        for (int s16 = 0; s16 < 4; ++s16) {
            __builtin_amdgcn_sched_barrier(0);
            bf16x8 pf; unsigned* pu = (unsigned*)&pf;
#pragma unroll
            for (int jj = 0; jj < 4; ++jj) pu[jj] = pack2(st[s16 >> 1][8 * (s16 & 1) + 2 * jj], st[s16 >> 1][8 * (s16 & 1) + 2 * jj + 1]);
#pragma unroll
            for (int d = 0; d < NDT; ++d) {
                const u16* base = v_ + (16 * s16 + tr_row) * VSTR + d * 32 + tr_col;
                const s16x4 lo = __builtin_amdgcn_ds_read_tr16_b64_v4i16((LAS s16x4*)(base));
                const s16x4 hi = __builtin_amdgcn_ds_read_tr16_b64_v4i16((LAS s16x4*)(base + 8 * VSTR));
                bf16x8 vf; vf[0] = lo[0]; vf[1] = lo[1]; vf[2] = lo[2]; vf[3] = lo[3]; vf[4] = hi[0]; vf[5] = hi[1]; vf[6] = hi[2]; vf[7] = hi[3];
                o[d] = __builtin_amdgcn_mfma_f32_32x32x16_bf16(vf, pf, o[d], 0, 0, 0);
            }
        }
    }
    float lt = lsum + xhalf(lsum);
    if (SWA) lt += __builtin_amdgcn_exp2f(m_init - m);
    const float inv = 1.f / lt;
    u16* orow = outp + (size_t)qpos * DM;
#pragma unroll
    for (int d = 0; d < NDT; ++d)
#pragma unroll
        for (int g = 0; g < 4; ++g) { uint2 v; v.x = pack2(o[d][4 * g] * inv, o[d][4 * g + 1] * inv); v.y = pack2(o[d][4 * g + 2] * inv, o[d][4 * g + 3] * inv); *(uint2*)(orow + d * 32 + 8 * g + 4 * h) = v; }
    __syncthreads();
}
DEVI void phase_attention(const Params& p, char* lds) {
    const u16* QA = (const u16*)(p.ws + A_QA); const u16* KA = (const u16*)(p.ws + A_KA); const u16* VA = (const u16*)(p.ws + A_VA);
    const u16* QS = (const u16*)(p.ws + A_QS); const u16* KS = (const u16*)(p.ws + A_KS); const u16* VS = (const u16*)(p.ws + A_VS);
    u16* mix = (u16*)(p.ws + A_N0);
    for (int uu = blockIdx.x; uu < 1792; uu += gridDim.x) {
        const int u = swz(uu); if (u >= 1632) continue;
        if (u < 544) {
            int b, hd, q0, na;
            if (u < 512) { b = u >> 6; hd = (u >> 4) & 3; q0 = LC + (u & 15) * 256; na = 68; }
            else { const int v = u - 512; b = v >> 2; hd = v & 3; q0 = 0; na = 4; }
            const size_t bh = (size_t)(b * 4 + hd) * LT;
            attn_unit<192, 128, false>(QA + bh * 192, KA + bh * 192, VA + bh * 128, q0, 0, na, 0, 0, -1e30f, mix + (size_t)b * LT * DM + hd * 128, lds);
        } else {
            int b, hd, q0, b0 = 0, nb2 = 0;
            if (u < 1568) { const int v = u - 544; b = v >> 7; hd = (v >> 4) & 7; const int s0 = (v & 15) * 256; q0 = LC + s0;
                int lo = s0 - 128; if (lo < 0) lo = 0; int hi = s0 + 256 + 128; if (hi > SEQ) hi = SEQ; b0 = LC + lo; nb2 = (hi - lo) >> 6; }
            else { const int v = u - 1568; b = v >> 3; hd = v & 7; q0 = 0; }
            const int kvh = hd >> 2; const size_t qb = (size_t)(b * 8 + hd) * LT, kb = (size_t)(b * 2 + kvh) * LT;
            attn_unit<64, 64, true>(QS + qb * 64, KS + kb * 64, VS + kb * 64, q0, 0, 4, b0, nb2, p.in[I_ASINK][hd] * LOG2E, mix + (size_t)b * LT * DM + 512 + hd * 64, lds);
        }
    }
}
DEVI void phase_gemm_wo(const Params& p, const u16* A, const u16* W, const RowSrc& resid, int mode, int layer, char* lds) {
    float* XC = (float*)(p.ws + OFF_XC); float* XL = p.out;
    const float* mods_l = (const float*)(p.ws + OFF_MODS) + (size_t)layer * 9 * 6144;
    const int MT = (mode == 0 ? T0 : TL) / 256;
    GemmRegs<4, 2> R; bool primed = false;
    for (int uu = blockIdx.x; uu < ((8 * MT + 255) & ~255); uu += gridDim.x) {
        const int u = swz(uu); if (u >= 8 * MT) continue;
        const int mt = u >> 3, nt = u & 7; const int m0 = mt * 256, n0 = nt * 128;
        const int un = (uu + (int)gridDim.x < ((8 * MT + 255) & ~255)) ? swz(uu + gridDim.x) : 8 * MT; const bool hasn = un < 8 * MT;
        const int m0n = (un >> 3) * 256, n0n = (un & 7) * 128;
        auto arow = [&](int r) { return A + (size_t)(m0 + r) * DM; };
        auto arow_n = [&](int r) { return A + (size_t)(m0n + r) * DM; };
        auto xf = [&](int, int, f32x16 (&)[2], int) {};
        auto st = [&](int r, int c8, u32x4 v) {
            int bb; const float* rs = row_ptr(resid, mode, m0 + r, bb); int bb2; float* xo = row_ptr_w(XC, XL, mode, m0 + r, bb2);
            const float* mg = mods_l + (size_t)bb * 6144 + 2 * 1024; const int c = n0 + c8;
            const float4 r0 = *(const float4*)(rs + c), r1 = *(const float4*)(rs + c + 4), g0 = *(const float4*)(mg + c), g1 = *(const float4*)(mg + c + 4);
            float4 o0, o1;
            o0.x = r0.x + g0.x * bf_lo(v[0]); o0.y = r0.y + g0.y * bf_hi(v[0]); o0.z = r0.z + g0.z * bf_lo(v[1]); o0.w = r0.w + g0.w * bf_hi(v[1]);
            o1.x = r1.x + g1.x * bf_lo(v[2]); o1.y = r1.y + g1.y * bf_hi(v[2]); o1.z = r1.z + g1.z * bf_lo(v[3]); o1.w = r1.w + g1.w * bf_hi(v[3]);
            *(float4*)(xo + c) = o0; *(float4*)(xo + c + 4) = o1;
        };
        gemm_tile<256, 128, false>(R, primed, arow, W + (size_t)n0 * DM, arow_n, hasn ? W + (size_t)n0n * DM : nullptr, DM, DM, xf, st, lds); primed = hasn;
    }
}

DEVI void phase_moe_norm(const Params& p, int layer) {
    const int mode = layer == 0 ? 0 : 1; const int ntok = layer == 0 ? T0 : TL;
    RowSrc src; src.ctx = (const float*)(p.ws + OFF_XC); src.lat = p.out;
    const float* gain = p.in[I_NFFN] + layer * 1024; const float* mods_l = (const float*)(p.ws + OFF_MODS) + (size_t)layer * 9 * 6144;
    u16* n1 = (u16*)(p.ws + M_N1); u16* nlo = (u16*)(p.ws + M_ACT);
    const int lane = tidx() & 63, w = tidx() >> 6;
    for (int r = blockIdx.x * 8 + w; r < ntok; r += gridDim.x * 8) {
        int bb; const float* xr = row_ptr(src, mode, r, bb);
        float4 v[4]; float ss = 0.f;
#pragma unroll
        for (int i = 0; i < 4; ++i) { v[i] = ((const float4*)xr)[lane + 64 * i]; ss += v[i].x * v[i].x + v[i].y * v[i].y + v[i].z * v[i].z + v[i].w * v[i].w; }
        ss = wave_sum(ss);
        const float rs = rsqrtf(ss * (1.f / 1024.f) + 1e-6f);
        const float* msh = mods_l + (size_t)bb * 6144 + 3 * 1024; const float* msc = mods_l + (size_t)bb * 6144 + 4 * 1024;
#pragma unroll
        for (int i = 0; i < 4; ++i) {
            const int c = (lane + 64 * i) * 4;
            const float4 g = *(const float4*)(gain + c), sh = *(const float4*)(msh + c), sc = *(const float4*)(msc + c);
            const float y0 = v[i].x * rs * g.x * (1.f + sc.x) + sh.x, y1 = v[i].y * rs * g.y * (1.f + sc.y) + sh.y, y2 = v[i].z * rs * g.z * (1.f + sc.z) + sh.z, y3 = v[i].w * rs * g.w * (1.f + sc.w) + sh.w;
            uint2 o; o.x = pack2(y0, y1); o.y = pack2(y2, y3);
            *(uint2*)(n1 + (size_t)r * DM + c) = o;
            uint2 ol; ol.x = pack2(y0 - bf_lo(o.x), y1 - bf_hi(o.x)); ol.y = pack2(y2 - bf_lo(o.y), y3 - bf_hi(o.y));
            *(uint2*)(nlo + (size_t)r * DM + c) = ol;
        }
    }
}
DEVI void router_tile(const u16* __restrict__ H, const u16* __restrict__ L, const u16* __restrict__ Wt, int m0, char* lds) {
    constexpr int BM = 256, BN = 128, WN = 2, NA = 4, NBC = 2, STR = 72;
    const int tid = tidx(), lane = tid & 63, w = tid >> 6, wm = w / WN, wn = w % WN, l31 = lane & 31, h = lane >> 5;
    u16* sA = (u16*)lds; u16* sB = sA + 2 * BM * STR;
    const int crow = tid >> 3, kc = tid & 7;
    const u16* ph[NA]; const u16* pl[NA]; const u16* pb[NBC];
#pragma unroll
    for (int i = 0; i < NA; ++i) { ph[i] = H + (size_t)(m0 + crow + 64 * i) * DM + kc * 8; pl[i] = L + (size_t)(m0 + crow + 64 * i) * DM + kc * 8; }
#pragma unroll
    for (int i = 0; i < NBC; ++i) pb[i] = Wt + (size_t)((crow + 64 * i) & 63) * 3072 + kc * 8;
    u32x4 ra[NA], rb[NBC];
    auto gload = [&](int kt) {
        const int seg = kt >> 4, kk = (kt & 15) * 64;
#pragma unroll
        for (int i = 0; i < NA; ++i) ra[i] = *(const u32x4*)((seg == 1 ? pl[i] : ph[i]) + kk);
#pragma unroll
        for (int i = 0; i < NBC; ++i) rb[i] = *(const u32x4*)(pb[i] + kt * 64);
    };
    gload(0);
    f32x16 acc[2][2];
#pragma unroll
    for (int a = 0; a < 2; ++a)
#pragma unroll
        for (int b = 0; b < 2; ++b)
#pragma unroll
            for (int i = 0; i < 16; ++i) acc[a][b][i] = 0.f;
    for (int kt = 0; kt < 48; ++kt) {
        u16* a_ = sA + (kt & 1) * BM * STR; u16* b_ = sB + (kt & 1) * BN * STR;
#pragma unroll
        for (int i = 0; i < NA; ++i) *(u32x4*)(a_ + (crow + 64 * i) * STR + kc * 8) = ra[i];
#pragma unroll
        for (int i = 0; i < NBC; ++i) *(u32x4*)(b_ + (crow + 64 * i) * STR + kc * 8) = rb[i];
        lds_barrier();
        gload(kt + 1 < 48 ? kt + 1 : 47);
#pragma unroll
        for (int ks = 0; ks < 4; ++ks) {
            bf16x8 af[2], bfr[2];
#pragma unroll
            for (int mi = 0; mi < 2; ++mi) af[mi] = *(const bf16x8*)(a_ + (wm * 64 + mi * 32 + l31) * STR + ks * 16 + h * 8);
#pragma unroll
            for (int ni = 0; ni < 2; ++ni) bfr[ni] = *(const bf16x8*)(b_ + (wn * 64 + ni * 32 + l31) * STR + ks * 16 + h * 8);
#pragma unroll
            for (int mi = 0; mi < 2; ++mi)
#pragma unroll
                for (int ni = 0; ni < 2; ++ni) acc[mi][ni] = __builtin_amdgcn_mfma_f32_32x32x16_bf16(bfr[ni], af[mi], acc[mi][ni], 0, 0, 0);
        }
    }
    lds_barrier();
    float* LG = (float*)lds;
    if (wn == 0) {
#pragma unroll
        for (int mi = 0; mi < 2; ++mi)
#pragma unroll
            for (int ni = 0; ni < 2; ++ni)
#pragma unroll
                for (int g = 0; g < 4; ++g)
                    *(float4*)(LG + (wm * 64 + mi * 32 + l31) * 64 + ni * 32 + 8 * g + 4 * h) = make_float4(acc[mi][ni][4 * g], acc[mi][ni][4 * g + 1], acc[mi][ni][4 * g + 2], acc[mi][ni][4 * g + 3]);
    }
    lds_barrier();
}
DEVI void phase_moe_route(const Params& p, int layer, char* lds) {
    const int ntok = layer == 0 ? T0 : TL; const int tc = ntok / NCHUNK;
    const float ebias = p.in[I_MBIAS][layer * 64 + (tidx() & 63)];
    int* cnt = (int*)(p.ws + OFF_CNT) + layer * NCHUNK * 64;
    int* tok_e = (int*)(p.ws + OFF_TOKE); int* tok_r = (int*)(p.ws + OFF_TOKR); int* ltok = (int*)(p.ws + OFF_LTOK); float* lg = (float*)(p.ws + OFF_LG);
    const u16* H = (const u16*)(p.ws + M_N1); const u16* L = (const u16*)(p.ws + M_ACT); const u16* Wt = (const u16*)(p.ws + OFF_WROUT) + (size_t)layer * 64 * 3072;
    const int lane = tidx() & 63, w = tidx() >> 6;
    const float* LG = (const float*)lds;
    for (int u = blockIdx.x; u < ntok / 256; u += gridDim.x) {
        router_tile(H, L, Wt, u * 256, lds);
        for (int j = 0; j < 32; ++j) {
            const int rl = w * 32 + j; const int tok = u * 256 + rl;
            const float lgt = LG[rl * 64 + lane];
            const float score = 1.f / (1.f + expf(-lgt)); const float choice = score + ebias;
            const float m1 = red8_max(choice);
            const unsigned long long bm = __ballot(choice == m1);
            const unsigned gm = (unsigned)(bm >> (lane & 56)) & 0xffu; const int first = __ffs(gm) - 1;
            const float m2 = red8_max(((lane & 7) == first) ? -INFINITY : choice);
            const float gs = m1 + m2;
            int rank = 0;
#pragma unroll
            for (int g2 = 0; g2 < 8; ++g2) { const float og = __shfl(gs, g2 * 8); rank += (og > gs || (og == gs && g2 < (lane >> 3))) ? 1 : 0; }
            float cm = rank < 4 ? choice : -INFINITY;
            unsigned long long sel = 0ull; float ssum = 0.f;
#pragma unroll
            for (int it = 0; it < 6; ++it) {
                const float mxv = wave_max(cm);
                const unsigned long long bmm = __ballot(cm == mxv);
                const int win = __ffsll((long long)bmm) - 1;
                sel |= 1ull << win; ssum += __shfl(score, win);
                if (lane == win) cm = -INFINITY;
            }
            if ((sel >> lane) & 1ull) {
                const int jj = __popcll(sel & ((1ull << lane) - 1ull));
                const int ch = tok / tc; const int rk = atomicAdd(&cnt[ch * 64 + lane], 1);
                tok_e[tok * 6 + jj] = lane; tok_r[tok * 6 + jj] = rk;
                ltok[((size_t)ch * 64 + lane) * tc + rk] = tok; lg[((size_t)ch * 64 + lane) * tc + rk] = 2.5f * score / ssum;
            }
        }
        lds_barrier();
    }
}
struct SegTab { int* cnt; int* off; int* tpre; };
DEVI SegTab build_segtab(const Params& p, int layer, int tc, char* lds_tab) {
    SegTab T; T.cnt = (int*)lds_tab; T.off = T.cnt + 264; T.tpre = T.off + 264;
    const int* cnt = (const int*)(p.ws + OFF_CNT) + layer * NCHUNK * 64;
    const int tid = tidx();
    if (tid < 260) { const int ch = tid / 65, e = tid % 65; T.cnt[tid] = e < 64 ? cnt[ch * 64 + e] : tc; }
    __syncthreads();
    if (tid < 64) {
        int lc[5], lt_[5]; int sc = 0, st = 0;
#pragma unroll
        for (int j = 0; j < 5; ++j) { const int s = 5 * tid + j; const int v = s < 260 ? T.cnt[s] : 0; lc[j] = sc; lt_[j] = st; sc += v; st += (v + 127) >> 7; }
        int ic = sc, it = st;
        for (int o = 1; o < 64; o <<= 1) { const int a = __shfl_up(ic, o), b2 = __shfl_up(it, o); if (tid >= o) { ic += a; it += b2; } }
        const int bc = ic - sc, bt = it - st;
#pragma unroll
        for (int j = 0; j < 5; ++j) { const int s = 5 * tid + j; if (s <= 260) { T.tpre[s] = bt + lt_[j]; T.off[s] = bc + lc[j]; } }
    }
    __syncthreads();
    return T;
}
DEVI int find_seg(const SegTab& T, int lo_seg, int hi_seg, int mt) {
    int lo = lo_seg, hi = hi_seg;
    while (hi - lo > 1) { const int mid = (lo + hi) >> 1; if (T.tpre[mid] <= mt) lo = mid; else hi = mid; }
    return lo;
}
DEVI void phase_moe_gemm1(const Params& p, int layer, char* lds) {
    const int ntok = layer == 0 ? T0 : TL; const int tc = ntok / NCHUNK;
    char* tabmem = lds + 110592; SegTab T = build_segtab(p, layer, tc, tabmem);
    const u16* n1 = (const u16*)(p.ws + M_N1); u16* act = (u16*)(p.ws + M_ACT);
    const int* ltok = (const int*)(p.ws + OFF_LTOK); const float* lg = (const float*)(p.ws + OFF_LG);
    const int nunits = T.tpre[260] * 2;
    GemmRegs<2, 4> R; bool primed = false;
    for (int uu = blockIdx.x; uu < ((nunits + 255) & ~255); uu += gridDim.x) {
        const int u = swz(uu); if (u >= nunits) continue;
        const int mt = u >> 1, nt = u & 1; const int seg = find_seg(T, 0, 260, mt); const int ch = seg / 65, e = seg % 65;
        const int un = (uu + (int)gridDim.x < ((nunits + 255) & ~255)) ? swz(uu + gridDim.x) : nunits; const bool hasn = un < nunits;
        const int mtn = hasn ? un >> 1 : mt; const int segn = find_seg(T, 0, 260, mtn); const int chn = segn / 65, en = segn % 65;
        const int cntn = T.cnt[segn], row0n = (mtn - T.tpre[segn]) * 128; const int* ltn = ltok + ((size_t)chn * 64 + en) * tc;
        const u16* Wn = en < 64 ? (const u16*)(p.ws + OFF_WGU) + (size_t)en * 512 * 1024 : (const u16*)(p.ws + W_SGU) + (size_t)layer * 512 * 1024;
        auto arow_n = [&](int r) { int s2 = row0n + r; if (s2 >= cntn) s2 = cntn - 1; const int tok = en < 64 ? ltn[s2] : chn * tc + s2; return n1 + (size_t)tok * DM; };
        const int cntv = T.cnt[seg], row0 = (mt - T.tpre[seg]) * 128; const int n0 = nt * 256;
        const int* lt = ltok + ((size_t)ch * 64 + e) * tc; const float* lgp = lg + ((size_t)ch * 64 + e) * tc;
        const u16* W = e < 64 ? (const u16*)(p.ws + OFF_WGU) + (size_t)e * 512 * 1024 : (const u16*)(p.ws + W_SGU) + (size_t)layer * 512 * 1024;
        auto arow = [&](int r) { int s = row0 + r; if (s >= cntv) s = cntv - 1; const int tok = e < 64 ? lt[s] : ch * tc + s; return n1 + (size_t)tok * DM; };
        const size_t arow0 = (size_t)ch * 7 * tc + (T.off[seg] - T.off[ch * 65]) + row0;
        auto xf = [&](int r, int cw, f32x16 (&t)[2], int h) {
            int s2 = row0 + r; if (s2 >= cntv) s2 = cntv - 1;
            const float gw = e < 64 ? lgp[s2] : 1.f;
#pragma unroll
            for (int i = 0; i < 16; ++i) { const float gt = t[0][i], up = t[1][i]; t[0][i] = gt / (1.f + __expf(-gt)) * up * gw; }
        };
        auto st = [&](int r, int c8, u32x4 v) {
            if (row0 + r >= cntv || (c8 & 32)) return;
            const int ac = ((n0 + (c8 & ~63)) >> 1) + (c8 & 31);
            *(u32x4*)(act + ((size_t)(ac >> 6) * (7 * (size_t)ntok) + arow0 + r) * 64 + (ac & 63)) = v;
        };
        gemm_tile<128, 256, false>(R, primed, arow, W + (size_t)n0 * DM, arow_n, hasn ? Wn + (size_t)((un & 1) * 256) * DM : nullptr, DM, DM, xf, st, lds); primed = hasn;
    }
}
DEVI void phase_moe_g2c(const Params& p, int layer, int chg, int chc, char* lds) {
    const int mode = layer == 0 ? 0 : 1; const int ntok = layer == 0 ? T0 : TL; const int tc = ntok / NCHUNK;
    char* tabmem = lds + 110592; SegTab T = build_segtab(p, layer, tc, tabmem);
    const u16* act = (const u16*)(p.ws + M_ACT);
    const int* tok_e = (const int*)(p.ws + OFF_TOKE); const int* tok_r = (const int*)(p.ws + OFF_TOKR);
    float* XC = (float*)(p.ws + OFF_XC); float* XL = p.out;
    const float* mods_l = (const float*)(p.ws + OFF_MODS) + (size_t)layer * 9 * 6144;
    const int lane = tidx() & 63, w = tidx() >> 6;
    int nunits = 0, t_lo = 0;
    if (chg >= 0) { t_lo = T.tpre[chg * 65]; nunits = (T.tpre[chg * 65 + 65] - t_lo) * 4; }
    const int G = gridDim.x; const int nround = (nunits + G - 1) / G;
    const int rho = (G & 7) ? (int)blockIdx.x : ((int)blockIdx.x & 7) * (G >> 3) + ((int)blockIdx.x >> 3); const int ubeg = rho * nround;
    int my_units = nunits - ubeg; if (my_units > nround) my_units = nround; if (my_units < 0) my_units = 0;
    const int crounds = chc >= 0 ? (tc + G * 8 - 1) / (G * 8) : 0;
    int cdone = 0;
    auto combine_rounds = [&](int upto) {
        const u16* outr = (const u16*)(p.ws + M_OUTR + (size_t)(chc & 1) * SZ_OUTR);
        for (; cdone < upto; ++cdone) {
            const int tl = (cdone * G + (int)blockIdx.x) * 8 + w; if (tl >= tc) continue;
            const int tok = chc * tc + tl; int bb; float* xr = row_ptr_w(XC, XL, mode, tok, bb);
            const float* mg = mods_l + (size_t)bb * 6144 + 5 * 1024;
            int rows[7];
#pragma unroll
            for (int j = 0; j < 6; ++j) rows[j] = T.off[chc * 65 + tok_e[tok * 6 + j]] - T.off[chc * 65] + tok_r[tok * 6 + j];
            rows[6] = 6 * tc + tl;
            float4 xs[2][2]; float fss = 0.f;
#pragma unroll
            for (int i = 0; i < 2; ++i) {
                const int c = (lane + 64 * i) * 8;
                float acc[8];
#pragma unroll
                for (int q = 0; q < 8; ++q) acc[q] = 0.f;
#pragma unroll
                for (int j = 0; j < 7; ++j) {
                    const uint4 v = *(const uint4*)(outr + (size_t)rows[j] * DM + c);
                    acc[0] += bf_lo(v.x); acc[1] += bf_hi(v.x); acc[2] += bf_lo(v.y); acc[3] += bf_hi(v.y); acc[4] += bf_lo(v.z); acc[5] += bf_hi(v.z); acc[6] += bf_lo(v.w); acc[7] += bf_hi(v.w);
                }
                float4 x0 = *(float4*)(xr + c), x1 = *(float4*)(xr + c + 4); const float4 g0 = *(const float4*)(mg + c), g1 = *(const float4*)(mg + c + 4);
                x0.x += g0.x * acc[0]; x0.y += g0.y * acc[1]; x0.z += g0.z * acc[2]; x0.w += g0.w * acc[3]; x1.x += g1.x * acc[4]; x1.y += g1.y * acc[5]; x1.z += g1.z * acc[6]; x1.w += g1.w * acc[7];
                xs[i][0] = x0; xs[i][1] = x1;
                fss += x0.x * x0.x + x0.y * x0.y + x0.z * x0.z + x0.w * x0.w + x1.x * x1.x + x1.y * x1.y + x1.z * x1.z + x1.w * x1.w;
            }
            if (layer == 1) {
                fss = wave_sum(fss); const float rs = rsqrtf(fss * (1.f / 1024.f) + 1e-6f); const float* gf = p.in[I_NFIN];
#pragma unroll
                for (int i = 0; i < 2; ++i) { const int c = (lane + 64 * i) * 8; const float4 f0 = *(const float4*)(gf + c), f1 = *(const float4*)(gf + c + 4);
                    xs[i][0].x *= rs * f0.x; xs[i][0].y *= rs * f0.y; xs[i][0].z *= rs * f0.z; xs[i][0].w *= rs * f0.w; xs[i][1].x *= rs * f1.x; xs[i][1].y *= rs * f1.y; xs[i][1].z *= rs * f1.z; xs[i][1].w *= rs * f1.w; }
            }
#pragma unroll
            for (int i = 0; i < 2; ++i) { const int c = (lane + 64 * i) * 8; *(float4*)(xr + c) = xs[i][0]; *(float4*)(xr + c + 4) = xs[i][1]; }
        }
    };
    int ui = 0;
    GemmRegs<2, 4> R; bool primed = false;
    for (int u = ubeg; u < ubeg + my_units; ++u) {
        u16* outw = (u16*)(p.ws + M_OUTR + (size_t)(chg & 1) * SZ_OUTR);
        const int mt = t_lo + (u >> 2), nt = u & 3; const int seg = find_seg(T, chg * 65, chg * 65 + 65, mt); const int e = seg % 65;
        const int un = u + 1; const bool hasn = un < ubeg + my_units;
        const int mtn = hasn ? t_lo + (un >> 2) : mt; const int segn = find_seg(T, chg * 65, chg * 65 + 65, mtn); const int en = segn % 65;
        const int cntn = T.cnt[segn], row0n = (mtn - T.tpre[segn]) * 128;
        const u16* An = act + ((size_t)chg * 7 * tc + (size_t)(T.off[segn] - T.off[chg * 65]) + row0n) * 64;
        const u16* Wn = en < 64 ? (const u16*)(p.ws + OFF_WD) + (size_t)en * 1024 * 256 : (const u16*)(p.ws + W_SD) + (size_t)layer * 1024 * 256;
        auto arow_n = [&](int r) { int s2 = row0n + r; if (s2 >= cntn) s2 = cntn - 1; return An + (size_t)(s2 - row0n) * 64; };
        const int cntv = T.cnt[seg], row0 = (mt - T.tpre[seg]) * 128; const int n0 = nt * 256;
        const size_t lrow0 = (size_t)(T.off[seg] - T.off[chg * 65]) + row0;
        const u16* A = act + ((size_t)chg * 7 * tc + lrow0) * 64;
        const u16* W = e < 64 ? (const u16*)(p.ws + OFF_WD) + (size_t)e * 1024 * 256 : (const u16*)(p.ws + W_SD) + (size_t)layer * 1024 * 256;
        auto arow = [&](int r) { int s2 = row0 + r; if (s2 >= cntv) s2 = cntv - 1; return A + (size_t)(s2 - row0) * 64; };
        auto xf = [&](int, int, f32x16 (&)[2], int) {};
        auto st = [&](int r, int c8, u32x4 v) { if (row0 + r < cntv) __builtin_nontemporal_store(v, (u32x4*)(outw + (lrow0 + r) * DM + n0 + c8)); };
        gemm_tile<128, 256, false>(R, primed, arow, W + (size_t)n0 * 64, arow_n, hasn ? Wn + (size_t)((un & 3) * 256) * 64 : nullptr, 64, 256, xf, st, lds, (size_t)7 * ntok * 64, (size_t)1024 * 64); primed = hasn;
        ++ui; combine_rounds((int)(((long)crounds * ui) / my_units));
    }
    combine_rounds(crounds);
}

DEVI void phase_rwkv_mix(const Params& p, int i0, int i1, int i2) {
    const u16* nn = (const u16*)(p.ws + R_NN); u16* xm = (u16*)(p.ws + R_XM0);
    const float* mu = p.in[I_RMU]; const int idx[3] = {i0, i1, i2};
    const int lane = tidx() & 63, w = tidx() >> 6;
    for (int r = blockIdx.x * 8 + w; r < T0; r += gridDim.x * 8) {
        const int b = r / LT, pp = r - b * LT;
        const bool hasprev = (pp != 0) && (pp != LC), hasnext = (pp != LC - 1) && (pp != LT - 1);
#pragma unroll
        for (int half = 0; half < 2; ++half) {
            const int c = half * 512 + lane * 8;
            const uint4 cur = *(const uint4*)(nn + (size_t)r * DM + c);
            uint4 sh = make_uint4(0, 0, 0, 0);
            if (half == 0) { if (hasprev) sh = *(const uint4*)(nn + (size_t)(r - 1) * DM + c); }
            else { if (hasnext) sh = *(const uint4*)(nn + (size_t)(r + 1) * DM + c); }
            float nv[8], xx[8];
            nv[0] = bf_lo(cur.x); nv[1] = bf_hi(cur.x); nv[2] = bf_lo(cur.y); nv[3] = bf_hi(cur.y); nv[4] = bf_lo(cur.z); nv[5] = bf_hi(cur.z); nv[6] = bf_lo(cur.w); nv[7] = bf_hi(cur.w);
            xx[0] = bf_lo(sh.x) - nv[0]; xx[1] = bf_hi(sh.x) - nv[1]; xx[2] = bf_lo(sh.y) - nv[2]; xx[3] = bf_hi(sh.y) - nv[3]; xx[4] = bf_lo(sh.z) - nv[4]; xx[5] = bf_hi(sh.z) - nv[5]; xx[6] = bf_lo(sh.w) - nv[6]; xx[7] = bf_hi(sh.w) - nv[7];
#pragma unroll
            for (int j = 0; j < 3; ++j) {
                const float4 m0 = *(const float4*)(mu + idx[j] * 1024 + c), m1 = *(const float4*)(mu + idx[j] * 1024 + c + 4);
                uint4 o; o.x = pack2(nv[0] + xx[0] * m0.x, nv[1] + xx[1] * m0.y); o.y = pack2(nv[2] + xx[2] * m0.z, nv[3] + xx[3] * m0.w);
                o.z = pack2(nv[4] + xx[4] * m1.x, nv[5] + xx[5] * m1.y); o.w = pack2(nv[6] + xx[6] * m1.z, nv[7] + xx[7] * m1.w);
                *(uint4*)(xm + (size_t)j * T0 * DM + (size_t)r * DM + c) = o;
            }
        }
    }
}
DEVI void phase_rwkv_gemm_rkv(const Params& p, char* lds) {
    const int MT = T0 / 256;
    GemmRegs<4, 2> R; bool primed = false;
    for (int uu = blockIdx.x; uu < ((3 * 8 * MT + 255) & ~255); uu += gridDim.x) {
        const int u = swz(uu); if (u >= 3 * 8 * MT) continue;
        const int j = u / (8 * MT), v = u % (8 * MT); const int mt = v >> 3, nt = v & 7; const int m0 = mt * 256, n0 = nt * 128;
        const u16* A = (const u16*)(p.ws + R_XM0) + (size_t)j * T0 * DM; const u16* W = (const u16*)(p.ws + W_RR) + (size_t)j * DM * DM; u16* O = (u16*)(p.ws + R_RR) + (size_t)j * T0 * DM;
        const int un = (uu + (int)gridDim.x < ((3 * 8 * MT + 255) & ~255)) ? swz(uu + gridDim.x) : 3 * 8 * MT; const bool hasn = un < 3 * 8 * MT;
        const int jn = hasn ? un / (8 * MT) : j, vn = hasn ? un % (8 * MT) : v;
        const u16* An = (const u16*)(p.ws + R_XM0) + (size_t)jn * T0 * DM + (size_t)((vn >> 3) * 256) * DM; const u16* Wn = (const u16*)(p.ws + W_RR) + (size_t)jn * DM * DM + (size_t)((vn & 7) * 128) * DM;
        auto arow = [&](int r) { return A + (size_t)(m0 + r) * DM; };
        auto arow_n = [&](int r) { return An + (size_t)r * DM; };
        auto xf = [&](int, int, f32x16 (&)[2], int) {};
        auto st = [&](int r, int c8, u32x4 v) { *(u32x4*)(O + (size_t)(m0 + r) * DM + n0 + c8) = v; };
        gemm_tile<256, 128, false>(R, primed, arow, W + (size_t)n0 * DM, arow_n, hasn ? Wn : nullptr, DM, DM, xf, st, lds); primed = hasn;
    }
}
DEVI void phase_rwkv_gemm_small(const Params& p, char* lds) {
    const int MT = T0 / 256;
    for (int u = blockIdx.x; u < 3 * MT; u += gridDim.x) {
        const int j = u / MT, mt = u % MT; const int m0 = mt * 256;
        const u16* A = (const u16*)(p.ws + R_XM0) + (size_t)j * T0 * DM;
        const u16* W = (const u16*)(p.ws + (j == 0 ? W_W1 : j == 1 ? W_A1 : W_G1)); u16* O = (u16*)(p.ws + (j == 0 ? R_HW : j == 1 ? R_HA : R_HG));
        auto arow = [&](int r) { return A + (size_t)(m0 + r) * DM; };
        auto xf = [&](int, int, f32x16 (&t)[2], int) {
#pragma unroll
            for (int ni = 0; ni < 2; ++ni)
#pragma unroll
                for (int i = 0; i < 16; ++i) { const float x = t[ni][i]; t[ni][i] = j == 0 ? tanhf_(x) : j == 1 ? x : sigmoidf_(x); }
        };
        auto st = [&](int r, int c8, u32x4 v) { *(u32x4*)(O + (size_t)(m0 + r) * 128 + c8) = v; };
        GemmRegs<4, 2> R; gemm_tile<256, 128, false>(R, false, arow, W, arow, (const u16*)nullptr, DM, DM, xf, st, lds);
    }
}
DEVI void phase_rwkv_gemm_g(const Params& p, char* lds) {
    const int MT = T0 / 256; const u16* A = (const u16*)(p.ws + R_HG); const u16* W = (const u16*)(p.ws + W_G2); u16* O = (u16*)(p.ws + R_GG);
    for (int uu = blockIdx.x; uu < ((8 * MT + 255) & ~255); uu += gridDim.x) {
        const int u = swz(uu); if (u >= 8 * MT) continue;
        const int mt = u >> 3, nt = u & 7; const int m0 = mt * 256, n0 = nt * 128;
        auto arow = [&](int r) { return A + (size_t)(m0 + r) * 128; };
        auto xf = [&](int, int, f32x16 (&)[2], int) {};
        auto st = [&](int r, int c8, u32x4 v) { *(u32x4*)(O + (size_t)(m0 + r) * DM + n0 + c8) = v; };
        GemmRegs<4, 2> R; gemm_tile<256, 128, false>(R, false, arow, W + (size_t)n0 * 128, arow, (const u16*)nullptr, 128, 128, xf, st, lds);
    }
}
DEVI float red16_sum(float x) { x += dppf(x, 0); x += dppf(x, 1); x += dppf(x, 2); int xi = __builtin_bit_cast(int, x); x += __builtin_bit_cast(float, __builtin_amdgcn_mov_dpp(xi, 0x140, 0xF, 0xF, true)); return x; }
DEVI bf16x8 frag_perm(const u16* rowp, int ks, int h) {
    const uint2 lo = *(const uint2*)(rowp + 16 * ks + 4 * h), hi = *(const uint2*)(rowp + 16 * ks + 8 + 4 * h);
    u32x4 v = {lo.x, lo.y, hi.x, hi.y}; return __builtin_bit_cast(bf16x8, v);
}
DEVI bf16x8 tr_frag(const u16* base, int stride, int lane) {
    const u16* q = base + (4 * (lane >> 5) + ((lane & 15) >> 2)) * stride + 16 * ((lane >> 4) & 1) + 4 * (lane & 3);
    const s16x4 lo = __builtin_amdgcn_ds_read_tr16_b64_v4i16((LAS s16x4*)q), hi = __builtin_amdgcn_ds_read_tr16_b64_v4i16((LAS s16x4*)(q + 8 * stride));
    bf16x8 v; v[0] = lo[0]; v[1] = lo[1]; v[2] = lo[2]; v[3] = lo[3]; v[4] = hi[0]; v[5] = hi[1]; v[6] = hi[2]; v[7] = hi[3]; return v;
}
DEVI bf16x8 frag_plain(const u16* rowp, int ks, int h) { return *(const bf16x8*)(rowp + 16 * ks + 8 * h); }
DEVI bf16x8 acc_to_b(const f32x16& t, int s) {
    u32x4 v = {pack2(t[8 * s], t[8 * s + 1]), pack2(t[8 * s + 2], t[8 * s + 3]), pack2(t[8 * s + 4], t[8 * s + 5]), pack2(t[8 * s + 6], t[8 * s + 7])};
    return __builtin_bit_cast(bf16x8, v);
}
#define MFMA(a, b, c) __builtin_amdgcn_mfma_f32_32x32x16_bf16(a, b, c, 0, 0, 0)
DEVI void phase_rwkv_scan(const Params& p, char* lds) {
    float* AAb = (float*)lds;
    float* CPb0 = (float*)(lds + 16384); float* CPb1 = (float*)(lds + 106496);
    u16* At = (u16*)(lds + 24576); u16* Bt = At + 2304; u16* Kt = Bt + 2304; u16* Rt = Kt + 2304;
    u16* Vr = (u16*)(lds + 43008); u16* Khr = Vr + 3072; u16* Bhr = Khr + 3072;
    float* Lf = (float*)(lds + 61440);
    u16* Lo = (u16*)(lds + 66048); u16* Lak = Lo + 1280; u16* Mrb = Lak + 1280; u16* Mrk = Mrb + 1280; u16* Td = Mrk + 1280;
    float* PC = (float*)(lds + 78848); u16* YS = (u16*)(lds + 79104);
    const u16* r_g = (const u16*)(p.ws + R_RR); const u16* k_g = (const u16*)(p.ws + R_RK); const u16* v_g = (const u16*)(p.ws + R_RV);
    const u16* hw = (const u16*)(p.ws + R_HW); const u16* ha = (const u16*)(p.ws + R_HA);
    const int tid = tidx(), lane = tid & 63, w = tid >> 6, l31 = lane & 31, hh = lane >> 5;
    for (int u = blockIdx.x; u < 256; u += gridDim.x) {
        const int dir = u & 1, hd = (u >> 1) & 15, b = u >> 5;
        u16* y_g = (u16*)(p.ws + (dir ? R_YB : R_YF)); float* rkb = (float*)(p.ws + R_RKB) + (size_t)dir * T0 * 16;
        const int wq = (w - 2) & 3; const int mat = (wq >> 1) & 1, ctt = wq & 1;
        u16* W2L = (u16*)(lds + 86016);
        float* KC = (float*)(lds + 86016 + 18432);
        for (int i = tid; i < 2 * 64 * 8; i += 512) { const int m = i >> 9, c = (i >> 3) & 63, ch = i & 7;
            *(u32x4*)(W2L + (m * 64 + c) * 72 + ch * 8) = *(const u32x4*)((const u16*)(p.ws + (m ? W_A2 : W_W2)) + (size_t)dir * 1024 * 64 + (size_t)(hd * 64 + c) * 64 + ch * 8); }
        if (tid < 64) { KC[tid] = p.in[I_RKK][hd * 64 + tid]; KC[64 + tid] = p.in[I_RKA][hd * 64 + tid]; KC[128 + tid] = p.in[I_RRK][hd * 64 + tid]; }
        const u16* w2l = W2L + (mat * 64 + ctt * 32 + l31) * 72;
        const float* bias0 = (mat ? p.in[I_RA0] : p.in[I_RW0]) + dir * 1024 + hd * 64 + ctt * 32;
        const u16* hsrc = mat ? ha : hw;
        const int t2 = tid >> 4, c4 = (tid & 15) * 4; const int cg = hd * 64 + c4;
        for (int i = tid; i < 1280; i += 512) Td[i] = 0;
        f32x16 Z[2];
#pragma unroll
        for (int a = 0; a < 2; ++a)
#pragma unroll
            for (int i = 0; i < 16; ++i) Z[a][i] = 0.f;
        __syncthreads();
        const size_t rowb = (size_t)b * LT;
        auto chunk_p0 = [&](int ci) { int pc; if (ci < 8) { pc = dir ? 7 - ci : ci; return 32 * pc; } pc = dir ? 135 - ci : ci - 8; return LC + 32 * pc; };
        bf16x8 hfr[4]; uint2 ru, ku, vu;
        {
            const int p0 = chunk_p0(0);
            const int pos = dir ? p0 + 31 - l31 : p0 + l31; const u16* hp = hsrc + (rowb + pos) * 128 + dir * 64;
#pragma unroll
            for (int ks = 0; ks < 4; ++ks) hfr[ks] = *(const bf16x8*)(hp + ks * 16 + hh * 8);
            const int pos2 = dir ? p0 + 31 - t2 : p0 + t2; const size_t go = (rowb + pos2) * DM + cg;
            ru = *(const uint2*)(r_g + go); ku = *(const uint2*)(k_g + go); vu = *(const uint2*)(v_g + go);
        }
        auto stage0 = [&](int pnn, int buf) {
            {
                f32x16 acc;
#pragma unroll
                for (int i = 0; i < 16; ++i) acc[i] = 0.f;
#pragma unroll
                for (int ks = 0; ks < 4; ++ks) acc = MFMA(hfr[ks], frag_plain(w2l, ks, hh), acc);
                {
                    const int pos = dir ? pnn + 31 - l31 : pnn + l31; const u16* hp = hsrc + (rowb + pos) * 128 + dir * 64;
#pragma unroll
                    for (int ks = 0; ks < 4; ++ks) hfr[ks] = *(const bf16x8*)(hp + ks * 16 + hh * 8);
                }
                const float bv = bias0[l31];
                float* dstm = (mat ? AAb + buf * 2048 : (buf ? CPb1 : CPb0)) + ctt * 32 + l31;
                if (mat) {
#pragma unroll
                    for (int i = 0; i < 16; ++i) dstm[((i & 3) + 8 * (i >> 2) + 4 * hh) * 64] = sigmoidf_(acc[i] + bv);
                } else {
                    f32x16 lo, cp;
#pragma unroll
                    for (int i = 0; i < 16; ++i) { const float lw = -0.6065306597126334f * sigmoidf_(acc[i] + bv); const float hi = bf1((u16)(pack2(lw, 0.f))); acc[i] = hi; lo[i] = lw - hi; cp[i] = 0.f; }
#pragma unroll
                    for (int ks = 0; ks < 2; ++ks) {
                        u32x4 tv;
#pragma unroll
                        for (int q = 0; q < 4; ++q) { const int ta = 16 * ks + 8 * (q >> 1) + 4 * hh + 2 * (q & 1); tv[q] = ((ta <= l31) ? 0x3F80u : 0u) | ((ta + 1 <= l31) ? 0x3F800000u : 0u); }
                        const bf16x8 tri = __builtin_bit_cast(bf16x8, tv);
                        cp = MFMA(tri, acc_to_b(acc, ks), cp); cp = MFMA(tri, acc_to_b(lo, ks), cp);
                    }
#pragma unroll
                    for (int i = 0; i < 16; ++i) dstm[((i & 3) + 8 * (i >> 2) + 4 * hh) * 64] = cp[i];
                }
            }
        };
        if (w >= 2 && w < 6) stage0(chunk_p0(1), 0);
        lds_barrier();
        for (int ci = 0; ci < 136; ++ci) {
            const int p0 = chunk_p0(ci); const int p0n = chunk_p0(ci < 135 ? ci + 1 : ci);
            const float* AA = AAb + (ci & 1) * 2048; const float* CP = (ci & 1) ? CPb1 : CPb0;
            const int pos2 = dir ? p0 + 31 - t2 : p0 + t2;
            {
                const float rv[4] = {bf_lo(ru.x), bf_hi(ru.x), bf_lo(ru.y), bf_hi(ru.y)}, kv[4] = {bf_lo(ku.x), bf_hi(ku.x), bf_lo(ku.y), bf_hi(ku.y)};
                const float4 a4 = *(const float4*)(AA + t2 * 64 + c4), cp4 = *(const float4*)(CP + t2 * 64 + c4), ce4 = *(const float4*)(CP + 31 * 64 + c4);
                float4 cq4 = make_float4(0.f, 0.f, 0.f, 0.f); if (t2 > 0) cq4 = *(const float4*)(CP + (t2 - 1) * 64 + c4);
                const float av[4] = {a4.x, a4.y, a4.z, a4.w}, cpv[4] = {cp4.x, cp4.y, cp4.z, cp4.w}, cev[4] = {ce4.x, ce4.y, ce4.z, ce4.w}, cqv[4] = {cq4.x, cq4.y, cq4.z, cq4.w};
                const float4 kkc = *(const float4*)(KC + c4), kac = *(const float4*)(KC + 64 + c4), rkc = *(const float4*)(KC + 128 + c4);
                const float kkcv[4] = {kkc.x, kkc.y, kkc.z, kkc.w}, kacv[4] = {kac.x, kac.y, kac.z, kac.w}, rkcv[4] = {rkc.x, rkc.y, rkc.z, rkc.w};
                float kk[4], km[4], ssq = 0.f, rks = 0.f;
#pragma unroll
                for (int i = 0; i < 4; ++i) { kk[i] = kv[i] * kkcv[i]; ssq += kk[i] * kk[i]; km[i] = kv[i] * (1.f + (av[i] - 1.f) * kacv[i]); rks += rv[i] * km[i] * rkcv[i]; }
                ssq = red16_sum(ssq); rks = red16_sum(rks);
                const float inv = 1.f / fmaxf(sqrtf(ssq), 1e-12f);
                float at[4], bt[4], kt[4], rt[4], bh[4], kh[4];
#pragma unroll
                for (int i = 0; i < 4; ++i) {
                    const float kn = kk[i] * inv, bb = kn * av[i];
                    const float en = __expf(-cpv[i]), eh = __expf(cev[i] - cpv[i]);
                    at[i] = -kn * __expf(cqv[i]); bt[i] = bb * en; kt[i] = km[i] * en; rt[i] = rv[i] * __expf(cpv[i]); bh[i] = bb * eh; kh[i] = km[i] * eh;
                }
                uint2 o;
                o.x = pack2(at[0], at[1]); o.y = pack2(at[2], at[3]); *(uint2*)(At + t2 * 72 + c4) = o;
                o.x = pack2(bt[0], bt[1]); o.y = pack2(bt[2], bt[3]); *(uint2*)(Bt + t2 * 72 + c4) = o;
                o.x = pack2(kt[0], kt[1]); o.y = pack2(kt[2], kt[3]); *(uint2*)(Kt + t2 * 72 + c4) = o;
                o.x = pack2(rt[0], rt[1]); o.y = pack2(rt[2], rt[3]); *(uint2*)(Rt + t2 * 72 + c4) = o;
                o.x = pack2(kh[0], kh[1]); o.y = pack2(kh[2], kh[3]); *(uint2*)(Khr + t2 * 96 + c4) = o;
                o.x = pack2(bh[0], bh[1]); o.y = pack2(bh[2], bh[3]); *(uint2*)(Bhr + t2 * 96 + c4) = o;
                *(uint2*)(Vr + t2 * 96 + c4) = vu;
                if (t2 == 0) *(float4*)(PC + c4) = make_float4(__expf(cev[0]), __expf(cev[1]), __expf(cev[2]), __expf(cev[3]));
                if ((tid & 15) == 0) rkb[(rowb + pos2) * 16 + hd] = rks;
                const int pos2n = dir ? p0n + 31 - t2 : p0n + t2; const size_t gon = (rowb + pos2n) * DM + cg;
                ru = *(const uint2*)(r_g + gon); ku = *(const uint2*)(k_g + gon); vu = *(const uint2*)(v_g + gon);
            }
            lds_barrier();
            if (w < 4) {
                const u16* X1 = (w < 2) ? At : Rt; const u16* X2 = (w & 1) ? Kt : Bt;
                f32x16 acc;
#pragma unroll
                for (int i = 0; i < 16; ++i) acc[i] = 0.f;
#pragma unroll
                for (int ks = 0; ks < 4; ++ks) acc = MFMA(frag_plain(X2 + l31 * 72, ks, hh), frag_plain(X1 + l31 * 72, ks, hh), acc);
#pragma unroll
                for (int i = 0; i < 16; ++i) { const int s = (i & 3) + 8 * (i >> 2) + 4 * hh; const bool keep = (w < 2) ? (s < l31) : (s <= l31); if (!keep) acc[i] = 0.f; }
                if (w == 0) {
#pragma unroll
                    for (int g = 0; g < 4; ++g) {
                        *(float4*)(Lf + l31 * 36 + 8 * g + 4 * hh) = make_float4(acc[4 * g], acc[4 * g + 1], acc[4 * g + 2], acc[4 * g + 3]);
                        const bool lo = (l31 >= 16) && (8 * g + 4 * hh < 16);
                        uint2 o; o.x = lo ? pack2(acc[4 * g], acc[4 * g + 1]) : 0u; o.y = lo ? pack2(acc[4 * g + 2], acc[4 * g + 3]) : 0u; *(uint2*)(Lo + l31 * 40 + 8 * g + 4 * hh) = o;
                    }
                } else {
                    u16* dst = (w == 1) ? Lak : (w == 2) ? Mrb : Mrk;
#pragma unroll
                    for (int g = 0; g < 4; ++g) { uint2 o; o.x = pack2(acc[4 * g], acc[4 * g + 1]); o.y = pack2(acc[4 * g + 2], acc[4 * g + 3]); *(uint2*)(dst + l31 * 40 + 8 * g + 4 * hh) = o; }
                }
            }
            lds_barrier();
            f32x16 XZ, Ya; bf16x8 zf[4];
            if (w >= 6) {
                const int blk = w - 6, j = lane & 15; const float* Lb = Lf + (16 * blk) * 36 + 16 * blk;
                const float4 l4 = *(const float4*)(Lb + (lane >> 2) * 36 + 4 * (lane & 3));
                const int li[4] = {__builtin_bit_cast(int, l4.x), __builtin_bit_cast(int, l4.y), __builtin_bit_cast(int, l4.z), __builtin_bit_cast(int, l4.w)};
                float x[16];
#pragma unroll
                for (int t = 0; t < 16; ++t) {
                    float a0 = (j == t) ? 1.f : 0.f, a1 = 0.f;
#pragma unroll
                    for (int s2 = 0; s2 < t; ++s2) {
                        const float lv = __builtin_bit_cast(float, __builtin_amdgcn_readlane(li[s2 & 3], 4 * t + (s2 >> 2)));
                        if (s2 & 1) a1 += lv * x[s2]; else a0 += lv * x[s2];
                    }
                    x[t] = a0 + a1;
                }
                if (lane < 16) {
#pragma unroll
                    for (int t = 0; t < 16; ++t) Td[(16 * blk + t) * 40 + 16 * blk + j] = (u16)(pack2(x[t], 0.f));
                }
            } else if (w >= 2) {
                if (ci + 1 < 136) stage0(chunk_p0(ci + 2 < 136 ? ci + 2 : 135), (ci + 1) & 1);
            } else {
#pragma unroll
                for (int s = 0; s < 4; ++s) zf[s] = acc_to_b(Z[s >> 1], s & 1);
#pragma unroll
                for (int i = 0; i < 16; ++i) { XZ[i] = 0.f; Ya[i] = 0.f; }
#pragma unroll
                for (int s = 0; s < 4; ++s) { XZ = MFMA(frag_perm(At + l31 * 72, s, hh), zf[s], XZ); Ya = MFMA(frag_perm(Rt + l31 * 72, s, hh), zf[s], Ya); }
                bf16x8 vf[2];
#pragma unroll
                for (int ks = 0; ks < 2; ++ks) {
                    vf[ks] = tr_frag(Vr + (16 * ks) * 96 + 32 * w, 96, lane);
                    XZ = MFMA(frag_perm(Lak + l31 * 40, ks, hh), vf[ks], XZ); Ya = MFMA(frag_perm(Mrk + l31 * 40, ks, hh), vf[ks], Ya);
                }
#pragma unroll
                for (int kt = 0; kt < 2; ++kt) {
#pragma unroll
                    for (int g = 0; g < 4; ++g) { const float4 pc4 = *(const float4*)(PC + 32 * kt + 8 * g + 4 * hh);
                        Z[kt][4 * g] *= pc4.x; Z[kt][4 * g + 1] *= pc4.y; Z[kt][4 * g + 2] *= pc4.z; Z[kt][4 * g + 3] *= pc4.w; }
#pragma unroll
                    for (int ks = 0; ks < 2; ++ks) Z[kt] = MFMA(tr_frag(Khr + (16 * ks) * 96 + 32 * kt, 96, lane), vf[ks], Z[kt]);
                }
            }
            lds_barrier();
            if (w < 2) {
                f32x16 U1 = {}, W = {};
#pragma unroll
                for (int i = 0; i < 16; ++i) { U1[i] = 0.f; W[i] = 0.f; }
#pragma unroll
                for (int ks = 0; ks < 2; ++ks) U1 = MFMA(frag_perm(Td + l31 * 40, ks, hh), acc_to_b(XZ, ks), U1);
#pragma unroll
                for (int ks = 0; ks < 2; ++ks) W = MFMA(frag_perm(Lo + l31 * 40, ks, hh), acc_to_b(U1, ks), W);
#pragma unroll
                for (int ks = 0; ks < 2; ++ks) U1 = MFMA(frag_perm(Td + l31 * 40, ks, hh), acc_to_b(W, ks), U1);
                const bf16x8 uf0 = acc_to_b(U1, 0), uf1 = acc_to_b(U1, 1);
                Ya = MFMA(frag_perm(Mrb + l31 * 40, 0, hh), uf0, Ya); Ya = MFMA(frag_perm(Mrb + l31 * 40, 1, hh), uf1, Ya);
#pragma unroll
                for (int kt = 0; kt < 2; ++kt) { Z[kt] = MFMA(tr_frag(Bhr + 32 * kt, 96, lane), uf0, Z[kt]); Z[kt] = MFMA(tr_frag(Bhr + 16 * 96 + 32 * kt, 96, lane), uf1, Z[kt]); }
#pragma unroll
                for (int i = 0; i < 16; ++i) { const int t = (i & 3) + 8 * (i >> 2) + 4 * hh; YS[t * 72 + 32 * w + l31] = (u16)pack2(Ya[i], 0.f); }
            }
            lds_barrier();
            if (ci >= 8) { const uint2 yv = *(const uint2*)(YS + t2 * 72 + c4); *(uint2*)(y_g + (rowb + pos2) * DM + cg) = yv; }
        }
        __syncthreads();
    }
}
DEVI void phase_rwkv_readout(const Params& p) {
    const u16* yf = (const u16*)(p.ws + R_YF); const u16* yb = (const u16*)(p.ws + R_YB); const u16* vg = (const u16*)(p.ws + R_RV); const u16* gg = (const u16*)(p.ws + R_GG);
    const float* rkb = (const float*)(p.ws + R_RKB); u16* rd = (u16*)(p.ws + R_RD);
    const float* lnw = p.in[I_RLNW]; const float* lnb = p.in[I_RLNB];
    const int lane = tidx() & 63, w = tidx() >> 6;
    for (int t = blockIdx.x * 8 + w; t < TL; t += gridDim.x * 8) {
        const int b = t >> 12, s = t & 4095; const size_t row = (size_t)b * LT + LC + s; const int c = lane * 16; const int hd = lane >> 2;
        float y[16], vv[16], gv[16];
#pragma unroll
        for (int q = 0; q < 2; ++q) {
            const uint4 a = *(const uint4*)(yf + row * DM + c + 8 * q), bq = *(const uint4*)(yb + row * DM + c + 8 * q), v4 = *(const uint4*)(vg + row * DM + c + 8 * q), g4 = *(const uint4*)(gg + row * DM + c + 8 * q);
            y[8 * q + 0] = bf_lo(a.x) + bf_lo(bq.x); y[8 * q + 1] = bf_hi(a.x) + bf_hi(bq.x); y[8 * q + 2] = bf_lo(a.y) + bf_lo(bq.y); y[8 * q + 3] = bf_hi(a.y) + bf_hi(bq.y);
            y[8 * q + 4] = bf_lo(a.z) + bf_lo(bq.z); y[8 * q + 5] = bf_hi(a.z) + bf_hi(bq.z); y[8 * q + 6] = bf_lo(a.w) + bf_lo(bq.w); y[8 * q + 7] = bf_hi(a.w) + bf_hi(bq.w);
            vv[8 * q + 0] = bf_lo(v4.x); vv[8 * q + 1] = bf_hi(v4.x); vv[8 * q + 2] = bf_lo(v4.y); vv[8 * q + 3] = bf_hi(v4.y); vv[8 * q + 4] = bf_lo(v4.z); vv[8 * q + 5] = bf_hi(v4.z); vv[8 * q + 6] = bf_lo(v4.w); vv[8 * q + 7] = bf_hi(v4.w);
            gv[8 * q + 0] = bf_lo(g4.x); gv[8 * q + 1] = bf_hi(g4.x); gv[8 * q + 2] = bf_lo(g4.y); gv[8 * q + 3] = bf_hi(g4.y); gv[8 * q + 4] = bf_lo(g4.z); gv[8 * q + 5] = bf_hi(g4.z); gv[8 * q + 6] = bf_lo(g4.w); gv[8 * q + 7] = bf_hi(g4.w);
        }
        float sm = 0.f;
#pragma unroll
        for (int i = 0; i < 16; ++i) sm += y[i];
        sm = red4_sum(sm); const float mean = sm * (1.f / 64.f);
        float vs = 0.f;
#pragma unroll
        for (int i = 0; i < 16; ++i) { const float d = y[i] - mean; vs += d * d; }
        vs = red4_sum(vs); const float rstd = rsqrtf(vs * (1.f / 64.f) + 64e-5f);
        const float bon = rkb[row * 16 + hd] + rkb[(size_t)T0 * 16 + row * 16 + hd];
        unsigned ow[8];
#pragma unroll
        for (int i = 0; i < 8; ++i) {
            const int c0 = c + 2 * i;
            const float o0 = ((y[2 * i] - mean) * rstd * lnw[c0] + lnb[c0] + bon * vv[2 * i]) * gv[2 * i];
            const float o1 = ((y[2 * i + 1] - mean) * rstd * lnw[c0 + 1] + lnb[c0 + 1] + bon * vv[2 * i + 1]) * gv[2 * i + 1];
            ow[i] = pack2(o0, o1);
        }
        *(uint4*)(rd + (size_t)t * DM + c) = make_uint4(ow[0], ow[1], ow[2], ow[3]); *(uint4*)(rd + (size_t)t * DM + c + 8) = make_uint4(ow[4], ow[5], ow[6], ow[7]);
    }
}
DEVI void phase_final_norm(const Params& p) {
    const float* g = p.in[I_NFIN]; float* X = p.out;
    const int lane = tidx() & 63, w = tidx() >> 6;
    for (int r = blockIdx.x * 8 + w; r < TL; r += gridDim.x * 8) {
        float4* xr = (float4*)(X + (size_t)r * DM); float4 v[4]; float ss = 0.f;
#pragma unroll
        for (int i = 0; i < 4; ++i) { v[i] = xr[lane + 64 * i]; ss += v[i].x * v[i].x + v[i].y * v[i].y + v[i].z * v[i].z + v[i].w * v[i].w; }
        ss = wave_sum(ss); const float rs = rsqrtf(ss * (1.f / 1024.f) + 1e-6f);
#pragma unroll
        for (int i = 0; i < 4; ++i) { const float4 gg = ((const float4*)g)[lane + 64 * i]; float4 o; o.x = v[i].x * rs * gg.x; o.y = v[i].y * rs * gg.y; o.z = v[i].z * rs * gg.z; o.w = v[i].w * rs * gg.w; xr[lane + 64 * i] = o; }
    }
}

constexpr int N_PHASES = 30;
template <int PH> DEVI void run_phase(const Params& p, char* lds) {
    const float* mods = (const float*)(p.ws + OFF_MODS);
    RowSrc in_src; in_src.ctx = p.in[I_CTX]; in_src.lat = p.in[I_X];
    RowSrc x_src; x_src.ctx = (const float*)(p.ws + OFF_XC); x_src.lat = p.out;
    if constexpr (PH == 0) phase_prologue(p, lds);
    else if constexpr (PH == 1) norm_rows(in_src, 0, T0, p.in[I_NMIX], mods, 0, 1, (u16*)(p.ws + A_N0));
    else if constexpr (PH == 2) phase_gemm_win(p, lds);
    else if constexpr (PH == 3) phase_gemm_qkv(p, lds);
    else if constexpr (PH == 4) { phase_attention(p, lds); conv_jobs(p, 25, 28, 0, 0, lds); }
    else if constexpr (PH == 5) phase_gemm_wo(p, (const u16*)(p.ws + A_N0), (const u16*)(p.ws + W_OA), in_src, 0, 0, lds);
    else if constexpr (PH == 6) phase_moe_norm(p, 0);
    else if constexpr (PH == 7) phase_moe_route(p, 0, lds);
    else if constexpr (PH == 8) phase_moe_gemm1(p, 0, lds);
    else if constexpr (PH >= 9 && PH <= 13) phase_moe_g2c(p, 0, PH - 9 < NCHUNK ? PH - 9 : -1, PH - 10, lds);
    else if constexpr (PH == 14) norm_rows(x_src, 0, T0, p.in[I_NMIX] + 1024, mods + 9 * 6144, 0, 1, (u16*)(p.ws + R_NN));
    else if constexpr (PH == 15) phase_rwkv_mix(p, 0, 2, 3);
    else if constexpr (PH == 16) phase_rwkv_gemm_rkv(p, lds);
    else if constexpr (PH == 17) phase_rwkv_mix(p, 1, 4, 5);
    else if constexpr (PH == 18) phase_rwkv_gemm_small(p, lds);
    else if constexpr (PH == 19) { phase_rwkv_gemm_g(p, lds); phase_rwkv_scan(p, lds); }
    else if constexpr (PH == 20) phase_rwkv_readout(p);
    else if constexpr (PH == 21) { phase_gemm_wo(p, (const u16*)(p.ws + R_RD), (const u16*)(p.ws + W_RO), x_src, 1, 1, lds); conv_jobs(p, 25, 28, 1, 0, lds); }
    else if constexpr (PH == 22) phase_moe_norm(p, 1);
    else if constexpr (PH == 23) phase_moe_route(p, 1, lds);
    else if constexpr (PH == 24) phase_moe_gemm1(p, 1, lds);
    else if constexpr (PH >= 25 && PH <= 29) phase_moe_g2c(p, 1, PH - 25 < NCHUNK ? PH - 25 : -1, PH - 26, lds);
}

#if MEGA
template <int PH, int END> DEVI void run_range(const Params& p_, char* lds, const XcdBarrier& bar) {
    const Params& p = *(const Params*)__builtin_amdgcn_kernarg_segment_ptr();
    run_phase<PH>(p, lds);
    if constexpr (PH + 1 < END) { xcd_barrier(bar); run_range<PH + 1, END>(p_, lds, bar); }
}
template <int A, int B> __global__ void __launch_bounds__(512, 2) k_range(Params p, unsigned* barw) {
    extern __shared__ __attribute__((aligned(16))) char smem[];
    if (threadIdx.x == 0) *(uint4*)smem = make_uint4(0u, 0u, 0u, 0u);
    __syncthreads();
    const XcdBarrier bar = xcd_barrier_post(barw, (volatile LAS unsigned*)smem);
    run_range<A, B>(p, smem + 64, bar);
}
template <int A, int B> static void launch_range(const Params& p, unsigned* barw, hipStream_t s) {
    static int grid = 0;
    if (!grid) {
        int dev = 0, cus = 0, per_cu = 0;
        (void)hipGetDevice(&dev);
        (void)hipDeviceGetAttribute(&cus, hipDeviceAttributeMultiprocessorCount, dev);
        (void)hipFuncSetAttribute((const void*)k_range<A, B>, hipFuncAttributeMaxDynamicSharedMemorySize, LDS_BYTES);
        (void)hipOccupancyMaxActiveBlocksPerMultiprocessor(&per_cu, (const void*)k_range<A, B>, 512, LDS_BYTES);
        if (per_cu < 1) fprintf(stderr, "occupancy query says 0 blocks per CU\n");
        grid = cus;
    }
    k_range<A, B><<<grid, 512, LDS_BYTES, s>>>(p, barw);
}
extern "C" void kernel_launch(void* const* d_in, const int* in_sizes, int n_in, void* d_out, int out_size, void* d_ws, size_t ws_size, hipStream_t stream) {
    Params p{};
    for (int i = 0; i < N_IN; ++i) p.in[i] = (const float*)d_in[i];
    p.out = (float*)d_out; p.ws = (char*)d_ws;
    if (ws_size < WS_NEED) { fprintf(stderr, "workspace too small\n"); return; }
    (void)hipMemsetAsync(p.ws + OFF_BAR, 0, XCD_BAR_WORDS * sizeof(unsigned), stream);
    launch_range<0, N_PHASES>(p, (unsigned*)(p.ws + OFF_BAR), stream);
}
#else
template <int PH> __global__ void __launch_bounds__(512, 2) k_phase(Params p) {
    extern __shared__ __attribute__((aligned(16))) char smem[];
    run_phase<PH>(p, smem + 64);
}
template <int PH> static void launch_phase(const Params& p, hipStream_t s) {
    static bool attr = false;
    if (!attr) { hipFuncSetAttribute((const void*)k_phase<PH>, hipFuncAttributeMaxDynamicSharedMemorySize, LDS_BYTES); attr = true; }
    k_phase<PH><<<256, 512, LDS_BYTES, s>>>(p);
}
template <int PH> static void launch_all(const Params& p, hipStream_t s) {
    launch_phase<PH>(p, s);
    if constexpr (PH + 1 < N_PHASES) launch_all<PH + 1>(p, s);
}

extern "C" void kernel_launch(void* const* d_in, const int* in_sizes, int n_in, void* d_out, int out_size, void* d_ws, size_t ws_size, hipStream_t stream) {
    Params p{};
    for (int i = 0; i < N_IN; ++i) p.in[i] = (const float*)d_in[i];
    p.out = (float*)d_out; p.ws = (char*)d_ws;
    if (ws_size < WS_NEED) { fprintf(stderr, "workspace too small: %zu < %zu\n", ws_size, (size_t)WS_NEED); return; }
    launch_all<0>(p, stream);
}
#endif
```
